# Optimizing an MI355X kernel written in HIP

```python
import math
import jax, jax.numpy as jnp
from jax import lax
import numpy as np

D_MODEL = 2048
BATCH = 8
SEQ = 2048
DEPTH = 2

HEAD_DIM = 64
H_FOX = 8
H_SB = 8
H_DSA = 8
W_FOX = H_FOX * HEAD_DIM
W_SB = H_SB * HEAD_DIM
W_DSA = H_DSA * HEAD_DIM
KV_RANK = 256
IDX_HEADS = 4
IDX_DIM = 64
TOPK_MAX = 256
N_BUCKETS = 32
MAX_DISTANCE = 128
Q_BLOCK = 128
D_FF = 7168
N_EXPERTS = 8
TOP_K_EXPERTS = 2
N_BRANCH = 3
EPS = 1e-6
N_DENSE = (DEPTH + 1) // 2
N_MOE = DEPTH // 2
SPLITS = (W_FOX, W_FOX, W_FOX, H_FOX, W_FOX,
          W_SB, W_SB, W_SB,
          W_DSA, KV_RANK, IDX_HEADS * IDX_DIM, IDX_DIM, IDX_HEADS,
          N_BRANCH * D_MODEL)
N_IN = sum(SPLITS)

kernel_name = "hybrid_fox_stickbreak_dsa_moe"


def rms_norm(x, g):
    xf = x.astype(jnp.float32)
    y = xf * lax.rsqrt(jnp.mean(xf * xf, axis=-1, keepdims=True) + EPS)
    return (y * g.astype(jnp.float32)).astype(x.dtype)


def t5_bucket(n):
    max_exact = N_BUCKETS // 2
    nf = jnp.maximum(n, 1).astype(jnp.float32)
    large = max_exact + (jnp.log(nf / max_exact) / math.log(MAX_DISTANCE / max_exact)
                         * (N_BUCKETS - max_exact)).astype(jnp.int32)
    large = jnp.minimum(large, N_BUCKETS - 1)
    return jnp.where(n < max_exact, n, large)


def to_blocks(a):
    b, s = a.shape[:2]
    a = a.reshape(b, s // Q_BLOCK, Q_BLOCK, *a.shape[2:])
    return jnp.moveaxis(a, 1, 0)


def from_blocks(o):
    o = jnp.moveaxis(o, 0, 1)
    return o.reshape(o.shape[0], -1, *o.shape[3:])


def block_starts(s):
    return jnp.arange(s // Q_BLOCK, dtype=jnp.int32) * Q_BLOCK


def forgetting_attention(q, k, v, log_f):
    s_len = q.shape[1]
    scale = HEAD_DIM ** -0.5
    c = jnp.cumsum(log_f, axis=1)
    c_k = jnp.transpose(c, (0, 2, 1))
    k_pos = jnp.arange(s_len)

    def block(args):
        qb, cb, start = args
        q_pos = start + jnp.arange(Q_BLOCK)
        logit = jnp.einsum('bqhd,bshd->bhqs', qb, k, preferred_element_type=jnp.float32) * scale
        logit = logit + jnp.transpose(cb, (0, 2, 1))[..., None] - c_k[:, :, None, :]
        logit = jnp.where(k_pos[None, :] <= q_pos[:, None], logit, -jnp.inf)
        p = jax.nn.softmax(logit, axis=-1)
        return jnp.einsum('bhqs,bshd->bqhd', p.astype(v.dtype), v)

    out = lax.map(block, (to_blocks(q), to_blocks(c), block_starts(s_len)))
    return from_blocks(out)


def stick_breaking_attention(q, k, v):
    s_len = q.shape[1]
    scale = HEAD_DIM ** -0.5
    k_pos = jnp.arange(s_len)

    def block(args):
        qb, start = args
        q_pos = start + jnp.arange(Q_BLOCK)
        z = jnp.einsum('bqhd,bshd->bhqs', qb, k, preferred_element_type=jnp.float32) * scale
        strict = k_pos[None, :] < q_pos[:, None]
        log_1m = jnp.where(strict, jax.nn.log_sigmoid(-z), 0.0)
        suffix = lax.cumsum(log_1m, axis=3, reverse=True) - log_1m
        a = jnp.where(strict, jnp.exp(jax.nn.log_sigmoid(z) + suffix), 0.0)
        return jnp.einsum('bhqs,bshd->bqhd', a.astype(v.dtype), v)

    out = lax.map(block, (to_blocks(q), block_starts(s_len)))
    return from_blocks(out)


def dsa_attention(q, k, v, q_idx, k_idx, w_idx, rel_bias):
    s_len = q.shape[1]
    n_sel = min(TOPK_MAX, s_len // 4)
    scale = HEAD_DIM ** -0.5
    idx_scale = (IDX_DIM ** -0.5) * (IDX_HEADS ** -0.5)
    k_pos = jnp.arange(s_len)

    def block(args):
        qb, qib, wb, start = args
        q_pos = start + jnp.arange(Q_BLOCK)
        dots = jnp.einsum('bqhd,bsd->bqhs', qib, k_idx, preferred_element_type=jnp.float32)
        score = jnp.einsum('bqhs,bqh->bqs', jax.nn.relu(dots), wb.astype(jnp.float32) * idx_scale)
        score = jnp.where((k_pos[None, :] <= q_pos[:, None])[None], score, -jnp.inf)
        _, sel = lax.top_k(score, n_sel)
        gather = jax.vmap(lambda kb, ib: kb[ib])
        k_sel = gather(k, sel)
        v_sel = gather(v, sel)
        dist = q_pos[None, :, None] - sel
        valid = dist >= 0
        bias = rel_bias[t5_bucket(jnp.maximum(dist, 0))]
        logit = jnp.einsum('bqhd,bqkhd->bhqk', qb, k_sel, preferred_element_type=jnp.float32) * scale
        logit = logit + jnp.transpose(bias, (0, 3, 1, 2)).astype(jnp.float32)
        logit = jnp.where(valid[:, None], logit, -jnp.inf)
        p = jax.nn.softmax(logit, axis=-1)
        return jnp.einsum('bhqk,bqkhd->bqhd', p.astype(v.dtype), v_sel)

    out = lax.map(block, (to_blocks(q), to_blocks(q_idx), to_blocks(w_idx), block_starts(s_len)))
    return from_blocks(out)


def hybrid_mixer(h, w_in, b_forget, q_norm, k_norm, kv_norm, w_ukv,
                 w_br_fox, w_br_sb, w_br_dsa, w_out, rel_bias):
    b, s, _ = h.shape
    z = h @ w_in
    offs, acc = [], 0
    for w in SPLITS[:-1]:
        acc += w
        offs.append(acc)
    (fq, fk, fv, ff, fo, sq, sk, sv, dq, dlat, diq, dik, diw, gates) = jnp.split(z, offs, axis=-1)
    heads = lambda t, n: t.reshape(b, s, n, HEAD_DIM)

    log_f = jax.nn.log_sigmoid(ff.astype(jnp.float32) + b_forget.astype(jnp.float32))
    y_fox = forgetting_attention(rms_norm(heads(fq, H_FOX), q_norm), rms_norm(heads(fk, H_FOX), k_norm),
                                 heads(fv, H_FOX), log_f)
    y_fox = y_fox.reshape(b, s, W_FOX) * jax.nn.sigmoid(fo)

    y_sb = stick_breaking_attention(heads(sq, H_SB), heads(sk, H_SB), heads(sv, H_SB)).reshape(b, s, W_SB)

    dk, dv = jnp.split(rms_norm(dlat, kv_norm) @ w_ukv, 2, axis=-1)
    y_dsa = dsa_attention(heads(dq, H_DSA), heads(dk, H_DSA), heads(dv, H_DSA),
                          diq.reshape(b, s, IDX_HEADS, IDX_DIM), dik, diw, rel_bias).reshape(b, s, W_DSA)

    g = jax.nn.sigmoid(gates).reshape(b, s, N_BRANCH, D_MODEL)
    m = (g[:, :, 0] * (y_fox @ w_br_fox) + g[:, :, 1] * (y_sb @ w_br_sb)
         + g[:, :, 2] * (y_dsa @ w_br_dsa))
    return m @ w_out


def swiglu(h, wg, wu, wd):
    return (jax.nn.silu(h @ wg) * (h @ wu)) @ wd


def moe_swiglu(h, w_router, wg, wu, wd):
    b, s, d = h.shape
    t = h.reshape(-1, d)
    logits = (t @ w_router).astype(jnp.float32)
    top_v, top_i = lax.top_k(logits, TOP_K_EXPERTS)
    top_w = jax.nn.softmax(top_v, axis=-1)
    comb = jnp.sum(jax.nn.one_hot(top_i, N_EXPERTS, dtype=jnp.float32) * top_w[..., None], axis=1)
    y = jnp.zeros_like(t)
    for e in range(N_EXPERTS):
        y = y + comb[:, e:e + 1].astype(t.dtype) * swiglu(t, wg[e], wu[e], wd[e])
    return y.reshape(b, s, d)


def setup_inputs(seed: int = 0) -> dict:
    key = jax.random.key(seed)
    ks = jax.random.split(key, 24)
    nrm = lambda k, shape, scale: jax.random.normal(k, shape, jnp.float32) * scale
    gain = lambda k, shape: 1.0 + nrm(k, shape, 0.02)
    return {
        "x": nrm(ks[0], (BATCH, SEQ, D_MODEL), 1.0),
        "w_in": nrm(ks[1], (DEPTH, D_MODEL, N_IN), D_MODEL ** -0.5),
        "b_forget": 2.0 + nrm(ks[2], (DEPTH, H_FOX), 0.1),
        "q_norm": gain(ks[3], (DEPTH, HEAD_DIM)),
        "k_norm": gain(ks[4], (DEPTH, HEAD_DIM)),
        "kv_norm": gain(ks[5], (DEPTH, KV_RANK)),
        "w_ukv": nrm(ks[6], (DEPTH, KV_RANK, 2 * W_DSA), KV_RANK ** -0.5),
        "w_br_fox": nrm(ks[7], (DEPTH, W_FOX, D_MODEL), W_FOX ** -0.5),
        "w_br_sb": nrm(ks[8], (DEPTH, W_SB, D_MODEL), W_SB ** -0.5),
        "w_br_dsa": nrm(ks[9], (DEPTH, W_DSA, D_MODEL), W_DSA ** -0.5),
        "w_out": nrm(ks[10], (DEPTH, D_MODEL, D_MODEL), D_MODEL ** -0.5),
        "rel_bias": nrm(ks[11], (N_BUCKETS, H_DSA), 0.5),
        "norm_mix": gain(ks[12], (DEPTH, D_MODEL)),
        "norm_ffn": gain(ks[13], (DEPTH, D_MODEL)),
        "w_ffn_gate": nrm(ks[14], (N_DENSE, D_MODEL, D_FF), D_MODEL ** -0.5),
        "w_ffn_up": nrm(ks[15], (N_DENSE, D_MODEL, D_FF), D_MODEL ** -0.5),
        "w_ffn_down": nrm(ks[16], (N_DENSE, D_FF, D_MODEL), D_FF ** -0.5),
        "w_router": nrm(ks[17], (N_MOE, D_MODEL, N_EXPERTS), D_MODEL ** -0.5),
        "w_moe_gate": nrm(ks[18], (N_MOE, N_EXPERTS, D_MODEL, D_FF), D_MODEL ** -0.5),
        "w_moe_up": nrm(ks[19], (N_MOE, N_EXPERTS, D_MODEL, D_FF), D_MODEL ** -0.5),
        "w_moe_down": nrm(ks[20], (N_MOE, N_EXPERTS, D_FF, D_MODEL), D_FF ** -0.5),
        "norm_final": gain(ks[21], (D_MODEL,)),
    }


def reference(x, w_in, b_forget, q_norm, k_norm, kv_norm, w_ukv, w_br_fox, w_br_sb, w_br_dsa,
              w_out, rel_bias, norm_mix, norm_ffn, w_ffn_gate, w_ffn_up, w_ffn_down,
              w_router, w_moe_gate, w_moe_up, w_moe_down, norm_final):
    for l in range(DEPTH):
        h = rms_norm(x, norm_mix[l])
        x = x + hybrid_mixer(h, w_in[l], b_forget[l], q_norm[l], k_norm[l], kv_norm[l], w_ukv[l],
                             w_br_fox[l], w_br_sb[l], w_br_dsa[l], w_out[l], rel_bias)
        h = rms_norm(x, norm_ffn[l])
        if l % 2 == 0:
            j = l // 2
            x = x + swiglu(h, w_ffn_gate[j], w_ffn_up[j], w_ffn_down[j])
        else:
            j = l // 2
            x = x + moe_swiglu(h, w_router[j], w_moe_gate[j], w_moe_up[j], w_moe_down[j])
    return rms_norm(x, norm_final)
```

```cpp
#include <hip/hip_runtime.h>
#include <cstdio>
#include <cstdint>

#ifndef SITE_MASK
#define SITE_MASK 0xffffffffu
#endif
#define SITE_ON(i) (((SITE_MASK) >> (i)) & 1u)

#ifndef MK_ONE_LAUNCH
#define MK_ONE_LAUNCH 0
#endif

namespace pg8 {
#define PG8_LAS __attribute__((address_space(3)))
typedef unsigned short bf16_t;
typedef short bf16x8 __attribute__((ext_vector_type(8)));
typedef float f32x4 __attribute__((ext_vector_type(4)));
typedef unsigned u32x4 __attribute__((ext_vector_type(4)));
constexpr int BM = 256, BK = 64, HALF = 128, HTB = HALF * BK * 2  , STAGE_BYTES = 8 * HTB, NXCD = 8, WGM = 8;

__host__ __device__ __forceinline__ int lds_byte(int r, int c) { const int st = (r >> 4) * 2 + (c >> 5), rr = r & 15, cc = c & 31, ob = rr * 64 + cc * 2; return st * 1024 + (ob ^ (((ob >> 9) & 1) << 5)); }
__host__ __device__ __forceinline__ void stage_rc(int b, int& R, int& C) { const int st = b / 1024, sb = b % 1024, swz = sb ^ (((sb >> 9) & 1) << 5); R = (st >> 1) * 16 + swz / 64; C = (st & 1) * 32 + (swz % 64) / 2; }
__host__ __device__ __forceinline__ int perm32(int rho) { const int n = rho >> 4, i = rho & 15; return 8 * (i >> 2) + 4 * n + (i & 3); }
struct Unit { int pm, pn, aux; const char* a; const char* b; };
struct Gemm { int K; };
__device__ __forceinline__ unsigned cvt_pk_bf16(float lo, float hi) { unsigned r; asm volatile("v_cvt_pk_bf16_f32 %0, %1, %2" : "=v"(r) : "v"(lo), "v"(hi)); return r; }
template <class Epi, class Sched, bool ALIGN_EPI = false, bool SP2 = false>
__device__ __forceinline__ void gemm_phase(PG8_LAS unsigned char* lds, const Gemm g, const Sched& S, const Epi& E) {
    int tid_ = threadIdx.x; asm volatile("" : "+v"(tid_)); const int tid = tid_, wid = __builtin_amdgcn_readfirstlane(tid >> 6), lane = tid & 63, wr = wid >> 2, wc = wid & 3, fr = lane & 15, fq = lane >> 4;
    const int K = g.K, nt = K / BK;
    unsigned voffA[2], voffB[2];
#pragma unroll
    for (int i = 0; i < 2; ++i) { int R, C; stage_rc(tid * 16 + i * 8192, R, C); const int Rb = Epi::PERM ? ((R & ~31) + perm32(R & 31)) : R;
        voffA[i] = (unsigned)(R * K + C) * 2u; voffB[i] = (unsigned)(Rb * K + C) * 2u; }
    const size_t kstep = (size_t)(BK * 2);
    const size_t hstep = (size_t)HALF * K * 2;
    const unsigned ldsw = (unsigned)wid * 1024u;
    const int aoff = lds_byte(wr * 64 + fr, fq * 8), boff = lds_byte(wc * 32 + fr, fq * 8);
#define PG8_SA(b, h) (((b) * 2 + (h)) * HTB)
#define PG8_SB(b, h) ((4 + (b) * 2 + (h)) * HTB)
#define PG8_STAGE(bufoff, gbase, voff) do { _Pragma("unroll") for (int _i = 0; _i < 2; ++_i) \
        __builtin_amdgcn_global_load_lds((const unsigned*)((const char*)(gbase) + (voff)[_i]), (PG8_LAS unsigned*)(lds + (bufoff) + ldsw + _i * 8192), 16, 0, 0); } while (0)
#define PG8_LDA(dst, b, h) do { _Pragma("unroll") for (int m = 0; m < 4; ++m) _Pragma("unroll") for (int k = 0; k < 2; ++k) dst[m][k] = *(const PG8_LAS bf16x8*)(lds + PG8_SA(b, h) + aoff + m * 2048 + k * 1024); } while (0)
#define PG8_LDB(dst, b, h) do { _Pragma("unroll") for (int n = 0; n < 2; ++n) _Pragma("unroll") for (int k = 0; k < 2; ++k) dst[n][k] = *(const PG8_LAS bf16x8*)(lds + PG8_SB(b, h) + boff + n * 2048 + k * 1024); } while (0)
#define PG8_MMA(ai, bj, At, Bt) do { __builtin_amdgcn_s_setprio(1); _Pragma("unroll") for (int m = 0; m < 4; ++m) _Pragma("unroll") for (int n = 0; n < 2; ++n) _Pragma("unroll") for (int k = 0; k < 2; ++k) \
        acc[ai][bj][m][n] = __builtin_amdgcn_mfma_f32_16x16x32_bf16(Bt[n][k], At[m][k], acc[ai][bj][m][n], 0, 0, 0); __builtin_amdgcn_s_setprio(0); } while (0)
#define PG8_WAIT_V(n) asm volatile("s_waitcnt vmcnt(" #n ")" ::: "memory")
#define PG8_WAIT_L(n) asm volatile("s_waitcnt lgkmcnt(" #n ")" ::: "memory")
#define PG8_BAR __builtin_amdgcn_s_barrier()
#define PG8_SCHED __builtin_amdgcn_sched_barrier(0)
    Unit cur, nxt; int ui = 0;
    if (!S.next(0, cur)) return;
    f32x4 acc[2][2][4][2];
#pragma unroll
    for (int a = 0; a < 2; ++a)
#pragma unroll
        for (int b = 0; b < 2; ++b)
#pragma unroll
            for (int m = 0; m < 4; ++m)
#pragma unroll
                for (int n = 0; n < 2; ++n) acc[a][b][m][n] = (f32x4){0.f, 0.f, 0.f, 0.f};
    bf16x8 At[4][2], B0[2][2], B1[2][2];
    const char* cA = cur.a; const char* cB = cur.b;
    S.a_ready(cur);
    if constexpr (SP2) {
        PG8_STAGE(PG8_SB(0, 0), cB, voffB); PG8_STAGE(PG8_SB(0, 1), cB + hstep, voffB); PG8_STAGE(PG8_SA(0, 0), cA, voffA); PG8_STAGE(PG8_SA(0, 1), cA + hstep, voffA);
        if (wr == 1) PG8_BAR;
        PG8_WAIT_V(2); PG8_BAR;
        PG8_STAGE(PG8_SB(1, 0), cB + kstep, voffB); PG8_STAGE(PG8_SA(1, 0), cA + kstep, voffA); PG8_STAGE(PG8_SB(1, 1), cB + hstep + kstep, voffB);
        PG8_WAIT_V(6); PG8_BAR;
    } else {
        PG8_STAGE(PG8_SB(0, 0), cB, voffB); PG8_STAGE(PG8_SA(0, 0), cA, voffA); PG8_STAGE(PG8_SB(0, 1), cB + hstep, voffB); PG8_STAGE(PG8_SA(0, 1), cA + hstep, voffA);
        if (wr == 1) PG8_BAR;
        PG8_WAIT_V(4); PG8_BAR;
        PG8_STAGE(PG8_SB(1, 0), cB + kstep, voffB); PG8_STAGE(PG8_SA(1, 0), cA + kstep, voffA); PG8_STAGE(PG8_SB(1, 1), cB + hstep + kstep, voffB);
        PG8_WAIT_V(6); PG8_BAR;
    }
    for (;;) {
        const bool has_next = S.next(ui + 1, nxt);
        const char* nA = has_next ? nxt.a : cA; const char* nB = has_next ? nxt.b : cB;
        for (int t = 0; t < nt; t += 2) {
            const bool last = (t == nt - 2);
            const char* a1 = cA + (size_t)(t + 1) * kstep;
            const char* a2 = last ? nA : cA + (size_t)(t + 2) * kstep; const char* b2 = last ? nB : cB + (size_t)(t + 2) * kstep;
            const char* a3 = a2 + kstep; const char* b3 = b2 + kstep;
            if (last && has_next) S.a_ready(nxt);
            if constexpr (SP2) {
            PG8_LDB(B0, 0, 0); PG8_LDB(B1, 0, 1); PG8_SCHED; PG8_LDA(At, 0, 0); PG8_STAGE(PG8_SA(1, 1), a1 + hstep, voffA);
            PG8_WAIT_V(8); PG8_WAIT_L(0); PG8_BAR; PG8_MMA(0, 0, At, B0); PG8_MMA(0, 1, At, B1); PG8_BAR; PG8_SCHED;
            PG8_LDA(At, 0, 1); PG8_STAGE(PG8_SB(0, 0), b2, voffB); PG8_STAGE(PG8_SB(0, 1), b2 + hstep, voffB); PG8_STAGE(PG8_SA(0, 0), a2, voffA);
            PG8_WAIT_V(8); PG8_WAIT_L(0); PG8_BAR; PG8_MMA(1, 0, At, B0); PG8_MMA(1, 1, At, B1); PG8_BAR; PG8_SCHED;
            PG8_LDB(B0, 1, 0); PG8_LDB(B1, 1, 1); PG8_SCHED; PG8_LDA(At, 1, 0); PG8_STAGE(PG8_SA(0, 1), a2 + hstep, voffA);
            PG8_WAIT_V(8); PG8_WAIT_L(0); PG8_BAR; PG8_MMA(0, 0, At, B0); PG8_MMA(0, 1, At, B1); PG8_BAR; PG8_SCHED;
            PG8_LDA(At, 1, 1); PG8_STAGE(PG8_SB(1, 0), b3, voffB); PG8_STAGE(PG8_SB(1, 1), b3 + hstep, voffB); PG8_STAGE(PG8_SA(1, 0), a3, voffA);
            PG8_WAIT_V(8); PG8_WAIT_L(0); PG8_BAR; PG8_MMA(1, 0, At, B0); PG8_MMA(1, 1, At, B1); PG8_BAR; PG8_SCHED;
            } else {
            PG8_LDB(B0, 0, 0); PG8_SCHED; PG8_LDA(At, 0, 0); PG8_STAGE(PG8_SA(1, 1), a1 + hstep, voffA);
            PG8_WAIT_L(8); PG8_BAR; PG8_WAIT_L(0); PG8_MMA(0, 0, At, B0); PG8_BAR; PG8_SCHED;
            PG8_LDB(B1, 0, 1); PG8_STAGE(PG8_SB(0, 0), b2, voffB);
            PG8_BAR; PG8_WAIT_L(0); PG8_MMA(0, 1, At, B1); PG8_BAR;
            PG8_LDA(At, 0, 1); PG8_STAGE(PG8_SA(0, 0), a2, voffA);
            PG8_BAR; PG8_WAIT_L(0); PG8_MMA(1, 0, At, B0); PG8_BAR; PG8_SCHED;
            PG8_STAGE(PG8_SB(0, 1), b2 + hstep, voffB);
            PG8_WAIT_V(6); PG8_BAR; PG8_MMA(1, 1, At, B1); PG8_BAR;
            PG8_LDB(B0, 1, 0); PG8_SCHED; PG8_LDA(At, 1, 0); PG8_STAGE(PG8_SA(0, 1), a2 + hstep, voffA);
            PG8_WAIT_L(8); PG8_BAR; PG8_WAIT_L(0); PG8_MMA(0, 0, At, B0); PG8_BAR; PG8_SCHED;
            PG8_LDB(B1, 1, 1); PG8_STAGE(PG8_SB(1, 0), b3, voffB);
            PG8_BAR; PG8_WAIT_L(0); PG8_MMA(0, 1, At, B1); PG8_BAR;
            PG8_LDA(At, 1, 1); PG8_STAGE(PG8_SA(1, 0), a3, voffA);
            PG8_BAR; PG8_WAIT_L(0); PG8_MMA(1, 0, At, B0); PG8_BAR; PG8_SCHED;
            PG8_STAGE(PG8_SB(1, 1), b3 + hstep, voffB);
            PG8_WAIT_V(6); PG8_BAR; PG8_MMA(1, 1, At, B1); PG8_BAR;
            }
        }
        if constexpr (ALIGN_EPI) { if (wr == 0) PG8_BAR; }
        if constexpr (!Epi::AFTER_DRAIN) { E(acc, cur, wr, wc, fr, fq); S.done(cur); }
        if (!has_next) break;
#pragma unroll
        for (int a = 0; a < 2; ++a)
#pragma unroll
            for (int b = 0; b < 2; ++b)
#pragma unroll
                for (int m = 0; m < 4; ++m)
#pragma unroll
                    for (int n = 0; n < 2; ++n) acc[a][b][m][n] = (f32x4){0.f, 0.f, 0.f, 0.f};
        cur = nxt; cA = nA; cB = nB; ++ui;
        if constexpr (ALIGN_EPI) { if (wr == 1) PG8_BAR; }
    }
    PG8_WAIT_V(0);
    if constexpr (!ALIGN_EPI) { if (wr == 0) PG8_BAR; }
    PG8_BAR;
    if constexpr (Epi::AFTER_DRAIN) { E.fused(acc, cur, wr, wc, fr, fq, lds, wid, lane); S.done(cur); }
#undef PG8_SA
#undef PG8_SB
#undef PG8_STAGE
#undef PG8_LDA
#undef PG8_LDB
#undef PG8_MMA
#undef PG8_WAIT_V
#undef PG8_WAIT_L
#undef PG8_BAR
#undef PG8_SCHED
}
struct OrderBase {
    int nM, nN, nwg, G, c;
    __device__ __forceinline__ void init(int nM_, int nN_, int G_, int c_) { nM = nM_; nN = nN_; nwg = nM_ * nN_; G = G_; c = c_; }
    __device__ __forceinline__ bool map(int i, int& pm, int& pn) const {
        const long L = (long)i * G + c; if (L >= nwg) return false;
        int wgid = (int)L; { const int q = nwg / NXCD, r = nwg % NXCD, xcd = wgid % NXCD, off = wgid / NXCD; wgid = (xcd < r ? xcd * (q + 1) : r * (q + 1) + (xcd - r) * q) + off; }
        const int nig = WGM * nN, gid = wgid / nig, fm = gid * WGM, gsz = (nM - fm) < WGM ? (nM - fm) : WGM;
        pm = fm + ((wgid % nig) % gsz); pn = (wgid % nig) / gsz; return true;
    }
    __device__ __forceinline__ void a_ready(const Unit&) const {}
    __device__ __forceinline__ void done(const Unit&) const {}
};
struct PlainOrder : OrderBase {
    const char* A; const char* B; size_t ta, tb;
    __device__ __forceinline__ bool next(int i, Unit& u) const { int pm, pn; if (!map(i, pm, pn)) return false; u.pm = pm; u.pn = pn; u.aux = 0; u.a = A + (size_t)pm * ta; u.b = B + (size_t)pn * tb; return true; }
};
struct BranchOrder : OrderBase {
    const char* A; const char* B; size_t ta, tb, za, zb;
    __device__ __forceinline__ bool next(int i, Unit& u) const { const int ti = i / 3, br = i - 3 * ti; int pm, pn; if (!map(ti, pm, pn)) return false; u.pm = pm; u.pn = pn; u.aux = br;
        u.a = A + (size_t)br * za + (size_t)pm * ta; u.b = B + (size_t)br * zb + (size_t)pn * tb; return true; }
};
struct MoeOrder : OrderBase {
    const char* A; const char* B; size_t ta, tb, zb; int t1, t2, t3, t4, t5, t6, t7;
    __device__ __forceinline__ bool next(int i, Unit& u) const { int pm, pn; if (!map(i, pm, pn)) return false; u.pm = pm; u.pn = pn;
        const int e = (pm >= t1) + (pm >= t2) + (pm >= t3) + (pm >= t4) + (pm >= t5) + (pm >= t6) + (pm >= t7); u.aux = e;
        u.a = A + (size_t)pm * ta; u.b = B + (size_t)e * zb + (size_t)pn * tb; return true; }
};
}

constexpr int NTOK = 16384, DM = 2048, SEQ = 2048, NBATCH = 8, NHEAD = 8, HD = 64, DFF = 7168, NEXP = 8;
constexpr int NIN = 10828, NINP = 11008;
constexpr int WBR_W = 512, KVR = 256;
constexpr float EPS = 1e-6f, LOG2E = 1.4426950408889634f, C2 = 0.125f * LOG2E;
constexpr int MOE_ROWS = 2 * NTOK + NEXP * 256;
constexpr int NSTEPS = 24;

constexpr size_t al256(size_t x) { return (x + 255) & ~(size_t)255; }
constexpr size_t WS_CTL = 0, CTL_ZERO_BYTES = 1u << 20;
constexpr size_t SZ_WIN = (size_t)NINP * DM * 2, SZ_WUKV = (size_t)1024 * KVR * 2, SZ_WBR = (size_t)DM * WBR_W * 2, SZ_WOUT = (size_t)DM * DM * 2;
constexpr size_t SZ_WGU = (size_t)2 * DFF * DM * 2, SZ_WD = (size_t)DM * DFF * 2;
constexpr size_t WS_WIN = CTL_ZERO_BYTES, WS_WUKV = WS_WIN + 2 * SZ_WIN, WS_WBR = WS_WUKV + 2 * SZ_WUKV, WS_WOUT = WS_WBR + 6 * SZ_WBR;
constexpr size_t WS_WGU0 = WS_WOUT + 2 * SZ_WOUT, WS_WD0 = WS_WGU0 + SZ_WGU, WS_WGUM = WS_WD0 + SZ_WD, WS_WDM = WS_WGUM + NEXP * SZ_WGU;
constexpr size_t WS_RSTD = WS_WDM + NEXP * SZ_WD, WS_SSP = WS_RSTD + (size_t)NTOK * 4, WS_XB = WS_SSP + (size_t)NTOK * 32 * 4;
constexpr size_t WS_R = WS_XB + (size_t)NTOK * DM * 2;
constexpr size_t WS_Z8 = WS_R, WS_DLAT = WS_Z8 + (size_t)8 * NTOK * 512 * 2, WS_DIQ = WS_DLAT + (size_t)NTOK * 256 * 2, WS_DIK = WS_DIQ + (size_t)NTOK * 256 * 2;
constexpr size_t WS_FFW = WS_DIK + (size_t)NTOK * 64 * 2, WS_GATES = WS_FFW + (size_t)NTOK * 16 * 4, WS_C2F = WS_GATES + (size_t)NTOK * 6144 * 2;
constexpr size_t WS_DKV = WS_C2F + (size_t)NBATCH * NHEAD * SEQ * 4, WS_SC = WS_DKV + (size_t)NTOK * 1024 * 2, WS_MASK = WS_SC + (size_t)NTOK * SEQ * 4;
constexpr size_t WS_YATT = WS_MASK + (size_t)NTOK * 64 * 4, WS_M = WS_YATT + (size_t)3 * NTOK * 512 * 2, WS_R_END1 = WS_M + (size_t)NTOK * DM * 2;
constexpr size_t WS_HID = WS_R;
constexpr size_t WS_XG = WS_R, WS_HIDM = WS_XG + (size_t)MOE_ROWS * DM * 2, WS_Y = WS_HIDM + (size_t)MOE_ROWS * DFF * 2, WS_ROWTOK = WS_Y + (size_t)2 * NTOK * DM * 4;
constexpr size_t WS_ROWW = WS_ROWTOK + (size_t)MOE_ROWS * 4, WS_RSTDG = WS_ROWW + (size_t)MOE_ROWS * 4, WS_TOKINFO = WS_RSTDG + (size_t)MOE_ROWS * 4;
constexpr size_t WS_TOKW = WS_TOKINFO + (size_t)2 * NTOK * 8, WS_WGCNT = WS_TOKW + (size_t)2 * NTOK * 4, WS_META = WS_WGCNT + 256 * 8 * 4, WS_R_END2 = WS_META + 256;
constexpr size_t WS_END = WS_R_END1 > WS_R_END2 ? WS_R_END1 : WS_R_END2;
constexpr int CW_BAR = 4096;

constexpr int RING_BYTES = 131072, LDSCTL_OFF = RING_BYTES, MISC_OFF = LDSCTL_OFF + 320, LDS_BYTES = 147456;

#define GAS __attribute__((address_space(1)))
#define LAS __attribute__((address_space(3)))
typedef unsigned short bf16_t;
typedef float f32x4 __attribute__((ext_vector_type(4)));
typedef unsigned u32x4 __attribute__((ext_vector_type(4)));
typedef unsigned u32x2 __attribute__((ext_vector_type(2)));
typedef short bf16x8 __attribute__((ext_vector_type(8)));
typedef float f32x16 __attribute__((ext_vector_type(16)));
#define LDS_WAIT() asm volatile("s_waitcnt lgkmcnt(0)" ::: "memory")
#define VM_WAIT() asm volatile("s_waitcnt vmcnt(0)" ::: "memory")
__device__ __forceinline__ float bflo(unsigned w) { return __uint_as_float(w << 16); }
__device__ __forceinline__ float bfhi(unsigned w) { return __uint_as_float(w & 0xffff0000u); }
typedef float f32x2_t __attribute__((ext_vector_type(2))); typedef __bf16 bf16x2_t __attribute__((ext_vector_type(2)));
__device__ __forceinline__ unsigned pk2(float lo, float hi) { f32x2_t v = {lo, hi}; bf16x2_t b = __builtin_convertvector(v, bf16x2_t); return __builtin_bit_cast(unsigned, b); }
__device__ __forceinline__ int opq(int v) { asm volatile("" : "+s"(v)); return v; }
__device__ __forceinline__ float wave_sum(float v) {
#pragma unroll
    for (int o = 1; o < 64; o <<= 1) v += __shfl_xor(v, o);
    return v;
}
__device__ __forceinline__ float sigm(float v) { return __builtin_amdgcn_rcpf(1.f + __builtin_amdgcn_exp2f(-v * LOG2E)); }
__device__ __forceinline__ float softplus2(float z) { return fmaxf(z, 0.f) + __builtin_amdgcn_logf(1.f + __builtin_amdgcn_exp2f(-fabsf(z))); }

#define XB_TMO      128
#define XB_XCNT(j)  (256  + 64 * (j))
#define XB_XSUB(j)  (1280 + 64 * (j))
#define XB_XGEN(j)  (2304 + 64 * (j))
#define XB_TOP      3328
#define XB_TOPGEN   3392
#define XCD_BAR_WORDS 3456
#define XB_SPIN_CAP (1u << 18)

__device__ __forceinline__ unsigned xb_ld(unsigned* p)              { return __hip_atomic_load(p, __ATOMIC_RELAXED, __HIP_MEMORY_SCOPE_AGENT); }
__device__ __forceinline__ unsigned xb_add(unsigned* p, unsigned v) { return __hip_atomic_fetch_add(p, v, __ATOMIC_RELAXED, __HIP_MEMORY_SCOPE_AGENT); }
__device__ __forceinline__ unsigned xb_xcc_id() { return (unsigned)__builtin_amdgcn_s_getreg((3 << 11) | 20) & 0xFu; }
#define XB_SPIN(cond, bar) do { unsigned _sp = 0; while (cond) { __builtin_amdgcn_s_sleep(1); \
    if ((++_sp & 255u) == 0u) { if (xb_ld(&(bar)[XB_TMO])) break; if (_sp > XB_SPIN_CAP) { atomicAdd(&(bar)[XB_TMO], 1u); break; } } } } while (0)

struct XcdBarrier {
    unsigned* bar; unsigned x;
    volatile LAS unsigned* st;
};

__device__ __forceinline__ XcdBarrier xcd_barrier_post(unsigned* bar, volatile LAS unsigned* st) {
    XcdBarrier b; b.bar = bar; b.x = xb_xcc_id(); b.st = st;
    if (threadIdx.x == 0) (void)xb_add(&bar[XB_XCNT(b.x)], 1u);
    return b;
}
__device__ __forceinline__ void xcd_barrier_complete(unsigned* bar, unsigned x, unsigned& nloc, unsigned& nx) {
    const unsigned G = gridDim.x * gridDim.y * gridDim.z;
    unsigned sum, cnt, mine, sp = 0u;
    for (;;) {
        sum = 0u; cnt = 0u; mine = 0u;
#pragma unroll
        for (unsigned j = 0; j < 16; ++j) { const unsigned c = xb_ld(&bar[XB_XCNT(j)]); sum += c; cnt += (c > 0u) ? 1u : 0u; mine = (j == x) ? c : mine; }
        if (sum == G) break;
        __builtin_amdgcn_s_sleep(1);
        if ((++sp & 255u) == 0u) { if (xb_ld(&bar[XB_TMO])) break; if (sp > XB_SPIN_CAP) { atomicAdd(&bar[XB_TMO], 1u); break; } }
    }
    nloc = mine > 0u ? mine : 1u; nx = cnt > 0u ? cnt : 1u;
}

__device__ __attribute__((noinline)) void xcd_barrier_impl(GAS unsigned* bar_, unsigned x_, LAS unsigned* st_) { XcdBarrier b; b.bar = (unsigned*)bar_; b.x = x_; b.st = st_;
    asm volatile("s_waitcnt vmcnt(0)" ::: "memory");
    __syncthreads();
    if (threadIdx.x == 0) {
        unsigned* bar = b.bar;
        __builtin_amdgcn_s_waitcnt(0);
        unsigned nloc = b.st[0], nx = b.st[1];
        if (nloc == 0u) { xcd_barrier_complete(bar, b.x, nloc, nx); b.st[0] = nloc; b.st[1] = nx; }
        const unsigned old = xb_add(&bar[XB_XSUB(b.x)], 1u);
        const unsigned gen = old / nloc;
        if (old + 1u == (gen + 1u) * nloc) {
            __builtin_amdgcn_fence(__ATOMIC_RELEASE, "agent");
            asm volatile("s_waitcnt vmcnt(0)" ::: "memory");
            const unsigned og = xb_add(&bar[XB_TOP], 1u);
            const unsigned tg = og / nx;
            if (og + 1u == (tg + 1u) * nx) xb_add(&bar[XB_TOPGEN], 1u);
            else XB_SPIN(xb_ld(&bar[XB_TOPGEN]) == tg, bar);
            __builtin_amdgcn_fence(__ATOMIC_ACQUIRE, "agent");
            xb_add(&bar[XB_XGEN(b.x)], 1u);
            asm volatile("s_waitcnt vmcnt(0)" ::: "memory");
        } else {
            XB_SPIN(xb_ld(&bar[XB_XGEN(b.x)]) == gen, bar);
            __builtin_amdgcn_fence(__ATOMIC_ACQUIRE, "agent");
            asm volatile("s_waitcnt vmcnt(0)" ::: "memory");
        }
    }
    __syncthreads();
}
__device__ __forceinline__ void xcd_barrier(const XcdBarrier& b) { xcd_barrier_impl((GAS unsigned*)b.bar, b.x, (LAS unsigned*)b.st); }

#define ACC_T const pg8::f32x4 (&acc)[2][2][4][2]
__device__ __forceinline__ u32x4 pack8(f32x4 v0, f32x4 v1) { u32x4 w; w.x = pk2(v0[0], v0[1]); w.y = pk2(v0[2], v0[3]); w.z = pk2(v1[0], v1[1]); w.w = pk2(v1[2], v1[3]); return w; }
__device__ __forceinline__ f32x4 sigm4(f32x4 v) { f32x4 r; r[0] = sigm(v[0]); r[1] = sigm(v[1]); r[2] = sigm(v[2]); r[3] = sigm(v[3]); return r; }

struct EpiWin {
    static constexpr bool PERM = true, AFTER_DRAIN = false;
    const float* rstd; bf16_t* z8; bf16_t* dlat; bf16_t* diq; bf16_t* dik; float* ffw; bf16_t* gates;
    __device__ __forceinline__ void operator()(ACC_T, const pg8::Unit& u, int wr, int wc, int fr, int fq) const {
        const int row0 = u.pm * 256 + wr * 64 + fr, pn = u.pn, cl = wc * 32 + 8 * fq;
        if (pn == 18) {
#pragma unroll
            for (int ai = 0; ai < 2; ++ai)
#pragma unroll
                for (int m = 0; m < 4; ++m) { const int row = row0 + ai * 128 + m * 16; const float rs = rstd[row];
                    const f32x4 v0 = acc[ai][0][m][0] * rs, v1 = acc[ai][0][m][1] * rs;
                    if (cl < 64) *(u32x4*)(dik + (size_t)row * 64 + cl) = pack8(v0, v1);
                    else if (cl == 64) { *(f32x4*)(ffw + (size_t)row * 16) = v0; *(f32x4*)(ffw + (size_t)row * 16 + 4) = v1; }
                    else if (cl == 72) { *(f32x4*)(ffw + (size_t)row * 16 + 8) = v0; } }
            return;
        }
        bf16_t* dst; int ldc, colbase; bool sg = false; float scale = 1.f;
        if (pn < 16) { const int idx = pn >> 1; dst = z8 + (size_t)idx * NTOK * 512; ldc = 512; colbase = (pn & 1) * 256; sg = (idx == 3); scale = (idx == 4 || idx == 7) ? C2 : 1.f; }
        else if (pn == 16) { dst = dlat; ldc = 256; colbase = 0; }
        else if (pn == 17) { dst = diq; ldc = 256; colbase = 0; }
        else { dst = gates; ldc = 6144; colbase = (pn - 19) * 256; sg = true; }
        if (sg) {
#pragma unroll
            for (int ai = 0; ai < 2; ++ai)
#pragma unroll
                for (int m = 0; m < 4; ++m) { const int row = row0 + ai * 128 + m * 16; const float rs = rstd[row]; bf16_t* rowp = dst + (size_t)row * ldc + colbase + cl;
#pragma unroll
                    for (int bj = 0; bj < 2; ++bj) *(u32x4*)(rowp + bj * 128) = pack8(sigm4(acc[ai][bj][m][0] * rs), sigm4(acc[ai][bj][m][1] * rs)); }
        } else {
#pragma unroll
            for (int ai = 0; ai < 2; ++ai)
#pragma unroll
                for (int m = 0; m < 4; ++m) { const int row = row0 + ai * 128 + m * 16; const float rs = rstd[row] * scale; bf16_t* rowp = dst + (size_t)row * ldc + colbase + cl;
#pragma unroll
                    for (int bj = 0; bj < 2; ++bj) *(u32x4*)(rowp + bj * 128) = pack8(acc[ai][bj][m][0] * rs, acc[ai][bj][m][1] * rs); }
        }
    }
};
struct EpiPlain {
    static constexpr bool PERM = true, AFTER_DRAIN = false;
    bf16_t* O; int ldc;
    __device__ __forceinline__ void operator()(ACC_T, const pg8::Unit& u, int wr, int wc, int fr, int fq) const {
        const int row0 = u.pm * 256 + wr * 64 + fr, col0 = u.pn * 256 + wc * 32 + 8 * fq;
#pragma unroll
        for (int ai = 0; ai < 2; ++ai)
#pragma unroll
            for (int m = 0; m < 4; ++m) { bf16_t* rowp = O + (size_t)(row0 + ai * 128 + m * 16) * ldc + col0;
#pragma unroll
                for (int bj = 0; bj < 2; ++bj) *(u32x4*)(rowp + bj * 128) = pack8(acc[ai][bj][m][0], acc[ai][bj][m][1]); }
    }
};
struct EpiBranch {
    static constexpr bool PERM = true, AFTER_DRAIN = false;
    const bf16_t* gates; bf16_t* M;
    __device__ __forceinline__ void operator()(ACC_T, const pg8::Unit& u, int wr, int wc, int fr, int fq) const {
        const int row0 = u.pm * 256 + wr * 64 + fr, col0 = u.pn * 256 + wc * 32 + 8 * fq, br = u.aux;
#pragma unroll
        for (int ai = 0; ai < 2; ++ai)
#pragma unroll
            for (int m = 0; m < 4; ++m) { const int row = row0 + ai * 128 + m * 16;
#pragma unroll
                for (int bj = 0; bj < 2; ++bj) { const int col = col0 + bj * 128;
                    const u32x4 g = *(const u32x4*)(gates + (size_t)row * 6144 + br * 2048 + col);
                    f32x4 v0 = acc[ai][bj][m][0], v1 = acc[ai][bj][m][1];
                    v0[0] *= bflo(g.x); v0[1] *= bfhi(g.x); v0[2] *= bflo(g.y); v0[3] *= bfhi(g.y); v1[0] *= bflo(g.z); v1[1] *= bfhi(g.z); v1[2] *= bflo(g.w); v1[3] *= bfhi(g.w);
                    bf16_t* mp = M + (size_t)row * DM + col;
                    if (br > 0) { const u32x4 o = *(const u32x4*)mp; v0[0] += bflo(o.x); v0[1] += bfhi(o.x); v0[2] += bflo(o.y); v0[3] += bfhi(o.y); v1[0] += bflo(o.z); v1[1] += bfhi(o.z); v1[2] += bflo(o.w); v1[3] += bfhi(o.w); }
                    *(u32x4*)mp = pack8(v0, v1); } }
    }
};
struct EpiResid {
    static constexpr bool PERM = true, AFTER_DRAIN = false;
    const float* xold; float* x; bf16_t* xb; float* ssp;
    __device__ __forceinline__ void operator()(ACC_T, const pg8::Unit& u, int wr, int wc, int fr, int fq) const {
        const int row0 = u.pm * 256 + wr * 64 + fr, col0 = u.pn * 256 + wc * 32 + 8 * fq;
#pragma unroll
        for (int ai = 0; ai < 2; ++ai)
#pragma unroll
            for (int m = 0; m < 4; ++m) { const int row = row0 + ai * 128 + m * 16; float ss = 0.f;
#pragma unroll
                for (int bj = 0; bj < 2; ++bj) { const size_t off = (size_t)row * DM + col0 + bj * 128;
                    const f32x4 o0 = *(const f32x4*)(xold + off), o1 = *(const f32x4*)(xold + off + 4);
                    const f32x4 v0 = o0 + acc[ai][bj][m][0], v1 = o1 + acc[ai][bj][m][1];
                    *(f32x4*)(x + off) = v0; *(f32x4*)(x + off + 4) = v1; *(u32x4*)(xb + off) = pack8(v0, v1);
                    ss += (v0[0] * v0[0] + v0[1] * v0[1]) + (v0[2] * v0[2] + v0[3] * v0[3]) + (v1[0] * v1[0] + v1[1] * v1[1]) + (v1[2] * v1[2] + v1[3] * v1[3]); }
                ss += __shfl_xor(ss, 16); ss += __shfl_xor(ss, 32);
                if (fq == 0) ssp[(size_t)row * 32 + u.pn * 4 + wc] = ss; }
    }
};
struct EpiSwiglu {
    static constexpr bool PERM = true, AFTER_DRAIN = false;
    const float* rstd; bf16_t* hid;
    __device__ __forceinline__ void operator()(ACC_T, const pg8::Unit& u, int wr, int wc, int fr, int fq) const {
        const int row0 = u.pm * 256 + wr * 64 + fr, col0 = u.pn * 128 + wc * 32 + 8 * fq;
#pragma unroll
        for (int ai = 0; ai < 2; ++ai)
#pragma unroll
            for (int m = 0; m < 4; ++m) { const int row = row0 + ai * 128 + m * 16; const float rs = rstd[row];
                f32x4 h0, h1;
#pragma unroll
                for (int j = 0; j < 4; ++j) { const float g0 = acc[ai][0][m][0][j] * rs, u0 = acc[ai][1][m][0][j] * rs, g1 = acc[ai][0][m][1][j] * rs, u1 = acc[ai][1][m][1][j] * rs;
                    h0[j] = g0 * u0 * sigm(g0); h1[j] = g1 * u1 * sigm(g1); }
                *(u32x4*)(hid + (size_t)row * DFF + col0) = pack8(h0, h1); }
    }
};
struct EpiMoeDown {
    static constexpr bool PERM = true, AFTER_DRAIN = false;
    const int* rowtok; const float* roww; float* y;
    __device__ __forceinline__ void operator()(ACC_T, const pg8::Unit& u, int wr, int wc, int fr, int fq) const {
        const int row0 = u.pm * 256 + wr * 64 + fr, col0 = u.pn * 256 + wc * 32 + 8 * fq;
#pragma unroll
        for (int ai = 0; ai < 2; ++ai)
#pragma unroll
            for (int m = 0; m < 4; ++m) { const int row = row0 + ai * 128 + m * 16; const int tk = rowtok[row];
                if (tk >= 0) { const float w = roww[row]; float* d = y + (size_t)(tk & 1) * NTOK * DM + (size_t)(tk >> 1) * DM + col0;
#pragma unroll
                    for (int bj = 0; bj < 2; ++bj) { *(f32x4*)(d + bj * 128) = acc[ai][bj][m][0] * w; *(f32x4*)(d + bj * 128 + 4) = acc[ai][bj][m][1] * w; } } }
    }
};

struct Args { const float* in[22]; float* out; unsigned char* ws; int ph_lo, ph_hi; };

__host__ __device__ __forceinline__ int win_src(int n) {
    if (n < 1536) return n;
    if (n < 2048) return 1544 + (n - 1536);
    if (n < 4096) return 2056 + (n - 2048);
    if (n < 4352) return 4104 + (n - 4096);
    if (n < 4608) return 4360 + (n - 4352);
    if (n < 4672) return 4616 + (n - 4608);
    if (n < 4680) return 1536 + (n - 4672);
    if (n < 4684) return 4680 + (n - 4680);
    if (n < 4864) return -1;
    return 4684 + (n - 4864);
}

__device__ __forceinline__ void conv_matrix(int map, const float* W0, const float* W1, int K, int Ns, int dstN, bf16_t* WT, const float* gain, LAS float* scr, int gw, int NGW, int lane) {
    const int nblk = dstN >> 5, nit = (K >> 6) * nblk;
    for (int it = gw; it < nit; it += NGW) {
        const int kb = it / nblk, nb = it - kb * nblk, k0 = kb << 6, n0 = nb << 5;
        const float* src = W0; int sc;
        if (map == 0) sc = n0 + (lane & 31);
        else if (map == 1) sc = win_src(n0 + (lane & 31));
        else { const int t = nb >> 3, r = nb & 7; src = (r < 4) ? W0 : W1; sc = 128 * t + 32 * (r & 3) + (lane & 31); }
        const float* sp = src + (size_t)k0 * Ns + (sc < 0 ? 0 : sc);
#pragma unroll 8
        for (int i = 0; i < 32; ++i) { const int kk = 2 * i + (lane >> 5); float v = sp[(size_t)kk * Ns]; if (sc < 0) v = 0.f; scr[kk * 33 + (lane & 31)] = v; }
        LDS_WAIT(); asm volatile("" ::: "memory");
        const int c = lane & 7;
        f32x4 g0 = {1.f, 1.f, 1.f, 1.f}, g1 = {1.f, 1.f, 1.f, 1.f};
        if (gain) { g0 = *(const f32x4*)(gain + k0 + 8 * c); g1 = *(const f32x4*)(gain + k0 + 8 * c + 4); }
#pragma unroll
        for (int j = 0; j < 4; ++j) { const int n = (lane >> 3) + 8 * j; const LAS float* s = scr + (8 * c) * 33 + n;
            u32x4 o; o.x = pk2(s[0 * 33] * g0[0], s[1 * 33] * g0[1]); o.y = pk2(s[2 * 33] * g0[2], s[3 * 33] * g0[3]); o.z = pk2(s[4 * 33] * g1[0], s[5 * 33] * g1[1]); o.w = pk2(s[6 * 33] * g1[2], s[7 * 33] * g1[3]);
            *(u32x4*)(WT + (size_t)(n0 + n) * K + k0 + 8 * c) = o; }
        LDS_WAIT(); asm volatile("" ::: "memory");
    }
}

#define DOT16(acc_, base_) do { _Pragma("unroll") for (int c = 0; c < 2; ++c) { const u32x4 w = (base_)[c]; \
    acc_ += q[8 * c] * bflo(w.x) + q[8 * c + 1] * bfhi(w.x) + q[8 * c + 2] * bflo(w.y) + q[8 * c + 3] * bfhi(w.y) + q[8 * c + 4] * bflo(w.z) + q[8 * c + 5] * bfhi(w.z) + q[8 * c + 6] * bflo(w.w) + q[8 * c + 7] * bfhi(w.w); } \
    acc_ += __shfl_xor(acc_, 1); acc_ += __shfl_xor(acc_, 2); } while (0)
#define AXPY16(p_, base_) do { _Pragma("unroll") for (int c = 0; c < 2; ++c) { const u32x4 w = (base_)[c]; \
    o[8 * c] += (p_) * bflo(w.x); o[8 * c + 1] += (p_) * bfhi(w.x); o[8 * c + 2] += (p_) * bflo(w.y); o[8 * c + 3] += (p_) * bfhi(w.y); o[8 * c + 4] += (p_) * bflo(w.z); o[8 * c + 5] += (p_) * bfhi(w.z); o[8 * c + 6] += (p_) * bflo(w.w); o[8 * c + 7] += (p_) * bfhi(w.w); } } while (0)
constexpr float NEG_BIG = -1.0e30f;
template <int VAR> __device__ __forceinline__ void attn_naive_unit(LAS unsigned char* lds, int tid, int b, int h, int qb  ,
        const bf16_t* Q, int pq, const bf16_t* K, int pk, const bf16_t* V, int pv, const float* c2f, const unsigned* mask, const float* relb, const bf16_t* ogate, bf16_t* O) {
    asm volatile("" : "+v"(tid));
    LAS bf16_t* Ks = (LAS bf16_t*)lds; LAS bf16_t* Vs = Ks + 4096; LAS float* aux = (LAS float*)(lds + 16384);
    const int part = tid & 3, t = qb * 128 + (tid >> 2); const size_t row = (size_t)b * SEQ + t;
    float q[16], o[16];
    { const u32x4* qp = (const u32x4*)(Q + row * pq + h * 64 + part * 16);
#pragma unroll
      for (int c = 0; c < 2; ++c) { const u32x4 w = qp[c]; q[8 * c + 0] = bflo(w.x); q[8 * c + 1] = bfhi(w.x); q[8 * c + 2] = bflo(w.y); q[8 * c + 3] = bfhi(w.y); q[8 * c + 4] = bflo(w.z); q[8 * c + 5] = bfhi(w.z); q[8 * c + 6] = bflo(w.w); q[8 * c + 7] = bfhi(w.w); } }
#pragma unroll
    for (int d = 0; d < 16; ++d) o[d] = 0.f;
    float mrun = NEG_BIG, lrun = 0.f, R = 0.f, c2t = 0.f;
    if (VAR == 0) c2t = c2f[((size_t)b * NHEAD + h) * SEQ + t];
    if (VAR == 2) { if (tid < 128) {
            int bk; if (tid < 16) bk = tid; else { bk = 16 + (int)(logf((float)tid / 16.0f) / 2.0794415416798357f * 16.0f); if (bk > 31) bk = 31; }
            aux[tid] = relb[bk * NHEAD + h] * LOG2E; } }
    const int ntile = (qb * 128 + 128) / 64;
#pragma unroll 1
    for (int it = 0; it < ntile; ++it) {
        const int kt = (VAR == 1) ? ntile - 1 - it : it;
        __syncthreads();
        { const int key = tid >> 3, ch = tid & 7; const size_t kr = (size_t)b * SEQ + kt * 64 + key;
          *(LAS u32x4*)(Ks + key * 64 + ch * 8) = *(const u32x4*)(K + kr * pk + h * 64 + ch * 8);
          *(LAS u32x4*)(Vs + key * 64 + ch * 8) = *(const u32x4*)(V + kr * pv + h * 64 + ch * 8);
          if (VAR == 0 && tid < 64) aux[tid] = c2f[((size_t)b * NHEAD + h) * SEQ + kt * 64 + tid]; }
        __syncthreads();
        if (VAR == 1) {
#pragma unroll 1
            for (int j = 63; j >= 0; --j) { const int s = kt * 64 + j; const bool ok = s < t;
                float z = 0.f; DOT16(z, (const LAS u32x4*)(Ks + j * 64 + part * 16));
                R += ok ? softplus2(z) : 0.f; const float a = ok ? __builtin_amdgcn_exp2f(z - R) : 0.f;
                AXPY16(a, (const LAS u32x4*)(Vs + j * 64 + part * 16)); }
        } else {
            unsigned mw0 = 0xffffffffu, mw1 = 0xffffffffu;
            if (VAR == 2) { const u32x2 mm = *(const u32x2*)(mask + row * 64 + kt * 2); mw0 = mm.x; mw1 = mm.y; }
#pragma unroll 1
            for (int c8 = 0; c8 < 8; ++c8) {
                float lg[8]; float cm = NEG_BIG;
#pragma unroll
                for (int jj = 0; jj < 8; ++jj) { const int j = c8 * 8 + jj, s = kt * 64 + j;
                    bool ok = s <= t; if (VAR == 2) ok = ok && (((j < 32 ? mw0 : mw1) >> (j & 31)) & 1u);
                    float z = 0.f; DOT16(z, (const LAS u32x4*)(Ks + j * 64 + part * 16));
                    if (VAR == 0) z += c2t - aux[j]; else { int dd = t - s; dd = dd < 0 ? 0 : (dd > 127 ? 127 : dd); z += aux[dd]; }
                    lg[jj] = ok ? z : NEG_BIG; cm = fmaxf(cm, lg[jj]); }
                const float newm = fmaxf(mrun, cm), f = __builtin_amdgcn_exp2f(mrun - newm); lrun *= f; mrun = newm;
#pragma unroll
                for (int d = 0; d < 16; ++d) o[d] *= f;
#pragma unroll
                for (int jj = 0; jj < 8; ++jj) { const float p = (lg[jj] > -1.0e29f) ? __builtin_amdgcn_exp2f(lg[jj] - mrun) : 0.f; lrun += p;
                    AXPY16(p, (const LAS u32x4*)(Vs + (c8 * 8 + jj) * 64 + part * 16)); }
            }
        }
    }
    float inv = 1.f; if (VAR != 1) inv = 1.f / lrun;
    u32x4* op = (u32x4*)(O + row * 512 + h * 64 + part * 16);
#pragma unroll
    for (int c = 0; c < 2; ++c) { float v[8];
#pragma unroll
        for (int i = 0; i < 8; ++i) v[i] = o[8 * c + i] * inv;
        if (VAR == 0) { const u32x4 g = *(const u32x4*)(ogate + row * 512 + h * 64 + part * 16 + 8 * c); v[0] *= bflo(g.x); v[1] *= bfhi(g.x); v[2] *= bflo(g.y); v[3] *= bfhi(g.y); v[4] *= bflo(g.z); v[5] *= bfhi(g.z); v[6] *= bflo(g.w); v[7] *= bfhi(g.w); }
        u32x4 w; w.x = pk2(v[0], v[1]); w.y = pk2(v[2], v[3]); w.z = pk2(v[4], v[5]); w.w = pk2(v[6], v[7]); op[c] = w; }
    __syncthreads();
}

__device__ __forceinline__ void select_row(const float* sc_row, unsigned* mask_row, int t, int lane) {
    asm volatile("" : "+v"(lane));
    if (t < 256) { const int lo = 32 * lane; mask_row[lane] = (t >= lo + 31) ? 0xffffffffu : (t < lo ? 0u : ((2u << (t - lo)) - 1u)); return; }
    unsigned key[32];
#pragma unroll
    for (int j = 0; j < 32; ++j) { const int s = 64 * j + lane; const unsigned u = __float_as_uint(sc_row[s <= t ? s : t]); const unsigned k = (u & 0x80000000u) ? ~u : (u | 0x80000000u); key[j] = (s <= t) ? k : 0u; }
    unsigned T = 0u;
    for (int bit = 31; bit >= 0; --bit) { const unsigned cand = T | (1u << bit); int c = 0;
#pragma unroll
        for (int j = 0; j < 32; ++j) c += (key[j] >= cand) ? 1 : 0;
#pragma unroll
        for (int o = 1; o < 64; o <<= 1) c += __shfl_xor(c, o);
        if (c >= 256) T = cand; }
    int gt = 0;
#pragma unroll
    for (int j = 0; j < 32; ++j) gt += (key[j] > T) ? 1 : 0;
#pragma unroll
    for (int o = 1; o < 64; o <<= 1) gt += __shfl_xor(gt, o);
    const int need = 256 - gt; int run = 0; unsigned myw = 0u;
#pragma unroll
    for (int j = 0; j < 32; ++j) { const bool eq = key[j] == T; const unsigned long long beq = __ballot(eq);
        const int pre = run + (int)__builtin_amdgcn_mbcnt_hi((unsigned)(beq >> 32), __builtin_amdgcn_mbcnt_lo((unsigned)beq, 0u));
        const bool sel = (key[j] > T) || (eq && pre < need); run += __popcll(beq);
        const unsigned long long bs = __ballot(sel); myw = (lane == 2 * j) ? (unsigned)bs : myw; myw = (lane == 2 * j + 1) ? (unsigned)(bs >> 32) : myw; }
    mask_row[lane] = myw;
}

typedef __attribute__((address_space(4))) const char* kptr_t; typedef const float* cfp_t; typedef const __attribute__((address_space(4))) cfp_t* kslot_t;
__device__ __forceinline__ const float* arg_ptr(int i) { kptr_t ka = (kptr_t)__builtin_amdgcn_kernarg_segment_ptr(); asm volatile("" : "+s"(ka)); return *(kslot_t)(ka + 8 * i); }
__global__ void __launch_bounds__(512, 2) mk_fwd(Args args) {
    extern __shared__ __attribute__((aligned(16))) unsigned char lds_raw[];
    LAS unsigned char* lds = (LAS unsigned char*)lds_raw;
    volatile LAS unsigned* MISC = (volatile LAS unsigned*)(lds + MISC_OFF);
    const int G = gridDim.x, bid = blockIdx.x, NGW = G * 8;
    unsigned* ctl = (unsigned*)((unsigned char*)arg_ptr(23) + WS_CTL);
    for (int u = threadIdx.x; u < (LDS_BYTES - LDSCTL_OFF) / 4; u += 512) ((LAS unsigned*)(lds + LDSCTL_OFF))[u] = 0u;
#define SITE_PROLOG unsigned char* ws = (unsigned char*)arg_ptr(23); int tid = threadIdx.x; asm volatile("" : "+v"(tid)); \
    const int lane = tid & 63, wave = __builtin_amdgcn_readfirstlane(tid >> 6), gw = bid * 8 + wave; (void)ws; (void)lane; (void)gw;
    __syncthreads();
    const int lo = args.ph_lo, hi = args.ph_hi;
    XcdBarrier bar; bar.bar = ctl + CW_BAR; bar.x = 0; bar.st = nullptr;
    if (hi - lo > 1) bar = xcd_barrier_post(ctl + CW_BAR, MISC + 8);
#define x_in arg_ptr(0)
#define w_in arg_ptr(1)
#define b_forget arg_ptr(2)
#define q_norm arg_ptr(3)
#define k_norm arg_ptr(4)
#define kv_norm arg_ptr(5)
#define w_ukv arg_ptr(6)
#define w_br0 arg_ptr(7)
#define w_br1 arg_ptr(8)
#define w_br2 arg_ptr(9)
#define w_out arg_ptr(10)
#define rel_bias arg_ptr(11)
#define norm_mix arg_ptr(12)
#define norm_ffn arg_ptr(13)
#define w_fg arg_ptr(14)
#define w_fu arg_ptr(15)
#define w_fd arg_ptr(16)
#define w_router arg_ptr(17)
#define w_mg arg_ptr(18)
#define w_mu arg_ptr(19)
#define w_md arg_ptr(20)
#define norm_final arg_ptr(21)
#define X ((float*)arg_ptr(22))
#define WIN ((bf16_t*)(ws + WS_WIN))
#define WUKV ((bf16_t*)(ws + WS_WUKV))
#define WBR ((bf16_t*)(ws + WS_WBR))
#define WOUT ((bf16_t*)(ws + WS_WOUT))
#define WGU0 ((bf16_t*)(ws + WS_WGU0))
#define WD0 ((bf16_t*)(ws + WS_WD0))
#define WGUM ((bf16_t*)(ws + WS_WGUM))
#define WDM ((bf16_t*)(ws + WS_WDM))
#define RSTD ((float*)(ws + WS_RSTD))
#define SSP ((float*)(ws + WS_SSP))
#define XB ((bf16_t*)(ws + WS_XB))
#define Z8 ((bf16_t*)(ws + WS_Z8))
#define DLAT ((bf16_t*)(ws + WS_DLAT))
#define DIQ ((bf16_t*)(ws + WS_DIQ))
#define DIK ((bf16_t*)(ws + WS_DIK))
#define FFW ((float*)(ws + WS_FFW))
#define GATES ((bf16_t*)(ws + WS_GATES))
#define C2F ((float*)(ws + WS_C2F))
#define DKV ((bf16_t*)(ws + WS_DKV))
#define SC ((float*)(ws + WS_SC))
#define MASK ((unsigned*)(ws + WS_MASK))
#define YATT ((bf16_t*)(ws + WS_YATT))
#define MB ((bf16_t*)(ws + WS_M))
#define HID ((bf16_t*)(ws + WS_HID))
#define XG ((bf16_t*)(ws + WS_XG))
#define HIDM ((bf16_t*)(ws + WS_HIDM))
#define Y ((float*)(ws + WS_Y))
#define ROWTOK ((int*)(ws + WS_ROWTOK))
#define ROWW ((float*)(ws + WS_ROWW))
#define RSTDG ((float*)(ws + WS_RSTDG))
#define TOKINFO ((int*)(ws + WS_TOKINFO))
#define TOKW ((float*)(ws + WS_TOKW))
#define WGCNT ((int*)(ws + WS_WGCNT))
#define META ((int*)(ws + WS_META))

    int step = 0;
#define STEP_IF if (step >= lo && step < hi)
#define STEP_END do { if (step >= lo && step + 1 < hi) xcd_barrier(bar); ++step; } while (0)

    if (SITE_ON(0)) STEP_IF { SITE_PROLOG
        LAS float* scr = (LAS float*)(lds + wave * 16384);
        for (int l = 0; l < 2; ++l) {
            conv_matrix(1, w_in + (size_t)l * DM * NIN, nullptr, DM, NIN, NINP, WIN + (size_t)l * NINP * DM, norm_mix + l * DM, scr, gw, NGW, lane);
            conv_matrix(0, w_ukv + (size_t)l * KVR * 1024, nullptr, KVR, 1024, 1024, WUKV + (size_t)l * 1024 * KVR, kv_norm + l * KVR, scr, gw, NGW, lane);
            conv_matrix(0, w_br0 + (size_t)l * WBR_W * DM, nullptr, WBR_W, DM, DM, WBR + (size_t)(l * 3 + 0) * DM * WBR_W, nullptr, scr, gw, NGW, lane);
            conv_matrix(0, w_br1 + (size_t)l * WBR_W * DM, nullptr, WBR_W, DM, DM, WBR + (size_t)(l * 3 + 1) * DM * WBR_W, nullptr, scr, gw, NGW, lane);
            conv_matrix(0, w_br2 + (size_t)l * WBR_W * DM, nullptr, WBR_W, DM, DM, WBR + (size_t)(l * 3 + 2) * DM * WBR_W, nullptr, scr, gw, NGW, lane);
            conv_matrix(0, w_out + (size_t)l * DM * DM, nullptr, DM, DM, DM, WOUT + (size_t)l * DM * DM, nullptr, scr, gw, NGW, lane);
        }
        conv_matrix(2, w_fg, w_fu, DM, DFF, 2 * DFF, WGU0, norm_ffn, scr, gw, NGW, lane);
        conv_matrix(0, w_fd, nullptr, DFF, DM, DM, WD0, nullptr, scr, gw, NGW, lane);
        for (int e = 0; e < NEXP; ++e) {
            conv_matrix(2, w_mg + (size_t)e * DM * DFF, w_mu + (size_t)e * DM * DFF, DM, DFF, 2 * DFF, WGUM + (size_t)e * 2 * DFF * DM, norm_ffn + DM, scr, gw, NGW, lane);
            conv_matrix(0, w_md + (size_t)e * DFF * DM, nullptr, DFF, DM, DM, WDM + (size_t)e * DM * DFF, nullptr, scr, gw, NGW, lane);
        }
        for (int m = gw; m < NTOK; m += NGW) {
            const f32x4* xr = (const f32x4*)(x_in + (size_t)m * DM) + lane; f32x4 v[8]; float s = 0.f;
#pragma unroll
            for (int j = 0; j < 8; ++j) { v[j] = xr[64 * j]; s += (v[j][0] * v[j][0] + v[j][1] * v[j][1]) + (v[j][2] * v[j][2] + v[j][3] * v[j][3]); }
            s = wave_sum(s);
            u32x2* o = (u32x2*)(XB + (size_t)m * DM) + lane;
#pragma unroll
            for (int j = 0; j < 8; ++j) { u32x2 w; w.x = pk2(v[j][0], v[j][1]); w.y = pk2(v[j][2], v[j][3]); o[64 * j] = w; }
            if (lane == 0) RSTD[m] = 1.0f / sqrtf(s * (1.0f / DM) + EPS);
        }
    }
    STEP_END;

    for (int l = 0; l < 2; ++l) {
        if (SITE_ON(1)) STEP_IF { SITE_PROLOG
            pg8::PlainOrder S; S.init(NTOK / 256, NINP / 256, G, bid); S.A = (const char*)XB; S.ta = (size_t)256 * DM * 2; S.B = (const char*)(WIN + (size_t)l * NINP * DM); S.tb = (size_t)256 * DM * 2;
            EpiWin E{RSTD, Z8, DLAT, DIQ, DIK, FFW, GATES};
            pg8::gemm_phase<EpiWin, pg8::PlainOrder, true, true>(lds, pg8::Gemm{opq(DM)}, S, E);
        }
        STEP_END;
        if (SITE_ON(2)) STEP_IF { SITE_PROLOG
            for (int m = gw; m < NTOK; m += NGW) {
#pragma unroll
                for (int which = 0; which < 2; ++which) {
                    bf16_t* p = Z8 + (size_t)which * NTOK * 512 + (size_t)m * 512 + 8 * lane; const u32x4 w = *(const u32x4*)p;
                    float v[8] = {bflo(w.x), bfhi(w.x), bflo(w.y), bfhi(w.y), bflo(w.z), bfhi(w.z), bflo(w.w), bfhi(w.w)}; float ss = 0.f;
#pragma unroll
                    for (int i = 0; i < 8; ++i) ss += v[i] * v[i];
                    ss += __shfl_xor(ss, 1); ss += __shfl_xor(ss, 2); ss += __shfl_xor(ss, 4);
                    const float rs = (1.0f / sqrtf(ss * (1.0f / 64.0f) + EPS)) * (which == 0 ? C2 : 1.0f);
                    const float* gp = (which == 0 ? q_norm : k_norm) + l * HD + 8 * (lane & 7); const f32x4 g0 = *(const f32x4*)gp, g1 = *(const f32x4*)(gp + 4);
                    u32x4 o; o.x = pk2(v[0] * rs * g0[0], v[1] * rs * g0[1]); o.y = pk2(v[2] * rs * g0[2], v[3] * rs * g0[3]); o.z = pk2(v[4] * rs * g1[0], v[5] * rs * g1[1]); o.w = pk2(v[6] * rs * g1[2], v[7] * rs * g1[3]);
                    *(u32x4*)p = o;
                }
                { bf16_t* p = DLAT + (size_t)m * 256 + 4 * lane; const u32x2 w = *(const u32x2*)p; const float a0 = bflo(w.x), a1 = bfhi(w.x), a2 = bflo(w.y), a3 = bfhi(w.y);
                  const float ss = wave_sum((a0 * a0 + a1 * a1) + (a2 * a2 + a3 * a3)); const float rs = 1.0f / sqrtf(ss * (1.0f / 256.0f) + EPS);
                  u32x2 o; o.x = pk2(a0 * rs, a1 * rs); o.y = pk2(a2 * rs, a3 * rs); *(u32x2*)p = o; }
            }
            if (gw < NBATCH * NHEAD) {
                const int b = gw >> 3, h = gw & 7; const float bias = b_forget[l * NHEAD + h];
                const float* fp = FFW + ((size_t)b * SEQ + 32 * lane) * 16 + h; float tot = 0.f;
                for (int i = 0; i < 32; ++i) tot += -softplus2(-(fp[i * 16] + bias) * LOG2E);
                float inc = tot;
#pragma unroll
                for (int o = 1; o < 64; o <<= 1) { const float tv = __shfl_up(inc, o); if (lane >= o) inc += tv; }
                float run = inc - tot; float* cp = C2F + ((size_t)b * NHEAD + h) * SEQ + 32 * lane;
                for (int i = 0; i < 32; ++i) { run += -softplus2(-(fp[i * 16] + bias) * LOG2E); cp[i] = run; }
            }
        }
        STEP_END;
        if (SITE_ON(3)) STEP_IF { SITE_PROLOG
            { pg8::PlainOrder S; S.init(NTOK / 256, 4, G, bid); S.A = (const char*)DLAT; S.ta = (size_t)256 * KVR * 2; S.B = (const char*)(WUKV + (size_t)l * 1024 * KVR); S.tb = (size_t)256 * KVR * 2;
              EpiPlain E{DKV, 1024};
              pg8::gemm_phase<EpiPlain, pg8::PlainOrder, true, true>(lds, pg8::Gemm{opq(KVR)}, S, E); }
            if ((wave & 3) == 0) {
                const int k = (bid * 2 + (wave >> 2)) % 512, pr = k >> 1, b = pr >> 5, uu = pr & 31, tt = (k & 1) ? 63 - uu : uu;
                int ln = lane; asm volatile("" : "+v"(ln)); const int r32 = ln & 31, hh = ln >> 5; const size_t trow = (size_t)b * SEQ + tt * 32 + r32;
                bf16x8 bq[4][4];
#pragma unroll
                for (int h = 0; h < 4; ++h)
#pragma unroll
                    for (int d0 = 0; d0 < 4; ++d0) bq[h][d0] = *(const bf16x8*)(DIQ + trow * 256 + h * 64 + d0 * 16 + 8 * hh);
                const f32x4 wv = *(const f32x4*)(FFW + trow * 16 + 8) * 0.0625f;
                for (int st = 0; st <= tt; ++st) {
                    const size_t srow = (size_t)b * SEQ + st * 32 + r32; bf16x8 ak[4];
#pragma unroll
                    for (int d0 = 0; d0 < 4; ++d0) ak[d0] = *(const bf16x8*)(DIK + srow * 64 + d0 * 16 + 8 * hh);
                    f32x16 sc;
#pragma unroll
                    for (int r = 0; r < 16; ++r) sc[r] = 0.f;
#pragma unroll
                    for (int h = 0; h < 4; ++h) { f32x16 a;
#pragma unroll
                        for (int r = 0; r < 16; ++r) a[r] = 0.f;
#pragma unroll
                        for (int d0 = 0; d0 < 4; ++d0) a = __builtin_amdgcn_mfma_f32_32x32x16_bf16(ak[d0], bq[h][d0], a, 0, 0, 0);
#pragma unroll
                        for (int r = 0; r < 16; ++r) sc[r] += fmaxf(a[r], 0.f) * wv[h]; }
                    float* sp = SC + trow * SEQ + st * 32 + 4 * hh;
#pragma unroll
                    for (int g = 0; g < 4; ++g) *(f32x4*)(sp + 8 * g) = (f32x4){sc[4 * g], sc[4 * g + 1], sc[4 * g + 2], sc[4 * g + 3]};
                }
            }
        }
        STEP_END;
        if (SITE_ON(4)) STEP_IF { SITE_PROLOG
            for (int idx = gw; idx < NTOK; idx += NGW) { const int b = idx / SEQ, t0 = idx - b * SEQ, t = (b & 1) ? SEQ - 1 - t0 : t0; const size_t row = (size_t)b * SEQ + t;
                select_row(SC + row * SEQ, MASK + row * 64, t, lane); }
        }
        STEP_END;
        if (SITE_ON(5)) STEP_IF { SITE_PROLOG
            for (int i = 0; i < 12; ++i) { const int U = i * G + bid; if (U >= 3072) break;
                const int var = U >> 10, rem = U & 1023, bh = rem >> 4, qb = (i & 1) ? 15 - (rem & 15) : (rem & 15), b = bh >> 3, h = bh & 7;
                if (var == 0) attn_naive_unit<0>(lds, tid, b, h, qb, Z8, 512, Z8 + (size_t)1 * NTOK * 512, 512, Z8 + (size_t)2 * NTOK * 512, 512, C2F, nullptr, nullptr, Z8 + (size_t)3 * NTOK * 512, YATT);
                else if (var == 1) attn_naive_unit<1>(lds, tid, b, h, qb, Z8 + (size_t)4 * NTOK * 512, 512, Z8 + (size_t)5 * NTOK * 512, 512, Z8 + (size_t)6 * NTOK * 512, 512, nullptr, nullptr, nullptr, nullptr, YATT + (size_t)NTOK * 512);
                else attn_naive_unit<2>(lds, tid, b, h, qb, Z8 + (size_t)7 * NTOK * 512, 512, DKV, 1024, DKV + 512, 1024, nullptr, MASK, rel_bias, nullptr, YATT + (size_t)2 * NTOK * 512);
            }
        }
        STEP_END;
        if (SITE_ON(6)) STEP_IF { SITE_PROLOG
            pg8::BranchOrder S; S.init(NTOK / 256, DM / 256, G, bid); S.A = (const char*)YATT; S.ta = (size_t)256 * WBR_W * 2; S.za = (size_t)NTOK * WBR_W * 2;
            S.B = (const char*)(WBR + (size_t)l * 3 * DM * WBR_W); S.tb = (size_t)256 * WBR_W * 2; S.zb = (size_t)DM * WBR_W * 2;
            EpiBranch E{GATES, MB};
            pg8::gemm_phase<EpiBranch, pg8::BranchOrder, true, true>(lds, pg8::Gemm{opq(WBR_W)}, S, E);
        }
        STEP_END;
        if (SITE_ON(7)) STEP_IF { SITE_PROLOG
            pg8::PlainOrder S; S.init(NTOK / 256, DM / 256, G, bid); S.A = (const char*)MB; S.ta = (size_t)256 * DM * 2; S.B = (const char*)(WOUT + (size_t)l * DM * DM); S.tb = (size_t)256 * DM * 2;
            EpiResid E{l == 0 ? x_in : (const float*)X, X, XB, SSP};
            pg8::gemm_phase<EpiResid, pg8::PlainOrder, true, true>(lds, pg8::Gemm{opq(DM)}, S, E);
        }
        STEP_END;
        if (l == 0) {
            if (SITE_ON(8)) STEP_IF { SITE_PROLOG for (int r = bid * 512 + tid; r < NTOK; r += G * 512) { const f32x4* p = (const f32x4*)(SSP + (size_t)r * 32); float s = 0.f;
#pragma unroll
                    for (int j = 0; j < 8; ++j) { const f32x4 v = p[j]; s += (v[0] + v[1]) + (v[2] + v[3]); }
                    RSTD[r] = 1.0f / sqrtf(s * (1.0f / DM) + EPS); } }
            STEP_END;
            if (SITE_ON(9)) STEP_IF { SITE_PROLOG
                pg8::PlainOrder S; S.init(NTOK / 256, DFF / 128, G, bid); S.A = (const char*)XB; S.ta = (size_t)256 * DM * 2; S.B = (const char*)WGU0; S.tb = (size_t)256 * DM * 2;
                EpiSwiglu E{RSTD, HID};
                pg8::gemm_phase<EpiSwiglu, pg8::PlainOrder, true, true>(lds, pg8::Gemm{opq(DM)}, S, E);
            }
            STEP_END;
            if (SITE_ON(10)) STEP_IF { SITE_PROLOG
                pg8::PlainOrder S; S.init(NTOK / 256, DM / 256, G, bid); S.A = (const char*)HID; S.ta = (size_t)256 * DFF * 2; S.B = (const char*)WD0; S.tb = (size_t)256 * DFF * 2;
                EpiResid E{X, X, XB, SSP};
                pg8::gemm_phase<EpiResid, pg8::PlainOrder, true, true>(lds, pg8::Gemm{opq(DFF)}, S, E);
            }
            STEP_END;
            if (SITE_ON(11)) STEP_IF { SITE_PROLOG for (int r = bid * 512 + tid; r < NTOK; r += G * 512) { const f32x4* p = (const f32x4*)(SSP + (size_t)r * 32); float s = 0.f;
#pragma unroll
                    for (int j = 0; j < 8; ++j) { const f32x4 v = p[j]; s += (v[0] + v[1]) + (v[2] + v[3]); }
                    RSTD[r] = 1.0f / sqrtf(s * (1.0f / DM) + EPS); } }
            STEP_END;
        } else {
            if (SITE_ON(12)) STEP_IF { SITE_PROLOG
                LAS int* le = (LAS int*)lds;
                for (int wgi = bid; wgi < NTOK / 64; wgi += G) {
                    __syncthreads();
                    for (int i = 0; i < 8; ++i) { const int tl = wave * 8 + i, tok = wgi * 64 + tl;
                        const f32x4* xr = (const f32x4*)(X + (size_t)tok * DM) + lane; f32x4 v[8]; float s = 0.f;
#pragma unroll
                        for (int j = 0; j < 8; ++j) { v[j] = xr[64 * j]; s += (v[j][0] * v[j][0] + v[j][1] * v[j][1]) + (v[j][2] * v[j][2] + v[j][3] * v[j][3]); }
                        s = wave_sum(s); const float rs = 1.0f / sqrtf(s * (1.0f / DM) + EPS);
                        float lg[8];
#pragma unroll
                        for (int e = 0; e < 8; ++e) lg[e] = 0.f;
#pragma unroll
                        for (int j = 0; j < 8; ++j) { const int k0 = 256 * j + 4 * lane; const f32x4 gn = *(const f32x4*)(norm_ffn + DM + k0);
#pragma unroll
                            for (int c = 0; c < 4; ++c) { const float xg = v[j][c] * gn[c]; const f32x4 w0 = *(const f32x4*)(w_router + (size_t)(k0 + c) * 8), w1 = *(const f32x4*)(w_router + (size_t)(k0 + c) * 8 + 4);
                                lg[0] += xg * w0[0]; lg[1] += xg * w0[1]; lg[2] += xg * w0[2]; lg[3] += xg * w0[3]; lg[4] += xg * w1[0]; lg[5] += xg * w1[1]; lg[6] += xg * w1[2]; lg[7] += xg * w1[3]; } }
#pragma unroll
                        for (int e = 0; e < 8; ++e) lg[e] = wave_sum(lg[e]) * rs;
                        float v0 = lg[0]; int i0 = 0;
#pragma unroll
                        for (int e = 1; e < 8; ++e) if (lg[e] > v0) { v0 = lg[e]; i0 = e; }
                        float v1 = -INFINITY; int i1 = 0;
#pragma unroll
                        for (int e = 0; e < 8; ++e) if (e != i0 && lg[e] > v1) { v1 = lg[e]; i1 = e; }
                        const float ex = __expf(v1 - v0), w0 = 1.0f / (1.0f + ex), w1 = ex / (1.0f + ex);
                        if (lane == 0) { le[tl * 2] = i0; le[tl * 2 + 1] = i1; TOKW[(size_t)tok * 2] = w0; TOKW[(size_t)tok * 2 + 1] = w1; RSTD[tok] = rs; }
                    }
                    __syncthreads();
                    if (tid < 128) { const int e = le[tid]; int rk = 0; for (int j = 0; j < tid; ++j) rk += (le[j] == e); const int tok = wgi * 64 + (tid >> 1);
                        TOKINFO[((size_t)tok * 2 + (tid & 1)) * 2] = e; TOKINFO[((size_t)tok * 2 + (tid & 1)) * 2 + 1] = rk; }
                    if (tid >= 128 && tid < 136) { const int e = tid - 128; int c = 0; for (int j = 0; j < 128; ++j) c += (le[j] == e); WGCNT[wgi * 8 + e] = c; }
                }
            }
            STEP_END;
            if (SITE_ON(13)) STEP_IF { SITE_PROLOG
                LAS int* lc = (LAS int*)lds;
                for (int wgi = bid; wgi < NTOK / 64; wgi += G) {
                    __syncthreads();
                    { const int e = wave; int all = 0, before = 0;
#pragma unroll
                      for (int c = 0; c < 4; ++c) { const int w = 4 * lane + c; const int v = WGCNT[w * 8 + e]; all += v; before += (w < wgi) ? v : 0; }
#pragma unroll
                      for (int o = 1; o < 64; o <<= 1) { all += __shfl_xor(all, o); before += __shfl_xor(before, o); }
                      if (lane == 0) { lc[e] = all; lc[8 + e] = before; } }
                    __syncthreads();
                    if (tid == 0) { int tb = 0; for (int e = 0; e < 8; ++e) { lc[16 + e] = tb * 256; tb += (lc[e] + 255) >> 8; if (wgi == 0) META[e] = lc[16 + e] >> 8; } if (wgi == 0) META[8] = tb; }
                    __syncthreads();
                    for (int i = 0; i < 16; ++i) { const int p = wave * 16 + i, tok = wgi * 64 + (p >> 1), slot = p & 1;
                        const int e = TOKINFO[((size_t)tok * 2 + slot) * 2], rk = TOKINFO[((size_t)tok * 2 + slot) * 2 + 1]; const int r = lc[16 + e] + lc[8 + e] + rk;
                        const u32x4* sp = (const u32x4*)(XB + (size_t)tok * DM) + lane; u32x4* dp = (u32x4*)(XG + (size_t)r * DM) + lane;
#pragma unroll
                        for (int c = 0; c < 4; ++c) dp[64 * c] = sp[64 * c];
                        if (lane == 0) { ROWTOK[r] = tok * 2 + slot; ROWW[r] = TOKW[(size_t)tok * 2 + slot]; RSTDG[r] = RSTD[tok]; } }
                    if (wgi < 8) { const int e = wgi, r0 = lc[16 + e] + lc[e], r1 = lc[16 + e] + (((lc[e] + 255) >> 8) << 8);
                        for (int r = r0 + wave; r < r1; r += 8) { u32x4* dp = (u32x4*)(XG + (size_t)r * DM) + lane;
#pragma unroll
                            for (int c = 0; c < 4; ++c) dp[64 * c] = (u32x4){0u, 0u, 0u, 0u};
                            if (lane == 0) { ROWTOK[r] = -1; ROWW[r] = 0.f; RSTDG[r] = 0.f; } } }
                }
            }
            STEP_END;
            if (SITE_ON(14)) STEP_IF { SITE_PROLOG
                pg8::MoeOrder S; S.t1 = META[1]; S.t2 = META[2]; S.t3 = META[3]; S.t4 = META[4]; S.t5 = META[5]; S.t6 = META[6]; S.t7 = META[7];
                S.init(META[8], DFF / 128, G, bid); S.A = (const char*)XG; S.ta = (size_t)256 * DM * 2; S.B = (const char*)WGUM; S.tb = (size_t)256 * DM * 2; S.zb = SZ_WGU;
                EpiSwiglu E{RSTDG, HIDM};
                pg8::gemm_phase<EpiSwiglu, pg8::MoeOrder, true, true>(lds, pg8::Gemm{opq(DM)}, S, E);
            }
            STEP_END;
            if (SITE_ON(15)) STEP_IF { SITE_PROLOG
                pg8::MoeOrder S; S.t1 = META[1]; S.t2 = META[2]; S.t3 = META[3]; S.t4 = META[4]; S.t5 = META[5]; S.t6 = META[6]; S.t7 = META[7];
                S.init(META[8], DM / 256, G, bid); S.A = (const char*)HIDM; S.ta = (size_t)256 * DFF * 2; S.B = (const char*)WDM; S.tb = (size_t)256 * DFF * 2; S.zb = SZ_WD;
                EpiMoeDown E{ROWTOK, ROWW, Y};
                pg8::gemm_phase<EpiMoeDown, pg8::MoeOrder, true, true>(lds, pg8::Gemm{opq(DFF)}, S, E);
            }
            STEP_END;
            if (SITE_ON(16)) STEP_IF { SITE_PROLOG
                for (int m = gw; m < NTOK; m += NGW) {
                    f32x4* xr = (f32x4*)(X + (size_t)m * DM) + lane; const f32x4* y0 = (const f32x4*)(Y + (size_t)m * DM) + lane; const f32x4* y1 = (const f32x4*)(Y + (size_t)NTOK * DM + (size_t)m * DM) + lane;
                    f32x4 v[8]; float s = 0.f;
#pragma unroll
                    for (int j = 0; j < 8; ++j) { v[j] = xr[64 * j] + y0[64 * j] + y1[64 * j]; s += (v[j][0] * v[j][0] + v[j][1] * v[j][1]) + (v[j][2] * v[j][2] + v[j][3] * v[j][3]); }
                    s = wave_sum(s); const float rs = 1.0f / sqrtf(s * (1.0f / DM) + EPS);
#pragma unroll
                    for (int j = 0; j < 8; ++j) { const f32x4 g = *((const f32x4*)norm_final + lane + 64 * j); xr[64 * j] = v[j] * rs * g; }
                }
            }
            STEP_END;
        }
    }
#undef STEP_IF
#undef STEP_END
}


#ifndef DBG_STOP
#define DBG_STOP -1
#endif
#ifndef DBG_LO
#define DBG_LO WS_WIN
#endif
#if DBG_STOP >= 0
__global__ void dbg_dump(const unsigned short* ws16, size_t n16, const unsigned* xin, float* out, int with_x) {
    for (size_t i = (size_t)blockIdx.x * blockDim.x + threadIdx.x; i < (size_t)NTOK * DM; i += (size_t)gridDim.x * blockDim.x) {
        unsigned acc = 0; for (size_t off = i; off < n16; off += (size_t)NTOK * DM) acc += ws16[off];
        if (with_x) { const unsigned u = xin[i]; acc += (u & 0xffffu) + (u >> 16); }
        out[i] = (float)(acc & 0xfffffu);
    }
}
#endif

#if DBG_STOP == 100
__global__ void dbg_cmp3(const unsigned short* a0, const unsigned short* b0, const unsigned short* a1, const unsigned short* b1, const unsigned short* a2, const unsigned short* b2, unsigned* cnt) {
    unsigned c0 = 0, c1 = 0, c2 = 0;
    for (size_t i = (size_t)blockIdx.x * blockDim.x + threadIdx.x; i < (size_t)NTOK * DM; i += (size_t)gridDim.x * blockDim.x) { c0 += a0[i] != b0[i]; c1 += a1[i] != b1[i]; c2 += a2[i] != b2[i]; }
    if (c0) atomicAdd(cnt, c0); if (c1) atomicAdd(cnt + 1, c1); if (c2) atomicAdd(cnt + 2, c2);
}
__global__ void dbg_fill(float* out, const unsigned* cnt) {
    const float E = (cnt[0] ? 3.f : 0.f) + (cnt[1] ? 10.f : 0.f) + (cnt[2] ? 30.f : 0.f);
    for (size_t i = (size_t)blockIdx.x * blockDim.x + threadIdx.x; i < (size_t)NTOK * DM; i += (size_t)gridDim.x * blockDim.x) out[i] = E;
}
#endif

#if DBG_STOP == 200
__global__ void dbg_cksum(const unsigned long long* p, size_t nblk, unsigned long long* ck) {
    for (size_t b = (size_t)blockIdx.x * blockDim.x + threadIdx.x; b < nblk; b += (size_t)gridDim.x * blockDim.x) {
        unsigned long long h = 0x9E3779B97F4A7C15ull; const unsigned long long* q = p + b * 128;
        for (int i = 0; i < 128; ++i) { h ^= q[i]; h *= 0xBF58476D1CE4E5B9ull; h ^= h >> 29; }
        ck[b] = h; }
}
__global__ void dbg_ckcmp(const unsigned long long* a, const unsigned long long* b, size_t nblk, unsigned long long* first) {
    for (size_t i = (size_t)blockIdx.x * blockDim.x + threadIdx.x; i < nblk; i += (size_t)gridDim.x * blockDim.x) if (a[i] != b[i]) atomicMin(first, (unsigned long long)i);
}
__global__ void dbg_fill2(float* out, const unsigned long long* first) {
    const unsigned long long off = WS_RSTD + (*first) * 1024ull; int id = 0;
    if (*first != ~0ull) { id = 1; if (off >= WS_Z8) id = 2; if (off >= WS_DLAT) id = 3; if (off >= WS_DIQ) id = 4; if (off >= WS_DIK) id = 5; if (off >= WS_FFW) id = 6; if (off >= WS_GATES) id = 7; if (off >= WS_C2F) id = 8;
        if (off >= WS_DKV) id = 9; if (off >= WS_SC) id = 10; if (off >= WS_MASK) id = 11; if (off >= WS_YATT) id = 12; if (off >= WS_M) id = 13; }
    const float E = 3.f * id;
    for (size_t i = (size_t)blockIdx.x * blockDim.x + threadIdx.x; i < (size_t)NTOK * DM; i += (size_t)gridDim.x * blockDim.x) out[i] = E;
}
#endif
extern "C" void kernel_launch(void* const* d_in, const int* in_sizes, int n_in, void* d_out, int out_size, void* d_ws, size_t ws_size, hipStream_t stream) {
    static int grid = 0;
    if (grid == 0) {
        if (n_in != 22 || out_size != NTOK * DM || ws_size < WS_END) { fprintf(stderr, "kernel_launch: unexpected problem (n_in %d, out %d, ws %zu, need %zu)\n", n_in, out_size, ws_size, (size_t)WS_END); grid = -1; return; }
        int dev = 0, cus = 0;
        if (hipGetDevice(&dev) != hipSuccess || hipDeviceGetAttribute(&cus, hipDeviceAttributeMultiprocessorCount, dev) != hipSuccess) { grid = -1; return; }
        if (hipFuncSetAttribute((const void*)mk_fwd, hipFuncAttributeMaxDynamicSharedMemorySize, LDS_BYTES) != hipSuccess) { fprintf(stderr, "kernel_launch: hipFuncSetAttribute failed\n"); grid = -1; return; }
        int per_cu = 0;
        if (hipOccupancyMaxActiveBlocksPerMultiprocessor(&per_cu, (const void*)mk_fwd, 512, LDS_BYTES) != hipSuccess || per_cu < 1) fprintf(stderr, "kernel_launch: occupancy query says %d\n", per_cu);
        (void)hipGetLastError();
        grid = cus;
    }
    if (grid < 0) return;
    (void)hipMemsetAsync((char*)d_ws + WS_CTL, 0, CTL_ZERO_BYTES, stream);
    Args a{};
    for (int i = 0; i < 22; ++i) a.in[i] = (const float*)d_in[i];
    a.out = (float*)d_out; a.ws = (unsigned char*)d_ws;
#if DBG_STOP == 200
    for (int s = 0; s <= DBG_HI; ++s) { a.ph_lo = s; a.ph_hi = s + 1; hipLaunchKernelGGL(mk_fwd, dim3(grid), dim3(512), LDS_BYTES, stream, a); }
    { char* w = (char*)d_ws; const size_t nblk = (WS_R_END1 - WS_RSTD) / 1024; unsigned long long* ck0 = (unsigned long long*)(w + WS_R_END1); unsigned long long* ck1 = ck0 + nblk; unsigned long long* first = (unsigned long long*)(w + 4096);
#ifdef DBG_WARMFIRST
      for (int s = DBG_LOSTEP; s <= DBG_HI; ++s) { a.ph_lo = s; a.ph_hi = s + 1; hipLaunchKernelGGL(mk_fwd, dim3(grid), dim3(512), LDS_BYTES, stream, a); }
#endif
      hipLaunchKernelGGL(dbg_cksum, dim3(2048), dim3(256), 0, stream, (const unsigned long long*)(w + WS_RSTD), nblk, ck0);
      for (int s = DBG_LOSTEP; s <= DBG_HI; ++s) { a.ph_lo = s; a.ph_hi = s + 1; hipLaunchKernelGGL(mk_fwd, dim3(grid), dim3(512), LDS_BYTES, stream, a); }
      hipLaunchKernelGGL(dbg_cksum, dim3(2048), dim3(256), 0, stream, (const unsigned long long*)(w + WS_RSTD), nblk, ck1);
      (void)hipMemsetAsync(first, 0xFF, 8, stream);
      hipLaunchKernelGGL(dbg_ckcmp, dim3(1024), dim3(256), 0, stream, (const unsigned long long*)ck0, (const unsigned long long*)ck1, nblk, first);
      hipLaunchKernelGGL(dbg_fill2, dim3(2048), dim3(256), 0, stream, (float*)d_out, (const unsigned long long*)first); }
#elif DBG_STOP == 100
    for (int s = 0; s <= 6; ++s) { a.ph_lo = s; a.ph_hi = s + 1; hipLaunchKernelGGL(mk_fwd, dim3(grid), dim3(512), LDS_BYTES, stream, a); }
    { char* w = (char*)d_ws; const size_t SZ = (size_t)NTOK * DM * 2; char* cp = w + WS_R_END1;
      hipMemcpyAsync(cp, w + WS_M, SZ, hipMemcpyDeviceToDevice, stream); hipMemcpyAsync(cp + SZ, w + WS_SC, 2 * SZ, hipMemcpyDeviceToDevice, stream);
      a.ph_lo = 6; a.ph_hi = 7; hipLaunchKernelGGL(mk_fwd, dim3(grid), dim3(512), LDS_BYTES, stream, a);
      unsigned* cnt = (unsigned*)(w + 4096); hipMemsetAsync(cnt, 0, 64, stream);
      hipLaunchKernelGGL(dbg_cmp3, dim3(2048), dim3(256), 0, stream, (const unsigned short*)(w + WS_M), (const unsigned short*)cp, (const unsigned short*)(w + WS_SC), (const unsigned short*)(cp + SZ), (const unsigned short*)(w + WS_SC + SZ), (const unsigned short*)(cp + 2 * SZ), cnt);
      hipLaunchKernelGGL(dbg_fill, dim3(2048), dim3(256), 0, stream, (float*)d_out, (const unsigned*)cnt); }
#elif DBG_STOP >= 0
    for (int s = 0; s <= DBG_STOP; ++s) { a.ph_lo = s; a.ph_hi = s + 1; hipLaunchKernelGGL(mk_fwd, dim3(grid), dim3(512), LDS_BYTES, stream, a); }
#ifdef DBG_TWICE
    { a.ph_lo = DBG_STOP; a.ph_hi = DBG_STOP + 1; hipLaunchKernelGGL(mk_fwd, dim3(grid), dim3(512), LDS_BYTES, stream, a); }
#endif
    hipLaunchKernelGGL(dbg_dump, dim3(2048), dim3(256), 0, stream, (const unsigned short*)((const char*)d_ws + DBG_LO), (size_t)((WS_END - DBG_LO) / 2), (const unsigned*)d_out, (float*)d_out, DBG_STOP >= 7 ? 1 : 0);
#elif MK_ONE_LAUNCH
    a.ph_lo = 0; a.ph_hi = NSTEPS;
    hipLaunchKernelGGL(mk_fwd, dim3(grid), dim3(512), LDS_BYTES, stream, a);
#else
    for (int s = 0; s < NSTEPS; ++s) { a.ph_lo = s; a.ph_hi = s + 1; hipLaunchKernelGGL(mk_fwd, dim3(grid), dim3(512), LDS_BYTES, stream, a); }
#endif
}
```

```cpp
#include <hip/hip_runtime.h>
#include <cstdio>
#include <cstdint>

#ifndef SITE_MASK
#define SITE_MASK 0xffffffffu
#endif
#define SITE_ON(i) (((SITE_MASK) >> (i)) & 1u)

#ifndef MK_ONE_LAUNCH
#define MK_ONE_LAUNCH 1
#endif

namespace pg8 {
#define PG8_LAS __attribute__((address_space(3)))
typedef unsigned short bf16_t;
typedef short bf16x8 __attribute__((ext_vector_type(8)));
typedef float f32x4 __attribute__((ext_vector_type(4)));
typedef unsigned u32x4 __attribute__((ext_vector_type(4)));
constexpr int BM = 256, BK = 64, HALF = 128, HTB = HALF * BK * 2  , STAGE_BYTES = 8 * HTB, NXCD = 8, WGM = 8;

__host__ __device__ __forceinline__ int lds_byte(int r, int c) { const int st = (r >> 4) * 2 + (c >> 5), rr = r & 15, cc = c & 31, ob = rr * 64 + cc * 2; return st * 1024 + (ob ^ (((ob >> 9) & 1) << 5)); }
__host__ __device__ __forceinline__ void stage_rc(int b, int& R, int& C) { const int st = b / 1024, sb = b % 1024, swz = sb ^ (((sb >> 9) & 1) << 5); R = (st >> 1) * 16 + swz / 64; C = (st & 1) * 32 + (swz % 64) / 2; }
__host__ __device__ __forceinline__ int perm32(int rho) { const int n = rho >> 4, i = rho & 15; return 8 * (i >> 2) + 4 * n + (i & 3); }
struct Unit { int pm, pn, aux; const char* a; const char* b; };
struct Gemm { int K; };
__device__ __forceinline__ unsigned cvt_pk_bf16(float lo, float hi) { unsigned r; asm volatile("v_cvt_pk_bf16_f32 %0, %1, %2" : "=v"(r) : "v"(lo), "v"(hi)); return r; }
template <class Epi, class Sched, bool ALIGN_EPI = false, bool SP2 = false>
__device__ __forceinline__ void gemm_phase(PG8_LAS unsigned char* lds, const Gemm g, const Sched& S, const Epi& E) {
    int tid_ = threadIdx.x; asm volatile("" : "+v"(tid_)); const int tid = tid_, wid = __builtin_amdgcn_readfirstlane(tid >> 6), lane = tid & 63, wr = wid >> 2, wc = wid & 3, fr = lane & 15, fq = lane >> 4;
    const int K = g.K, nt = K / BK;
    unsigned voffA[2], voffB[2];
#pragma unroll
    for (int i = 0; i < 2; ++i) { int R, C; stage_rc(tid * 16 + i * 8192, R, C); const int Rb = Epi::PERM ? ((R & ~31) + perm32(R & 31)) : R;
        voffA[i] = (unsigned)(R * K + C) * 2u; voffB[i] = (unsigned)(Rb * K + C) * 2u; }
    const size_t kstep = (size_t)(BK * 2);
    const size_t hstep = (size_t)HALF * K * 2;
    const unsigned ldsw = (unsigned)wid * 1024u;
    const int aoff = lds_byte(wr * 64 + fr, fq * 8), boff = lds_byte(wc * 32 + fr, fq * 8);
#define PG8_SA(b, h) (((b) * 2 + (h)) * HTB)
#define PG8_SB(b, h) ((4 + (b) * 2 + (h)) * HTB)
#define PG8_STAGE(bufoff, gbase, voff) do { _Pragma("unroll") for (int _i = 0; _i < 2; ++_i) \
        __builtin_amdgcn_global_load_lds((const unsigned*)((const char*)(gbase) + (voff)[_i]), (PG8_LAS unsigned*)(lds + (bufoff) + ldsw + _i * 8192), 16, 0, 0); } while (0)
#define PG8_LDA(dst, b, h) do { _Pragma("unroll") for (int m = 0; m < 4; ++m) _Pragma("unroll") for (int k = 0; k < 2; ++k) dst[m][k] = *(const PG8_LAS bf16x8*)(lds + PG8_SA(b, h) + aoff + m * 2048 + k * 1024); } while (0)
#define PG8_LDB(dst, b, h) do { _Pragma("unroll") for (int n = 0; n < 2; ++n) _Pragma("unroll") for (int k = 0; k < 2; ++k) dst[n][k] = *(const PG8_LAS bf16x8*)(lds + PG8_SB(b, h) + boff + n * 2048 + k * 1024); } while (0)
#define PG8_MMA(ai, bj, At, Bt) do { __builtin_amdgcn_s_setprio(1); _Pragma("unroll") for (int m = 0; m < 4; ++m) _Pragma("unroll") for (int n = 0; n < 2; ++n) _Pragma("unroll") for (int k = 0; k < 2; ++k) \
        acc[ai][bj][m][n] = __builtin_amdgcn_mfma_f32_16x16x32_bf16(Bt[n][k], At[m][k], acc[ai][bj][m][n], 0, 0, 0); __builtin_amdgcn_s_setprio(0); } while (0)
#define PG8_WAIT_V(n) asm volatile("s_waitcnt vmcnt(" #n ")" ::: "memory")
#define PG8_WAIT_L(n) asm volatile("s_waitcnt lgkmcnt(" #n ")" ::: "memory")
#define PG8_BAR __builtin_amdgcn_s_barrier()
#define PG8_SCHED __builtin_amdgcn_sched_barrier(0)
    Unit cur, nxt; int ui = 0;
    if (!S.next(0, cur)) return;
    f32x4 acc[2][2][4][2];
#pragma unroll
    for (int a = 0; a < 2; ++a)
#pragma unroll
        for (int b = 0; b < 2; ++b)
#pragma unroll
            for (int m = 0; m < 4; ++m)
#pragma unroll
                for (int n = 0; n < 2; ++n) acc[a][b][m][n] = (f32x4){0.f, 0.f, 0.f, 0.f};
    bf16x8 At[4][2], B0[2][2], B1[2][2];
    const char* cA = cur.a; const char* cB = cur.b;
    S.a_ready(cur);
    if constexpr (SP2) {
        PG8_STAGE(PG8_SB(0, 0), cB, voffB); PG8_STAGE(PG8_SB(0, 1), cB + hstep, voffB); PG8_STAGE(PG8_SA(0, 0), cA, voffA); PG8_STAGE(PG8_SA(0, 1), cA + hstep, voffA);
        if (wr == 1) PG8_BAR;
        PG8_WAIT_V(2); PG8_BAR;
        PG8_STAGE(PG8_SB(1, 0), cB + kstep, voffB); PG8_STAGE(PG8_SA(1, 0), cA + kstep, voffA); PG8_STAGE(PG8_SB(1, 1), cB + hstep + kstep, voffB);
        PG8_WAIT_V(6); PG8_BAR;
    } else {
        PG8_STAGE(PG8_SB(0, 0), cB, voffB); PG8_STAGE(PG8_SA(0, 0), cA, voffA); PG8_STAGE(PG8_SB(0, 1), cB + hstep, voffB); PG8_STAGE(PG8_SA(0, 1), cA + hstep, voffA);
        if (wr == 1) PG8_BAR;
        PG8_WAIT_V(4); PG8_BAR;
        PG8_STAGE(PG8_SB(1, 0), cB + kstep, voffB); PG8_STAGE(PG8_SA(1, 0), cA + kstep, voffA); PG8_STAGE(PG8_SB(1, 1), cB + hstep + kstep, voffB);
        PG8_WAIT_V(6); PG8_BAR;
    }
    for (;;) {
        const bool has_next = S.next(ui + 1, nxt);
        const char* nA = has_next ? nxt.a : cA; const char* nB = has_next ? nxt.b : cB;
        for (int t = 0; t < nt; t += 2) {
            const bool last = (t == nt - 2);
            const char* a1 = cA + (size_t)(t + 1) * kstep;
            const char* a2 = last ? nA : cA + (size_t)(t + 2) * kstep; const char* b2 = last ? nB : cB + (size_t)(t + 2) * kstep;
            const char* a3 = a2 + kstep; const char* b3 = b2 + kstep;
            if (last && has_next) S.a_ready(nxt);
            if constexpr (SP2) {
            PG8_LDB(B0, 0, 0); PG8_LDB(B1, 0, 1); PG8_SCHED; PG8_LDA(At, 0, 0); PG8_STAGE(PG8_SA(1, 1), a1 + hstep, voffA);
            PG8_WAIT_V(8); PG8_WAIT_L(0); PG8_BAR; PG8_MMA(0, 0, At, B0); PG8_MMA(0, 1, At, B1); PG8_BAR; PG8_SCHED;
            PG8_LDA(At, 0, 1); PG8_STAGE(PG8_SB(0, 0), b2, voffB); PG8_STAGE(PG8_SB(0, 1), b2 + hstep, voffB); PG8_STAGE(PG8_SA(0, 0), a2, voffA);
            PG8_WAIT_V(8); PG8_WAIT_L(0); PG8_BAR; PG8_MMA(1, 0, At, B0); PG8_MMA(1, 1, At, B1); PG8_BAR; PG8_SCHED;
            PG8_LDB(B0, 1, 0); PG8_LDB(B1, 1, 1); PG8_SCHED; PG8_LDA(At, 1, 0); PG8_STAGE(PG8_SA(0, 1), a2 + hstep, voffA);
            PG8_WAIT_V(8); PG8_WAIT_L(0); PG8_BAR; PG8_MMA(0, 0, At, B0); PG8_MMA(0, 1, At, B1); PG8_BAR; PG8_SCHED;
            PG8_LDA(At, 1, 1); PG8_STAGE(PG8_SB(1, 0), b3, voffB); PG8_STAGE(PG8_SB(1, 1), b3 + hstep, voffB); PG8_STAGE(PG8_SA(1, 0), a3, voffA);
            PG8_WAIT_V(8); PG8_WAIT_L(0); PG8_BAR; PG8_MMA(1, 0, At, B0); PG8_MMA(1, 1, At, B1); PG8_BAR; PG8_SCHED;
            } else {
            PG8_LDB(B0, 0, 0); PG8_SCHED; PG8_LDA(At, 0, 0); PG8_STAGE(PG8_SA(1, 1), a1 + hstep, voffA);
            PG8_WAIT_L(8); PG8_BAR; PG8_WAIT_L(0); PG8_MMA(0, 0, At, B0); PG8_BAR; PG8_SCHED;
            PG8_LDB(B1, 0, 1); PG8_STAGE(PG8_SB(0, 0), b2, voffB);
            PG8_BAR; PG8_WAIT_L(0); PG8_MMA(0, 1, At, B1); PG8_BAR;
            PG8_LDA(At, 0, 1); PG8_STAGE(PG8_SA(0, 0), a2, voffA);
            PG8_BAR; PG8_WAIT_L(0); PG8_MMA(1, 0, At, B0); PG8_BAR; PG8_SCHED;
            PG8_STAGE(PG8_SB(0, 1), b2 + hstep, voffB);
            PG8_WAIT_V(6); PG8_BAR; PG8_MMA(1, 1, At, B1); PG8_BAR;
            PG8_LDB(B0, 1, 0); PG8_SCHED; PG8_LDA(At, 1, 0); PG8_STAGE(PG8_SA(0, 1), a2 + hstep, voffA);
            PG8_WAIT_L(8); PG8_BAR; PG8_WAIT_L(0); PG8_MMA(0, 0, At, B0); PG8_BAR; PG8_SCHED;
            PG8_LDB(B1, 1, 1); PG8_STAGE(PG8_SB(1, 0), b3, voffB);
            PG8_BAR; PG8_WAIT_L(0); PG8_MMA(0, 1, At, B1); PG8_BAR;
            PG8_LDA(At, 1, 1); PG8_STAGE(PG8_SA(1, 0), a3, voffA);
            PG8_BAR; PG8_WAIT_L(0); PG8_MMA(1, 0, At, B0); PG8_BAR; PG8_SCHED;
            PG8_STAGE(PG8_SB(1, 1), b3 + hstep, voffB);
            PG8_WAIT_V(6); PG8_BAR; PG8_MMA(1, 1, At, B1); PG8_BAR;
            }
        }
        if constexpr (ALIGN_EPI) { if (wr == 0) PG8_BAR; }
        if constexpr (!Epi::AFTER_DRAIN) { E(acc, cur, wr, wc, fr, fq); S.done(cur); }
        if (!has_next) break;
#pragma unroll
        for (int a = 0; a < 2; ++a)
#pragma unroll
            for (int b = 0; b < 2; ++b)
#pragma unroll
                for (int m = 0; m < 4; ++m)
#pragma unroll
                    for (int n = 0; n < 2; ++n) acc[a][b][m][n] = (f32x4){0.f, 0.f, 0.f, 0.f};
        cur = nxt; cA = nA; cB = nB; ++ui;
        if constexpr (ALIGN_EPI) { if (wr == 1) PG8_BAR; }
    }
    PG8_WAIT_V(0);
    if constexpr (!ALIGN_EPI) { if (wr == 0) PG8_BAR; }
    PG8_BAR;
    if constexpr (Epi::AFTER_DRAIN) { E.fused(acc, cur, wr, wc, fr, fq, lds, wid, lane); S.done(cur); }
#undef PG8_SA
#undef PG8_SB
#undef PG8_STAGE
#undef PG8_LDA
#undef PG8_LDB
#undef PG8_MMA
#undef PG8_WAIT_V
#undef PG8_WAIT_L
#undef PG8_BAR
#undef PG8_SCHED
}
struct OrderBase {
    int nM, nN, nwg, G, c;
    __device__ __forceinline__ void init(int nM_, int nN_, int G_, int c_) { nM = nM_; nN = nN_; nwg = nM_ * nN_; G = G_; c = c_; }
    __device__ __forceinline__ bool map(int i, int& pm, int& pn) const {
        const long L = (long)i * G + c; if (L >= nwg) return false;
        int wgid = (int)L; { const int q = nwg / NXCD, r = nwg % NXCD, xcd = wgid % NXCD, off = wgid / NXCD; wgid = (xcd < r ? xcd * (q + 1) : r * (q + 1) + (xcd - r) * q) + off; }
        const int nig = WGM * nN, gid = wgid / nig, fm = gid * WGM, gsz = (nM - fm) < WGM ? (nM - fm) : WGM;
        pm = fm + ((wgid % nig) % gsz); pn = (wgid % nig) / gsz; return true;
    }
    __device__ __forceinline__ void a_ready(const Unit&) const {}
    __device__ __forceinline__ void done(const Unit&) const {}
};
struct PlainOrder : OrderBase {
    const char* A; const char* B; size_t ta, tb;
    __device__ __forceinline__ bool next(int i, Unit& u) const { int pm, pn; if (!map(i, pm, pn)) return false; u.pm = pm; u.pn = pn; u.aux = 0; u.a = A + (size_t)pm * ta; u.b = B + (size_t)pn * tb; return true; }
};
struct BranchOrder : OrderBase {
    const char* A; const char* B; size_t ta, tb, za, zb;
    __device__ __forceinline__ bool next(int i, Unit& u) const { const int ti = i / 3, br = i - 3 * ti; int pm, pn; if (!map(ti, pm, pn)) return false; u.pm = pm; u.pn = pn; u.aux = br;
        u.a = A + (size_t)br * za + (size_t)pm * ta; u.b = B + (size_t)br * zb + (size_t)pn * tb; return true; }
};
struct MoeOrder : OrderBase {
    const char* A; const char* B; size_t ta, tb, zb; int t1, t2, t3, t4, t5, t6, t7;
    __device__ __forceinline__ bool next(int i, Unit& u) const { int pm, pn; if (!map(i, pm, pn)) return false; u.pm = pm; u.pn = pn;
        const int e = (pm >= t1) + (pm >= t2) + (pm >= t3) + (pm >= t4) + (pm >= t5) + (pm >= t6) + (pm >= t7); u.aux = e;
        u.a = A + (size_t)pm * ta; u.b = B + (size_t)e * zb + (size_t)pn * tb; return true; }
};
}

constexpr int NTOK = 16384, DM = 2048, SEQ = 2048, NBATCH = 8, NHEAD = 8, HD = 64, DFF = 7168, NEXP = 8;
constexpr int NIN = 10828, NINP = 11008;
constexpr int WBR_W = 512, KVR = 256;
constexpr float EPS = 1e-6f, LOG2E = 1.4426950408889634f, C2 = 0.125f * LOG2E;
constexpr int MOE_ROWS = 2 * NTOK + NEXP * 256;
constexpr int NSTEPS = 24;

constexpr size_t al256(size_t x) { return (x + 255) & ~(size_t)255; }
constexpr size_t WS_CTL = 0, CTL_ZERO_BYTES = 1u << 20;
constexpr size_t SZ_WIN = (size_t)NINP * DM * 2, SZ_WUKV = (size_t)1024 * KVR * 2, SZ_WBR = (size_t)DM * WBR_W * 2, SZ_WOUT = (size_t)DM * DM * 2;
constexpr size_t SZ_WGU = (size_t)2 * DFF * DM * 2, SZ_WD = (size_t)DM * DFF * 2;
constexpr size_t WS_WIN = CTL_ZERO_BYTES, WS_WUKV = WS_WIN + 2 * SZ_WIN, WS_WBR = WS_WUKV + 2 * SZ_WUKV, WS_WOUT = WS_WBR + 6 * SZ_WBR;
constexpr size_t WS_WGU0 = WS_WOUT + 2 * SZ_WOUT, WS_WD0 = WS_WGU0 + SZ_WGU, WS_WGUM = WS_WD0 + SZ_WD, WS_WDM = WS_WGUM + NEXP * SZ_WGU;
constexpr size_t WS_RSTD = WS_WDM + NEXP * SZ_WD, WS_SSP = WS_RSTD + (size_t)NTOK * 4, WS_XB = WS_SSP + (size_t)NTOK * 32 * 4;
constexpr size_t WS_R = WS_XB + (size_t)NTOK * DM * 2;
constexpr size_t WS_Z8 = WS_R, WS_DLAT = WS_Z8 + (size_t)8 * NTOK * 512 * 2, WS_DIQ = WS_DLAT + (size_t)NTOK * 256 * 2, WS_DIK = WS_DIQ + (size_t)NTOK * 256 * 2;
constexpr size_t WS_FFW = WS_DIK + (size_t)NTOK * 64 * 2, WS_GATES = WS_FFW + (size_t)NTOK * 16 * 4, WS_C2F = WS_GATES + (size_t)NTOK * 6144 * 2;
constexpr size_t WS_DKV = WS_C2F + (size_t)NBATCH * NHEAD * SEQ * 4, WS_SC = WS_DKV + (size_t)NTOK * 1024 * 2, WS_MASK = WS_SC + (size_t)NTOK * SEQ * 4;
constexpr size_t WS_YATT = WS_MASK + (size_t)NTOK * 64 * 4, WS_M = WS_YATT + (size_t)3 * NTOK * 512 * 2, WS_R_END1 = WS_M + (size_t)NTOK * DM * 2;
constexpr size_t WS_HID = WS_R;
constexpr size_t WS_XG = WS_R, WS_HIDM = WS_XG + (size_t)MOE_ROWS * DM * 2, WS_Y = WS_HIDM + (size_t)MOE_ROWS * DFF * 2, WS_ROWTOK = WS_Y + (size_t)2 * NTOK * DM * 4;
constexpr size_t WS_ROWW = WS_ROWTOK + (size_t)MOE_ROWS * 4, WS_RSTDG = WS_ROWW + (size_t)MOE_ROWS * 4, WS_TOKINFO = WS_RSTDG + (size_t)MOE_ROWS * 4;
constexpr size_t WS_TOKW = WS_TOKINFO + (size_t)2 * NTOK * 8, WS_WGCNT = WS_TOKW + (size_t)2 * NTOK * 4, WS_META = WS_WGCNT + 256 * 8 * 4, WS_R_END2 = WS_META + 256;
constexpr size_t WS_END = WS_R_END1 > WS_R_END2 ? WS_R_END1 : WS_R_END2;
constexpr int CW_BAR = 4096;

constexpr int RING_BYTES = 131072, LDSCTL_OFF = RING_BYTES, MISC_OFF = LDSCTL_OFF + 320, LDS_BYTES = 147456;

#define GAS __attribute__((address_space(1)))
#define LAS __attribute__((address_space(3)))
typedef unsigned short bf16_t;
typedef float f32x4 __attribute__((ext_vector_type(4)));
typedef unsigned u32x4 __attribute__((ext_vector_type(4)));
typedef unsigned u32x2 __attribute__((ext_vector_type(2)));
typedef short bf16x8 __attribute__((ext_vector_type(8)));
typedef float f32x16 __attribute__((ext_vector_type(16)));
#define LDS_WAIT() asm volatile("s_waitcnt lgkmcnt(0)" ::: "memory")
#define VM_WAIT() asm volatile("s_waitcnt vmcnt(0)" ::: "memory")
__device__ __forceinline__ float bflo(unsigned w) { return __uint_as_float(w << 16); }
__device__ __forceinline__ float bfhi(unsigned w) { return __uint_as_float(w & 0xffff0000u); }
typedef float f32x2_t __attribute__((ext_vector_type(2))); typedef __bf16 bf16x2_t __attribute__((ext_vector_type(2)));
__device__ __forceinline__ unsigned pk2(float lo, float hi) { f32x2_t v = {lo, hi}; bf16x2_t b = __builtin_convertvector(v, bf16x2_t); return __builtin_bit_cast(unsigned, b); }
__device__ __forceinline__ int opq(int v) { asm volatile("" : "+s"(v)); return v; }
__device__ __forceinline__ float wave_sum(float v) {
#pragma unroll
    for (int o = 1; o < 64; o <<= 1) v += __shfl_xor(v, o);
    return v;
}
__device__ __forceinline__ float sigm(float v) { return __builtin_amdgcn_rcpf(1.f + __builtin_amdgcn_exp2f(-v * LOG2E)); }
__device__ __forceinline__ float softplus2(float z) { return fmaxf(z, 0.f) + __builtin_amdgcn_logf(1.f + __builtin_amdgcn_exp2f(-fabsf(z))); }

#define XB_TMO      128
#define XB_XCNT(j)  (256  + 64 * (j))
#define XB_XSUB(j)  (1280 + 64 * (j))
#define XB_XGEN(j)  (2304 + 64 * (j))
#define XB_TOP      3328
#define XB_TOPGEN   3392
#define XCD_BAR_WORDS 3456
#define XB_SPIN_CAP (1u << 18)

__device__ __forceinline__ unsigned xb_ld(unsigned* p)              { return __hip_atomic_load(p, __ATOMIC_RELAXED, __HIP_MEMORY_SCOPE_AGENT); }
__device__ __forceinline__ unsigned xb_add(unsigned* p, unsigned v) { return __hip_atomic_fetch_add(p, v, __ATOMIC_RELAXED, __HIP_MEMORY_SCOPE_AGENT); }
__device__ __forceinline__ unsigned xb_xcc_id() { return (unsigned)__builtin_amdgcn_s_getreg((3 << 11) | 20) & 0xFu; }
#define XB_SPIN(cond, bar) do { unsigned _sp = 0; while (cond) { __builtin_amdgcn_s_sleep(1); \
    if ((++_sp & 255u) == 0u) { if (xb_ld(&(bar)[XB_TMO])) break; if (_sp > XB_SPIN_CAP) { atomicAdd(&(bar)[XB_TMO], 1u); break; } } } } while (0)

struct XcdBarrier {
    unsigned* bar; unsigned x;
    volatile LAS unsigned* st;
};

__device__ __forceinline__ XcdBarrier xcd_barrier_post(unsigned* bar, volatile LAS unsigned* st) {
    XcdBarrier b; b.bar = bar; b.x = xb_xcc_id(); b.st = st;
    if (threadIdx.x == 0) (void)xb_add(&bar[XB_XCNT(b.x)], 1u);
    return b;
}
__device__ __forceinline__ void xcd_barrier_complete(unsigned* bar, unsigned x, unsigned& nloc, unsigned& nx) {
    const unsigned G = gridDim.x * gridDim.y * gridDim.z;
    unsigned sum, cnt, mine, sp = 0u;
    for (;;) {
        sum = 0u; cnt = 0u; mine = 0u;
#pragma unroll
        for (unsigned j = 0; j < 16; ++j) { const unsigned c = xb_ld(&bar[XB_XCNT(j)]); sum += c; cnt += (c > 0u) ? 1u : 0u; mine = (j == x) ? c : mine; }
        if (sum == G) break;
        __builtin_amdgcn_s_sleep(1);
        if ((++sp & 255u) == 0u) { if (xb_ld(&bar[XB_TMO])) break; if (sp > XB_SPIN_CAP) { atomicAdd(&bar[XB_TMO], 1u); break; } }
    }
    nloc = mine > 0u ? mine : 1u; nx = cnt > 0u ? cnt : 1u;
}

__device__ __attribute__((noinline)) void xcd_barrier_impl(GAS unsigned* bar_, unsigned x_, LAS unsigned* st_) { XcdBarrier b; b.bar = (unsigned*)bar_; b.x = x_; b.st = st_;
    asm volatile("s_waitcnt vmcnt(0)" ::: "memory");
    __syncthreads();
    if (threadIdx.x == 0) {
        unsigned* bar = b.bar;
        __builtin_amdgcn_s_waitcnt(0);
        unsigned nloc = b.st[0], nx = b.st[1];
        if (nloc == 0u) { xcd_barrier_complete(bar, b.x, nloc, nx); b.st[0] = nloc; b.st[1] = nx; }
        const unsigned old = xb_add(&bar[XB_XSUB(b.x)], 1u);
        const unsigned gen = old / nloc;
        if (old + 1u == (gen + 1u) * nloc) {
            __builtin_amdgcn_fence(__ATOMIC_RELEASE, "agent");
            asm volatile("s_waitcnt vmcnt(0)" ::: "memory");
            const unsigned og = xb_add(&bar[XB_TOP], 1u);
            const unsigned tg = og / nx;
            if (og + 1u == (tg + 1u) * nx) xb_add(&bar[XB_TOPGEN], 1u);
            else XB_SPIN(xb_ld(&bar[XB_TOPGEN]) == tg, bar);
            __builtin_amdgcn_fence(__ATOMIC_ACQUIRE, "agent");
            xb_add(&bar[XB_XGEN(b.x)], 1u);
            asm volatile("s_waitcnt vmcnt(0)" ::: "memory");
        } else {
            XB_SPIN(xb_ld(&bar[XB_XGEN(b.x)]) == gen, bar);
            __builtin_amdgcn_fence(__ATOMIC_ACQUIRE, "agent");
            asm volatile("s_waitcnt vmcnt(0)" ::: "memory");
        }
    }
    __syncthreads();
}
__device__ __forceinline__ void xcd_barrier(const XcdBarrier& b) { xcd_barrier_impl((GAS unsigned*)b.bar, b.x, (LAS unsigned*)b.st); }

#define ACC_T const pg8::f32x4 (&acc)[2][2][4][2]
__device__ __forceinline__ u32x4 pack8(f32x4 v0, f32x4 v1) { u32x4 w; w.x = pk2(v0[0], v0[1]); w.y = pk2(v0[2], v0[3]); w.z = pk2(v1[0], v1[1]); w.w = pk2(v1[2], v1[3]); return w; }
__device__ __forceinline__ f32x4 sigm4(f32x4 v) { f32x4 r; r[0] = sigm(v[0]); r[1] = sigm(v[1]); r[2] = sigm(v[2]); r[3] = sigm(v[3]); return r; }

struct EpiWin {
    static constexpr bool PERM = true, AFTER_DRAIN = false;
    const float* rstd; bf16_t* z8; bf16_t* dlat; bf16_t* diq; bf16_t* dik; float* ffw; bf16_t* gates;
    __device__ __forceinline__ void operator()(ACC_T, const pg8::Unit& u, int wr, int wc, int fr, int fq) const {
        const int row0 = u.pm * 256 + wr * 64 + fr, pn = u.pn, cl = wc * 32 + 8 * fq;
        if (pn == 18) {
#pragma unroll
            for (int ai = 0; ai < 2; ++ai)
#pragma unroll
                for (int m = 0; m < 4; ++m) { const int row = row0 + ai * 128 + m * 16; const float rs = rstd[row];
                    const f32x4 v0 = acc[ai][0][m][0] * rs, v1 = acc[ai][0][m][1] * rs;
                    if (cl < 64) *(u32x4*)(dik + (size_t)row * 64 + cl) = pack8(v0, v1);
                    else if (cl == 64) { *(f32x4*)(ffw + (size_t)row * 16) = v0; *(f32x4*)(ffw + (size_t)row * 16 + 4) = v1; }
                    else if (cl == 72) { *(f32x4*)(ffw + (size_t)row * 16 + 8) = v0; } }
            return;
        }
        bf16_t* dst; int ldc, colbase; bool sg = false; float scale = 1.f;
        if (pn < 16) { const int idx = pn >> 1; dst = z8 + (size_t)idx * NTOK * 512; ldc = 512; colbase = (pn & 1) * 256; sg = (idx == 3); scale = (idx == 4 || idx == 7) ? C2 : 1.f; }
        else if (pn == 16) { dst = dlat; ldc = 256; colbase = 0; }
        else if (pn == 17) { dst = diq; ldc = 256; colbase = 0; }
        else { dst = gates; ldc = 6144; colbase = (pn - 19) * 256; sg = true; }
        if (sg) {
#pragma unroll
            for (int ai = 0; ai < 2; ++ai)
#pragma unroll
                for (int m = 0; m < 4; ++m) { const int row = row0 + ai * 128 + m * 16; const float rs = rstd[row]; bf16_t* rowp = dst + (size_t)row * ldc + colbase + cl;
#pragma unroll
                    for (int bj = 0; bj < 2; ++bj) *(u32x4*)(rowp + bj * 128) = pack8(sigm4(acc[ai][bj][m][0] * rs), sigm4(acc[ai][bj][m][1] * rs)); }
        } else {
#pragma unroll
            for (int ai = 0; ai < 2; ++ai)
#pragma unroll
                for (int m = 0; m < 4; ++m) { const int row = row0 + ai * 128 + m * 16; const float rs = rstd[row] * scale; bf16_t* rowp = dst + (size_t)row * ldc + colbase + cl;
#pragma unroll
                    for (int bj = 0; bj < 2; ++bj) *(u32x4*)(rowp + bj * 128) = pack8(acc[ai][bj][m][0] * rs, acc[ai][bj][m][1] * rs); }
        }
    }
};
struct EpiPlain {
    static constexpr bool PERM = true, AFTER_DRAIN = false;
    bf16_t* O; int ldc;
    __device__ __forceinline__ void operator()(ACC_T, const pg8::Unit& u, int wr, int wc, int fr, int fq) const {
        const int row0 = u.pm * 256 + wr * 64 + fr, col0 = u.pn * 256 + wc * 32 + 8 * fq;
#pragma unroll
        for (int ai = 0; ai < 2; ++ai)
#pragma unroll
            for (int m = 0; m < 4; ++m) { bf16_t* rowp = O + (size_t)(row0 + ai * 128 + m * 16) * ldc + col0;
#pragma unroll
                for (int bj = 0; bj < 2; ++bj) *(u32x4*)(rowp + bj * 128) = pack8(acc[ai][bj][m][0], acc[ai][bj][m][1]); }
    }
};
struct EpiBranch {
    static constexpr bool PERM = true, AFTER_DRAIN = false;
    const bf16_t* gates; bf16_t* M;
    __device__ __forceinline__ void operator()(ACC_T, const pg8::Unit& u, int wr, int wc, int fr, int fq) const {
        const int row0 = u.pm * 256 + wr * 64 + fr, col0 = u.pn * 256 + wc * 32 + 8 * fq, br = u.aux;
#pragma unroll
        for (int ai = 0; ai < 2; ++ai)
#pragma unroll
            for (int m = 0; m < 4; ++m) { const int row = row0 + ai * 128 + m * 16;
#pragma unroll
                for (int bj = 0; bj < 2; ++bj) { const int col = col0 + bj * 128;
                    const u32x4 g = *(const u32x4*)(gates + (size_t)row * 6144 + br * 2048 + col);
                    f32x4 v0 = acc[ai][bj][m][0], v1 = acc[ai][bj][m][1];
                    v0[0] *= bflo(g.x); v0[1] *= bfhi(g.x); v0[2] *= bflo(g.y); v0[3] *= bfhi(g.y); v1[0] *= bflo(g.z); v1[1] *= bfhi(g.z); v1[2] *= bflo(g.w); v1[3] *= bfhi(g.w);
                    bf16_t* mp = M + (size_t)row * DM + col;
                    if (br > 0) { const u32x4 o = *(const u32x4*)mp; v0[0] += bflo(o.x); v0[1] += bfhi(o.x); v0[2] += bflo(o.y); v0[3] += bfhi(o.y); v1[0] += bflo(o.z); v1[1] += bfhi(o.z); v1[2] += bflo(o.w); v1[3] += bfhi(o.w); }
                    *(u32x4*)mp = pack8(v0, v1); } }
    }
};
struct EpiResid {
    static constexpr bool PERM = true, AFTER_DRAIN = false;
    const float* xold; float* x; bf16_t* xb; float* ssp;
    __device__ __forceinline__ void operator()(ACC_T, const pg8::Unit& u, int wr, int wc, int fr, int fq) const {
        const int row0 = u.pm * 256 + wr * 64 + fr, col0 = u.pn * 256 + wc * 32 + 8 * fq;
#pragma unroll
        for (int ai = 0; ai < 2; ++ai)
#pragma unroll
            for (int m = 0; m < 4; ++m) { const int row = row0 + ai * 128 + m * 16; float ss = 0.f;
#pragma unroll
                for (int bj = 0; bj < 2; ++bj) { const size_t off = (size_t)row * DM + col0 + bj * 128;
                    const f32x4 o0 = *(const f32x4*)(xold + off), o1 = *(const f32x4*)(xold + off + 4);
                    const f32x4 v0 = o0 + acc[ai][bj][m][0], v1 = o1 + acc[ai][bj][m][1];
                    *(f32x4*)(x + off) = v0; *(f32x4*)(x + off + 4) = v1; *(u32x4*)(xb + off) = pack8(v0, v1);
                    ss += (v0[0] * v0[0] + v0[1] * v0[1]) + (v0[2] * v0[2] + v0[3] * v0[3]) + (v1[0] * v1[0] + v1[1] * v1[1]) + (v1[2] * v1[2] + v1[3] * v1[3]); }
                ss += __shfl_xor(ss, 16); ss += __shfl_xor(ss, 32);
                if (fq == 0) ssp[(size_t)row * 32 + u.pn * 4 + wc] = ss; }
    }
};
struct EpiSwiglu {
    static constexpr bool PERM = true, AFTER_DRAIN = false;
    const float* rstd; bf16_t* hid;
    __device__ __forceinline__ void operator()(ACC_T, const pg8::Unit& u, int wr, int wc, int fr, int fq) const {
        const int row0 = u.pm * 256 + wr * 64 + fr, col0 = u.pn * 128 + wc * 32 + 8 * fq;
#pragma unroll
        for (int ai = 0; ai < 2; ++ai)
#pragma unroll
            for (int m = 0; m < 4; ++m) { const int row = row0 + ai * 128 + m * 16; const float rs = rstd[row];
                f32x4 h0, h1;
#pragma unroll
                for (int j = 0; j < 4; ++j) { const float g0 = acc[ai][0][m][0][j] * rs, u0 = acc[ai][1][m][0][j] * rs, g1 = acc[ai][0][m][1][j] * rs, u1 = acc[ai][1][m][1][j] * rs;
                    h0[j] = g0 * u0 * sigm(g0); h1[j] = g1 * u1 * sigm(g1); }
                *(u32x4*)(hid + (size_t)row * DFF + col0) = pack8(h0, h1); }
    }
};
struct EpiMoeDown {
    static constexpr bool PERM = true, AFTER_DRAIN = false;
    const int* rowtok; const float* roww; float* y;
    __device__ __forceinline__ void operator()(ACC_T, const pg8::Unit& u, int wr, int wc, int fr, int fq) const {
        const int row0 = u.pm * 256 + wr * 64 + fr, col0 = u.pn * 256 + wc * 32 + 8 * fq;
#pragma unroll
        for (int ai = 0; ai < 2; ++ai)
#pragma unroll
            for (int m = 0; m < 4; ++m) { const int row = row0 + ai * 128 + m * 16; const int tk = rowtok[row];
                if (tk >= 0) { const float w = roww[row]; float* d = y + (size_t)(tk & 1) * NTOK * DM + (size_t)(tk >> 1) * DM + col0;
#pragma unroll
                    for (int bj = 0; bj < 2; ++bj) { *(f32x4*)(d + bj * 128) = acc[ai][bj][m][0] * w; *(f32x4*)(d + bj * 128 + 4) = acc[ai][bj][m][1] * w; } } }
    }
};

struct Args { const float* in[22]; float* out; unsigned char* ws; int ph_lo, ph_hi; };

__host__ __device__ __forceinline__ int win_src(int n) {
    if (n < 1536) return n;
    if (n < 2048) return 1544 + (n - 1536);
    if (n < 4096) return 2056 + (n - 2048);
    if (n < 4352) return 4104 + (n - 4096);
    if (n < 4608) return 4360 + (n - 4352);
    if (n < 4672) return 4616 + (n - 4608);
    if (n < 4680) return 1536 + (n - 4672);
    if (n < 4684) return 4680 + (n - 4680);
    if (n < 4864) return -1;
    return 4684 + (n - 4864);
}

__device__ __forceinline__ void conv_matrix(int map, const float* W0, const float* W1, int K, int Ns, int dstN, bf16_t* WT, const float* gain, LAS float* scr, int gw, int NGW, int lane) {
    const int nblk = dstN >> 5, nit = (K >> 6) * nblk;
    for (int it = gw; it < nit; it += NGW) {
        const int kb = it / nblk, nb = it - kb * nblk, k0 = kb << 6, n0 = nb << 5;
        const float* src = W0; int sc;
        if (map == 0) sc = n0 + (lane & 31);
        else if (map == 1) sc = win_src(n0 + (lane & 31));
        else { const int t = nb >> 3, r = nb & 7; src = (r < 4) ? W0 : W1; sc = 128 * t + 32 * (r & 3) + (lane & 31); }
        const float* sp = src + (size_t)k0 * Ns + (sc < 0 ? 0 : sc);
#pragma unroll 8
        for (int i = 0; i < 32; ++i) { const int kk = 2 * i + (lane >> 5); float v = sp[(size_t)kk * Ns]; if (sc < 0) v = 0.f; scr[kk * 33 + (lane & 31)] = v; }
        LDS_WAIT(); asm volatile("" ::: "memory");
        const int c = lane & 7;
        f32x4 g0 = {1.f, 1.f, 1.f, 1.f}, g1 = {1.f, 1.f, 1.f, 1.f};
        if (gain) { g0 = *(const f32x4*)(gain + k0 + 8 * c); g1 = *(const f32x4*)(gain + k0 + 8 * c + 4); }
#pragma unroll
        for (int j = 0; j < 4; ++j) { const int n = (lane >> 3) + 8 * j; const LAS float* s = scr + (8 * c) * 33 + n;
            u32x4 o; o.x = pk2(s[0 * 33] * g0[0], s[1 * 33] * g0[1]); o.y = pk2(s[2 * 33] * g0[2], s[3 * 33] * g0[3]); o.z = pk2(s[4 * 33] * g1[0], s[5 * 33] * g1[1]); o.w = pk2(s[6 * 33] * g1[2], s[7 * 33] * g1[3]);
            *(u32x4*)(WT + (size_t)(n0 + n) * K + k0 + 8 * c) = o; }
        LDS_WAIT(); asm volatile("" ::: "memory");
    }
}

#define DOT16(acc_, base_) do { _Pragma("unroll") for (int c = 0; c < 2; ++c) { const u32x4 w = (base_)[c]; \
    acc_ += q[8 * c] * bflo(w.x) + q[8 * c + 1] * bfhi(w.x) + q[8 * c + 2] * bflo(w.y) + q[8 * c + 3] * bfhi(w.y) + q[8 * c + 4] * bflo(w.z) + q[8 * c + 5] * bfhi(w.z) + q[8 * c + 6] * bflo(w.w) + q[8 * c + 7] * bfhi(w.w); } \
    acc_ += __shfl_xor(acc_, 1); acc_ += __shfl_xor(acc_, 2); } while (0)
#define AXPY16(p_, base_) do { _Pragma("unroll") for (int c = 0; c < 2; ++c) { const u32x4 w = (base_)[c]; \
    o[8 * c] += (p_) * bflo(w.x); o[8 * c + 1] += (p_) * bfhi(w.x); o[8 * c + 2] += (p_) * bflo(w.y); o[8 * c + 3] += (p_) * bfhi(w.y); o[8 * c + 4] += (p_) * bflo(w.z); o[8 * c + 5] += (p_) * bfhi(w.z); o[8 * c + 6] += (p_) * bflo(w.w); o[8 * c + 7] += (p_) * bfhi(w.w); } } while (0)
constexpr float NEG_BIG = -1.0e30f;
template <int VAR> __device__ __forceinline__ void attn_naive_unit(LAS unsigned char* lds, int tid, int b, int h, int qb  ,
        const bf16_t* Q, int pq, const bf16_t* K, int pk, const bf16_t* V, int pv, const float* c2f, const unsigned* mask, const float* relb, const bf16_t* ogate, bf16_t* O) {
    asm volatile("" : "+v"(tid));
    LAS bf16_t* Ks = (LAS bf16_t*)lds; LAS bf16_t* Vs = Ks + 4096; LAS float* aux = (LAS float*)(lds + 16384);
    const int part = tid & 3, t = qb * 128 + (tid >> 2); const size_t row = (size_t)b * SEQ + t;
    float q[16], o[16];
    { const u32x4* qp = (const u32x4*)(Q + row * pq + h * 64 + part * 16);
#pragma unroll
      for (int c = 0; c < 2; ++c) { const u32x4 w = qp[c]; q[8 * c + 0] = bflo(w.x); q[8 * c + 1] = bfhi(w.x); q[8 * c + 2] = bflo(w.y); q[8 * c + 3] = bfhi(w.y); q[8 * c + 4] = bflo(w.z); q[8 * c + 5] = bfhi(w.z); q[8 * c + 6] = bflo(w.w); q[8 * c + 7] = bfhi(w.w); } }
#pragma unroll
    for (int d = 0; d < 16; ++d) o[d] = 0.f;
    float mrun = NEG_BIG, lrun = 0.f, R = 0.f, c2t = 0.f;
    if (VAR == 0) c2t = c2f[((size_t)b * NHEAD + h) * SEQ + t];
    if (VAR == 2) { if (tid < 128) {
            int bk; if (tid < 16) bk = tid; else { bk = 16 + (int)(logf((float)tid / 16.0f) / 2.0794415416798357f * 16.0f); if (bk > 31) bk = 31; }
            aux[tid] = relb[bk * NHEAD + h] * LOG2E; } }
    const int ntile = (qb * 128 + 128) / 64;
#pragma unroll 1
    for (int it = 0; it < ntile; ++it) {
        const int kt = (VAR == 1) ? ntile - 1 - it : it;
        __syncthreads();
        { const int key = tid >> 3, ch = tid & 7; const size_t kr = (size_t)b * SEQ + kt * 64 + key;
          *(LAS u32x4*)(Ks + key * 64 + ch * 8) = *(const u32x4*)(K + kr * pk + h * 64 + ch * 8);
          *(LAS u32x4*)(Vs + key * 64 + ch * 8) = *(const u32x4*)(V + kr * pv + h * 64 + ch * 8);
          if (VAR == 0 && tid < 64) aux[tid] = c2f[((size_t)b * NHEAD + h) * SEQ + kt * 64 + tid]; }
        __syncthreads();
        if (VAR == 1) {
#pragma unroll 1
            for (int j = 63; j >= 0; --j) { const int s = kt * 64 + j; const bool ok = s < t;
                float z = 0.f; DOT16(z, (const LAS u32x4*)(Ks + j * 64 + part * 16));
                R += ok ? softplus2(z) : 0.f; const float a = ok ? __builtin_amdgcn_exp2f(z - R) : 0.f;
                AXPY16(a, (const LAS u32x4*)(Vs + j * 64 + part * 16)); }
        } else {
            unsigned mw0 = 0xffffffffu, mw1 = 0xffffffffu;
            if (VAR == 2) { const u32x2 mm = *(const u32x2*)(mask + row * 64 + kt * 2); mw0 = mm.x; mw1 = mm.y; }
#pragma unroll 1
            for (int c8 = 0; c8 < 8; ++c8) {
                float lg[8]; float cm = NEG_BIG;
#pragma unroll
                for (int jj = 0; jj < 8; ++jj) { const int j = c8 * 8 + jj, s = kt * 64 + j;
                    bool ok = s <= t; if (VAR == 2) ok = ok && (((j < 32 ? mw0 : mw1) >> (j & 31)) & 1u);
                    float z = 0.f; DOT16(z, (const LAS u32x4*)(Ks + j * 64 + part * 16));
                    if (VAR == 0) z += c2t - aux[j]; else { int dd = t - s; dd = dd < 0 ? 0 : (dd > 127 ? 127 : dd); z += aux[dd]; }
                    lg[jj] = ok ? z : NEG_BIG; cm = fmaxf(cm, lg[jj]); }
                const float newm = fmaxf(mrun, cm), f = __builtin_amdgcn_exp2f(mrun - newm); lrun *= f; mrun = newm;
#pragma unroll
                for (int d = 0; d < 16; ++d) o[d] *= f;
#pragma unroll
                for (int jj = 0; jj < 8; ++jj) { const float p = (lg[jj] > -1.0e29f) ? __builtin_amdgcn_exp2f(lg[jj] - mrun) : 0.f; lrun += p;
                    AXPY16(p, (const LAS u32x4*)(Vs + (c8 * 8 + jj) * 64 + part * 16)); }
            }
        }
    }
    float inv = 1.f; if (VAR != 1) inv = 1.f / lrun;
    u32x4* op = (u32x4*)(O + row * 512 + h * 64 + part * 16);
#pragma unroll
    for (int c = 0; c < 2; ++c) { float v[8];
#pragma unroll
        for (int i = 0; i < 8; ++i) v[i] = o[8 * c + i] * inv;
        if (VAR == 0) { const u32x4 g = *(const u32x4*)(ogate + row * 512 + h * 64 + part * 16 + 8 * c); v[0] *= bflo(g.x); v[1] *= bfhi(g.x); v[2] *= bflo(g.y); v[3] *= bfhi(g.y); v[4] *= bflo(g.z); v[5] *= bfhi(g.z); v[6] *= bflo(g.w); v[7] *= bfhi(g.w); }
        u32x4 w; w.x = pk2(v[0], v[1]); w.y = pk2(v[2], v[3]); w.z = pk2(v[4], v[5]); w.w = pk2(v[6], v[7]); op[c] = w; }
    __syncthreads();
}

__device__ __forceinline__ void select_row(const float* sc_row, unsigned* mask_row, int t, int lane) {
    asm volatile("" : "+v"(lane));
    if (t < 256) { const int lo = 32 * lane; mask_row[lane] = (t >= lo + 31) ? 0xffffffffu : (t < lo ? 0u : ((2u << (t - lo)) - 1u)); return; }
    unsigned key[32];
#pragma unroll
    for (int j = 0; j < 32; ++j) { const int s = 64 * j + lane; const unsigned u = __float_as_uint(sc_row[s <= t ? s : t]); const unsigned k = (u & 0x80000000u) ? ~u : (u | 0x80000000u); key[j] = (s <= t) ? k : 0u; }
    unsigned T = 0u;
    for (int bit = 31; bit >= 0; --bit) { const unsigned cand = T | (1u << bit); int c = 0;
#pragma unroll
        for (int j = 0; j < 32; ++j) c += (key[j] >= cand) ? 1 : 0;
#pragma unroll
        for (int o = 1; o < 64; o <<= 1) c += __shfl_xor(c, o);
        if (c >= 256) T = cand; }
    int gt = 0;
#pragma unroll
    for (int j = 0; j < 32; ++j) gt += (key[j] > T) ? 1 : 0;
#pragma unroll
    for (int o = 1; o < 64; o <<= 1) gt += __shfl_xor(gt, o);
    const int need = 256 - gt; int run = 0; unsigned myw = 0u;
#pragma unroll
    for (int j = 0; j < 32; ++j) { const bool eq = key[j] == T; const unsigned long long beq = __ballot(eq);
        const int pre = run + (int)__builtin_amdgcn_mbcnt_hi((unsigned)(beq >> 32), __builtin_amdgcn_mbcnt_lo((unsigned)beq, 0u));
        const bool sel = (key[j] > T) || (eq && pre < need); run += __popcll(beq);
        const unsigned long long bs = __ballot(sel); myw = (lane == 2 * j) ? (unsigned)bs : myw; myw = (lane == 2 * j + 1) ? (unsigned)(bs >> 32) : myw; }
    mask_row[lane] = myw;
}

typedef __attribute__((address_space(4))) const char* kptr_t; typedef const float* cfp_t; typedef const __attribute__((address_space(4))) cfp_t* kslot_t;
__device__ __forceinline__ const float* arg_ptr(int i) { kptr_t ka = (kptr_t)__builtin_amdgcn_kernarg_segment_ptr(); asm volatile("" : "+s"(ka)); return *(kslot_t)(ka + 8 * i); }
__global__ void __launch_bounds__(512, 2) mk_fwd(Args args) {
    extern __shared__ __attribute__((aligned(16))) unsigned char lds_raw[];
    LAS unsigned char* lds = (LAS unsigned char*)lds_raw;
    volatile LAS unsigned* MISC = (volatile LAS unsigned*)(lds + MISC_OFF);
    const int G = gridDim.x, bid = blockIdx.x, NGW = G * 8;
    unsigned* ctl = (unsigned*)((unsigned char*)arg_ptr(23) + WS_CTL);
    for (int u = threadIdx.x; u < (LDS_BYTES - LDSCTL_OFF) / 4; u += 512) ((LAS unsigned*)(lds + LDSCTL_OFF))[u] = 0u;
#define SITE_PROLOG unsigned char* ws = (unsigned char*)arg_ptr(23); int tid = threadIdx.x; asm volatile("" : "+v"(tid)); \
    const int lane = tid & 63, wave = __builtin_amdgcn_readfirstlane(tid >> 6), gw = bid * 8 + wave; (void)ws; (void)lane; (void)gw;
    __syncthreads();
    const int lo = args.ph_lo, hi = args.ph_hi;
    XcdBarrier bar; bar.bar = ctl + CW_BAR; bar.x = 0; bar.st = nullptr;
    if (hi - lo > 1) bar = xcd_barrier_post(ctl + CW_BAR, MISC + 8);
#define x_in arg_ptr(0)
#define w_in arg_ptr(1)
#define b_forget arg_ptr(2)
#define q_norm arg_ptr(3)
#define k_norm arg_ptr(4)
#define kv_norm arg_ptr(5)
#define w_ukv arg_ptr(6)
#define w_br0 arg_ptr(7)
#define w_br1 arg_ptr(8)
#define w_br2 arg_ptr(9)
#define w_out arg_ptr(10)
#define rel_bias arg_ptr(11)
#define norm_mix arg_ptr(12)
#define norm_ffn arg_ptr(13)
#define w_fg arg_ptr(14)
#define w_fu arg_ptr(15)
#define w_fd arg_ptr(16)
#define w_router arg_ptr(17)
#define w_mg arg_ptr(18)
#define w_mu arg_ptr(19)
#define w_md arg_ptr(20)
#define norm_final arg_ptr(21)
#define X ((float*)arg_ptr(22))
#define WIN ((bf16_t*)(ws + WS_WIN))
#define WUKV ((bf16_t*)(ws + WS_WUKV))
#define WBR ((bf16_t*)(ws + WS_WBR))
#define WOUT ((bf16_t*)(ws + WS_WOUT))
#define WGU0 ((bf16_t*)(ws + WS_WGU0))
#define WD0 ((bf16_t*)(ws + WS_WD0))
#define WGUM ((bf16_t*)(ws + WS_WGUM))
#define WDM ((bf16_t*)(ws + WS_WDM))
#define RSTD ((float*)(ws + WS_RSTD))
#define SSP ((float*)(ws + WS_SSP))
#define XB ((bf16_t*)(ws + WS_XB))
#define Z8 ((bf16_t*)(ws + WS_Z8))
#define DLAT ((bf16_t*)(ws + WS_DLAT))
#define DIQ ((bf16_t*)(ws + WS_DIQ))
#define DIK ((bf16_t*)(ws + WS_DIK))
#define FFW ((float*)(ws + WS_FFW))
#define GATES ((bf16_t*)(ws + WS_GATES))
#define C2F ((float*)(ws + WS_C2F))
#define DKV ((bf16_t*)(ws + WS_DKV))
#define SC ((float*)(ws + WS_SC))
#define MASK ((unsigned*)(ws + WS_MASK))
#define YATT ((bf16_t*)(ws + WS_YATT))
#define MB ((bf16_t*)(ws + WS_M))
#define HID ((bf16_t*)(ws + WS_HID))
#define XG ((bf16_t*)(ws + WS_XG))
#define HIDM ((bf16_t*)(ws + WS_HIDM))
#define Y ((float*)(ws + WS_Y))
#define ROWTOK ((int*)(ws + WS_ROWTOK))
#define ROWW ((float*)(ws + WS_ROWW))
#define RSTDG ((float*)(ws + WS_RSTDG))
#define TOKINFO ((int*)(ws + WS_TOKINFO))
#define TOKW ((float*)(ws + WS_TOKW))
#define WGCNT ((int*)(ws + WS_WGCNT))
#define META ((int*)(ws + WS_META))

    int step = 0;
#define STEP_IF if (step >= lo && step < hi)
#define STEP_END do { if (step >= lo && step + 1 < hi) xcd_barrier(bar); ++step; } while (0)

    if (SITE_ON(0)) STEP_IF { SITE_PROLOG
        LAS float* scr = (LAS float*)(lds + wave * 16384);
        for (int l = 0; l < 2; ++l) {
            conv_matrix(1, w_in + (size_t)l * DM * NIN, nullptr, DM, NIN, NINP, WIN + (size_t)l * NINP * DM, norm_mix + l * DM, scr, gw, NGW, lane);
            conv_matrix(0, w_ukv + (size_t)l * KVR * 1024, nullptr, KVR, 1024, 1024, WUKV + (size_t)l * 1024 * KVR, kv_norm + l * KVR, scr, gw, NGW, lane);
            conv_matrix(0, w_br0 + (size_t)l * WBR_W * DM, nullptr, WBR_W, DM, DM, WBR + (size_t)(l * 3 + 0) * DM * WBR_W, nullptr, scr, gw, NGW, lane);
            conv_matrix(0, w_br1 + (size_t)l * WBR_W * DM, nullptr, WBR_W, DM, DM, WBR + (size_t)(l * 3 + 1) * DM * WBR_W, nullptr, scr, gw, NGW, lane);
            conv_matrix(0, w_br2 + (size_t)l * WBR_W * DM, nullptr, WBR_W, DM, DM, WBR + (size_t)(l * 3 + 2) * DM * WBR_W, nullptr, scr, gw, NGW, lane);
            conv_matrix(0, w_out + (size_t)l * DM * DM, nullptr, DM, DM, DM, WOUT + (size_t)l * DM * DM, nullptr, scr, gw, NGW, lane);
        }
        conv_matrix(2, w_fg, w_fu, DM, DFF, 2 * DFF, WGU0, norm_ffn, scr, gw, NGW, lane);
        conv_matrix(0, w_fd, nullptr, DFF, DM, DM, WD0, nullptr, scr, gw, NGW, lane);
        for (int e = 0; e < NEXP; ++e) {
            conv_matrix(2, w_mg + (size_t)e * DM * DFF, w_mu + (size_t)e * DM * DFF, DM, DFF, 2 * DFF, WGUM + (size_t)e * 2 * DFF * DM, norm_ffn + DM, scr, gw, NGW, lane);
            conv_matrix(0, w_md + (size_t)e * DFF * DM, nullptr, DFF, DM, DM, WDM + (size_t)e * DM * DFF, nullptr, scr, gw, NGW, lane);
        }
        for (int m = gw; m < NTOK; m += NGW) {
            const f32x4* xr = (const f32x4*)(x_in + (size_t)m * DM) + lane; f32x4 v[8]; float s = 0.f;
#pragma unroll
            for (int j = 0; j < 8; ++j) { v[j] = xr[64 * j]; s += (v[j][0] * v[j][0] + v[j][1] * v[j][1]) + (v[j][2] * v[j][2] + v[j][3] * v[j][3]); }
            s = wave_sum(s);
            u32x2* o = (u32x2*)(XB + (size_t)m * DM) + lane;
#pragma unroll
            for (int j = 0; j < 8; ++j) { u32x2 w; w.x = pk2(v[j][0], v[j][1]); w.y = pk2(v[j][2], v[j][3]); o[64 * j] = w; }
            if (lane == 0) RSTD[m] = 1.0f / sqrtf(s * (1.0f / DM) + EPS);
        }
    }
    STEP_END;

    for (int l = 0; l < 2; ++l) {
        if (SITE_ON(1)) STEP_IF { SITE_PROLOG
            pg8::PlainOrder S; S.init(NTOK / 256, NINP / 256, G, bid); S.A = (const char*)XB; S.ta = (size_t)256 * DM * 2; S.B = (const char*)(WIN + (size_t)l * NINP * DM); S.tb = (size_t)256 * DM * 2;
            EpiWin E{RSTD, Z8, DLAT, DIQ, DIK, FFW, GATES};
            pg8::gemm_phase<EpiWin, pg8::PlainOrder, true, true>(lds, pg8::Gemm{opq(DM)}, S, E);
        }
        STEP_END;
        if (SITE_ON(2)) STEP_IF { SITE_PROLOG
            for (int m = gw; m < NTOK; m += NGW) {
#pragma unroll
                for (int which = 0; which < 2; ++which) {
                    bf16_t* p = Z8 + (size_t)which * NTOK * 512 + (size_t)m * 512 + 8 * lane; const u32x4 w = *(const u32x4*)p;
                    float v[8] = {bflo(w.x), bfhi(w.x), bflo(w.y), bfhi(w.y), bflo(w.z), bfhi(w.z), bflo(w.w), bfhi(w.w)}; float ss = 0.f;
#pragma unroll
                    for (int i = 0; i < 8; ++i) ss += v[i] * v[i];
                    ss += __shfl_xor(ss, 1); ss += __shfl_xor(ss, 2); ss += __shfl_xor(ss, 4);
                    const float rs = (1.0f / sqrtf(ss * (1.0f / 64.0f) + EPS)) * (which == 0 ? C2 : 1.0f);
                    const float* gp = (which == 0 ? q_norm : k_norm) + l * HD + 8 * (lane & 7); const f32x4 g0 = *(const f32x4*)gp, g1 = *(const f32x4*)(gp + 4);
                    u32x4 o; o.x = pk2(v[0] * rs * g0[0], v[1] * rs * g0[1]); o.y = pk2(v[2] * rs * g0[2], v[3] * rs * g0[3]); o.z = pk2(v[4] * rs * g1[0], v[5] * rs * g1[1]); o.w = pk2(v[6] * rs * g1[2], v[7] * rs * g1[3]);
                    *(u32x4*)p = o;
                }
                { bf16_t* p = DLAT + (size_t)m * 256 + 4 * lane; const u32x2 w = *(const u32x2*)p; const float a0 = bflo(w.x), a1 = bfhi(w.x), a2 = bflo(w.y), a3 = bfhi(w.y);
                  const float ss = wave_sum((a0 * a0 + a1 * a1) + (a2 * a2 + a3 * a3)); const float rs = 1.0f / sqrtf(ss * (1.0f / 256.0f) + EPS);
                  u32x2 o; o.x = pk2(a0 * rs, a1 * rs); o.y = pk2(a2 * rs, a3 * rs); *(u32x2*)p = o; }
            }
            if (gw < NBATCH * NHEAD) {
                const int b = gw >> 3, h = gw & 7; const float bias = b_forget[l * NHEAD + h];
                const float* fp = FFW + ((size_t)b * SEQ + 32 * lane) * 16 + h; float tot = 0.f;
                for (int i = 0; i < 32; ++i) tot += -softplus2(-(fp[i * 16] + bias) * LOG2E);
                float inc = tot;
#pragma unroll
                for (int o = 1; o < 64; o <<= 1) { const float tv = __shfl_up(inc, o); if (lane >= o) inc += tv; }
                float run = inc - tot; float* cp = C2F + ((size_t)b * NHEAD + h) * SEQ + 32 * lane;
                for (int i = 0; i < 32; ++i) { run += -softplus2(-(fp[i * 16] + bias) * LOG2E); cp[i] = run; }
            }
        }
        STEP_END;
        if (SITE_ON(3)) STEP_IF { SITE_PROLOG
            { pg8::PlainOrder S; S.init(NTOK / 256, 4, G, bid); S.A = (const char*)DLAT; S.ta = (size_t)256 * KVR * 2; S.B = (const char*)(WUKV + (size_t)l * 1024 * KVR); S.tb = (size_t)256 * KVR * 2;
              EpiPlain E{DKV, 1024};
              pg8::gemm_phase<EpiPlain, pg8::PlainOrder, true, true>(lds, pg8::Gemm{opq(KVR)}, S, E); }
            if ((wave & 3) == 0) {
                const int k = (bid * 2 + (wave >> 2)) % 512, pr = k >> 1, b = pr >> 5, uu = pr & 31, tt = (k & 1) ? 63 - uu : uu;
                int ln = lane; asm volatile("" : "+v"(ln)); const int r32 = ln & 31, hh = ln >> 5; const size_t trow = (size_t)b * SEQ + tt * 32 + r32;
                bf16x8 bq[4][4];
#pragma unroll
                for (int h = 0; h < 4; ++h)
#pragma unroll
                    for (int d0 = 0; d0 < 4; ++d0) bq[h][d0] = *(const bf16x8*)(DIQ + trow * 256 + h * 64 + d0 * 16 + 8 * hh);
                const f32x4 wv = *(const f32x4*)(FFW + trow * 16 + 8) * 0.0625f;
                for (int st = 0; st <= tt; ++st) {
                    const size_t srow = (size_t)b * SEQ + st * 32 + r32; bf16x8 ak[4];
#pragma unroll
                    for (int d0 = 0; d0 < 4; ++d0) ak[d0] = *(const bf16x8*)(DIK + srow * 64 + d0 * 16 + 8 * hh);
                    f32x16 sc;
#pragma unroll
                    for (int r = 0; r < 16; ++r) sc[r] = 0.f;
#pragma unroll
                    for (int h = 0; h < 4; ++h) { f32x16 a;
#pragma unroll
                        for (int r = 0; r < 16; ++r) a[r] = 0.f;
#pragma unroll
                        for (int d0 = 0; d0 < 4; ++d0) a = __builtin_amdgcn_mfma_f32_32x32x16_bf16(ak[d0], bq[h][d0], a, 0, 0, 0);
#pragma unroll
                        for (int r = 0; r < 16; ++r) sc[r] += fmaxf(a[r], 0.f) * wv[h]; }
                    float* sp = SC + trow * SEQ + st * 32 + 4 * hh;
#pragma unroll
                    for (int g = 0; g < 4; ++g) *(f32x4*)(sp + 8 * g) = (f32x4){sc[4 * g], sc[4 * g + 1], sc[4 * g + 2], sc[4 * g + 3]};
                }
            }
        }
        STEP_END;
        if (SITE_ON(4)) STEP_IF { SITE_PROLOG
            for (int idx = gw; idx < NTOK; idx += NGW) { const int b = idx / SEQ, t0 = idx - b * SEQ, t = (b & 1) ? SEQ - 1 - t0 : t0; const size_t row = (size_t)b * SEQ + t;
                select_row(SC + row * SEQ, MASK + row * 64, t, lane); }
        }
        STEP_END;
        if (SITE_ON(5)) STEP_IF { SITE_PROLOG
            for (int i = 0; i < 12; ++i) { const int U = i * G + bid; if (U >= 3072) break;
                const int var = U >> 10, rem = U & 1023, bh = rem >> 4, qb = (i & 1) ? 15 - (rem & 15) : (rem & 15), b = bh >> 3, h = bh & 7;
                if (var == 0) attn_naive_unit<0>(lds, tid, b, h, qb, Z8, 512, Z8 + (size_t)1 * NTOK * 512, 512, Z8 + (size_t)2 * NTOK * 512, 512, C2F, nullptr, nullptr, Z8 + (size_t)3 * NTOK * 512, YATT);
                else if (var == 1) attn_naive_unit<1>(lds, tid, b, h, qb, Z8 + (size_t)4 * NTOK * 512, 512, Z8 + (size_t)5 * NTOK * 512, 512, Z8 + (size_t)6 * NTOK * 512, 512, nullptr, nullptr, nullptr, nullptr, YATT + (size_t)NTOK * 512);
                else attn_naive_unit<2>(lds, tid, b, h, qb, Z8 + (size_t)7 * NTOK * 512, 512, DKV, 1024, DKV + 512, 1024, nullptr, MASK, rel_bias, nullptr, YATT + (size_t)2 * NTOK * 512);
            }
        }
        STEP_END;
        if (SITE_ON(6)) STEP_IF { SITE_PROLOG
            pg8::BranchOrder S; S.init(NTOK / 256, DM / 256, G, bid); S.A = (const char*)YATT; S.ta = (size_t)256 * WBR_W * 2; S.za = (size_t)NTOK * WBR_W * 2;
            S.B = (const char*)(WBR + (size_t)l * 3 * DM * WBR_W); S.tb = (size_t)256 * WBR_W * 2; S.zb = (size_t)DM * WBR_W * 2;
            EpiBranch E{GATES, MB};
            pg8::gemm_phase<EpiBranch, pg8::BranchOrder, true, true>(lds, pg8::Gemm{opq(WBR_W)}, S, E);
        }
        STEP_END;
        if (SITE_ON(7)) STEP_IF { SITE_PROLOG
            pg8::PlainOrder S; S.init(NTOK / 256, DM / 256, G, bid); S.A = (const char*)MB; S.ta = (size_t)256 * DM * 2; S.B = (const char*)(WOUT + (size_t)l * DM * DM); S.tb = (size_t)256 * DM * 2;
            EpiResid E{l == 0 ? x_in : (const float*)X, X, XB, SSP};
            pg8::gemm_phase<EpiResid, pg8::PlainOrder, true, true>(lds, pg8::Gemm{opq(DM)}, S, E);
        }
        STEP_END;
        if (l == 0) {
            if (SITE_ON(8)) STEP_IF { SITE_PROLOG for (int r = bid * 512 + tid; r < NTOK; r += G * 512) { const f32x4* p = (const f32x4*)(SSP + (size_t)r * 32); float s = 0.f;
#pragma unroll
                    for (int j = 0; j < 8; ++j) { const f32x4 v = p[j]; s += (v[0] + v[1]) + (v[2] + v[3]); }
                    RSTD[r] = 1.0f / sqrtf(s * (1.0f / DM) + EPS); } }
            STEP_END;
            if (SITE_ON(9)) STEP_IF { SITE_PROLOG
                pg8::PlainOrder S; S.init(NTOK / 256, DFF / 128, G, bid); S.A = (const char*)XB; S.ta = (size_t)256 * DM * 2; S.B = (const char*)WGU0; S.tb = (size_t)256 * DM * 2;
                EpiSwiglu E{RSTD, HID};
                pg8::gemm_phase<EpiSwiglu, pg8::PlainOrder, true, true>(lds, pg8::Gemm{opq(DM)}, S, E);
            }
            STEP_END;
            if (SITE_ON(10)) STEP_IF { SITE_PROLOG
                pg8::PlainOrder S; S.init(NTOK / 256, DM / 256, G, bid); S.A = (const char*)HID; S.ta = (size_t)256 * DFF * 2; S.B = (const char*)WD0; S.tb = (size_t)256 * DFF * 2;
                EpiResid E{X, X, XB, SSP};
                pg8::gemm_phase<EpiResid, pg8::PlainOrder, true, true>(lds, pg8::Gemm{opq(DFF)}, S, E);
            }
            STEP_END;
            if (SITE_ON(11)) STEP_IF { SITE_PROLOG for (int r = bid * 512 + tid; r < NTOK; r += G * 512) { const f32x4* p = (const f32x4*)(SSP + (size_t)r * 32); float s = 0.f;
#pragma unroll
                    for (int j = 0; j < 8; ++j) { const f32x4 v = p[j]; s += (v[0] + v[1]) + (v[2] + v[3]); }
                    RSTD[r] = 1.0f / sqrtf(s * (1.0f / DM) + EPS); } }
            STEP_END;
        } else {
            if (SITE_ON(12)) STEP_IF { SITE_PROLOG
                LAS int* le = (LAS int*)lds;
                for (int wgi = bid; wgi < NTOK / 64; wgi += G) {
                    __syncthreads();
                    for (int i = 0; i < 8; ++i) { const int tl = wave * 8 + i, tok = wgi * 64 + tl;
                        const f32x4* xr = (const f32x4*)(X + (size_t)tok * DM) + lane; f32x4 v[8]; float s = 0.f;
#pragma unroll
                        for (int j = 0; j < 8; ++j) { v[j] = xr[64 * j]; s += (v[j][0] * v[j][0] + v[j][1] * v[j][1]) + (v[j][2] * v[j][2] + v[j][3] * v[j][3]); }
                        s = wave_sum(s); const float rs = 1.0f / sqrtf(s * (1.0f / DM) + EPS);
                        float lg[8];
#pragma unroll
                        for (int e = 0; e < 8; ++e) lg[e] = 0.f;
#pragma unroll
                        for (int j = 0; j < 8; ++j) { const int k0 = 256 * j + 4 * lane; const f32x4 gn = *(const f32x4*)(norm_ffn + DM + k0);
#pragma unroll
                            for (int c = 0; c < 4; ++c) { const float xg = v[j][c] * gn[c]; const f32x4 w0 = *(const f32x4*)(w_router + (size_t)(k0 + c) * 8), w1 = *(const f32x4*)(w_router + (size_t)(k0 + c) * 8 + 4);
                                lg[0] += xg * w0[0]; lg[1] += xg * w0[1]; lg[2] += xg * w0[2]; lg[3] += xg * w0[3]; lg[4] += xg * w1[0]; lg[5] += xg * w1[1]; lg[6] += xg * w1[2]; lg[7] += xg * w1[3]; } }
#pragma unroll
                        for (int e = 0; e < 8; ++e) lg[e] = wave_sum(lg[e]) * rs;
                        float v0 = lg[0]; int i0 = 0;
#pragma unroll
                        for (int e = 1; e < 8; ++e) if (lg[e] > v0) { v0 = lg[e]; i0 = e; }
                        float v1 = -INFINITY; int i1 = 0;
#pragma unroll
                        for (int e = 0; e < 8; ++e) if (e != i0 && lg[e] > v1) { v1 = lg[e]; i1 = e; }
                        const float ex = __expf(v1 - v0), w0 = 1.0f / (1.0f + ex), w1 = ex / (1.0f + ex);
                        if (lane == 0) { le[tl * 2] = i0; le[tl * 2 + 1] = i1; TOKW[(size_t)tok * 2] = w0; TOKW[(size_t)tok * 2 + 1] = w1; RSTD[tok] = rs; }
                    }
                    __syncthreads();
                    if (tid < 128) { const int e = le[tid]; int rk = 0; for (int j = 0; j < tid; ++j) rk += (le[j] == e); const int tok = wgi * 64 + (tid >> 1);
                        TOKINFO[((size_t)tok * 2 + (tid & 1)) * 2] = e; TOKINFO[((size_t)tok * 2 + (tid & 1)) * 2 + 1] = rk; }
                    if (tid >= 128 && tid < 136) { const int e = tid - 128; int c = 0; for (int j = 0; j < 128; ++j) c += (le[j] == e); WGCNT[wgi * 8 + e] = c; }
                }
            }
            STEP_END;
            if (SITE_ON(13)) STEP_IF { SITE_PROLOG
                LAS int* lc = (LAS int*)lds;
                for (int wgi = bid; wgi < NTOK / 64; wgi += G) {
                    __syncthreads();
                    { const int e = wave; int all = 0, before = 0;
#pragma unroll
                      for (int c = 0; c < 4; ++c) { const int w = 4 * lane + c; const int v = WGCNT[w * 8 + e]; all += v; before += (w < wgi) ? v : 0; }
#pragma unroll
                      for (int o = 1; o < 64; o <<= 1) { all += __shfl_xor(all, o); before += __shfl_xor(before, o); }
                      if (lane == 0) { lc[e] = all; lc[8 + e] = before; } }
                    __syncthreads();
                    if (tid == 0) { int tb = 0; for (int e = 0; e < 8; ++e) { lc[16 + e] = tb * 256; tb += (lc[e] + 255) >> 8; if (wgi == 0) META[e] = lc[16 + e] >> 8; } if (wgi == 0) META[8] = tb; }
                    __syncthreads();
                    for (int i = 0; i < 16; ++i) { const int p = wave * 16 + i, tok = wgi * 64 + (p >> 1), slot = p & 1;
                        const int e = TOKINFO[((size_t)tok * 2 + slot) * 2], rk = TOKINFO[((size_t)tok * 2 + slot) * 2 + 1]; const int r = lc[16 + e] + lc[8 + e] + rk;
                        const u32x4* sp = (const u32x4*)(XB + (size_t)tok * DM) + lane; u32x4* dp = (u32x4*)(XG + (size_t)r * DM) + lane;
#pragma unroll
                        for (int c = 0; c < 4; ++c) dp[64 * c] = sp[64 * c];
                        if (lane == 0) { ROWTOK[r] = tok * 2 + slot; ROWW[r] = TOKW[(size_t)tok * 2 + slot]; RSTDG[r] = RSTD[tok]; } }
                    if (wgi < 8) { const int e = wgi, r0 = lc[16 + e] + lc[e], r1 = lc[16 + e] + (((lc[e] + 255) >> 8) << 8);
                        for (int r = r0 + wave; r < r1; r += 8) { u32x4* dp = (u32x4*)(XG + (size_t)r * DM) + lane;
#pragma unroll
                            for (int c = 0; c < 4; ++c) dp[64 * c] = (u32x4){0u, 0u, 0u, 0u};
                            if (lane == 0) { ROWTOK[r] = -1; ROWW[r] = 0.f; RSTDG[r] = 0.f; } } }
                }
            }
            STEP_END;
            if (SITE_ON(14)) STEP_IF { SITE_PROLOG
                pg8::MoeOrder S; S.t1 = META[1]; S.t2 = META[2]; S.t3 = META[3]; S.t4 = META[4]; S.t5 = META[5]; S.t6 = META[6]; S.t7 = META[7];
                S.init(META[8], DFF / 128, G, bid); S.A = (const char*)XG; S.ta = (size_t)256 * DM * 2; S.B = (const char*)WGUM; S.tb = (size_t)256 * DM * 2; S.zb = SZ_WGU;
                EpiSwiglu E{RSTDG, HIDM};
                pg8::gemm_phase<EpiSwiglu, pg8::MoeOrder, true, true>(lds, pg8::Gemm{opq(DM)}, S, E);
            }
            STEP_END;
            if (SITE_ON(15)) STEP_IF { SITE_PROLOG
                pg8::MoeOrder S; S.t1 = META[1]; S.t2 = META[2]; S.t3 = META[3]; S.t4 = META[4]; S.t5 = META[5]; S.t6 = META[6]; S.t7 = META[7];
                S.init(META[8], DM / 256, G, bid); S.A = (const char*)HIDM; S.ta = (size_t)256 * DFF * 2; S.B = (const char*)WDM; S.tb = (size_t)256 * DFF * 2; S.zb = SZ_WD;
                EpiMoeDown E{ROWTOK, ROWW, Y};
                pg8::gemm_phase<EpiMoeDown, pg8::MoeOrder, true, true>(lds, pg8::Gemm{opq(DFF)}, S, E);
            }
            STEP_END;
            if (SITE_ON(16)) STEP_IF { SITE_PROLOG
                for (int m = gw; m < NTOK; m += NGW) {
                    f32x4* xr = (f32x4*)(X + (size_t)m * DM) + lane; const f32x4* y0 = (const f32x4*)(Y + (size_t)m * DM) + lane; const f32x4* y1 = (const f32x4*)(Y + (size_t)NTOK * DM + (size_t)m * DM) + lane;
                    f32x4 v[8]; float s = 0.f;
#pragma unroll
                    for (int j = 0; j < 8; ++j) { v[j] = xr[64 * j] + y0[64 * j] + y1[64 * j]; s += (v[j][0] * v[j][0] + v[j][1] * v[j][1]) + (v[j][2] * v[j][2] + v[j][3] * v[j][3]); }
                    s = wave_sum(s); const float rs = 1.0f / sqrtf(s * (1.0f / DM) + EPS);
#pragma unroll
                    for (int j = 0; j < 8; ++j) { const f32x4 g = *((const f32x4*)norm_final + lane + 64 * j); xr[64 * j] = v[j] * rs * g; }
                }
            }
            STEP_END;
        }
    }
#undef STEP_IF
#undef STEP_END
}


#ifndef DBG_STOP
#define DBG_STOP -1
#endif
#ifndef DBG_LO
#define DBG_LO WS_WIN
#endif
#if DBG_STOP >= 0
__global__ void dbg_dump(const unsigned short* ws16, size_t n16, const unsigned* xin, float* out, int with_x) {
    for (size_t i = (size_t)blockIdx.x * blockDim.x + threadIdx.x; i < (size_t)NTOK * DM; i += (size_t)gridDim.x * blockDim.x) {
        unsigned acc = 0; for (size_t off = i; off < n16; off += (size_t)NTOK * DM) acc += ws16[off];
        if (with_x) { const unsigned u = xin[i]; acc += (u & 0xffffu) + (u >> 16); }
        out[i] = (float)(acc & 0xfffffu);
    }
}
#endif

#if DBG_STOP == 100
__global__ void dbg_cmp3(const unsigned short* a0, const unsigned short* b0, const unsigned short* a1, const unsigned short* b1, const unsigned short* a2, const unsigned short* b2, unsigned* cnt) {
    unsigned c0 = 0, c1 = 0, c2 = 0;
    for (size_t i = (size_t)blockIdx.x * blockDim.x + threadIdx.x; i < (size_t)NTOK * DM; i += (size_t)gridDim.x * blockDim.x) { c0 += a0[i] != b0[i]; c1 += a1[i] != b1[i]; c2 += a2[i] != b2[i]; }
    if (c0) atomicAdd(cnt, c0); if (c1) atomicAdd(cnt + 1, c1); if (c2) atomicAdd(cnt + 2, c2);
}
__global__ void dbg_fill(float* out, const unsigned* cnt) {
    const float E = (cnt[0] ? 3.f : 0.f) + (cnt[1] ? 10.f : 0.f) + (cnt[2] ? 30.f : 0.f);
    for (size_t i = (size_t)blockIdx.x * blockDim.x + threadIdx.x; i < (size_t)NTOK * DM; i += (size_t)gridDim.x * blockDim.x) out[i] = E;
}
#endif

#if DBG_STOP == 200
__global__ void dbg_cksum(const unsigned long long* p, size_t nblk, unsigned long long* ck) {
    for (size_t b = (size_t)blockIdx.x * blockDim.x + threadIdx.x; b < nblk; b += (size_t)gridDim.x * blockDim.x) {
        unsigned long long h = 0x9E3779B97F4A7C15ull; const unsigned long long* q = p + b * 128;
        for (int i = 0; i < 128; ++i) { h ^= q[i]; h *= 0xBF58476D1CE4E5B9ull; h ^= h >> 29; }
        ck[b] = h; }
}
__global__ void dbg_ckcmp(const unsigned long long* a, const unsigned long long* b, size_t nblk, unsigned long long* first) {
    for (size_t i = (size_t)blockIdx.x * blockDim.x + threadIdx.x; i < nblk; i += (size_t)gridDim.x * blockDim.x) if (a[i] != b[i]) atomicMin(first, (unsigned long long)i);
}
__global__ void dbg_fill2(float* out, const unsigned long long* first) {
    const unsigned long long off = WS_RSTD + (*first) * 1024ull; int id = 0;
    if (*first != ~0ull) { id = 1; if (off >= WS_Z8) id = 2; if (off >= WS_DLAT) id = 3; if (off >= WS_DIQ) id = 4; if (off >= WS_DIK) id = 5; if (off >= WS_FFW) id = 6; if (off >= WS_GATES) id = 7; if (off >= WS_C2F) id = 8;
        if (off >= WS_DKV) id = 9; if (off >= WS_SC) id = 10; if (off >= WS_MASK) id = 11; if (off >= WS_YATT) id = 12; if (off >= WS_M) id = 13; }
    const float E = 3.f * id;
    for (size_t i = (size_t)blockIdx.x * blockDim.x + threadIdx.x; i < (size_t)NTOK * DM; i += (size_t)gridDim.x * blockDim.x) out[i] = E;
}
#endif
extern "C" void kernel_launch(void* const* d_in, const int* in_sizes, int n_in, void* d_out, int out_size, void* d_ws, size_t ws_size, hipStream_t stream) {
    static int grid = 0;
    if (grid == 0) {
        if (n_in != 22 || out_size != NTOK * DM || ws_size < WS_END) { fprintf(stderr, "kernel_launch: unexpected problem (n_in %d, out %d, ws %zu, need %zu)\n", n_in, out_size, ws_size, (size_t)WS_END); grid = -1; return; }
        int dev = 0, cus = 0;
        if (hipGetDevice(&dev) != hipSuccess || hipDeviceGetAttribute(&cus, hipDeviceAttributeMultiprocessorCount, dev) != hipSuccess) { grid = -1; return; }
        if (hipFuncSetAttribute((const void*)mk_fwd, hipFuncAttributeMaxDynamicSharedMemorySize, LDS_BYTES) != hipSuccess) { fprintf(stderr, "kernel_launch: hipFuncSetAttribute failed\n"); grid = -1; return; }
        int per_cu = 0;
        if (hipOccupancyMaxActiveBlocksPerMultiprocessor(&per_cu, (const void*)mk_fwd, 512, LDS_BYTES) != hipSuccess || per_cu < 1) fprintf(stderr, "kernel_launch: occupancy query says %d\n", per_cu);
        (void)hipGetLastError();
        grid = cus;
    }
    if (grid < 0) return;
    (void)hipMemsetAsync((char*)d_ws + WS_CTL, 0, CTL_ZERO_BYTES, stream);
    Args a{};
    for (int i = 0; i < 22; ++i) a.in[i] = (const float*)d_in[i];
    a.out = (float*)d_out; a.ws = (unsigned char*)d_ws;
#if DBG_STOP == 200
    for (int s = 0; s <= DBG_HI; ++s) { a.ph_lo = s; a.ph_hi = s + 1; hipLaunchKernelGGL(mk_fwd, dim3(grid), dim3(512), LDS_BYTES, stream, a); }
    { char* w = (char*)d_ws; const size_t nblk = (WS_R_END1 - WS_RSTD) / 1024; unsigned long long* ck0 = (unsigned long long*)(w + WS_R_END1); unsigned long long* ck1 = ck0 + nblk; unsigned long long* first = (unsigned long long*)(w + 4096);
#ifdef DBG_WARMFIRST
      for (int s = DBG_LOSTEP; s <= DBG_HI; ++s) { a.ph_lo = s; a.ph_hi = s + 1; hipLaunchKernelGGL(mk_fwd, dim3(grid), dim3(512), LDS_BYTES, stream, a); }
#endif
      hipLaunchKernelGGL(dbg_cksum, dim3(2048), dim3(256), 0, stream, (const unsigned long long*)(w + WS_RSTD), nblk, ck0);
      for (int s = DBG_LOSTEP; s <= DBG_HI; ++s) { a.ph_lo = s; a.ph_hi = s + 1; hipLaunchKernelGGL(mk_fwd, dim3(grid), dim3(512), LDS_BYTES, stream, a); }
      hipLaunchKernelGGL(dbg_cksum, dim3(2048), dim3(256), 0, stream, (const unsigned long long*)(w + WS_RSTD), nblk, ck1);
      (void)hipMemsetAsync(first, 0xFF, 8, stream);
      hipLaunchKernelGGL(dbg_ckcmp, dim3(1024), dim3(256), 0, stream, (const unsigned long long*)ck0, (const unsigned long long*)ck1, nblk, first);
      hipLaunchKernelGGL(dbg_fill2, dim3(2048), dim3(256), 0, stream, (float*)d_out, (const unsigned long long*)first); }
#elif DBG_STOP == 100
    for (int s = 0; s <= 6; ++s) { a.ph_lo = s; a.ph_hi = s + 1; hipLaunchKernelGGL(mk_fwd, dim3(grid), dim3(512), LDS_BYTES, stream, a); }
    { char* w = (char*)d_ws; const size_t SZ = (size_t)NTOK * DM * 2; char* cp = w + WS_R_END1;
      hipMemcpyAsync(cp, w + WS_M, SZ, hipMemcpyDeviceToDevice, stream); hipMemcpyAsync(cp + SZ, w + WS_SC, 2 * SZ, hipMemcpyDeviceToDevice, stream);
      a.ph_lo = 6; a.ph_hi = 7; hipLaunchKernelGGL(mk_fwd, dim3(grid), dim3(512), LDS_BYTES, stream, a);
      unsigned* cnt = (unsigned*)(w + 4096); hipMemsetAsync(cnt, 0, 64, stream);
      hipLaunchKernelGGL(dbg_cmp3, dim3(2048), dim3(256), 0, stream, (const unsigned short*)(w + WS_M), (const unsigned short*)cp, (const unsigned short*)(w + WS_SC), (const unsigned short*)(cp + SZ), (const unsigned short*)(w + WS_SC + SZ), (const unsigned short*)(cp + 2 * SZ), cnt);
      hipLaunchKernelGGL(dbg_fill, dim3(2048), dim3(256), 0, stream, (float*)d_out, (const unsigned*)cnt); }
#elif DBG_STOP >= 0
    for (int s = 0; s <= DBG_STOP; ++s) { a.ph_lo = s; a.ph_hi = s + 1; hipLaunchKernelGGL(mk_fwd, dim3(grid), dim3(512), LDS_BYTES, stream, a); }
#ifdef DBG_TWICE
    { a.ph_lo = DBG_STOP; a.ph_hi = DBG_STOP + 1; hipLaunchKernelGGL(mk_fwd, dim3(grid), dim3(512), LDS_BYTES, stream, a); }
#endif
    hipLaunchKernelGGL(dbg_dump, dim3(2048), dim3(256), 0, stream, (const unsigned short*)((const char*)d_ws + DBG_LO), (size_t)((WS_END - DBG_LO) / 2), (const unsigned*)d_out, (float*)d_out, DBG_STOP >= 7 ? 1 : 0);
#elif MK_ONE_LAUNCH
    a.ph_lo = 0; a.ph_hi = NSTEPS;
    hipLaunchKernelGGL(mk_fwd, dim3(grid), dim3(512), LDS_BYTES, stream, a);
#else
    for (int s = 0; s < NSTEPS; ++s) { a.ph_lo = s; a.ph_hi = s + 1; hipLaunchKernelGGL(mk_fwd, dim3(grid), dim3(512), LDS_BYTES, stream, a); }
#endif
}
```

```cpp
#include <hip/hip_runtime.h>
#include <cstdio>
#include <cstdint>

#ifndef SITE_MASK
#define SITE_MASK 0xffffffffu
#endif
#define SITE_ON(i) (((SITE_MASK) >> (i)) & 1u)

#ifndef MK_ONE_LAUNCH
#define MK_ONE_LAUNCH 1
#endif

namespace pg8 {
#define PG8_LAS __attribute__((address_space(3)))
typedef unsigned short bf16_t;
typedef short bf16x8 __attribute__((ext_vector_type(8)));
typedef float f32x4 __attribute__((ext_vector_type(4)));
typedef unsigned u32x4 __attribute__((ext_vector_type(4)));
constexpr int BM = 256, BK = 64, HALF = 128, HTB = HALF * BK * 2  , STAGE_BYTES = 8 * HTB, NXCD = 8, WGM = 8;

__host__ __device__ __forceinline__ int lds_byte(int r, int c) { const int st = (r >> 4) * 2 + (c >> 5), rr = r & 15, cc = c & 31, ob = rr * 64 + cc * 2; return st * 1024 + (ob ^ (((ob >> 9) & 1) << 5)); }
__host__ __device__ __forceinline__ void stage_rc(int b, int& R, int& C) { const int st = b / 1024, sb = b % 1024, swz = sb ^ (((sb >> 9) & 1) << 5); R = (st >> 1) * 16 + swz / 64; C = (st & 1) * 32 + (swz % 64) / 2; }
__host__ __device__ __forceinline__ int perm32(int rho) { const int n = rho >> 4, i = rho & 15; return 8 * (i >> 2) + 4 * n + (i & 3); }
struct Unit { int pm, pn, aux; const char* a; const char* b; };
struct Gemm { int K; };
__device__ __forceinline__ unsigned cvt_pk_bf16(float lo, float hi) { unsigned r; asm volatile("v_cvt_pk_bf16_f32 %0, %1, %2" : "=v"(r) : "v"(lo), "v"(hi)); return r; }
template <class Epi, class Sched, bool ALIGN_EPI = false, bool SP2 = false>
__device__ __forceinline__ void gemm_phase(PG8_LAS unsigned char* lds, const Gemm g, const Sched& S, const Epi& E) {
    int tid_ = threadIdx.x; asm volatile("" : "+v"(tid_)); const int tid = tid_, wid = __builtin_amdgcn_readfirstlane(tid >> 6), lane = tid & 63, wr = wid >> 2, wc = wid & 3, fr = lane & 15, fq = lane >> 4;
    const int K = g.K, nt = K / BK;
    unsigned voffA[2], voffB[2];
#pragma unroll
    for (int i = 0; i < 2; ++i) { int R, C; stage_rc(tid * 16 + i * 8192, R, C); const int Rb = Epi::PERM ? ((R & ~31) + perm32(R & 31)) : R;
        voffA[i] = (unsigned)(R * K + C) * 2u; voffB[i] = (unsigned)(Rb * K + C) * 2u; }
    const size_t kstep = (size_t)(BK * 2);
    const size_t hstep = (size_t)HALF * K * 2;
    const unsigned ldsw = (unsigned)wid * 1024u;
    const int aoff = lds_byte(wr * 64 + fr, fq * 8), boff = lds_byte(wc * 32 + fr, fq * 8);
#define PG8_SA(b, h) (((b) * 2 + (h)) * HTB)
#define PG8_SB(b, h) ((4 + (b) * 2 + (h)) * HTB)
#define PG8_STAGE(bufoff, gbase, voff) do { _Pragma("unroll") for (int _i = 0; _i < 2; ++_i) \
        __builtin_amdgcn_global_load_lds((const unsigned*)((const char*)(gbase) + (voff)[_i]), (PG8_LAS unsigned*)(lds + (bufoff) + ldsw + _i * 8192), 16, 0, 0); } while (0)
#define PG8_LDA(dst, b, h) do { _Pragma("unroll") for (int m = 0; m < 4; ++m) _Pragma("unroll") for (int k = 0; k < 2; ++k) dst[m][k] = *(const PG8_LAS bf16x8*)(lds + PG8_SA(b, h) + aoff + m * 2048 + k * 1024); } while (0)
#define PG8_LDB(dst, b, h) do { _Pragma("unroll") for (int n = 0; n < 2; ++n) _Pragma("unroll") for (int k = 0; k < 2; ++k) dst[n][k] = *(const PG8_LAS bf16x8*)(lds + PG8_SB(b, h) + boff + n * 2048 + k * 1024); } while (0)
#define PG8_MMA(ai, bj, At, Bt) do { __builtin_amdgcn_s_setprio(1); _Pragma("unroll") for (int m = 0; m < 4; ++m) _Pragma("unroll") for (int n = 0; n < 2; ++n) _Pragma("unroll") for (int k = 0; k < 2; ++k) \
        acc[ai][bj][m][n] = __builtin_amdgcn_mfma_f32_16x16x32_bf16(Bt[n][k], At[m][k], acc[ai][bj][m][n], 0, 0, 0); __builtin_amdgcn_s_setprio(0); } while (0)
#define PG8_WAIT_V(n) asm volatile("s_waitcnt vmcnt(" #n ")" ::: "memory")
#define PG8_WAIT_L(n) asm volatile("s_waitcnt lgkmcnt(" #n ")" ::: "memory")
#define PG8_BAR __builtin_amdgcn_s_barrier()
#define PG8_SCHED __builtin_amdgcn_sched_barrier(0)
    Unit cur, nxt; int ui = 0;
    if (!S.next(0, cur)) return;
    f32x4 acc[2][2][4][2];
#pragma unroll
    for (int a = 0; a < 2; ++a)
#pragma unroll
        for (int b = 0; b < 2; ++b)
#pragma unroll
            for (int m = 0; m < 4; ++m)
#pragma unroll
                for (int n = 0; n < 2; ++n) acc[a][b][m][n] = (f32x4){0.f, 0.f, 0.f, 0.f};
    bf16x8 At[4][2], B0[2][2], B1[2][2];
    const char* cA = cur.a; const char* cB = cur.b;
    S.a_ready(cur);
    if constexpr (SP2) {
        PG8_STAGE(PG8_SB(0, 0), cB, voffB); PG8_STAGE(PG8_SB(0, 1), cB + hstep, voffB); PG8_STAGE(PG8_SA(0, 0), cA, voffA); PG8_STAGE(PG8_SA(0, 1), cA + hstep, voffA);
        if (wr == 1) PG8_BAR;
        PG8_WAIT_V(2); PG8_BAR;
        PG8_STAGE(PG8_SB(1, 0), cB + kstep, voffB); PG8_STAGE(PG8_SA(1, 0), cA + kstep, voffA); PG8_STAGE(PG8_SB(1, 1), cB + hstep + kstep, voffB);
        PG8_WAIT_V(6); PG8_BAR;
    } else {
        PG8_STAGE(PG8_SB(0, 0), cB, voffB); PG8_STAGE(PG8_SA(0, 0), cA, voffA); PG8_STAGE(PG8_SB(0, 1), cB + hstep, voffB); PG8_STAGE(PG8_SA(0, 1), cA + hstep, voffA);
        if (wr == 1) PG8_BAR;
        PG8_WAIT_V(4); PG8_BAR;
        PG8_STAGE(PG8_SB(1, 0), cB + kstep, voffB); PG8_STAGE(PG8_SA(1, 0), cA + kstep, voffA); PG8_STAGE(PG8_SB(1, 1), cB + hstep + kstep, voffB);
        PG8_WAIT_V(6); PG8_BAR;
    }
    for (;;) {
        const bool has_next = S.next(ui + 1, nxt);
        const char* nA = has_next ? nxt.a : cA; const char* nB = has_next ? nxt.b : cB;
        for (int t = 0; t < nt; t += 2) {
            const bool last = (t == nt - 2);
            const char* a1 = cA + (size_t)(t + 1) * kstep;
            const char* a2 = last ? nA : cA + (size_t)(t + 2) * kstep; const char* b2 = last ? nB : cB + (size_t)(t + 2) * kstep;
            const char* a3 = a2 + kstep; const char* b3 = b2 + kstep;
            if (last && has_next) S.a_ready(nxt);
            if constexpr (SP2) {
            PG8_LDB(B0, 0, 0); PG8_LDB(B1, 0, 1); PG8_SCHED; PG8_LDA(At, 0, 0); PG8_STAGE(PG8_SA(1, 1), a1 + hstep, voffA);
            PG8_WAIT_V(8); PG8_WAIT_L(0); PG8_BAR; PG8_MMA(0, 0, At, B0); PG8_MMA(0, 1, At, B1); PG8_BAR; PG8_SCHED;
            PG8_LDA(At, 0, 1); PG8_STAGE(PG8_SB(0, 0), b2, voffB); PG8_STAGE(PG8_SB(0, 1), b2 + hstep, voffB); PG8_STAGE(PG8_SA(0, 0), a2, voffA);
            PG8_WAIT_V(8); PG8_WAIT_L(0); PG8_BAR; PG8_MMA(1, 0, At, B0); PG8_MMA(1, 1, At, B1); PG8_BAR; PG8_SCHED;
            PG8_LDB(B0, 1, 0); PG8_LDB(B1, 1, 1); PG8_SCHED; PG8_LDA(At, 1, 0); PG8_STAGE(PG8_SA(0, 1), a2 + hstep, voffA);
            PG8_WAIT_V(8); PG8_WAIT_L(0); PG8_BAR; PG8_MMA(0, 0, At, B0); PG8_MMA(0, 1, At, B1); PG8_BAR; PG8_SCHED;
            PG8_LDA(At, 1, 1); PG8_STAGE(PG8_SB(1, 0), b3, voffB); PG8_STAGE(PG8_SB(1, 1), b3 + hstep, voffB); PG8_STAGE(PG8_SA(1, 0), a3, voffA);
            PG8_WAIT_V(8); PG8_WAIT_L(0); PG8_BAR; PG8_MMA(1, 0, At, B0); PG8_MMA(1, 1, At, B1); PG8_BAR; PG8_SCHED;
            } else {
            PG8_LDB(B0, 0, 0); PG8_SCHED; PG8_LDA(At, 0, 0); PG8_STAGE(PG8_SA(1, 1), a1 + hstep, voffA);
            PG8_WAIT_L(8); PG8_BAR; PG8_WAIT_L(0); PG8_MMA(0, 0, At, B0); PG8_BAR; PG8_SCHED;
            PG8_LDB(B1, 0, 1); PG8_STAGE(PG8_SB(0, 0), b2, voffB);
            PG8_BAR; PG8_WAIT_L(0); PG8_MMA(0, 1, At, B1); PG8_BAR;
            PG8_LDA(At, 0, 1); PG8_STAGE(PG8_SA(0, 0), a2, voffA);
            PG8_BAR; PG8_WAIT_L(0); PG8_MMA(1, 0, At, B0); PG8_BAR; PG8_SCHED;
            PG8_STAGE(PG8_SB(0, 1), b2 + hstep, voffB);
            PG8_WAIT_V(6); PG8_BAR; PG8_MMA(1, 1, At, B1); PG8_BAR;
            PG8_LDB(B0, 1, 0); PG8_SCHED; PG8_LDA(At, 1, 0); PG8_STAGE(PG8_SA(0, 1), a2 + hstep, voffA);
            PG8_WAIT_L(8); PG8_BAR; PG8_WAIT_L(0); PG8_MMA(0, 0, At, B0); PG8_BAR; PG8_SCHED;
            PG8_LDB(B1, 1, 1); PG8_STAGE(PG8_SB(1, 0), b3, voffB);
            PG8_BAR; PG8_WAIT_L(0); PG8_MMA(0, 1, At, B1); PG8_BAR;
            PG8_LDA(At, 1, 1); PG8_STAGE(PG8_SA(1, 0), a3, voffA);
            PG8_BAR; PG8_WAIT_L(0); PG8_MMA(1, 0, At, B0); PG8_BAR; PG8_SCHED;
            PG8_STAGE(PG8_SB(1, 1), b3 + hstep, voffB);
            PG8_WAIT_V(6); PG8_BAR; PG8_MMA(1, 1, At, B1); PG8_BAR;
            }
        }
        if constexpr (ALIGN_EPI) { if (wr == 0) PG8_BAR; }
        if constexpr (!Epi::AFTER_DRAIN) { E(acc, cur, wr, wc, fr, fq); S.done(cur); }
        if (!has_next) break;
#pragma unroll
        for (int a = 0; a < 2; ++a)
#pragma unroll
            for (int b = 0; b < 2; ++b)
#pragma unroll
                for (int m = 0; m < 4; ++m)
#pragma unroll
                    for (int n = 0; n < 2; ++n) acc[a][b][m][n] = (f32x4){0.f, 0.f, 0.f, 0.f};
        cur = nxt; cA = nA; cB = nB; ++ui;
        if constexpr (ALIGN_EPI) { if (wr == 1) PG8_BAR; }
    }
    PG8_WAIT_V(0);
    if constexpr (!ALIGN_EPI) { if (wr == 0) PG8_BAR; }
    PG8_BAR;
    if constexpr (Epi::AFTER_DRAIN) { E.fused(acc, cur, wr, wc, fr, fq, lds, wid, lane); S.done(cur); }
#undef PG8_SA
#undef PG8_SB
#undef PG8_STAGE
#undef PG8_LDA
#undef PG8_LDB
#undef PG8_MMA
#undef PG8_WAIT_V
#undef PG8_WAIT_L
#undef PG8_BAR
#undef PG8_SCHED
}
struct OrderBase {
    int nM, nN, nwg, G, c;
    __device__ __forceinline__ void init(int nM_, int nN_, int G_, int c_) { nM = nM_; nN = nN_; nwg = nM_ * nN_; G = G_; c = c_; }
    __device__ __forceinline__ bool map(int i, int& pm, int& pn) const {
        const long L = (long)i * G + c; if (L >= nwg) return false;
        int wgid = (int)L; { const int q = nwg / NXCD, r = nwg % NXCD, xcd = wgid % NXCD, off = wgid / NXCD; wgid = (xcd < r ? xcd * (q + 1) : r * (q + 1) + (xcd - r) * q) + off; }
        const int nig = WGM * nN, gid = wgid / nig, fm = gid * WGM, gsz = (nM - fm) < WGM ? (nM - fm) : WGM;
        pm = fm + ((wgid % nig) % gsz); pn = (wgid % nig) / gsz; return true;
    }
    __device__ __forceinline__ void a_ready(const Unit&) const {}
    __device__ __forceinline__ void done(const Unit&) const {}
};
struct PlainOrder : OrderBase {
    const char* A; const char* B; size_t ta, tb;
    __device__ __forceinline__ bool next(int i, Unit& u) const { int pm, pn; if (!map(i, pm, pn)) return false; u.pm = pm; u.pn = pn; u.aux = 0; u.a = A + (size_t)pm * ta; u.b = B + (size_t)pn * tb; return true; }
};
struct BranchOrder : OrderBase {
    const char* A; const char* B; size_t ta, tb, za, zb;
    __device__ __forceinline__ bool next(int i, Unit& u) const { const int ti = i / 3, br = i - 3 * ti; int pm, pn; if (!map(ti, pm, pn)) return false; u.pm = pm; u.pn = pn; u.aux = br;
        u.a = A + (size_t)br * za + (size_t)pm * ta; u.b = B + (size_t)br * zb + (size_t)pn * tb; return true; }
};
struct MoeOrder : OrderBase {
    const char* A; const char* B; size_t ta, tb, zb; int t1, t2, t3, t4, t5, t6, t7;
    __device__ __forceinline__ bool next(int i, Unit& u) const { int pm, pn; if (!map(i, pm, pn)) return false; u.pm = pm; u.pn = pn;
        const int e = (pm >= t1) + (pm >= t2) + (pm >= t3) + (pm >= t4) + (pm >= t5) + (pm >= t6) + (pm >= t7); u.aux = e;
        u.a = A + (size_t)pm * ta; u.b = B + (size_t)e * zb + (size_t)pn * tb; return true; }
};
}

constexpr int NTOK = 16384, DM = 2048, SEQ = 2048, NBATCH = 8, NHEAD = 8, HD = 64, DFF = 7168, NEXP = 8;
constexpr int NIN = 10828, NINP = 11008;
constexpr int WBR_W = 512, KVR = 256;
constexpr float EPS = 1e-6f, LOG2E = 1.4426950408889634f, C2 = 0.125f * LOG2E;
constexpr int MOE_ROWS = 2 * NTOK + NEXP * 256;
constexpr int NSTEPS = 24;

constexpr size_t al256(size_t x) { return (x + 255) & ~(size_t)255; }
constexpr size_t WS_CTL = 0, CTL_ZERO_BYTES = 1u << 20;
constexpr size_t SZ_WIN = (size_t)NINP * DM * 2, SZ_WUKV = (size_t)1024 * KVR * 2, SZ_WBR = (size_t)DM * WBR_W * 2, SZ_WOUT = (size_t)DM * DM * 2;
constexpr size_t SZ_WGU = (size_t)2 * DFF * DM * 2, SZ_WD = (size_t)DM * DFF * 2;
constexpr size_t WS_WIN = CTL_ZERO_BYTES, WS_WUKV = WS_WIN + 2 * SZ_WIN, WS_WBR = WS_WUKV + 2 * SZ_WUKV, WS_WOUT = WS_WBR + 6 * SZ_WBR;
constexpr size_t WS_WGU0 = WS_WOUT + 2 * SZ_WOUT, WS_WD0 = WS_WGU0 + SZ_WGU, WS_WGUM = WS_WD0 + SZ_WD, WS_WDM = WS_WGUM + NEXP * SZ_WGU;
constexpr size_t WS_RSTD = WS_WDM + NEXP * SZ_WD, WS_SSP = WS_RSTD + (size_t)NTOK * 4, WS_XB = WS_SSP + (size_t)NTOK * 32 * 4;
constexpr size_t WS_R = WS_XB + (size_t)NTOK * DM * 2;
constexpr size_t WS_Z8 = WS_R, WS_DLAT = WS_Z8 + (size_t)8 * NTOK * 512 * 2, WS_DIQ = WS_DLAT + (size_t)NTOK * 256 * 2, WS_DIK = WS_DIQ + (size_t)NTOK * 256 * 2;
constexpr size_t WS_FFW = WS_DIK + (size_t)NTOK * 64 * 2, WS_GATES = WS_FFW + (size_t)NTOK * 16 * 4, WS_C2F = WS_GATES + (size_t)NTOK * 6144 * 2;
constexpr size_t WS_DKV = WS_C2F + (size_t)NBATCH * NHEAD * SEQ * 4, WS_SC = WS_DKV + (size_t)NTOK * 1024 * 2, WS_MASK = WS_SC + (size_t)NTOK * SEQ * 4;
constexpr size_t WS_YATT = WS_MASK + (size_t)NTOK * 64 * 4, WS_M = WS_YATT + (size_t)3 * NTOK * 512 * 2, WS_R_END1 = WS_M + (size_t)NTOK * DM * 2;
constexpr size_t WS_HID = WS_R;
constexpr size_t WS_XG = WS_R, WS_HIDM = WS_XG + (size_t)MOE_ROWS * DM * 2, WS_Y = WS_HIDM + (size_t)MOE_ROWS * DFF * 2, WS_ROWTOK = WS_Y + (size_t)2 * NTOK * DM * 4;
constexpr size_t WS_ROWW = WS_ROWTOK + (size_t)MOE_ROWS * 4, WS_RSTDG = WS_ROWW + (size_t)MOE_ROWS * 4, WS_TOKINFO = WS_RSTDG + (size_t)MOE_ROWS * 4;
constexpr size_t WS_TOKW = WS_TOKINFO + (size_t)2 * NTOK * 8, WS_WGCNT = WS_TOKW + (size_t)2 * NTOK * 4, WS_META = WS_WGCNT + 256 * 8 * 4, WS_R_END2 = WS_META + 256;
constexpr size_t WS_END = WS_R_END1 > WS_R_END2 ? WS_R_END1 : WS_R_END2;
constexpr int CW_BAR = 4096;

constexpr int RING_BYTES = 131072, LDSCTL_OFF = RING_BYTES, MISC_OFF = LDSCTL_OFF + 320, LDS_BYTES = 147456;

#define GAS __attribute__((address_space(1)))
#define LAS __attribute__((address_space(3)))
typedef unsigned short bf16_t;
typedef float f32x4 __attribute__((ext_vector_type(4)));
typedef unsigned u32x4 __attribute__((ext_vector_type(4)));
typedef unsigned u32x2 __attribute__((ext_vector_type(2)));
typedef short bf16x8 __attribute__((ext_vector_type(8)));
typedef float f32x16 __attribute__((ext_vector_type(16)));
#define LDS_WAIT() asm volatile("s_waitcnt lgkmcnt(0)" ::: "memory")
#define VM_WAIT() asm volatile("s_waitcnt vmcnt(0)" ::: "memory")
__device__ __forceinline__ float bflo(unsigned w) { return __uint_as_float(w << 16); }
__device__ __forceinline__ float bfhi(unsigned w) { return __uint_as_float(w & 0xffff0000u); }
typedef float f32x2_t __attribute__((ext_vector_type(2))); typedef __bf16 bf16x2_t __attribute__((ext_vector_type(2)));
__device__ __forceinline__ unsigned pk2(float lo, float hi) { f32x2_t v = {lo, hi}; bf16x2_t b = __builtin_convertvector(v, bf16x2_t); return __builtin_bit_cast(unsigned, b); }
__device__ __forceinline__ int opq(int v) { asm volatile("" : "+s"(v)); return v; }
__device__ __forceinline__ float wave_sum(float v) {
#pragma unroll
    for (int o = 1; o < 64; o <<= 1) v += __shfl_xor(v, o);
    return v;
}
__device__ __forceinline__ float sigm(float v) { return __builtin_amdgcn_rcpf(1.f + __builtin_amdgcn_exp2f(-v * LOG2E)); }
__device__ __forceinline__ float softplus2(float z) { return fmaxf(z, 0.f) + __builtin_amdgcn_logf(1.f + __builtin_amdgcn_exp2f(-fabsf(z))); }

#define XB_TMO      128
#define XB_XCNT(j)  (256  + 64 * (j))
#define XB_XSUB(j)  (1280 + 64 * (j))
#define XB_XGEN(j)  (2304 + 64 * (j))
#define XB_TOP      3328
#define XB_TOPGEN   3392
#define XCD_BAR_WORDS 3456
#define XB_SPIN_CAP (1u << 18)

__device__ __forceinline__ unsigned xb_ld(unsigned* p)              { return __hip_atomic_load(p, __ATOMIC_RELAXED, __HIP_MEMORY_SCOPE_AGENT); }
__device__ __forceinline__ unsigned xb_add(unsigned* p, unsigned v) { return __hip_atomic_fetch_add(p, v, __ATOMIC_RELAXED, __HIP_MEMORY_SCOPE_AGENT); }
__device__ __forceinline__ unsigned xb_xcc_id() { return (unsigned)__builtin_amdgcn_s_getreg((3 << 11) | 20) & 0xFu; }
#define XB_SPIN(cond, bar) do { unsigned _sp = 0; while (cond) { __builtin_amdgcn_s_sleep(1); \
    if ((++_sp & 255u) == 0u) { if (xb_ld(&(bar)[XB_TMO])) break; if (_sp > XB_SPIN_CAP) { atomicAdd(&(bar)[XB_TMO], 1u); break; } } } } while (0)

struct XcdBarrier {
    unsigned* bar; unsigned x;
    volatile LAS unsigned* st;
};

__device__ __forceinline__ XcdBarrier xcd_barrier_post(unsigned* bar, volatile LAS unsigned* st) {
    XcdBarrier b; b.bar = bar; b.x = xb_xcc_id(); b.st = st;
    if (threadIdx.x == 0) (void)xb_add(&bar[XB_XCNT(b.x)], 1u);
    return b;
}
__device__ __forceinline__ void xcd_barrier_complete(unsigned* bar, unsigned x, unsigned& nloc, unsigned& nx) {
    const unsigned G = gridDim.x * gridDim.y * gridDim.z;
    unsigned sum, cnt, mine, sp = 0u;
    for (;;) {
        sum = 0u; cnt = 0u; mine = 0u;
#pragma unroll
        for (unsigned j = 0; j < 16; ++j) { const unsigned c = xb_ld(&bar[XB_XCNT(j)]); sum += c; cnt += (c > 0u) ? 1u : 0u; mine = (j == x) ? c : mine; }
        if (sum == G) break;
        __builtin_amdgcn_s_sleep(1);
        if ((++sp & 255u) == 0u) { if (xb_ld(&bar[XB_TMO])) break; if (sp > XB_SPIN_CAP) { atomicAdd(&bar[XB_TMO], 1u); break; } }
    }
    nloc = mine > 0u ? mine : 1u; nx = cnt > 0u ? cnt : 1u;
}

__device__ __attribute__((noinline)) void xcd_barrier_impl(GAS unsigned* bar_, unsigned x_, LAS unsigned* st_) { XcdBarrier b; b.bar = (unsigned*)bar_; b.x = x_; b.st = st_;
    asm volatile("s_waitcnt vmcnt(0)" ::: "memory");
    __syncthreads();
    if (threadIdx.x == 0) {
        unsigned* bar = b.bar;
        __builtin_amdgcn_s_waitcnt(0);
        unsigned nloc = b.st[0], nx = b.st[1];
        if (nloc == 0u) { xcd_barrier_complete(bar, b.x, nloc, nx); b.st[0] = nloc; b.st[1] = nx; }
        const unsigned old = xb_add(&bar[XB_XSUB(b.x)], 1u);
        const unsigned gen = old / nloc;
        if (old + 1u == (gen + 1u) * nloc) {
            __builtin_amdgcn_fence(__ATOMIC_RELEASE, "agent");
            asm volatile("s_waitcnt vmcnt(0)" ::: "memory");
            const unsigned og = xb_add(&bar[XB_TOP], 1u);
            const unsigned tg = og / nx;
            if (og + 1u == (tg + 1u) * nx) xb_add(&bar[XB_TOPGEN], 1u);
            else XB_SPIN(xb_ld(&bar[XB_TOPGEN]) == tg, bar);
            __builtin_amdgcn_fence(__ATOMIC_ACQUIRE, "agent");
            xb_add(&bar[XB_XGEN(b.x)], 1u);
            asm volatile("s_waitcnt vmcnt(0)" ::: "memory");
        } else {
            XB_SPIN(xb_ld(&bar[XB_XGEN(b.x)]) == gen, bar);
            __builtin_amdgcn_fence(__ATOMIC_ACQUIRE, "agent");
            asm volatile("s_waitcnt vmcnt(0)" ::: "memory");
        }
    }
    __syncthreads();
}
__device__ __forceinline__ void xcd_barrier(const XcdBarrier& b) { xcd_barrier_impl((GAS unsigned*)b.bar, b.x, (LAS unsigned*)b.st); }

#define ACC_T const pg8::f32x4 (&acc)[2][2][4][2]
__device__ __forceinline__ u32x4 pack8(f32x4 v0, f32x4 v1) { u32x4 w; w.x = pk2(v0[0], v0[1]); w.y = pk2(v0[2], v0[3]); w.z = pk2(v1[0], v1[1]); w.w = pk2(v1[2], v1[3]); return w; }
__device__ __forceinline__ f32x4 sigm4(f32x4 v) { f32x4 r; r[0] = sigm(v[0]); r[1] = sigm(v[1]); r[2] = sigm(v[2]); r[3] = sigm(v[3]); return r; }

struct EpiWin {
    static constexpr bool PERM = true, AFTER_DRAIN = false;
    const float* rstd; bf16_t* z8; bf16_t* dlat; bf16_t* diq; bf16_t* dik; float* ffw; bf16_t* gates;
    __device__ __forceinline__ void operator()(ACC_T, const pg8::Unit& u, int wr, int wc, int fr, int fq) const {
        const int row0 = u.pm * 256 + wr * 64 + fr, pn = u.pn, cl = wc * 32 + 8 * fq;
        if (pn == 18) {
#pragma unroll
            for (int ai = 0; ai < 2; ++ai)
#pragma unroll
                for (int m = 0; m < 4; ++m) { const int row = row0 + ai * 128 + m * 16; const float rs = rstd[row];
                    const f32x4 v0 = acc[ai][0][m][0] * rs, v1 = acc[ai][0][m][1] * rs;
                    if (cl < 64) *(u32x4*)(dik + (size_t)row * 64 + cl) = pack8(v0, v1);
                    else if (cl == 64) { *(f32x4*)(ffw + (size_t)row * 16) = v0; *(f32x4*)(ffw + (size_t)row * 16 + 4) = v1; }
                    else if (cl == 72) { *(f32x4*)(ffw + (size_t)row * 16 + 8) = v0; } }
            return;
        }
        bf16_t* dst; int ldc, colbase; bool sg = false; float scale = 1.f;
        if (pn < 16) { const int idx = pn >> 1; dst = z8 + (size_t)idx * NTOK * 512; ldc = 512; colbase = (pn & 1) * 256; sg = (idx == 3); scale = (idx == 4 || idx == 7) ? C2 : 1.f; }
        else if (pn == 16) { dst = dlat; ldc = 256; colbase = 0; }
        else if (pn == 17) { dst = diq; ldc = 256; colbase = 0; }
        else { dst = gates; ldc = 6144; colbase = (pn - 19) * 256; sg = true; }
        if (sg) {
#pragma unroll
            for (int ai = 0; ai < 2; ++ai)
#pragma unroll
                for (int m = 0; m < 4; ++m) { const int row = row0 + ai * 128 + m * 16; const float rs = rstd[row]; bf16_t* rowp = dst + (size_t)row * ldc + colbase + cl;
#pragma unroll
                    for (int bj = 0; bj < 2; ++bj) *(u32x4*)(rowp + bj * 128) = pack8(sigm4(acc[ai][bj][m][0] * rs), sigm4(acc[ai][bj][m][1] * rs)); }
        } else {
#pragma unroll
            for (int ai = 0; ai < 2; ++ai)
#pragma unroll
                for (int m = 0; m < 4; ++m) { const int row = row0 + ai * 128 + m * 16; const float rs = rstd[row] * scale; bf16_t* rowp = dst + (size_t)row * ldc + colbase + cl;
#pragma unroll
                    for (int bj = 0; bj < 2; ++bj) *(u32x4*)(rowp + bj * 128) = pack8(acc[ai][bj][m][0] * rs, acc[ai][bj][m][1] * rs); }
        }
    }
};
struct EpiPlain {
    static constexpr bool PERM = true, AFTER_DRAIN = false;
    bf16_t* O; int ldc;
    __device__ __forceinline__ void operator()(ACC_T, const pg8::Unit& u, int wr, int wc, int fr, int fq) const {
        const int row0 = u.pm * 256 + wr * 64 + fr, col0 = u.pn * 256 + wc * 32 + 8 * fq;
#pragma unroll
        for (int ai = 0; ai < 2; ++ai)
#pragma unroll
            for (int m = 0; m < 4; ++m) { bf16_t* rowp = O + (size_t)(row0 + ai * 128 + m * 16) * ldc + col0;
#pragma unroll
                for (int bj = 0; bj < 2; ++bj) *(u32x4*)(rowp + bj * 128) = pack8(acc[ai][bj][m][0], acc[ai][bj][m][1]); }
    }
};
struct EpiBranch {
    static constexpr bool PERM = true, AFTER_DRAIN = false;
    const bf16_t* gates; bf16_t* M;
    __device__ __forceinline__ void operator()(ACC_T, const pg8::Unit& u, int wr, int wc, int fr, int fq) const {
        const int row0 = u.pm * 256 + wr * 64 + fr, col0 = u.pn * 256 + wc * 32 + 8 * fq, br = u.aux;
#pragma unroll
        for (int ai = 0; ai < 2; ++ai)
#pragma unroll
            for (int m = 0; m < 4; ++m) { const int row = row0 + ai * 128 + m * 16;
#pragma unroll
                for (int bj = 0; bj < 2; ++bj) { const int col = col0 + bj * 128;
                    const u32x4 g = *(const u32x4*)(gates + (size_t)row * 6144 + br * 2048 + col);
                    f32x4 v0 = acc[ai][bj][m][0], v1 = acc[ai][bj][m][1];
                    v0[0] *= bflo(g.x); v0[1] *= bfhi(g.x); v0[2] *= bflo(g.y); v0[3] *= bfhi(g.y); v1[0] *= bflo(g.z); v1[1] *= bfhi(g.z); v1[2] *= bflo(g.w); v1[3] *= bfhi(g.w);
                    bf16_t* mp = M + (size_t)row * DM + col;
                    if (br > 0) { const u32x4 o = *(const u32x4*)mp; v0[0] += bflo(o.x); v0[1] += bfhi(o.x); v0[2] += bflo(o.y); v0[3] += bfhi(o.y); v1[0] += bflo(o.z); v1[1] += bfhi(o.z); v1[2] += bflo(o.w); v1[3] += bfhi(o.w); }
                    *(u32x4*)mp = pack8(v0, v1); } }
    }
};
struct EpiResid {
    static constexpr bool PERM = true, AFTER_DRAIN = false;
    const float* xold; float* x; bf16_t* xb; float* ssp;
    __device__ __forceinline__ void operator()(ACC_T, const pg8::Unit& u, int wr, int wc, int fr, int fq) const {
        const int row0 = u.pm * 256 + wr * 64 + fr, col0 = u.pn * 256 + wc * 32 + 8 * fq;
#pragma unroll
        for (int ai = 0; ai < 2; ++ai)
#pragma unroll
            for (int m = 0; m < 4; ++m) { const int row = row0 + ai * 128 + m * 16; float ss = 0.f;
#pragma unroll
                for (int bj = 0; bj < 2; ++bj) { const size_t off = (size_t)row * DM + col0 + bj * 128;
                    const f32x4 o0 = *(const f32x4*)(xold + off), o1 = *(const f32x4*)(xold + off + 4);
                    const f32x4 v0 = o0 + acc[ai][bj][m][0], v1 = o1 + acc[ai][bj][m][1];
                    *(f32x4*)(x + off) = v0; *(f32x4*)(x + off + 4) = v1; *(u32x4*)(xb + off) = pack8(v0, v1);
                    ss += (v0[0] * v0[0] + v0[1] * v0[1]) + (v0[2] * v0[2] + v0[3] * v0[3]) + (v1[0] * v1[0] + v1[1] * v1[1]) + (v1[2] * v1[2] + v1[3] * v1[3]); }
                ss += __shfl_xor(ss, 16); ss += __shfl_xor(ss, 32);
                if (fq == 0) ssp[(size_t)row * 32 + u.pn * 4 + wc] = ss; }
    }
};
struct EpiSwiglu {
    static constexpr bool PERM = true, AFTER_DRAIN = false;
    const float* rstd; bf16_t* hid;
    __device__ __forceinline__ void operator()(ACC_T, const pg8::Unit& u, int wr, int wc, int fr, int fq) const {
        const int row0 = u.pm * 256 + wr * 64 + fr, col0 = u.pn * 128 + wc * 32 + 8 * fq;
#pragma unroll
        for (int ai = 0; ai < 2; ++ai)
#pragma unroll
            for (int m = 0; m < 4; ++m) { const int row = row0 + ai * 128 + m * 16; const float rs = rstd[row];
                f32x4 h0, h1;
#pragma unroll
                for (int j = 0; j < 4; ++j) { const float g0 = acc[ai][0][m][0][j] * rs, u0 = acc[ai][1][m][0][j] * rs, g1 = acc[ai][0][m][1][j] * rs, u1 = acc[ai][1][m][1][j] * rs;
                    h0[j] = g0 * u0 * sigm(g0); h1[j] = g1 * u1 * sigm(g1); }
                *(u32x4*)(hid + (size_t)row * DFF + col0) = pack8(h0, h1); }
    }
};
struct EpiMoeDown {
    static constexpr bool PERM = true, AFTER_DRAIN = false;
    const int* rowtok; const float* roww; float* y;
    __device__ __forceinline__ void operator()(ACC_T, const pg8::Unit& u, int wr, int wc, int fr, int fq) const {
        const int row0 = u.pm * 256 + wr * 64 + fr, col0 = u.pn * 256 + wc * 32 + 8 * fq;
#pragma unroll
        for (int ai = 0; ai < 2; ++ai)
#pragma unroll
            for (int m = 0; m < 4; ++m) { const int row = row0 + ai * 128 + m * 16; const int tk = rowtok[row];
                if (tk >= 0) { const float w = roww[row]; float* d = y + (size_t)(tk & 1) * NTOK * DM + (size_t)(tk >> 1) * DM + col0;
#pragma unroll
                    for (int bj = 0; bj < 2; ++bj) { *(f32x4*)(d + bj * 128) = acc[ai][bj][m][0] * w; *(f32x4*)(d + bj * 128 + 4) = acc[ai][bj][m][1] * w; } } }
    }
};

struct Args { const float* in[22]; float* out; unsigned char* ws; int ph_lo, ph_hi; };

__host__ __device__ __forceinline__ int win_src(int n) {
    if (n < 1536) return n;
    if (n < 2048) return 1544 + (n - 1536);
    if (n < 4096) return 2056 + (n - 2048);
    if (n < 4352) return 4104 + (n - 4096);
    if (n < 4608) return 4360 + (n - 4352);
    if (n < 4672) return 4616 + (n - 4608);
    if (n < 4680) return 1536 + (n - 4672);
    if (n < 4684) return 4680 + (n - 4680);
    if (n < 4864) return -1;
    return 4684 + (n - 4864);
}

__device__ __forceinline__ void conv_matrix(int map, const float* W0, const float* W1, int K, int Ns, int dstN, bf16_t* WT, const float* gain, LAS float* scr, int gw, int NGW, int lane) {
    const int nblk = dstN >> 5, nit = (K >> 6) * nblk;
    for (int it = gw; it < nit; it += NGW) {
        const int kb = it / nblk, nb = it - kb * nblk, k0 = kb << 6, n0 = nb << 5;
        const float* src = W0; int sc;
        if (map == 0) sc = n0 + (lane & 31);
        else if (map == 1) sc = win_src(n0 + (lane & 31));
        else { const int t = nb >> 3, r = nb & 7; src = (r < 4) ? W0 : W1; sc = 128 * t + 32 * (r & 3) + (lane & 31); }
        const float* sp = src + (size_t)k0 * Ns + (sc < 0 ? 0 : sc);
#pragma unroll 8
        for (int i = 0; i < 32; ++i) { const int kk = 2 * i + (lane >> 5); float v = sp[(size_t)kk * Ns]; if (sc < 0) v = 0.f; scr[kk * 33 + (lane & 31)] = v; }
        LDS_WAIT(); asm volatile("" ::: "memory");
        const int c = lane & 7;
        f32x4 g0 = {1.f, 1.f, 1.f, 1.f}, g1 = {1.f, 1.f, 1.f, 1.f};
        if (gain) { g0 = *(const f32x4*)(gain + k0 + 8 * c); g1 = *(const f32x4*)(gain + k0 + 8 * c + 4); }
#pragma unroll
        for (int j = 0; j < 4; ++j) { const int n = (lane >> 3) + 8 * j; const LAS float* s = scr + (8 * c) * 33 + n;
            u32x4 o; o.x = pk2(s[0 * 33] * g0[0], s[1 * 33] * g0[1]); o.y = pk2(s[2 * 33] * g0[2], s[3 * 33] * g0[3]); o.z = pk2(s[4 * 33] * g1[0], s[5 * 33] * g1[1]); o.w = pk2(s[6 * 33] * g1[2], s[7 * 33] * g1[3]);
            *(u32x4*)(WT + (size_t)(n0 + n) * K + k0 + 8 * c) = o; }
        LDS_WAIT(); asm volatile("" ::: "memory");
    }
}

namespace att {
constexpr int SLOTB = 8192, L_K = 0, L_V = 2 * SLOTB, L_WS = 4 * SLOTB, L_CS = L_WS + 2048, L_LUT = L_CS + 512, L_OST = L_LUT + 512, L_END = L_OST + 8 * 4096;
typedef short s16x4 __attribute__((ext_vector_type(4)));
__device__ __forceinline__ int crow(int r, int hi) { return (r & 3) + 8 * (r >> 2) + 4 * hi; }
__device__ __forceinline__ void glds16(const void* gsrc, unsigned lds_dst) { unsigned keep;
    asm volatile("s_mov_b32 %0, m0\n\ts_mov_b32 m0, %2\n\ts_nop 0\n\tglobal_load_lds_dwordx4 %1, off\n\ts_mov_b32 m0, %0" : "=&s"(keep) : "v"(gsrc), "s"(lds_dst) : "memory"); }
__device__ __forceinline__ void glds4(const void* gsrc, unsigned lds_dst) { unsigned keep;
    asm volatile("s_mov_b32 %0, m0\n\ts_mov_b32 m0, %2\n\ts_nop 0\n\tglobal_load_lds_dword %1, off\n\ts_mov_b32 m0, %0" : "=&s"(keep) : "v"(gsrc), "s"(lds_dst) : "memory"); }
#define ATT_MFMA(a, b, c) __builtin_amdgcn_mfma_f32_32x32x16_bf16(a, b, c, 0, 0, 0)
__device__ __forceinline__ void qkt(f32x16& p0, f32x16& p1, const LAS unsigned char* Kslot, const bf16x8* qr, int r32, int hi) {
    const LAS unsigned char* kb = Kslot + hi * 1024 + r32 * 16;
#pragma unroll
    for (int r = 0; r < 16; ++r) { p0[r] = 0.f; p1[r] = 0.f; }
#pragma unroll
    for (int d0 = 0; d0 < 4; ++d0) { const bf16x8 b0 = *(const LAS bf16x8*)(kb + d0 * 2048), b1 = *(const LAS bf16x8*)(kb + d0 * 2048 + 512);
        p0 = ATT_MFMA(b0, qr[d0], p0); p1 = ATT_MFMA(b1, qr[d0], p1); }
}
__device__ __forceinline__ void pv(f32x16* o, int vb, bf16x8 pa0, bf16x8 pa1, bf16x8 pa2, bf16x8 pa3) {
#pragma unroll
    for (int d0 = 0; d0 < 2; ++d0) { s16x4 lo[4], hi[4];
#pragma unroll
        for (int ks = 0; ks < 4; ++ks) {
            asm volatile("ds_read_b64_tr_b16 %0,%1 offset:%c2" : "=&v"(lo[ks]) : "v"(vb), "i"(d0 * 4096 + ks * 1024) : "memory");
            asm volatile("ds_read_b64_tr_b16 %0,%1 offset:%c2" : "=&v"(hi[ks]) : "v"(vb), "i"(d0 * 4096 + ks * 1024 + 512) : "memory"); }
        asm volatile("s_waitcnt lgkmcnt(0)" ::: "memory"); __builtin_amdgcn_sched_barrier(0);
#define ATT_PK(k) (bf16x8){lo[k][0], lo[k][1], lo[k][2], lo[k][3], hi[k][0], hi[k][1], hi[k][2], hi[k][3]}
        o[d0] = ATT_MFMA(pa0, ATT_PK(0), o[d0]); o[d0] = ATT_MFMA(pa1, ATT_PK(1), o[d0]); o[d0] = ATT_MFMA(pa2, ATT_PK(2), o[d0]); o[d0] = ATT_MFMA(pa3, ATT_PK(3), o[d0]);
#undef ATT_PK
    }
}
__device__ __forceinline__ float hmax(float v) { const auto rr = __builtin_amdgcn_permlane32_swap(__float_as_uint(v), __float_as_uint(v), false, false); return fmaxf(__uint_as_float(rr[0]), __uint_as_float(rr[1])); }
__device__ __forceinline__ float hsum(float v) { const auto rr = __builtin_amdgcn_permlane32_swap(__float_as_uint(v), __float_as_uint(v), false, false); return __uint_as_float(rr[0]) + __uint_as_float(rr[1]); }

template <int VAR> __device__ __forceinline__ void attn_unit(LAS unsigned char* lds, int b, int h, int qb,
        const bf16_t* Q, const bf16_t* K, int pk, const bf16_t* V, int pv_, const float* c2f, const unsigned* mask, const float* relb, const bf16_t* ogate, bf16_t* O) {
    int tid = threadIdx.x; asm volatile("" : "+v"(tid));
    const int lane = tid & 63, r32 = lane & 31, hi = lane >> 5, wid = __builtin_amdgcn_readfirstlane(tid >> 6);
    const size_t rowbase = (size_t)b * SEQ; const int q0 = qb * 256, qrel = wid * 32 + r32, t = q0 + qrel;
    const unsigned lds0 = (unsigned)(uintptr_t)lds;
    LAS float* wsf = (LAS float*)(lds + L_WS) + wid * 64;
    const bf16_t* Kh = K + rowbase * pk + h * 64; const bf16_t* Vh = V + rowbase * pv_ + h * 64;
    const bf16_t* ksrc = Kh + (size_t)lane * pk + wid * 8;
    const bf16_t* vsrc = Vh + (size_t)(16 * (wid & 3) + (lane >> 2)) * pv_ + (wid >> 2) * 32 + (lane & 3) * 8;
    const unsigned kdst = lds0 + L_K + wid * 1024, vdst = lds0 + L_V + wid * 1024;
    const int vb0 = (int)(lds0 + L_V) + ((lane >> 4) & 1) * 32 + (lane & 3) * 8 + (4 * hi + ((lane & 15) >> 2)) * 64;
    const int NT = (q0 + 256) / 64;
    const float* c2h = c2f + ((size_t)b * NHEAD + h) * SEQ;
#define ATT_DMA(tile, slot) do { glds16(ksrc + (size_t)(tile) * 64 * pk, (unsigned)__builtin_amdgcn_readfirstlane(kdst + (slot) * SLOTB)); glds16(vsrc + (size_t)(tile) * 64 * pv_, (unsigned)__builtin_amdgcn_readfirstlane(vdst + (slot) * SLOTB)); \
        if (VAR == 0 && wid == 0) glds4(c2h + (tile) * 64 + lane, (unsigned)__builtin_amdgcn_readfirstlane(lds0 + L_CS + (slot) * 256)); } while (0)
    const int tile0 = (VAR == 1) ? NT - 1 : 0;
    ATT_DMA(tile0, 0);
    if (VAR == 2 && tid < 128) {
        int bk; if (tid < 16) bk = tid; else { bk = 16 + (int)(logf((float)tid / 16.0f) / 2.0794415416798357f * 16.0f); if (bk > 31) bk = 31; }
        ((LAS float*)(lds + L_LUT))[tid] = relb[bk * NHEAD + h] * LOG2E; }
    bf16x8 qr[4];
    { const bf16_t* Qw = Q + (rowbase + t) * 512 + h * 64;
#pragma unroll
      for (int d0 = 0; d0 < 4; ++d0) qr[d0] = *(const bf16x8*)(Qw + d0 * 16 + hi * 8); }
    float c2t = 0.f; if (VAR == 0) c2t = c2h[t];
    float mrun = -1.0e30f, lrun = 0.f, R = 0.f;
    f32x16 o[2];
#pragma unroll
    for (int r = 0; r < 16; ++r) { o[0][r] = 0.f; o[1][r] = 0.f; }
    u32x2 mwn = {0u, 0u}; if (VAR == 2) mwn = *(const u32x2*)(mask + (rowbase + t) * 64);
    asm volatile("s_waitcnt vmcnt(0) lgkmcnt(0)\n\ts_barrier" ::: "memory");
#pragma unroll 1
    for (int it = 0; it < NT; ++it) {
        const int tile = (VAR == 1) ? NT - 1 - it : it, slot = it & 1;
        if (it + 1 < NT) { const int ntile = (VAR == 1) ? NT - 2 - it : it + 1; ATT_DMA(ntile, slot ^ 1); }
        const u32x2 mw = mwn; if (VAR == 2 && it + 1 < NT) mwn = *(const u32x2*)(mask + (rowbase + t) * 64 + (it + 1) * 2);
        f32x16 p0, p1;
        qkt(p0, p1, lds + L_K + slot * SLOTB, qr, r32, hi);
        const int kv0 = tile * 64 + 4 * hi;
        const bool band = (tile * 64 + 63 > q0 + wid * 32);
        f32x16 pw0v, pw1v;
        if (VAR == 1) {
            f32x16 L0, L1;
#pragma unroll
            for (int r = 0; r < 16; ++r) { L0[r] = softplus2(p0[r]); L1[r] = softplus2(p1[r]); }
            if (band) {
#pragma unroll
                for (int r = 0; r < 16; ++r) { const int kv = kv0 + (r & 3) + 8 * (r >> 2); if (kv >= t) L0[r] = 0.f; if (kv + 32 >= t) L1[r] = 0.f; } }
            float G[8], T[8], S[8];
#pragma unroll
            for (int g = 0; g < 4; ++g) { G[g] = (L0[4 * g] + L0[4 * g + 1]) + (L0[4 * g + 2] + L0[4 * g + 3]); G[4 + g] = (L1[4 * g] + L1[4 * g + 1]) + (L1[4 * g + 2] + L1[4 * g + 3]); }
#pragma unroll
            for (int k = 0; k < 8; ++k) T[k] = hsum(G[k]);
            S[7] = 0.f;
#pragma unroll
            for (int k = 6; k >= 0; --k) S[k] = S[k + 1] + T[k + 1];
            const float tot = S[0] + T[0];
#pragma unroll
            for (int g = 0; g < 4; ++g) {
#pragma unroll
                for (int blk = 0; blk < 2; ++blk) { const int k = blk * 4 + g; const float off = R + S[k] + (hi == 0 ? T[k] - G[k] : 0.f);
                    f32x16& Lb = blk ? L1 : L0; f32x16& zb = blk ? p1 : p0; f32x16& ob = blk ? pw1v : pw0v;
                    const float e3 = Lb[4 * g + 3], e2 = e3 + Lb[4 * g + 2], e1 = e2 + Lb[4 * g + 1], e0 = e1 + Lb[4 * g];
                    ob[4 * g + 3] = __builtin_amdgcn_exp2f(zb[4 * g + 3] - (off + e3)); ob[4 * g + 2] = __builtin_amdgcn_exp2f(zb[4 * g + 2] - (off + e2));
                    ob[4 * g + 1] = __builtin_amdgcn_exp2f(zb[4 * g + 1] - (off + e1)); ob[4 * g] = __builtin_amdgcn_exp2f(zb[4 * g] - (off + e0)); } }
            if (band) {
#pragma unroll
                for (int r = 0; r < 16; ++r) { const int kv = kv0 + (r & 3) + 8 * (r >> 2); if (kv >= t) pw0v[r] = 0.f; if (kv + 32 >= t) pw1v[r] = 0.f; } }
            R += tot;
        } else {
            if (VAR == 0) {
                const LAS f32x4* cs = (const LAS f32x4*)(lds + L_CS + slot * 256 + 16 * hi);
#pragma unroll
                for (int g = 0; g < 4; ++g) { const f32x4 ca = cs[2 * g], cb = cs[8 + 2 * g];
#pragma unroll
                    for (int i = 0; i < 4; ++i) { p0[4 * g + i] += c2t - ca[i]; p1[4 * g + i] += c2t - cb[i]; } }
                if (band) {
#pragma unroll
                    for (int r = 0; r < 16; ++r) { const int kv = kv0 + (r & 3) + 8 * (r >> 2); if (kv > t) p0[r] = -INFINITY; if (kv + 32 > t) p1[r] = -INFINITY; } }
            } else {
                const LAS float* lut = (const LAS float*)(lds + L_LUT);
                if (tile * 64 + 63 + 113 <= q0 + wid * 32) {
                    const float bfar = lut[127];
#pragma unroll
                    for (int r = 0; r < 16; ++r) { p0[r] += bfar; p1[r] += bfar; }
                } else {
#pragma unroll
                    for (int r = 0; r < 16; ++r) { const int kv = kv0 + (r & 3) + 8 * (r >> 2); int d0 = t - kv, d1 = d0 - 32; d0 = d0 < 0 ? 0 : (d0 > 127 ? 127 : d0); d1 = d1 < 0 ? 0 : (d1 > 127 ? 127 : d1);
                        p0[r] += lut[d0]; p1[r] += lut[d1]; } }
#pragma unroll
                for (int r = 0; r < 16; ++r) { const int bit = (r & 3) + 8 * (r >> 2) + 4 * hi; if (!((mw.x >> bit) & 1u)) p0[r] = -INFINITY; if (!((mw.y >> bit) & 1u)) p1[r] = -INFINITY; }
            }
            float rm = fmaxf(p0[0], p1[0]);
#pragma unroll
            for (int r = 1; r < 16; ++r) rm = fmaxf(rm, fmaxf(p0[r], p1[r]));
            rm = hmax(rm);
            const float mnew = fmaxf(mrun, rm), f = __builtin_amdgcn_exp2f(mrun - mnew);
            if (__any(mnew > mrun)) {
                lrun *= f; if (hi == 0) wsf[r32] = f;
                asm volatile("s_waitcnt lgkmcnt(0)" ::: "memory");
#pragma unroll
                for (int r = 0; r < 16; ++r) { const float fr = wsf[crow(r, hi)]; o[0][r] *= fr; o[1][r] *= fr; }
            }
            mrun = mnew;
            float sacc = 0.f;
#pragma unroll
            for (int r = 0; r < 16; ++r) { pw0v[r] = __builtin_amdgcn_exp2f(p0[r] - mnew); pw1v[r] = __builtin_amdgcn_exp2f(p1[r] - mnew); sacc += pw0v[r] + pw1v[r]; }
            lrun += sacc;
        }
        u32x4 w0, w1, w2, w3;
        w0 = (u32x4){pk2(pw0v[0], pw0v[1]), pk2(pw0v[2], pw0v[3]), pk2(pw0v[4], pw0v[5]), pk2(pw0v[6], pw0v[7])}; w1 = (u32x4){pk2(pw0v[8], pw0v[9]), pk2(pw0v[10], pw0v[11]), pk2(pw0v[12], pw0v[13]), pk2(pw0v[14], pw0v[15])};
        w2 = (u32x4){pk2(pw1v[0], pw1v[1]), pk2(pw1v[2], pw1v[3]), pk2(pw1v[4], pw1v[5]), pk2(pw1v[6], pw1v[7])}; w3 = (u32x4){pk2(pw1v[8], pw1v[9]), pk2(pw1v[10], pw1v[11]), pk2(pw1v[12], pw1v[13]), pk2(pw1v[14], pw1v[15])};
        pv(o, vb0 + slot * SLOTB, __builtin_bit_cast(bf16x8, w0), __builtin_bit_cast(bf16x8, w1), __builtin_bit_cast(bf16x8, w2), __builtin_bit_cast(bf16x8, w3));
        asm volatile("s_waitcnt vmcnt(0) lgkmcnt(0)\n\ts_barrier" ::: "memory");
    }
    float linv = 1.f;
    if (VAR != 1) { const float lt = hsum(lrun); linv = 1.0f / lt; }
    if (hi == 0) wsf[32 + r32] = linv; asm volatile("s_waitcnt lgkmcnt(0)" ::: "memory");
    { LAS bf16_t* stg = (LAS bf16_t*)(lds + L_OST) + wid * 2048;
#pragma unroll
      for (int r = 0; r < 16; ++r) { const int orow = crow(r, hi); const float li = wsf[32 + orow];
#pragma unroll
          for (int d0 = 0; d0 < 2; ++d0) stg[orow * 64 + d0 * 32 + r32] = (bf16_t)(pk2(o[d0][r] * li, 0.f) & 0xffffu); }
      asm volatile("s_waitcnt lgkmcnt(0)" ::: "memory");
      bf16_t* Ow = O + (rowbase + q0 + wid * 32) * 512 + h * 64;
#pragma unroll
      for (int i = 0; i < 4; ++i) { const int row = i * 8 + (lane >> 3), ch = lane & 7; u32x4 v = *(const LAS u32x4*)(stg + row * 64 + ch * 8);
          if (VAR == 0) { const u32x4 g = *(const u32x4*)(ogate + (rowbase + q0 + wid * 32 + row) * 512 + h * 64 + ch * 8);
              v.x = pk2(bflo(v.x) * bflo(g.x), bfhi(v.x) * bfhi(g.x)); v.y = pk2(bflo(v.y) * bflo(g.y), bfhi(v.y) * bfhi(g.y)); v.z = pk2(bflo(v.z) * bflo(g.z), bfhi(v.z) * bfhi(g.z)); v.w = pk2(bflo(v.w) * bflo(g.w), bfhi(v.w) * bfhi(g.w)); }
          *(u32x4*)(Ow + (size_t)row * 512 + ch * 8) = v; } }
    asm volatile("s_waitcnt vmcnt(0) lgkmcnt(0)\n\ts_barrier" ::: "memory");
#undef ATT_DMA
}
}

__device__ __forceinline__ void select_row(const float* sc_row, unsigned* mask_row, int t, int lane) {
    asm volatile("" : "+v"(lane));
    if (t < 256) { const int lo = 32 * lane; mask_row[lane] = (t >= lo + 31) ? 0xffffffffu : (t < lo ? 0u : ((2u << (t - lo)) - 1u)); return; }
    unsigned key[32];
#pragma unroll
    for (int j = 0; j < 32; ++j) { const int s = 64 * j + lane; const unsigned u = __float_as_uint(sc_row[s <= t ? s : t]); const unsigned k = (u & 0x80000000u) ? ~u : (u | 0x80000000u); key[j] = (s <= t) ? k : 0u; }
    unsigned T = 0u;
    for (int bit = 31; bit >= 0; --bit) { const unsigned cand = T | (1u << bit); int c = 0;
#pragma unroll
        for (int j = 0; j < 32; ++j) c += (key[j] >= cand) ? 1 : 0;
#pragma unroll
        for (int o = 1; o < 64; o <<= 1) c += __shfl_xor(c, o);
        if (c >= 256) T = cand; }
    int gt = 0;
#pragma unroll
    for (int j = 0; j < 32; ++j) gt += (key[j] > T) ? 1 : 0;
#pragma unroll
    for (int o = 1; o < 64; o <<= 1) gt += __shfl_xor(gt, o);
    const int need = 256 - gt; int run = 0; unsigned myw = 0u;
#pragma unroll
    for (int j = 0; j < 32; ++j) { const bool eq = key[j] == T; const unsigned long long beq = __ballot(eq);
        const int pre = run + (int)__builtin_amdgcn_mbcnt_hi((unsigned)(beq >> 32), __builtin_amdgcn_mbcnt_lo((unsigned)beq, 0u));
        const bool sel = (key[j] > T) || (eq && pre < need); run += __popcll(beq);
        const unsigned long long bs = __ballot(sel); myw = (lane == 2 * j) ? (unsigned)bs : myw; myw = (lane == 2 * j + 1) ? (unsigned)(bs >> 32) : myw; }
    mask_row[lane] = myw;
}

typedef __attribute__((address_space(4))) const char* kptr_t; typedef const float* cfp_t; typedef const __attribute__((address_space(4))) cfp_t* kslot_t;
__device__ __forceinline__ const float* arg_ptr(int i) { kptr_t ka = (kptr_t)__builtin_amdgcn_kernarg_segment_ptr(); asm volatile("" : "+s"(ka)); return *(kslot_t)(ka + 8 * i); }
__global__ void __launch_bounds__(512, 2) mk_fwd(Args args) {
    extern __shared__ __attribute__((aligned(16))) unsigned char lds_raw[];
    LAS unsigned char* lds = (LAS unsigned char*)lds_raw;
    volatile LAS unsigned* MISC = (volatile LAS unsigned*)(lds + MISC_OFF);
    const int G = gridDim.x, bid = blockIdx.x, NGW = G * 8;
    unsigned* ctl = (unsigned*)((unsigned char*)arg_ptr(23) + WS_CTL);
    for (int u = threadIdx.x; u < (LDS_BYTES - LDSCTL_OFF) / 4; u += 512) ((LAS unsigned*)(lds + LDSCTL_OFF))[u] = 0u;
#define SITE_PROLOG unsigned char* ws = (unsigned char*)arg_ptr(23); int tid = threadIdx.x; asm volatile("" : "+v"(tid)); \
    const int lane = tid & 63, wave = __builtin_amdgcn_readfirstlane(tid >> 6), gw = bid * 8 + wave; (void)ws; (void)lane; (void)gw;
    __syncthreads();
    const int lo = args.ph_lo, hi = args.ph_hi;
    XcdBarrier bar; bar.bar = ctl + CW_BAR; bar.x = 0; bar.st = nullptr;
    if (hi - lo > 1) bar = xcd_barrier_post(ctl + CW_BAR, MISC + 8);
#define x_in arg_ptr(0)
#define w_in arg_ptr(1)
#define b_forget arg_ptr(2)
#define q_norm arg_ptr(3)
#define k_norm arg_ptr(4)
#define kv_norm arg_ptr(5)
#define w_ukv arg_ptr(6)
#define w_br0 arg_ptr(7)
#define w_br1 arg_ptr(8)
#define w_br2 arg_ptr(9)
#define w_out arg_ptr(10)
#define rel_bias arg_ptr(11)
#define norm_mix arg_ptr(12)
#define norm_ffn arg_ptr(13)
#define w_fg arg_ptr(14)
#define w_fu arg_ptr(15)
#define w_fd arg_ptr(16)
#define w_router arg_ptr(17)
#define w_mg arg_ptr(18)
#define w_mu arg_ptr(19)
#define w_md arg_ptr(20)
#define norm_final arg_ptr(21)
#define X ((float*)arg_ptr(22))
#define WIN ((bf16_t*)(ws + WS_WIN))
#define WUKV ((bf16_t*)(ws + WS_WUKV))
#define WBR ((bf16_t*)(ws + WS_WBR))
#define WOUT ((bf16_t*)(ws + WS_WOUT))
#define WGU0 ((bf16_t*)(ws + WS_WGU0))
#define WD0 ((bf16_t*)(ws + WS_WD0))
#define WGUM ((bf16_t*)(ws + WS_WGUM))
#define WDM ((bf16_t*)(ws + WS_WDM))
#define RSTD ((float*)(ws + WS_RSTD))
#define SSP ((float*)(ws + WS_SSP))
#define XB ((bf16_t*)(ws + WS_XB))
#define Z8 ((bf16_t*)(ws + WS_Z8))
#define DLAT ((bf16_t*)(ws + WS_DLAT))
#define DIQ ((bf16_t*)(ws + WS_DIQ))
#define DIK ((bf16_t*)(ws + WS_DIK))
#define FFW ((float*)(ws + WS_FFW))
#define GATES ((bf16_t*)(ws + WS_GATES))
#define C2F ((float*)(ws + WS_C2F))
#define DKV ((bf16_t*)(ws + WS_DKV))
#define SC ((float*)(ws + WS_SC))
#define MASK ((unsigned*)(ws + WS_MASK))
#define YATT ((bf16_t*)(ws + WS_YATT))
#define MB ((bf16_t*)(ws + WS_M))
#define HID ((bf16_t*)(ws + WS_HID))
#define XG ((bf16_t*)(ws + WS_XG))
#define HIDM ((bf16_t*)(ws + WS_HIDM))
#define Y ((float*)(ws + WS_Y))
#define ROWTOK ((int*)(ws + WS_ROWTOK))
#define ROWW ((float*)(ws + WS_ROWW))
#define RSTDG ((float*)(ws + WS_RSTDG))
#define TOKINFO ((int*)(ws + WS_TOKINFO))
#define TOKW ((float*)(ws + WS_TOKW))
#define WGCNT ((int*)(ws + WS_WGCNT))
#define META ((int*)(ws + WS_META))

    int step = 0;
#define STEP_IF if (step >= lo && step < hi)
#define STEP_END do { if (step >= lo && step + 1 < hi) xcd_barrier(bar); ++step; } while (0)

    if (SITE_ON(0)) STEP_IF { SITE_PROLOG
        LAS float* scr = (LAS float*)(lds + wave * 16384);
        for (int l = 0; l < 2; ++l) {
            conv_matrix(1, w_in + (size_t)l * DM * NIN, nullptr, DM, NIN, NINP, WIN + (size_t)l * NINP * DM, norm_mix + l * DM, scr, gw, NGW, lane);
            conv_matrix(0, w_ukv + (size_t)l * KVR * 1024, nullptr, KVR, 1024, 1024, WUKV + (size_t)l * 1024 * KVR, kv_norm + l * KVR, scr, gw, NGW, lane);
            conv_matrix(0, w_br0 + (size_t)l * WBR_W * DM, nullptr, WBR_W, DM, DM, WBR + (size_t)(l * 3 + 0) * DM * WBR_W, nullptr, scr, gw, NGW, lane);
            conv_matrix(0, w_br1 + (size_t)l * WBR_W * DM, nullptr, WBR_W, DM, DM, WBR + (size_t)(l * 3 + 1) * DM * WBR_W, nullptr, scr, gw, NGW, lane);
            conv_matrix(0, w_br2 + (size_t)l * WBR_W * DM, nullptr, WBR_W, DM, DM, WBR + (size_t)(l * 3 + 2) * DM * WBR_W, nullptr, scr, gw, NGW, lane);
            conv_matrix(0, w_out + (size_t)l * DM * DM, nullptr, DM, DM, DM, WOUT + (size_t)l * DM * DM, nullptr, scr, gw, NGW, lane);
        }
        conv_matrix(2, w_fg, w_fu, DM, DFF, 2 * DFF, WGU0, norm_ffn, scr, gw, NGW, lane);
        conv_matrix(0, w_fd, nullptr, DFF, DM, DM, WD0, nullptr, scr, gw, NGW, lane);
        for (int e = 0; e < NEXP; ++e) {
            conv_matrix(2, w_mg + (size_t)e * DM * DFF, w_mu + (size_t)e * DM * DFF, DM, DFF, 2 * DFF, WGUM + (size_t)e * 2 * DFF * DM, norm_ffn + DM, scr, gw, NGW, lane);
            conv_matrix(0, w_md + (size_t)e * DFF * DM, nullptr, DFF, DM, DM, WDM + (size_t)e * DM * DFF, nullptr, scr, gw, NGW, lane);
        }
        for (int m = gw; m < NTOK; m += NGW) {
            const f32x4* xr = (const f32x4*)(x_in + (size_t)m * DM) + lane; f32x4 v[8]; float s = 0.f;
#pragma unroll
            for (int j = 0; j < 8; ++j) { v[j] = xr[64 * j]; s += (v[j][0] * v[j][0] + v[j][1] * v[j][1]) + (v[j][2] * v[j][2] + v[j][3] * v[j][3]); }
            s = wave_sum(s);
            u32x2* o = (u32x2*)(XB + (size_t)m * DM) + lane;
#pragma unroll
            for (int j = 0; j < 8; ++j) { u32x2 w; w.x = pk2(v[j][0], v[j][1]); w.y = pk2(v[j][2], v[j][3]); o[64 * j] = w; }
            if (lane == 0) RSTD[m] = 1.0f / sqrtf(s * (1.0f / DM) + EPS);
        }
    }
    STEP_END;

    for (int l = 0; l < 2; ++l) {
        if (SITE_ON(1)) STEP_IF { SITE_PROLOG
            pg8::PlainOrder S; S.init(NTOK / 256, NINP / 256, G, bid); S.A = (const char*)XB; S.ta = (size_t)256 * DM * 2; S.B = (const char*)(WIN + (size_t)l * NINP * DM); S.tb = (size_t)256 * DM * 2;
            EpiWin E{RSTD, Z8, DLAT, DIQ, DIK, FFW, GATES};
            pg8::gemm_phase<EpiWin, pg8::PlainOrder, true, true>(lds, pg8::Gemm{opq(DM)}, S, E);
        }
        STEP_END;
        if (SITE_ON(2)) STEP_IF { SITE_PROLOG
            for (int m = gw; m < NTOK; m += NGW) {
#pragma unroll
                for (int which = 0; which < 2; ++which) {
                    bf16_t* p = Z8 + (size_t)which * NTOK * 512 + (size_t)m * 512 + 8 * lane; const u32x4 w = *(const u32x4*)p;
                    float v[8] = {bflo(w.x), bfhi(w.x), bflo(w.y), bfhi(w.y), bflo(w.z), bfhi(w.z), bflo(w.w), bfhi(w.w)}; float ss = 0.f;
#pragma unroll
                    for (int i = 0; i < 8; ++i) ss += v[i] * v[i];
                    ss += __shfl_xor(ss, 1); ss += __shfl_xor(ss, 2); ss += __shfl_xor(ss, 4);
                    const float rs = (1.0f / sqrtf(ss * (1.0f / 64.0f) + EPS)) * (which == 0 ? C2 : 1.0f);
                    const float* gp = (which == 0 ? q_norm : k_norm) + l * HD + 8 * (lane & 7); const f32x4 g0 = *(const f32x4*)gp, g1 = *(const f32x4*)(gp + 4);
                    u32x4 o; o.x = pk2(v[0] * rs * g0[0], v[1] * rs * g0[1]); o.y = pk2(v[2] * rs * g0[2], v[3] * rs * g0[3]); o.z = pk2(v[4] * rs * g1[0], v[5] * rs * g1[1]); o.w = pk2(v[6] * rs * g1[2], v[7] * rs * g1[3]);
                    *(u32x4*)p = o;
                }
                { bf16_t* p = DLAT + (size_t)m * 256 + 4 * lane; const u32x2 w = *(const u32x2*)p; const float a0 = bflo(w.x), a1 = bfhi(w.x), a2 = bflo(w.y), a3 = bfhi(w.y);
                  const float ss = wave_sum((a0 * a0 + a1 * a1) + (a2 * a2 + a3 * a3)); const float rs = 1.0f / sqrtf(ss * (1.0f / 256.0f) + EPS);
                  u32x2 o; o.x = pk2(a0 * rs, a1 * rs); o.y = pk2(a2 * rs, a3 * rs); *(u32x2*)p = o; }
            }
            if (gw < NBATCH * NHEAD) {
                const int b = gw >> 3, h = gw & 7; const float bias = b_forget[l * NHEAD + h];
                const float* fp = FFW + ((size_t)b * SEQ + 32 * lane) * 16 + h; float tot = 0.f;
                for (int i = 0; i < 32; ++i) tot += -softplus2(-(fp[i * 16] + bias) * LOG2E);
                float inc = tot;
#pragma unroll
                for (int o = 1; o < 64; o <<= 1) { const float tv = __shfl_up(inc, o); if (lane >= o) inc += tv; }
                float run = inc - tot; float* cp = C2F + ((size_t)b * NHEAD + h) * SEQ + 32 * lane;
                for (int i = 0; i < 32; ++i) { run += -softplus2(-(fp[i * 16] + bias) * LOG2E); cp[i] = run; }
            }
        }
        STEP_END;
        if (SITE_ON(3)) STEP_IF { SITE_PROLOG
            { pg8::PlainOrder S; S.init(NTOK / 256, 4, G, bid); S.A = (const char*)DLAT; S.ta = (size_t)256 * KVR * 2; S.B = (const char*)(WUKV + (size_t)l * 1024 * KVR); S.tb = (size_t)256 * KVR * 2;
              EpiPlain E{DKV, 1024};
              pg8::gemm_phase<EpiPlain, pg8::PlainOrder, true, true>(lds, pg8::Gemm{opq(KVR)}, S, E); }
            if ((wave & 3) == 0) {
                const int k = (bid * 2 + (wave >> 2)) % 512, pr = k >> 1, b = pr >> 5, uu = pr & 31, tt = (k & 1) ? 63 - uu : uu;
                int ln = lane; asm volatile("" : "+v"(ln)); const int r32 = ln & 31, hh = ln >> 5; const size_t trow = (size_t)b * SEQ + tt * 32 + r32;
                bf16x8 bq[4][4];
#pragma unroll
                for (int h = 0; h < 4; ++h)
#pragma unroll
                    for (int d0 = 0; d0 < 4; ++d0) bq[h][d0] = *(const bf16x8*)(DIQ + trow * 256 + h * 64 + d0 * 16 + 8 * hh);
                const f32x4 wv = *(const f32x4*)(FFW + trow * 16 + 8) * 0.0625f;
                for (int st = 0; st <= tt; ++st) {
                    const size_t srow = (size_t)b * SEQ + st * 32 + r32; bf16x8 ak[4];
#pragma unroll
                    for (int d0 = 0; d0 < 4; ++d0) ak[d0] = *(const bf16x8*)(DIK + srow * 64 + d0 * 16 + 8 * hh);
                    f32x16 sc;
#pragma unroll
                    for (int r = 0; r < 16; ++r) sc[r] = 0.f;
#pragma unroll
                    for (int h = 0; h < 4; ++h) { f32x16 a;
#pragma unroll
                        for (int r = 0; r < 16; ++r) a[r] = 0.f;
#pragma unroll
                        for (int d0 = 0; d0 < 4; ++d0) a = __builtin_amdgcn_mfma_f32_32x32x16_bf16(ak[d0], bq[h][d0], a, 0, 0, 0);
#pragma unroll
                        for (int r = 0; r < 16; ++r) sc[r] += fmaxf(a[r], 0.f) * wv[h]; }
                    float* sp = SC + trow * SEQ + st * 32 + 4 * hh;
#pragma unroll
                    for (int g = 0; g < 4; ++g) *(f32x4*)(sp + 8 * g) = (f32x4){sc[4 * g], sc[4 * g + 1], sc[4 * g + 2], sc[4 * g + 3]};
                }
            }
        }
        STEP_END;
        if (SITE_ON(4)) STEP_IF { SITE_PROLOG
            for (int idx = gw; idx < NTOK; idx += NGW) { const int b = idx / SEQ, t0 = idx - b * SEQ, t = (b & 1) ? SEQ - 1 - t0 : t0; const size_t row = (size_t)b * SEQ + t;
                select_row(SC + row * SEQ, MASK + row * 64, t, lane); }
        }
        STEP_END;
        if (SITE_ON(5)) STEP_IF { SITE_PROLOG
            const int vcu = (bid & 7) * (G >> 3) + (bid >> 3);
            for (int i = 0; i < 6; ++i) { const int var = i >> 1, p = vcu & 255, bh = p >> 2, qb = (i & 1) ? 7 - (p & 3) : (p & 3), b = bh >> 3, h = bh & 7;
                if (var == 0) att::attn_unit<0>(lds, b, h, qb, Z8, Z8 + (size_t)1 * NTOK * 512, 512, Z8 + (size_t)2 * NTOK * 512, 512, C2F, nullptr, nullptr, Z8 + (size_t)3 * NTOK * 512, YATT);
                else if (var == 1) att::attn_unit<1>(lds, b, h, qb, Z8 + (size_t)4 * NTOK * 512, Z8 + (size_t)5 * NTOK * 512, 512, Z8 + (size_t)6 * NTOK * 512, 512, nullptr, nullptr, nullptr, nullptr, YATT + (size_t)NTOK * 512);
                else att::attn_unit<2>(lds, b, h, qb, Z8 + (size_t)7 * NTOK * 512, DKV, 1024, DKV + 512, 1024, nullptr, MASK, rel_bias, nullptr, YATT + (size_t)2 * NTOK * 512);
            }
        }
        STEP_END;
        if (SITE_ON(6)) STEP_IF { SITE_PROLOG
            pg8::BranchOrder S; S.init(NTOK / 256, DM / 256, G, bid); S.A = (const char*)YATT; S.ta = (size_t)256 * WBR_W * 2; S.za = (size_t)NTOK * WBR_W * 2;
            S.B = (const char*)(WBR + (size_t)l * 3 * DM * WBR_W); S.tb = (size_t)256 * WBR_W * 2; S.zb = (size_t)DM * WBR_W * 2;
            EpiBranch E{GATES, MB};
            pg8::gemm_phase<EpiBranch, pg8::BranchOrder, true, true>(lds, pg8::Gemm{opq(WBR_W)}, S, E);
        }
        STEP_END;
        if (SITE_ON(7)) STEP_IF { SITE_PROLOG
            pg8::PlainOrder S; S.init(NTOK / 256, DM / 256, G, bid); S.A = (const char*)MB; S.ta = (size_t)256 * DM * 2; S.B = (const char*)(WOUT + (size_t)l * DM * DM); S.tb = (size_t)256 * DM * 2;
            EpiResid E{l == 0 ? x_in : (const float*)X, X, XB, SSP};
            pg8::gemm_phase<EpiResid, pg8::PlainOrder, true, true>(lds, pg8::Gemm{opq(DM)}, S, E);
        }
        STEP_END;
        if (l == 0) {
            if (SITE_ON(8)) STEP_IF { SITE_PROLOG for (int r = bid * 512 + tid; r < NTOK; r += G * 512) { const f32x4* p = (const f32x4*)(SSP + (size_t)r * 32); float s = 0.f;
#pragma unroll
                    for (int j = 0; j < 8; ++j) { const f32x4 v = p[j]; s += (v[0] + v[1]) + (v[2] + v[3]); }
                    RSTD[r] = 1.0f / sqrtf(s * (1.0f / DM) + EPS); } }
            STEP_END;
            if (SITE_ON(9)) STEP_IF { SITE_PROLOG
                pg8::PlainOrder S; S.init(NTOK / 256, DFF / 128, G, bid); S.A = (const char*)XB; S.ta = (size_t)256 * DM * 2; S.B = (const char*)WGU0; S.tb = (size_t)256 * DM * 2;
                EpiSwiglu E{RSTD, HID};
                pg8::gemm_phase<EpiSwiglu, pg8::PlainOrder, true, true>(lds, pg8::Gemm{opq(DM)}, S, E);
            }
            STEP_END;
            if (SITE_ON(10)) STEP_IF { SITE_PROLOG
                pg8::PlainOrder S; S.init(NTOK / 256, DM / 256, G, bid); S.A = (const char*)HID; S.ta = (size_t)256 * DFF * 2; S.B = (const char*)WD0; S.tb = (size_t)256 * DFF * 2;
                EpiResid E{X, X, XB, SSP};
                pg8::gemm_phase<EpiResid, pg8::PlainOrder, true, true>(lds, pg8::Gemm{opq(DFF)}, S, E);
            }
            STEP_END;
            if (SITE_ON(11)) STEP_IF { SITE_PROLOG for (int r = bid * 512 + tid; r < NTOK; r += G * 512) { const f32x4* p = (const f32x4*)(SSP + (size_t)r * 32); float s = 0.f;
#pragma unroll
                    for (int j = 0; j < 8; ++j) { const f32x4 v = p[j]; s += (v[0] + v[1]) + (v[2] + v[3]); }
                    RSTD[r] = 1.0f / sqrtf(s * (1.0f / DM) + EPS); } }
            STEP_END;
        } else {
            if (SITE_ON(12)) STEP_IF { SITE_PROLOG
                LAS int* le = (LAS int*)lds;
                for (int wgi = bid; wgi < NTOK / 64; wgi += G) {
                    __syncthreads();
                    for (int i = 0; i < 8; ++i) { const int tl = wave * 8 + i, tok = wgi * 64 + tl;
                        const f32x4* xr = (const f32x4*)(X + (size_t)tok * DM) + lane; f32x4 v[8]; float s = 0.f;
#pragma unroll
                        for (int j = 0; j < 8; ++j) { v[j] = xr[64 * j]; s += (v[j][0] * v[j][0] + v[j][1] * v[j][1]) + (v[j][2] * v[j][2] + v[j][3] * v[j][3]); }
                        s = wave_sum(s); const float rs = 1.0f / sqrtf(s * (1.0f / DM) + EPS);
                        float lg[8];
#pragma unroll
                        for (int e = 0; e < 8; ++e) lg[e] = 0.f;
#pragma unroll
                        for (int j = 0; j < 8; ++j) { const int k0 = 256 * j + 4 * lane; const f32x4 gn = *(const f32x4*)(norm_ffn + DM + k0);
#pragma unroll
                            for (int c = 0; c < 4; ++c) { const float xg = v[j][c] * gn[c]; const f32x4 w0 = *(const f32x4*)(w_router + (size_t)(k0 + c) * 8), w1 = *(const f32x4*)(w_router + (size_t)(k0 + c) * 8 + 4);
                                lg[0] += xg * w0[0]; lg[1] += xg * w0[1]; lg[2] += xg * w0[2]; lg[3] += xg * w0[3]; lg[4] += xg * w1[0]; lg[5] += xg * w1[1]; lg[6] += xg * w1[2]; lg[7] += xg * w1[3]; } }
#pragma unroll
                        for (int e = 0; e < 8; ++e) lg[e] = wave_sum(lg[e]) * rs;
                        float v0 = lg[0]; int i0 = 0;
#pragma unroll
                        for (int e = 1; e < 8; ++e) if (lg[e] > v0) { v0 = lg[e]; i0 = e; }
                        float v1 = -INFINITY; int i1 = 0;
#pragma unroll
                        for (int e = 0; e < 8; ++e) if (e != i0 && lg[e] > v1) { v1 = lg[e]; i1 = e; }
                        const float ex = __expf(v1 - v0), w0 = 1.0f / (1.0f + ex), w1 = ex / (1.0f + ex);
                        if (lane == 0) { le[tl * 2] = i0; le[tl * 2 + 1] = i1; TOKW[(size_t)tok * 2] = w0; TOKW[(size_t)tok * 2 + 1] = w1; RSTD[tok] = rs; }
                    }
                    __syncthreads();
                    if (tid < 128) { const int e = le[tid]; int rk = 0; for (int j = 0; j < tid; ++j) rk += (le[j] == e); const int tok = wgi * 64 + (tid >> 1);
                        TOKINFO[((size_t)tok * 2 + (tid & 1)) * 2] = e; TOKINFO[((size_t)tok * 2 + (tid & 1)) * 2 + 1] = rk; }
                    if (tid >= 128 && tid < 136) { const int e = tid - 128; int c = 0; for (int j = 0; j < 128; ++j) c += (le[j] == e); WGCNT[wgi * 8 + e] = c; }
                }
            }
            STEP_END;
            if (SITE_ON(13)) STEP_IF { SITE_PROLOG
                LAS int* lc = (LAS int*)lds;
                for (int wgi = bid; wgi < NTOK / 64; wgi += G) {
                    __syncthreads();
                    { const int e = wave; int all = 0, before = 0;
#pragma unroll
                      for (int c = 0; c < 4; ++c) { const int w = 4 * lane + c; const int v = WGCNT[w * 8 + e]; all += v; before += (w < wgi) ? v : 0; }
#pragma unroll
                      for (int o = 1; o < 64; o <<= 1) { all += __shfl_xor(all, o); before += __shfl_xor(before, o); }
                      if (lane == 0) { lc[e] = all; lc[8 + e] = before; } }
                    __syncthreads();
                    if (tid == 0) { int tb = 0; for (int e = 0; e < 8; ++e) { lc[16 + e] = tb * 256; tb += (lc[e] + 255) >> 8; if (wgi == 0) META[e] = lc[16 + e] >> 8; } if (wgi == 0) META[8] = tb; }
                    __syncthreads();
                    for (int i = 0; i < 16; ++i) { const int p = wave * 16 + i, tok = wgi * 64 + (p >> 1), slot = p & 1;
                        const int e = TOKINFO[((size_t)tok * 2 + slot) * 2], rk = TOKINFO[((size_t)tok * 2 + slot) * 2 + 1]; const int r = lc[16 + e] + lc[8 + e] + rk;
                        const u32x4* sp = (const u32x4*)(XB + (size_t)tok * DM) + lane; u32x4* dp = (u32x4*)(XG + (size_t)r * DM) + lane;
#pragma unroll
                        for (int c = 0; c < 4; ++c) dp[64 * c] = sp[64 * c];
                        if (lane == 0) { ROWTOK[r] = tok * 2 + slot; ROWW[r] = TOKW[(size_t)tok * 2 + slot]; RSTDG[r] = RSTD[tok]; } }
                    if (wgi < 8) { const int e = wgi, r0 = lc[16 + e] + lc[e], r1 = lc[16 + e] + (((lc[e] + 255) >> 8) << 8);
                        for (int r = r0 + wave; r < r1; r += 8) { u32x4* dp = (u32x4*)(XG + (size_t)r * DM) + lane;
#pragma unroll
                            for (int c = 0; c < 4; ++c) dp[64 * c] = (u32x4){0u, 0u, 0u, 0u};
                            if (lane == 0) { ROWTOK[r] = -1; ROWW[r] = 0.f; RSTDG[r] = 0.f; } } }
                }
            }
            STEP_END;
            if (SITE_ON(14)) STEP_IF { SITE_PROLOG
                pg8::MoeOrder S; S.t1 = META[1]; S.t2 = META[2]; S.t3 = META[3]; S.t4 = META[4]; S.t5 = META[5]; S.t6 = META[6]; S.t7 = META[7];
                S.init(META[8], DFF / 128, G, bid); S.A = (const char*)XG; S.ta = (size_t)256 * DM * 2; S.B = (const char*)WGUM; S.tb = (size_t)256 * DM * 2; S.zb = SZ_WGU;
                EpiSwiglu E{RSTDG, HIDM};
                pg8::gemm_phase<EpiSwiglu, pg8::MoeOrder, true, true>(lds, pg8::Gemm{opq(DM)}, S, E);
            }
            STEP_END;
            if (SITE_ON(15)) STEP_IF { SITE_PROLOG
                pg8::MoeOrder S; S.t1 = META[1]; S.t2 = META[2]; S.t3 = META[3]; S.t4 = META[4]; S.t5 = META[5]; S.t6 = META[6]; S.t7 = META[7];
                S.init(META[8], DM / 256, G, bid); S.A = (const char*)HIDM; S.ta = (size_t)256 * DFF * 2; S.B = (const char*)WDM; S.tb = (size_t)256 * DFF * 2; S.zb = SZ_WD;
                EpiMoeDown E{ROWTOK, ROWW, Y};
                pg8::gemm_phase<EpiMoeDown, pg8::MoeOrder, true, true>(lds, pg8::Gemm{opq(DFF)}, S, E);
            }
            STEP_END;
            if (SITE_ON(16)) STEP_IF { SITE_PROLOG
                for (int m = gw; m < NTOK; m += NGW) {
                    f32x4* xr = (f32x4*)(X + (size_t)m * DM) + lane; const f32x4* y0 = (const f32x4*)(Y + (size_t)m * DM) + lane; const f32x4* y1 = (const f32x4*)(Y + (size_t)NTOK * DM + (size_t)m * DM) + lane;
                    f32x4 v[8]; float s = 0.f;
#pragma unroll
                    for (int j = 0; j < 8; ++j) { v[j] = xr[64 * j] + y0[64 * j] + y1[64 * j]; s += (v[j][0] * v[j][0] + v[j][1] * v[j][1]) + (v[j][2] * v[j][2] + v[j][3] * v[j][3]); }
                    s = wave_sum(s); const float rs = 1.0f / sqrtf(s * (1.0f / DM) + EPS);
#pragma unroll
                    for (int j = 0; j < 8; ++j) { const f32x4 g = *((const f32x4*)norm_final + lane + 64 * j); xr[64 * j] = v[j] * rs * g; }
                }
            }
            STEP_END;
        }
    }
#undef STEP_IF
#undef STEP_END
}


#ifndef DBG_STOP
#define DBG_STOP -1
#endif
#ifndef DBG_LO
#define DBG_LO WS_WIN
#endif
#if DBG_STOP >= 0
__global__ void dbg_dump(const unsigned short* ws16, size_t n16, const unsigned* xin, float* out, int with_x) {
    for (size_t i = (size_t)blockIdx.x * blockDim.x + threadIdx.x; i < (size_t)NTOK * DM; i += (size_t)gridDim.x * blockDim.x) {
        unsigned acc = 0; for (size_t off = i; off < n16; off += (size_t)NTOK * DM) acc += ws16[off];
        if (with_x) { const unsigned u = xin[i]; acc += (u & 0xffffu) + (u >> 16); }
        out[i] = (float)(acc & 0xfffffu);
    }
}
#endif

#if DBG_STOP == 100
__global__ void dbg_cmp3(const unsigned short* a0, const unsigned short* b0, const unsigned short* a1, const unsigned short* b1, const unsigned short* a2, const unsigned short* b2, unsigned* cnt) {
    unsigned c0 = 0, c1 = 0, c2 = 0;
    for (size_t i = (size_t)blockIdx.x * blockDim.x + threadIdx.x; i < (size_t)NTOK * DM; i += (size_t)gridDim.x * blockDim.x) { c0 += a0[i] != b0[i]; c1 += a1[i] != b1[i]; c2 += a2[i] != b2[i]; }
    if (c0) atomicAdd(cnt, c0); if (c1) atomicAdd(cnt + 1, c1); if (c2) atomicAdd(cnt + 2, c2);
}
__global__ void dbg_fill(float* out, const unsigned* cnt) {
    const float E = (cnt[0] ? 3.f : 0.f) + (cnt[1] ? 10.f : 0.f) + (cnt[2] ? 30.f : 0.f);
    for (size_t i = (size_t)blockIdx.x * blockDim.x + threadIdx.x; i < (size_t)NTOK * DM; i += (size_t)gridDim.x * blockDim.x) out[i] = E;
}
#endif

#if DBG_STOP == 200
__global__ void dbg_cksum(const unsigned long long* p, size_t nblk, unsigned long long* ck) {
    for (size_t b = (size_t)blockIdx.x * blockDim.x + threadIdx.x; b < nblk; b += (size_t)gridDim.x * blockDim.x) {
        unsigned long long h = 0x9E3779B97F4A7C15ull; const unsigned long long* q = p + b * 128;
        for (int i = 0; i < 128; ++i) { h ^= q[i]; h *= 0xBF58476D1CE4E5B9ull; h ^= h >> 29; }
        ck[b] = h; }
}
__global__ void dbg_ckcmp(const unsigned long long* a, const unsigned long long* b, size_t nblk, unsigned long long* first) {
    for (size_t i = (size_t)blockIdx.x * blockDim.x + threadIdx.x; i < nblk; i += (size_t)gridDim.x * blockDim.x) if (a[i] != b[i]) atomicMin(first, (unsigned long long)i);
}
__global__ void dbg_fill2(float* out, const unsigned long long* first) {
    const unsigned long long off = WS_RSTD + (*first) * 1024ull; int id = 0;
    if (*first != ~0ull) { id = 1; if (off >= WS_Z8) id = 2; if (off >= WS_DLAT) id = 3; if (off >= WS_DIQ) id = 4; if (off >= WS_DIK) id = 5; if (off >= WS_FFW) id = 6; if (off >= WS_GATES) id = 7; if (off >= WS_C2F) id = 8;
        if (off >= WS_DKV) id = 9; if (off >= WS_SC) id = 10; if (off >= WS_MASK) id = 11; if (off >= WS_YATT) id = 12; if (off >= WS_M) id = 13; }
    const float E = 3.f * id;
    for (size_t i = (size_t)blockIdx.x * blockDim.x + threadIdx.x; i < (size_t)NTOK * DM; i += (size_t)gridDim.x * blockDim.x) out[i] = E;
}
#endif
extern "C" void kernel_launch(void* const* d_in, const int* in_sizes, int n_in, void* d_out, int out_size, void* d_ws, size_t ws_size, hipStream_t stream) {
    static int grid = 0;
    if (grid == 0) {
        if (n_in != 22 || out_size != NTOK * DM || ws_size < WS_END) { fprintf(stderr, "kernel_launch: unexpected problem (n_in %d, out %d, ws %zu, need %zu)\n", n_in, out_size, ws_size, (size_t)WS_END); grid = -1; return; }
        int dev = 0, cus = 0;
        if (hipGetDevice(&dev) != hipSuccess || hipDeviceGetAttribute(&cus, hipDeviceAttributeMultiprocessorCount, dev) != hipSuccess) { grid = -1; return; }
        if (hipFuncSetAttribute((const void*)mk_fwd, hipFuncAttributeMaxDynamicSharedMemorySize, LDS_BYTES) != hipSuccess) { fprintf(stderr, "kernel_launch: hipFuncSetAttribute failed\n"); grid = -1; return; }
        int per_cu = 0;
        if (hipOccupancyMaxActiveBlocksPerMultiprocessor(&per_cu, (const void*)mk_fwd, 512, LDS_BYTES) != hipSuccess || per_cu < 1) fprintf(stderr, "kernel_launch: occupancy query says %d\n", per_cu);
        (void)hipGetLastError();
        grid = cus;
    }
    if (grid < 0) return;
    (void)hipMemsetAsync((char*)d_ws + WS_CTL, 0, CTL_ZERO_BYTES, stream);
    Args a{};
    for (int i = 0; i < 22; ++i) a.in[i] = (const float*)d_in[i];
    a.out = (float*)d_out; a.ws = (unsigned char*)d_ws;
#if DBG_STOP == 200
    for (int s = 0; s <= DBG_HI; ++s) { a.ph_lo = s; a.ph_hi = s + 1; hipLaunchKernelGGL(mk_fwd, dim3(grid), dim3(512), LDS_BYTES, stream, a); }
    { char* w = (char*)d_ws; const size_t nblk = (WS_R_END1 - WS_RSTD) / 1024; unsigned long long* ck0 = (unsigned long long*)(w + WS_R_END1); unsigned long long* ck1 = ck0 + nblk; unsigned long long* first = (unsigned long long*)(w + 4096);
#ifdef DBG_WARMFIRST
      for (int s = DBG_LOSTEP; s <= DBG_HI; ++s) { a.ph_lo = s; a.ph_hi = s + 1; hipLaunchKernelGGL(mk_fwd, dim3(grid), dim3(512), LDS_BYTES, stream, a); }
#endif
      hipLaunchKernelGGL(dbg_cksum, dim3(2048), dim3(256), 0, stream, (const unsigned long long*)(w + WS_RSTD), nblk, ck0);
      for (int s = DBG_LOSTEP; s <= DBG_HI; ++s) { a.ph_lo = s; a.ph_hi = s + 1; hipLaunchKernelGGL(mk_fwd, dim3(grid), dim3(512), LDS_BYTES, stream, a); }
      hipLaunchKernelGGL(dbg_cksum, dim3(2048), dim3(256), 0, stream, (const unsigned long long*)(w + WS_RSTD), nblk, ck1);
      (void)hipMemsetAsync(first, 0xFF, 8, stream);
      hipLaunchKernelGGL(dbg_ckcmp, dim3(1024), dim3(256), 0, stream, (const unsigned long long*)ck0, (const unsigned long long*)ck1, nblk, first);
      hipLaunchKernelGGL(dbg_fill2, dim3(2048), dim3(256), 0, stream, (float*)d_out, (const unsigned long long*)first); }
#elif DBG_STOP == 100
    for (int s = 0; s <= 6; ++s) { a.ph_lo = s; a.ph_hi = s + 1; hipLaunchKernelGGL(mk_fwd, dim3(grid), dim3(512), LDS_BYTES, stream, a); }
    { char* w = (char*)d_ws; const size_t SZ = (size_t)NTOK * DM * 2; char* cp = w + WS_R_END1;
      hipMemcpyAsync(cp, w + WS_M, SZ, hipMemcpyDeviceToDevice, stream); hipMemcpyAsync(cp + SZ, w + WS_SC, 2 * SZ, hipMemcpyDeviceToDevice, stream);
      a.ph_lo = 6; a.ph_hi = 7; hipLaunchKernelGGL(mk_fwd, dim3(grid), dim3(512), LDS_BYTES, stream, a);
      unsigned* cnt = (unsigned*)(w + 4096); hipMemsetAsync(cnt, 0, 64, stream);
      hipLaunchKernelGGL(dbg_cmp3, dim3(2048), dim3(256), 0, stream, (const unsigned short*)(w + WS_M), (const unsigned short*)cp, (const unsigned short*)(w + WS_SC), (const unsigned short*)(cp + SZ), (const unsigned short*)(w + WS_SC + SZ), (const unsigned short*)(cp + 2 * SZ), cnt);
      hipLaunchKernelGGL(dbg_fill, dim3(2048), dim3(256), 0, stream, (float*)d_out, (const unsigned*)cnt); }
#elif DBG_STOP >= 0
    for (int s = 0; s <= DBG_STOP; ++s) { a.ph_lo = s; a.ph_hi = s + 1; hipLaunchKernelGGL(mk_fwd, dim3(grid), dim3(512), LDS_BYTES, stream, a); }
#ifdef DBG_TWICE
    { a.ph_lo = DBG_STOP; a.ph_hi = DBG_STOP + 1; hipLaunchKernelGGL(mk_fwd, dim3(grid), dim3(512), LDS_BYTES, stream, a); }
#endif
    hipLaunchKernelGGL(dbg_dump, dim3(2048), dim3(256), 0, stream, (const unsigned short*)((const char*)d_ws + DBG_LO), (size_t)((WS_END - DBG_LO) / 2), (const unsigned*)d_out, (float*)d_out, DBG_STOP >= 7 ? 1 : 0);
#elif MK_ONE_LAUNCH
    a.ph_lo = 0; a.ph_hi = NSTEPS;
    hipLaunchKernelGGL(mk_fwd, dim3(grid), dim3(512), LDS_BYTES, stream, a);
#else
    for (int s = 0; s < NSTEPS; ++s) { a.ph_lo = s; a.ph_hi = s + 1; hipLaunchKernelGGL(mk_fwd, dim3(grid), dim3(512), LDS_BYTES, stream, a); }
#endif
}
```

```cpp
#include <hip/hip_runtime.h>
#include <cstdio>
#include <cstdint>

#ifndef SITE_MASK
#define SITE_MASK 0xffffffffu
#endif
#define SITE_ON(i) (((SITE_MASK) >> (i)) & 1u)

#ifndef DUP_DRY
#define DUP_DRY 0
#endif
#ifndef MK_ONE_LAUNCH
#define MK_ONE_LAUNCH 1
#endif

namespace pg8 {
#define PG8_LAS __attribute__((address_space(3)))
typedef unsigned short bf16_t;
typedef short bf16x8 __attribute__((ext_vector_type(8)));
typedef float f32x4 __attribute__((ext_vector_type(4)));
typedef unsigned u32x4 __attribute__((ext_vector_type(4)));
constexpr int BM = 256, BK = 64, HALF = 128, HTB = HALF * BK * 2  , STAGE_BYTES = 8 * HTB, NXCD = 8, WGM = 8;

__host__ __device__ __forceinline__ int lds_byte(int r, int c) { const int st = (r >> 4) * 2 + (c >> 5), rr = r & 15, cc = c & 31, ob = rr * 64 + cc * 2; return st * 1024 + (ob ^ (((ob >> 9) & 1) << 5)); }
__host__ __device__ __forceinline__ void stage_rc(int b, int& R, int& C) { const int st = b / 1024, sb = b % 1024, swz = sb ^ (((sb >> 9) & 1) << 5); R = (st >> 1) * 16 + swz / 64; C = (st & 1) * 32 + (swz % 64) / 2; }
__host__ __device__ __forceinline__ int perm32(int rho) { const int n = rho >> 4, i = rho & 15; return 8 * (i >> 2) + 4 * n + (i & 3); }
struct Unit { int pm, pn, aux; const char* a; const char* b; };
struct Gemm { int K; };
__device__ __forceinline__ unsigned cvt_pk_bf16(float lo, float hi) { unsigned r; asm volatile("v_cvt_pk_bf16_f32 %0, %1, %2" : "=v"(r) : "v"(lo), "v"(hi)); return r; }
template <class Epi, class Sched, bool ALIGN_EPI = false, bool SP2 = false>
__device__ __forceinline__ void gemm_phase(PG8_LAS unsigned char* lds, const Gemm g, const Sched& S, const Epi& E) {
    int tid_ = threadIdx.x; asm volatile("" : "+v"(tid_)); const int tid = tid_, wid = __builtin_amdgcn_readfirstlane(tid >> 6), lane = tid & 63, wr = wid >> 2, wc = wid & 3, fr = lane & 15, fq = lane >> 4;
    const int K = g.K, nt = K / BK;
    unsigned voffA[2], voffB[2];
#pragma unroll
    for (int i = 0; i < 2; ++i) { int R, C; stage_rc(tid * 16 + i * 8192, R, C); const int Rb = Epi::PERM ? ((R & ~31) + perm32(R & 31)) : R;
        voffA[i] = (unsigned)(R * K + C) * 2u; voffB[i] = (unsigned)(Rb * K + C) * 2u; }
    const size_t kstep = (size_t)(BK * 2);
    const size_t hstep = (size_t)HALF * K * 2;
    const unsigned ldsw = (unsigned)wid * 1024u;
    const int aoff = lds_byte(wr * 64 + fr, fq * 8), boff = lds_byte(wc * 32 + fr, fq * 8);
#define PG8_SA(b, h) (((b) * 2 + (h)) * HTB)
#define PG8_SB(b, h) ((4 + (b) * 2 + (h)) * HTB)
#define PG8_STAGE(bufoff, gbase, voff) do { _Pragma("unroll") for (int _i = 0; _i < 2; ++_i) \
        __builtin_amdgcn_global_load_lds((const unsigned*)((const char*)(gbase) + (voff)[_i]), (PG8_LAS unsigned*)(lds + (bufoff) + ldsw + _i * 8192), 16, 0, 0); } while (0)
#define PG8_LDA(dst, b, h) do { _Pragma("unroll") for (int m = 0; m < 4; ++m) _Pragma("unroll") for (int k = 0; k < 2; ++k) dst[m][k] = *(const PG8_LAS bf16x8*)(lds + PG8_SA(b, h) + aoff + m * 2048 + k * 1024); } while (0)
#define PG8_LDB(dst, b, h) do { _Pragma("unroll") for (int n = 0; n < 2; ++n) _Pragma("unroll") for (int k = 0; k < 2; ++k) dst[n][k] = *(const PG8_LAS bf16x8*)(lds + PG8_SB(b, h) + boff + n * 2048 + k * 1024); } while (0)
#define PG8_MMA(ai, bj, At, Bt) do { __builtin_amdgcn_s_setprio(1); _Pragma("unroll") for (int m = 0; m < 4; ++m) _Pragma("unroll") for (int n = 0; n < 2; ++n) _Pragma("unroll") for (int k = 0; k < 2; ++k) \
        acc[ai][bj][m][n] = __builtin_amdgcn_mfma_f32_16x16x32_bf16(Bt[n][k], At[m][k], acc[ai][bj][m][n], 0, 0, 0); __builtin_amdgcn_s_setprio(0); } while (0)
#define PG8_WAIT_V(n) asm volatile("s_waitcnt vmcnt(" #n ")" ::: "memory")
#define PG8_WAIT_L(n) asm volatile("s_waitcnt lgkmcnt(" #n ")" ::: "memory")
#define PG8_BAR __builtin_amdgcn_s_barrier()
#define PG8_SCHED __builtin_amdgcn_sched_barrier(0)
    Unit cur, nxt; int ui = 0;
    if (!S.next(0, cur)) return;
    f32x4 acc[2][2][4][2];
#pragma unroll
    for (int a = 0; a < 2; ++a)
#pragma unroll
        for (int b = 0; b < 2; ++b)
#pragma unroll
            for (int m = 0; m < 4; ++m)
#pragma unroll
                for (int n = 0; n < 2; ++n) acc[a][b][m][n] = (f32x4){0.f, 0.f, 0.f, 0.f};
    bf16x8 At[4][2], B0[2][2], B1[2][2];
    const char* cA = cur.a; const char* cB = cur.b;
    S.a_ready(cur);
    if constexpr (SP2) {
        PG8_STAGE(PG8_SB(0, 0), cB, voffB); PG8_STAGE(PG8_SB(0, 1), cB + hstep, voffB); PG8_STAGE(PG8_SA(0, 0), cA, voffA); PG8_STAGE(PG8_SA(0, 1), cA + hstep, voffA);
        if (wr == 1) PG8_BAR;
        PG8_WAIT_V(2); PG8_BAR;
        PG8_STAGE(PG8_SB(1, 0), cB + kstep, voffB); PG8_STAGE(PG8_SA(1, 0), cA + kstep, voffA); PG8_STAGE(PG8_SB(1, 1), cB + hstep + kstep, voffB);
        PG8_WAIT_V(6); PG8_BAR;
    } else {
        PG8_STAGE(PG8_SB(0, 0), cB, voffB); PG8_STAGE(PG8_SA(0, 0), cA, voffA); PG8_STAGE(PG8_SB(0, 1), cB + hstep, voffB); PG8_STAGE(PG8_SA(0, 1), cA + hstep, voffA);
        if (wr == 1) PG8_BAR;
        PG8_WAIT_V(4); PG8_BAR;
        PG8_STAGE(PG8_SB(1, 0), cB + kstep, voffB); PG8_STAGE(PG8_SA(1, 0), cA + kstep, voffA); PG8_STAGE(PG8_SB(1, 1), cB + hstep + kstep, voffB);
        PG8_WAIT_V(6); PG8_BAR;
    }
    for (;;) {
        const bool has_next = S.next(ui + 1, nxt);
        const char* nA = has_next ? nxt.a : cA; const char* nB = has_next ? nxt.b : cB;
        for (int t = 0; t < nt; t += 2) {
            const bool last = (t == nt - 2);
            const char* a1 = cA + (size_t)(t + 1) * kstep;
            const char* a2 = last ? nA : cA + (size_t)(t + 2) * kstep; const char* b2 = last ? nB : cB + (size_t)(t + 2) * kstep;
            const char* a3 = a2 + kstep; const char* b3 = b2 + kstep;
            if (last && has_next) S.a_ready(nxt);
            if constexpr (SP2) {
            PG8_LDB(B0, 0, 0); PG8_LDB(B1, 0, 1); PG8_SCHED; PG8_LDA(At, 0, 0); PG8_STAGE(PG8_SA(1, 1), a1 + hstep, voffA);
            PG8_WAIT_V(8); PG8_WAIT_L(0); PG8_BAR; PG8_MMA(0, 0, At, B0); PG8_MMA(0, 1, At, B1); PG8_BAR; PG8_SCHED;
            PG8_LDA(At, 0, 1); PG8_STAGE(PG8_SB(0, 0), b2, voffB); PG8_STAGE(PG8_SB(0, 1), b2 + hstep, voffB); PG8_STAGE(PG8_SA(0, 0), a2, voffA);
            PG8_WAIT_V(8); PG8_WAIT_L(0); PG8_BAR; PG8_MMA(1, 0, At, B0); PG8_MMA(1, 1, At, B1); PG8_BAR; PG8_SCHED;
            PG8_LDB(B0, 1, 0); PG8_LDB(B1, 1, 1); PG8_SCHED; PG8_LDA(At, 1, 0); PG8_STAGE(PG8_SA(0, 1), a2 + hstep, voffA);
            PG8_WAIT_V(8); PG8_WAIT_L(0); PG8_BAR; PG8_MMA(0, 0, At, B0); PG8_MMA(0, 1, At, B1); PG8_BAR; PG8_SCHED;
            PG8_LDA(At, 1, 1); PG8_STAGE(PG8_SB(1, 0), b3, voffB); PG8_STAGE(PG8_SB(1, 1), b3 + hstep, voffB); PG8_STAGE(PG8_SA(1, 0), a3, voffA);
            PG8_WAIT_V(8); PG8_WAIT_L(0); PG8_BAR; PG8_MMA(1, 0, At, B0); PG8_MMA(1, 1, At, B1); PG8_BAR; PG8_SCHED;
            } else {
            PG8_LDB(B0, 0, 0); PG8_SCHED; PG8_LDA(At, 0, 0); PG8_STAGE(PG8_SA(1, 1), a1 + hstep, voffA);
            PG8_WAIT_L(8); PG8_BAR; PG8_WAIT_L(0); PG8_MMA(0, 0, At, B0); PG8_BAR; PG8_SCHED;
            PG8_LDB(B1, 0, 1); PG8_STAGE(PG8_SB(0, 0), b2, voffB);
            PG8_BAR; PG8_WAIT_L(0); PG8_MMA(0, 1, At, B1); PG8_BAR;
            PG8_LDA(At, 0, 1); PG8_STAGE(PG8_SA(0, 0), a2, voffA);
            PG8_BAR; PG8_WAIT_L(0); PG8_MMA(1, 0, At, B0); PG8_BAR; PG8_SCHED;
            PG8_STAGE(PG8_SB(0, 1), b2 + hstep, voffB);
            PG8_WAIT_V(6); PG8_BAR; PG8_MMA(1, 1, At, B1); PG8_BAR;
            PG8_LDB(B0, 1, 0); PG8_SCHED; PG8_LDA(At, 1, 0); PG8_STAGE(PG8_SA(0, 1), a2 + hstep, voffA);
            PG8_WAIT_L(8); PG8_BAR; PG8_WAIT_L(0); PG8_MMA(0, 0, At, B0); PG8_BAR; PG8_SCHED;
            PG8_LDB(B1, 1, 1); PG8_STAGE(PG8_SB(1, 0), b3, voffB);
            PG8_BAR; PG8_WAIT_L(0); PG8_MMA(0, 1, At, B1); PG8_BAR;
            PG8_LDA(At, 1, 1); PG8_STAGE(PG8_SA(1, 0), a3, voffA);
            PG8_BAR; PG8_WAIT_L(0); PG8_MMA(1, 0, At, B0); PG8_BAR; PG8_SCHED;
            PG8_STAGE(PG8_SB(1, 1), b3 + hstep, voffB);
            PG8_WAIT_V(6); PG8_BAR; PG8_MMA(1, 1, At, B1); PG8_BAR;
            }
        }
        if constexpr (ALIGN_EPI) { if (wr == 0) PG8_BAR; }
        if constexpr (!Epi::AFTER_DRAIN) { E(acc, cur, wr, wc, fr, fq); S.done(cur); }
        if (!has_next) break;
#pragma unroll
        for (int a = 0; a < 2; ++a)
#pragma unroll
            for (int b = 0; b < 2; ++b)
#pragma unroll
                for (int m = 0; m < 4; ++m)
#pragma unroll
                    for (int n = 0; n < 2; ++n) acc[a][b][m][n] = (f32x4){0.f, 0.f, 0.f, 0.f};
        cur = nxt; cA = nA; cB = nB; ++ui;
        if constexpr (ALIGN_EPI) { if (wr == 1) PG8_BAR; }
    }
    PG8_WAIT_V(0);
    if constexpr (!ALIGN_EPI) { if (wr == 0) PG8_BAR; }
    PG8_BAR;
    if constexpr (Epi::AFTER_DRAIN) { E.fused(acc, cur, wr, wc, fr, fq, lds, wid, lane); S.done(cur); }
#undef PG8_SA
#undef PG8_SB
#undef PG8_STAGE
#undef PG8_LDA
#undef PG8_LDB
#undef PG8_MMA
#undef PG8_WAIT_V
#undef PG8_WAIT_L
#undef PG8_BAR
#undef PG8_SCHED
}
typedef int i32x4v __attribute__((ext_vector_type(4))); typedef int i32x8v __attribute__((ext_vector_type(8)));
__device__ __forceinline__ f32x4 mma8(bf16x8 b0, bf16x8 b1, bf16x8 a0, bf16x8 a1, f32x4 c) {
    const i32x4v bl = __builtin_bit_cast(i32x4v, b0), bh = __builtin_bit_cast(i32x4v, b1), al = __builtin_bit_cast(i32x4v, a0), ah = __builtin_bit_cast(i32x4v, a1);
    const i32x8v B = __builtin_shufflevector(bl, bh, 0, 1, 2, 3, 4, 5, 6, 7), A = __builtin_shufflevector(al, ah, 0, 1, 2, 3, 4, 5, 6, 7);
    return __builtin_amdgcn_mfma_scale_f32_16x16x128_f8f6f4(B, A, c, 0, 0, 0, 0x7f7f7f7f, 0, 0x7f7f7f7f);
}
__device__ __forceinline__ f32x4 mma8v(const i32x8v& B, const i32x8v& A, f32x4 c) { const int one = 0x7f7f7f7f;
    asm volatile("v_mfma_scale_f32_16x16x128_f8f6f4 %0, %1, %2, %0, %3, %3 op_sel_hi:[0,0,0]" : "+v"(c) : "v"(B), "v"(A), "v"(one)); return c; }
template <class Epi, class Sched, bool ALIGN_EPI = false, bool SP2 = false>
__device__ __forceinline__ void gemm_phase8(PG8_LAS unsigned char* lds, const Gemm g, const Sched& S, const Epi& E) {
    int tid_ = threadIdx.x; asm volatile("" : "+v"(tid_)); const int tid = tid_, wid = __builtin_amdgcn_readfirstlane(tid >> 6), lane = tid & 63, wr = wid >> 2, wc = wid & 3, fr = lane & 15, fq = lane >> 4;
    const int K = g.K, nt = K / BK;
    unsigned voffA[2], voffB[2];
#pragma unroll
    for (int i = 0; i < 2; ++i) { int R, C; stage_rc(tid * 16 + i * 8192, R, C); const int Rb = Epi::PERM ? ((R & ~31) + perm32(R & 31)) : R;
        voffA[i] = (unsigned)(R * K + C) * 2u; voffB[i] = (unsigned)(Rb * K + C) * 2u; }
    const size_t kstep = (size_t)(BK * 2);
    const size_t hstep = (size_t)HALF * K * 2;
    const unsigned ldsw = (unsigned)wid * 1024u;
    const int aoff = lds_byte(wr * 64 + fr, fq * 8), boff = lds_byte(wc * 32 + fr, fq * 8);
#define PG8_SA(b, h) (((b) * 2 + (h)) * HTB)
#define PG8_SB(b, h) ((4 + (b) * 2 + (h)) * HTB)
#define PG8_STAGE(bufoff, gbase, voff) do { _Pragma("unroll") for (int _i = 0; _i < 2; ++_i) \
        __builtin_amdgcn_global_load_lds((const unsigned*)((const char*)(gbase) + (voff)[_i]), (PG8_LAS unsigned*)(lds + (bufoff) + ldsw + _i * 8192), 16, 0, 0); } while (0)
#define PG8_LDA(dst, b, h) do { _Pragma("unroll") for (int m = 0; m < 4; ++m) { dst[m].lo = *(const PG8_LAS i32x4v*)(lds + PG8_SA(b, h) + aoff + m * 2048); dst[m].hi = *(const PG8_LAS i32x4v*)(lds + PG8_SA(b, h) + aoff + m * 2048 + 1024); } } while (0)
#define PG8_LDB(dst, b, h) do { _Pragma("unroll") for (int n = 0; n < 2; ++n) { dst[n].lo = *(const PG8_LAS i32x4v*)(lds + PG8_SB(b, h) + boff + n * 2048); dst[n].hi = *(const PG8_LAS i32x4v*)(lds + PG8_SB(b, h) + boff + n * 2048 + 1024); } } while (0)
#define PG8_MMA(ai, bj, At, Bt) do { __builtin_amdgcn_s_setprio(1); _Pragma("unroll") for (int m = 0; m < 4; ++m) _Pragma("unroll") for (int n = 0; n < 2; ++n) \
        acc[ai][bj][m][n] = mma8v(Bt[n], At[m], acc[ai][bj][m][n]); __builtin_amdgcn_s_setprio(0); } while (0)
#define PG8_WAIT_V(n) asm volatile("s_waitcnt vmcnt(" #n ")" ::: "memory")
#define PG8_WAIT_L(n) asm volatile("s_waitcnt lgkmcnt(" #n ")" ::: "memory")
#define PG8_BAR __builtin_amdgcn_s_barrier()
#define PG8_SCHED __builtin_amdgcn_sched_barrier(0)
    Unit cur, nxt; int ui = 0;
    if (!S.next(0, cur)) return;
    f32x4 acc[2][2][4][2];
#pragma unroll
    for (int a = 0; a < 2; ++a)
#pragma unroll
        for (int b = 0; b < 2; ++b)
#pragma unroll
            for (int m = 0; m < 4; ++m)
#pragma unroll
                for (int n = 0; n < 2; ++n) acc[a][b][m][n] = (f32x4){0.f, 0.f, 0.f, 0.f};
    i32x8v At[4], B0[2], B1[2];
    const char* cA = cur.a; const char* cB = cur.b;
    S.a_ready(cur);
    if constexpr (SP2) {
        PG8_STAGE(PG8_SB(0, 0), cB, voffB); PG8_STAGE(PG8_SB(0, 1), cB + hstep, voffB); PG8_STAGE(PG8_SA(0, 0), cA, voffA); PG8_STAGE(PG8_SA(0, 1), cA + hstep, voffA);
        if (wr == 1) PG8_BAR;
        PG8_WAIT_V(2); PG8_BAR;
        PG8_STAGE(PG8_SB(1, 0), cB + kstep, voffB); PG8_STAGE(PG8_SA(1, 0), cA + kstep, voffA); PG8_STAGE(PG8_SB(1, 1), cB + hstep + kstep, voffB);
        PG8_WAIT_V(6); PG8_BAR;
    } else {
        PG8_STAGE(PG8_SB(0, 0), cB, voffB); PG8_STAGE(PG8_SA(0, 0), cA, voffA); PG8_STAGE(PG8_SB(0, 1), cB + hstep, voffB); PG8_STAGE(PG8_SA(0, 1), cA + hstep, voffA);
        if (wr == 1) PG8_BAR;
        PG8_WAIT_V(4); PG8_BAR;
        PG8_STAGE(PG8_SB(1, 0), cB + kstep, voffB); PG8_STAGE(PG8_SA(1, 0), cA + kstep, voffA); PG8_STAGE(PG8_SB(1, 1), cB + hstep + kstep, voffB);
        PG8_WAIT_V(6); PG8_BAR;
    }
    for (;;) {
        const bool has_next = S.next(ui + 1, nxt);
        const char* nA = has_next ? nxt.a : cA; const char* nB = has_next ? nxt.b : cB;
        for (int t = 0; t < nt; t += 2) {
            const bool last = (t == nt - 2);
            const char* a1 = cA + (size_t)(t + 1) * kstep;
            const char* a2 = last ? nA : cA + (size_t)(t + 2) * kstep; const char* b2 = last ? nB : cB + (size_t)(t + 2) * kstep;
            const char* a3 = a2 + kstep; const char* b3 = b2 + kstep;
            if (last && has_next) S.a_ready(nxt);
            if constexpr (SP2) {
            PG8_LDB(B0, 0, 0); PG8_LDB(B1, 0, 1); PG8_SCHED; PG8_LDA(At, 0, 0); PG8_STAGE(PG8_SA(1, 1), a1 + hstep, voffA);
            PG8_WAIT_V(8); PG8_WAIT_L(0); PG8_BAR; PG8_MMA(0, 0, At, B0); PG8_MMA(0, 1, At, B1); PG8_BAR; PG8_SCHED;
            PG8_LDA(At, 0, 1); PG8_STAGE(PG8_SB(0, 0), b2, voffB); PG8_STAGE(PG8_SB(0, 1), b2 + hstep, voffB); PG8_STAGE(PG8_SA(0, 0), a2, voffA);
            PG8_WAIT_V(8); PG8_WAIT_L(0); PG8_BAR; PG8_MMA(1, 0, At, B0); PG8_MMA(1, 1, At, B1); PG8_BAR; PG8_SCHED;
            PG8_LDB(B0, 1, 0); PG8_LDB(B1, 1, 1); PG8_SCHED; PG8_LDA(At, 1, 0); PG8_STAGE(PG8_SA(0, 1), a2 + hstep, voffA);
            PG8_WAIT_V(8); PG8_WAIT_L(0); PG8_BAR; PG8_MMA(0, 0, At, B0); PG8_MMA(0, 1, At, B1); PG8_BAR; PG8_SCHED;
            PG8_LDA(At, 1, 1); PG8_STAGE(PG8_SB(1, 0), b3, voffB); PG8_STAGE(PG8_SB(1, 1), b3 + hstep, voffB); PG8_STAGE(PG8_SA(1, 0), a3, voffA);
            PG8_WAIT_V(8); PG8_WAIT_L(0); PG8_BAR; PG8_MMA(1, 0, At, B0); PG8_MMA(1, 1, At, B1); PG8_BAR; PG8_SCHED;
            } else {
            PG8_LDB(B0, 0, 0); PG8_SCHED; PG8_LDA(At, 0, 0); PG8_STAGE(PG8_SA(1, 1), a1 + hstep, voffA);
            PG8_WAIT_L(8); PG8_BAR; PG8_WAIT_L(0); PG8_MMA(0, 0, At, B0); PG8_BAR; PG8_SCHED;
            PG8_LDB(B1, 0, 1); PG8_STAGE(PG8_SB(0, 0), b2, voffB);
            PG8_BAR; PG8_WAIT_L(0); PG8_MMA(0, 1, At, B1); PG8_BAR;
            PG8_LDA(At, 0, 1); PG8_STAGE(PG8_SA(0, 0), a2, voffA);
            PG8_BAR; PG8_WAIT_L(0); PG8_MMA(1, 0, At, B0); PG8_BAR; PG8_SCHED;
            PG8_STAGE(PG8_SB(0, 1), b2 + hstep, voffB);
            PG8_WAIT_V(6); PG8_BAR; PG8_MMA(1, 1, At, B1); PG8_BAR;
            PG8_LDB(B0, 1, 0); PG8_SCHED; PG8_LDA(At, 1, 0); PG8_STAGE(PG8_SA(0, 1), a2 + hstep, voffA);
            PG8_WAIT_L(8); PG8_BAR; PG8_WAIT_L(0); PG8_MMA(0, 0, At, B0); PG8_BAR; PG8_SCHED;
            PG8_LDB(B1, 1, 1); PG8_STAGE(PG8_SB(1, 0), b3, voffB);
            PG8_BAR; PG8_WAIT_L(0); PG8_MMA(0, 1, At, B1); PG8_BAR;
            PG8_LDA(At, 1, 1); PG8_STAGE(PG8_SA(1, 0), a3, voffA);
            PG8_BAR; PG8_WAIT_L(0); PG8_MMA(1, 0, At, B0); PG8_BAR; PG8_SCHED;
            PG8_STAGE(PG8_SB(1, 1), b3 + hstep, voffB);
            PG8_WAIT_V(6); PG8_BAR; PG8_MMA(1, 1, At, B1); PG8_BAR;
            }
        }
        if constexpr (ALIGN_EPI) { if (wr == 0) PG8_BAR; }
        if constexpr (!Epi::AFTER_DRAIN) { E(acc, cur, wr, wc, fr, fq); S.done(cur); }
        if (!has_next) break;
#pragma unroll
        for (int a = 0; a < 2; ++a)
#pragma unroll
            for (int b = 0; b < 2; ++b)
#pragma unroll
                for (int m = 0; m < 4; ++m)
#pragma unroll
                    for (int n = 0; n < 2; ++n) acc[a][b][m][n] = (f32x4){0.f, 0.f, 0.f, 0.f};
        cur = nxt; cA = nA; cB = nB; ++ui;
        if constexpr (ALIGN_EPI) { if (wr == 1) PG8_BAR; }
    }
    PG8_WAIT_V(0);
    if constexpr (!ALIGN_EPI) { if (wr == 0) PG8_BAR; }
    PG8_BAR;
    if constexpr (Epi::AFTER_DRAIN) { E.fused(acc, cur, wr, wc, fr, fq, lds, wid, lane); S.done(cur); }
#undef PG8_SA
#undef PG8_SB
#undef PG8_STAGE
#undef PG8_LDA
#undef PG8_LDB
#undef PG8_MMA
#undef PG8_WAIT_V
#undef PG8_WAIT_L
#undef PG8_BAR
#undef PG8_SCHED
}
struct OrderBase {
    int nM, nN, nwg, G, c;
    __device__ __forceinline__ void init(int nM_, int nN_, int G_, int c_) { nM = nM_; nN = nN_; nwg = nM_ * nN_; G = G_; c = c_; }
    __device__ __forceinline__ bool map(int i, int& pm, int& pn) const {
        const long L = (long)i * G + c; if (L >= nwg) return false;
        int wgid = (int)L; { const int q = nwg / NXCD, r = nwg % NXCD, xcd = wgid % NXCD, off = wgid / NXCD; wgid = (xcd < r ? xcd * (q + 1) : r * (q + 1) + (xcd - r) * q) + off; }
        const int nig = WGM * nN, gid = wgid / nig, fm = gid * WGM, gsz = (nM - fm) < WGM ? (nM - fm) : WGM;
        pm = fm + ((wgid % nig) % gsz); pn = (wgid % nig) / gsz; return true;
    }
    __device__ __forceinline__ void a_ready(const Unit&) const {}
    __device__ __forceinline__ void done(const Unit&) const {}
};
struct PlainOrder : OrderBase {
    const char* A; const char* B; size_t ta, tb;
    __device__ __forceinline__ bool next(int i, Unit& u) const { int pm, pn; if (!map(i, pm, pn)) return false; u.pm = pm; u.pn = pn; u.aux = 0; u.a = A + (size_t)pm * ta; u.b = B + (size_t)pn * tb; return true; }
};
struct BranchOrder : OrderBase {
    const char* A; const char* B; size_t ta, tb, za, zb;
    __device__ __forceinline__ bool next(int i, Unit& u) const { const int ti = i / 3, br = i - 3 * ti; int pm, pn; if (!map(ti, pm, pn)) return false; u.pm = pm; u.pn = pn; u.aux = br;
        u.a = A + (size_t)br * za + (size_t)pm * ta; u.b = B + (size_t)br * zb + (size_t)pn * tb; return true; }
};
struct MoeOrder : OrderBase {
    const char* A; const char* B; size_t ta, tb, zb; int t1, t2, t3, t4, t5, t6, t7;
    __device__ __forceinline__ bool next(int i, Unit& u) const { int pm, pn; if (!map(i, pm, pn)) return false; u.pm = pm; u.pn = pn;
        const int e = (pm >= t1) + (pm >= t2) + (pm >= t3) + (pm >= t4) + (pm >= t5) + (pm >= t6) + (pm >= t7); u.aux = e;
        u.a = A + (size_t)pm * ta; u.b = B + (size_t)e * zb + (size_t)pn * tb; return true; }
};
}

constexpr int NTOK = 16384, DM = 2048, SEQ = 2048, NBATCH = 8, NHEAD = 8, HD = 64, DFF = 7168, NEXP = 8;
constexpr int NIN = 10828, NINP = 11008;
constexpr int WBR_W = 512, KVR = 256;
constexpr float EPS = 1e-6f, LOG2E = 1.4426950408889634f, C2 = 0.125f * LOG2E;
constexpr int MOE_ROWS = 2 * NTOK + NEXP * 256;
constexpr int NSTEPS = 24;
constexpr float W8SCALE = 64.f, WD8SCALE = 128.f, H8SCALE = 8.f;

constexpr size_t al256(size_t x) { return (x + 255) & ~(size_t)255; }
constexpr size_t WS_CTL = 0, CTL_ZERO_BYTES = 1u << 20;
constexpr size_t SZ_WIN = (size_t)NINP * DM * 2, SZ_WUKV = (size_t)1024 * KVR * 2, SZ_WBR = (size_t)DM * WBR_W * 2, SZ_WOUT = (size_t)DM * DM * 2;
constexpr size_t SZ_WGU = (size_t)2 * DFF * DM * 2, SZ_WD = (size_t)DM * DFF * 2;
constexpr size_t WS_WIN = CTL_ZERO_BYTES, WS_WUKV = WS_WIN + 2 * SZ_WIN, WS_WBR = WS_WUKV + 2 * SZ_WUKV, WS_WOUT = WS_WBR + 6 * SZ_WBR;
constexpr size_t WS_WGU0 = WS_WOUT + 2 * SZ_WOUT, WS_WD0 = WS_WGU0 + SZ_WGU, WS_WGUM = WS_WD0 + SZ_WD, WS_WDM = WS_WGUM + NEXP * SZ_WGU;
constexpr size_t WS_RSTD = WS_WDM + NEXP * SZ_WD, WS_SSP = WS_RSTD + (size_t)NTOK * 4, WS_XB = WS_SSP + (size_t)NTOK * 32 * 4;
constexpr size_t WS_R = WS_XB + (size_t)NTOK * DM * 2;
constexpr size_t WS_Z8 = WS_R, WS_DLAT = WS_Z8 + (size_t)8 * NTOK * 512 * 2, WS_DIQ = WS_DLAT + (size_t)NTOK * 256 * 2, WS_DIK = WS_DIQ + (size_t)NTOK * 256 * 2;
constexpr size_t WS_FFW = WS_DIK + (size_t)NTOK * 64 * 2, WS_GATES = WS_FFW + (size_t)NTOK * 16 * 4, WS_C2F = WS_GATES + (size_t)NTOK * 6144 * 2;
constexpr size_t WS_DKV = WS_C2F + (size_t)NBATCH * NHEAD * SEQ * 4, WS_SC = WS_DKV + (size_t)NTOK * 1024 * 2, WS_MASK = WS_SC + (size_t)NTOK * SEQ * 4;
constexpr size_t WS_YATT = WS_MASK + (size_t)NTOK * 64 * 4, WS_M = WS_YATT + (size_t)3 * NTOK * 512 * 2, WS_R_END1 = WS_M + (size_t)NTOK * DM * 2;
constexpr size_t WS_HID = WS_R;
constexpr size_t WS_XG = WS_R, WS_HIDM = WS_XG + (size_t)MOE_ROWS * DM * 2, WS_Y = WS_HIDM + (size_t)MOE_ROWS * DFF * 2, WS_ROWTOK = WS_Y + (size_t)2 * NTOK * DM * 4;
constexpr size_t WS_ROWW = WS_ROWTOK + (size_t)MOE_ROWS * 4, WS_RSTDG = WS_ROWW + (size_t)MOE_ROWS * 4, WS_TOKINFO = WS_RSTDG + (size_t)MOE_ROWS * 4;
constexpr size_t WS_TOKW = WS_TOKINFO + (size_t)2 * NTOK * 8, WS_WGCNT = WS_TOKW + (size_t)2 * NTOK * 4, WS_META = WS_WGCNT + 256 * 8 * 4, WS_R_END2 = WS_META + 256;
constexpr size_t WS_END = WS_R_END1 > WS_R_END2 ? WS_R_END1 : WS_R_END2;
constexpr size_t WS_XB8 = WS_WGUM + NEXP * SZ_WGU / 2;
constexpr int CW_BAR = 4096;

constexpr int RING_BYTES = 131072, LDSCTL_OFF = RING_BYTES, MISC_OFF = LDSCTL_OFF + 320, LDS_BYTES = 147456;

#define GAS __attribute__((address_space(1)))
#define LAS __attribute__((address_space(3)))
typedef unsigned short bf16_t;
typedef float f32x4 __attribute__((ext_vector_type(4)));
typedef unsigned u32x4 __attribute__((ext_vector_type(4)));
typedef unsigned u32x2 __attribute__((ext_vector_type(2)));
typedef short bf16x8 __attribute__((ext_vector_type(8)));
typedef float f32x16 __attribute__((ext_vector_type(16)));
#define LDS_WAIT() asm volatile("s_waitcnt lgkmcnt(0)" ::: "memory")
#define VM_WAIT() asm volatile("s_waitcnt vmcnt(0)" ::: "memory")
__device__ __forceinline__ float bflo(unsigned w) { return __uint_as_float(w << 16); }
__device__ __forceinline__ float bfhi(unsigned w) { return __uint_as_float(w & 0xffff0000u); }
typedef float f32x2_t __attribute__((ext_vector_type(2))); typedef __bf16 bf16x2_t __attribute__((ext_vector_type(2)));
__device__ __forceinline__ unsigned pk2(float lo, float hi) { f32x2_t v = {lo, hi}; bf16x2_t b = __builtin_convertvector(v, bf16x2_t); return __builtin_bit_cast(unsigned, b); }
__device__ __forceinline__ int opq(int v) { asm volatile("" : "+s"(v)); return v; }
__device__ __forceinline__ float wave_sum(float v) {
#pragma unroll
    for (int o = 1; o < 64; o <<= 1) v += __shfl_xor(v, o);
    return v;
}
__device__ __forceinline__ u32x2 pack8_fp8(const float (&e)[8]) {
    float c[8];
#pragma unroll
    for (int i = 0; i < 8; ++i) c[i] = __builtin_amdgcn_fmed3f(e[i], -448.f, 448.f);
    int w0 = __builtin_amdgcn_cvt_pk_fp8_f32(c[0], c[1], 0, false); w0 = __builtin_amdgcn_cvt_pk_fp8_f32(c[2], c[3], w0, true);
    int w1 = __builtin_amdgcn_cvt_pk_fp8_f32(c[4], c[5], 0, false); w1 = __builtin_amdgcn_cvt_pk_fp8_f32(c[6], c[7], w1, true);
    u32x2 r; r.x = (unsigned)w0; r.y = (unsigned)w1; return r; }
__device__ __forceinline__ float sigm(float v) { return __builtin_amdgcn_rcpf(1.f + __builtin_amdgcn_exp2f(-v * LOG2E)); }
__device__ __forceinline__ float softplus2(float z) { return fmaxf(z, 0.f) + __builtin_amdgcn_logf(1.f + __builtin_amdgcn_exp2f(-fabsf(z))); }

#define XB_TMO      128
#define XB_XCNT(j)  (256  + 64 * (j))
#define XB_XSUB(j)  (1280 + 64 * (j))
#define XB_XGEN(j)  (2304 + 64 * (j))
#define XB_TOP      3328
#define XB_TOPGEN   3392
#define XCD_BAR_WORDS 3456
#define XB_SPIN_CAP (1u << 18)

__device__ __forceinline__ unsigned xb_ld(unsigned* p)              { return __hip_atomic_load(p, __ATOMIC_RELAXED, __HIP_MEMORY_SCOPE_AGENT); }
__device__ __forceinline__ unsigned xb_add(unsigned* p, unsigned v) { return __hip_atomic_fetch_add(p, v, __ATOMIC_RELAXED, __HIP_MEMORY_SCOPE_AGENT); }
__device__ __forceinline__ unsigned xb_xcc_id() { return (unsigned)__builtin_amdgcn_s_getreg((3 << 11) | 20) & 0xFu; }
#define XB_SPIN(cond, bar) do { unsigned _sp = 0; while (cond) { __builtin_amdgcn_s_sleep(1); \
    if ((++_sp & 255u) == 0u) { if (xb_ld(&(bar)[XB_TMO])) break; if (_sp > XB_SPIN_CAP) { atomicAdd(&(bar)[XB_TMO], 1u); break; } } } } while (0)

struct XcdBarrier {
    unsigned* bar; unsigned x;
    volatile LAS unsigned* st;
};

__device__ __forceinline__ XcdBarrier xcd_barrier_post(unsigned* bar, volatile LAS unsigned* st) {
    XcdBarrier b; b.bar = bar; b.x = xb_xcc_id(); b.st = st;
    if (threadIdx.x == 0) (void)xb_add(&bar[XB_XCNT(b.x)], 1u);
    return b;
}
__device__ __forceinline__ void xcd_barrier_complete(unsigned* bar, unsigned x, unsigned& nloc, unsigned& nx) {
    const unsigned G = gridDim.x * gridDim.y * gridDim.z;
    unsigned sum, cnt, mine, sp = 0u;
    for (;;) {
        sum = 0u; cnt = 0u; mine = 0u;
#pragma unroll
        for (unsigned j = 0; j < 16; ++j) { const unsigned c = xb_ld(&bar[XB_XCNT(j)]); sum += c; cnt += (c > 0u) ? 1u : 0u; mine = (j == x) ? c : mine; }
        if (sum == G) break;
        __builtin_amdgcn_s_sleep(1);
        if ((++sp & 255u) == 0u) { if (xb_ld(&bar[XB_TMO])) break; if (sp > XB_SPIN_CAP) { atomicAdd(&bar[XB_TMO], 1u); break; } }
    }
    nloc = mine > 0u ? mine : 1u; nx = cnt > 0u ? cnt : 1u;
}

__device__ __attribute__((noinline)) void xcd_barrier_impl(GAS unsigned* bar_, unsigned x_, LAS unsigned* st_) { XcdBarrier b; b.bar = (unsigned*)bar_; b.x = x_; b.st = st_;
    asm volatile("s_waitcnt vmcnt(0)" ::: "memory");
    __syncthreads();
    if (threadIdx.x == 0) {
        unsigned* bar = b.bar;
        __builtin_amdgcn_s_waitcnt(0);
        unsigned nloc = b.st[0], nx = b.st[1];
        if (nloc == 0u) { xcd_barrier_complete(bar, b.x, nloc, nx); b.st[0] = nloc; b.st[1] = nx; }
        const unsigned old = xb_add(&bar[XB_XSUB(b.x)], 1u);
        const unsigned gen = old / nloc;
        if (old + 1u == (gen + 1u) * nloc) {
            __builtin_amdgcn_fence(__ATOMIC_RELEASE, "agent");
            asm volatile("s_waitcnt vmcnt(0)" ::: "memory");
            const unsigned og = xb_add(&bar[XB_TOP], 1u);
            const unsigned tg = og / nx;
            if (og + 1u == (tg + 1u) * nx) xb_add(&bar[XB_TOPGEN], 1u);
            else XB_SPIN(xb_ld(&bar[XB_TOPGEN]) == tg, bar);
            __builtin_amdgcn_fence(__ATOMIC_ACQUIRE, "agent");
            xb_add(&bar[XB_XGEN(b.x)], 1u);
            asm volatile("s_waitcnt vmcnt(0)" ::: "memory");
        } else {
            XB_SPIN(xb_ld(&bar[XB_XGEN(b.x)]) == gen, bar);
            __builtin_amdgcn_fence(__ATOMIC_ACQUIRE, "agent");
            asm volatile("s_waitcnt vmcnt(0)" ::: "memory");
        }
    }
    __syncthreads();
}
__device__ __forceinline__ void xcd_barrier(const XcdBarrier& b) { xcd_barrier_impl((GAS unsigned*)b.bar, b.x, (LAS unsigned*)b.st); }

#define ACC_T const pg8::f32x4 (&acc)[2][2][4][2]
__device__ __forceinline__ u32x4 pack8(f32x4 v0, f32x4 v1) { u32x4 w; w.x = pk2(v0[0], v0[1]); w.y = pk2(v0[2], v0[3]); w.z = pk2(v1[0], v1[1]); w.w = pk2(v1[2], v1[3]); return w; }
__device__ __forceinline__ f32x4 sigm4(f32x4 v) { f32x4 r; r[0] = sigm(v[0]); r[1] = sigm(v[1]); r[2] = sigm(v[2]); r[3] = sigm(v[3]); return r; }

struct EpiWin {
    static constexpr bool PERM = true, AFTER_DRAIN = false;
    const float* rstd; bf16_t* z8; bf16_t* dlat; bf16_t* diq; bf16_t* dik; float* ffw; bf16_t* gates;
    __device__ __forceinline__ void operator()(ACC_T, const pg8::Unit& u, int wr, int wc, int fr, int fq) const {
        const int row0 = u.pm * 256 + wr * 64 + fr, pn = u.pn, cl = wc * 32 + 8 * fq;
        if (pn == 18) {
#pragma unroll
            for (int ai = 0; ai < 2; ++ai)
#pragma unroll
                for (int m = 0; m < 4; ++m) { const int row = row0 + ai * 128 + m * 16; const float rs = rstd[row];
                    const f32x4 v0 = acc[ai][0][m][0] * rs, v1 = acc[ai][0][m][1] * rs;
                    if (cl < 64) *(u32x4*)(dik + (size_t)row * 64 + cl) = pack8(v0, v1);
                    else if (cl == 64) { *(f32x4*)(ffw + (size_t)row * 16) = v0; *(f32x4*)(ffw + (size_t)row * 16 + 4) = v1; }
                    else if (cl == 72) { *(f32x4*)(ffw + (size_t)row * 16 + 8) = v0; } }
            return;
        }
        bf16_t* dst; int ldc, colbase; bool sg = false; float scale = 1.f;
        if (pn < 16) { const int idx = pn >> 1; dst = z8 + (size_t)idx * NTOK * 512; ldc = 512; colbase = (pn & 1) * 256; sg = (idx == 3); scale = (idx == 4 || idx == 7) ? C2 : 1.f; }
        else if (pn == 16) { dst = dlat; ldc = 256; colbase = 0; }
        else if (pn == 17) { dst = diq; ldc = 256; colbase = 0; }
        else { dst = gates; ldc = 6144; colbase = (pn - 19) * 256; sg = true; }
        if (sg) {
#pragma unroll
            for (int ai = 0; ai < 2; ++ai)
#pragma unroll
                for (int m = 0; m < 4; ++m) { const int row = row0 + ai * 128 + m * 16; const float rs = rstd[row]; bf16_t* rowp = dst + (size_t)row * ldc + colbase + cl;
#pragma unroll
                    for (int bj = 0; bj < 2; ++bj) *(u32x4*)(rowp + bj * 128) = pack8(sigm4(acc[ai][bj][m][0] * rs), sigm4(acc[ai][bj][m][1] * rs)); }
        } else {
#pragma unroll
            for (int ai = 0; ai < 2; ++ai)
#pragma unroll
                for (int m = 0; m < 4; ++m) { const int row = row0 + ai * 128 + m * 16; const float rs = rstd[row] * scale; bf16_t* rowp = dst + (size_t)row * ldc + colbase + cl;
#pragma unroll
                    for (int bj = 0; bj < 2; ++bj) *(u32x4*)(rowp + bj * 128) = pack8(acc[ai][bj][m][0] * rs, acc[ai][bj][m][1] * rs); }
        }
    }
};
struct EpiPlain {
    static constexpr bool PERM = true, AFTER_DRAIN = false;
    bf16_t* O; int ldc;
    __device__ __forceinline__ void operator()(ACC_T, const pg8::Unit& u, int wr, int wc, int fr, int fq) const {
        const int row0 = u.pm * 256 + wr * 64 + fr, col0 = u.pn * 256 + wc * 32 + 8 * fq;
#pragma unroll
        for (int ai = 0; ai < 2; ++ai)
#pragma unroll
            for (int m = 0; m < 4; ++m) { bf16_t* rowp = O + (size_t)(row0 + ai * 128 + m * 16) * ldc + col0;
#pragma unroll
                for (int bj = 0; bj < 2; ++bj) *(u32x4*)(rowp + bj * 128) = pack8(acc[ai][bj][m][0], acc[ai][bj][m][1]); }
    }
};
struct EpiBranch {
    static constexpr bool PERM = true, AFTER_DRAIN = false;
    const bf16_t* gates; bf16_t* M;
    __device__ __forceinline__ void operator()(ACC_T, const pg8::Unit& u, int wr, int wc, int fr, int fq) const {
        const int row0 = u.pm * 256 + wr * 64 + fr, col0 = u.pn * 256 + wc * 32 + 8 * fq, br = u.aux;
#pragma unroll
        for (int ai = 0; ai < 2; ++ai)
#pragma unroll
            for (int m = 0; m < 4; ++m) { const int row = row0 + ai * 128 + m * 16;
#pragma unroll
                for (int bj = 0; bj < 2; ++bj) { const int col = col0 + bj * 128;
                    const u32x4 g = *(const u32x4*)(gates + (size_t)row * 6144 + br * 2048 + col);
                    f32x4 v0 = acc[ai][bj][m][0], v1 = acc[ai][bj][m][1];
                    v0[0] *= bflo(g.x); v0[1] *= bfhi(g.x); v0[2] *= bflo(g.y); v0[3] *= bfhi(g.y); v1[0] *= bflo(g.z); v1[1] *= bfhi(g.z); v1[2] *= bflo(g.w); v1[3] *= bfhi(g.w);
                    bf16_t* mp = M + (size_t)row * DM + col;
                    if (br > 0) { const u32x4 o = *(const u32x4*)mp; v0[0] += bflo(o.x); v0[1] += bfhi(o.x); v0[2] += bflo(o.y); v0[3] += bfhi(o.y); v1[0] += bflo(o.z); v1[1] += bfhi(o.z); v1[2] += bflo(o.w); v1[3] += bfhi(o.w); }
                    *(u32x4*)mp = pack8(v0, v1); } }
    }
};
struct EpiResid {
    static constexpr bool PERM = true, AFTER_DRAIN = false;
    const float* xold; float* x; bf16_t* xb; float* ssp; unsigned char* xb8; float ascale;
    __device__ __forceinline__ void operator()(ACC_T, const pg8::Unit& u, int wr, int wc, int fr, int fq) const {
        const int row0 = u.pm * 256 + wr * 64 + fr, col0 = u.pn * 256 + wc * 32 + 8 * fq;
#pragma unroll
        for (int ai = 0; ai < 2; ++ai)
#pragma unroll
            for (int m = 0; m < 4; ++m) { const int row = row0 + ai * 128 + m * 16; float ss = 0.f;
#pragma unroll
                for (int bj = 0; bj < 2; ++bj) { const size_t off = (size_t)row * DM + col0 + bj * 128;
                    const f32x4 o0 = *(const f32x4*)(xold + off), o1 = *(const f32x4*)(xold + off + 4);
                    const f32x4 v0 = o0 + acc[ai][bj][m][0] * ascale, v1 = o1 + acc[ai][bj][m][1] * ascale;
                    *(f32x4*)(x + off) = v0; *(f32x4*)(x + off + 4) = v1; *(u32x4*)(xb + off) = pack8(v0, v1);
                    if (xb8) { const float e[8] = {v0[0], v0[1], v0[2], v0[3], v1[0], v1[1], v1[2], v1[3]}; *(u32x2*)(xb8 + off) = pack8_fp8(e); }
                    ss += (v0[0] * v0[0] + v0[1] * v0[1]) + (v0[2] * v0[2] + v0[3] * v0[3]) + (v1[0] * v1[0] + v1[1] * v1[1]) + (v1[2] * v1[2] + v1[3] * v1[3]); }
                ss += __shfl_xor(ss, 16); ss += __shfl_xor(ss, 32);
                if (fq == 0) ssp[(size_t)row * 32 + u.pn * 4 + wc] = ss; }
    }
};
struct EpiSwiglu {
    static constexpr bool PERM = true, AFTER_DRAIN = false;
    const float* rstd; bf16_t* hid; int dry; float oscale; int f8out;
    __device__ __forceinline__ void operator()(ACC_T, const pg8::Unit& u, int wr, int wc, int fr, int fq) const {
        if (dry) return;
        const int row0 = u.pm * 256 + wr * 64 + fr, col0 = u.pn * 128 + wc * 32 + 8 * fq;
#pragma unroll
        for (int ai = 0; ai < 2; ++ai)
#pragma unroll
            for (int m = 0; m < 4; ++m) { const int row = row0 + ai * 128 + m * 16; const float rs = rstd[row] * oscale;
                f32x4 h0, h1;
#pragma unroll
                for (int j = 0; j < 4; ++j) { const float g0 = acc[ai][0][m][0][j] * rs, u0 = acc[ai][1][m][0][j] * rs, g1 = acc[ai][0][m][1][j] * rs, u1 = acc[ai][1][m][1][j] * rs;
                    h0[j] = g0 * u0 * sigm(g0); h1[j] = g1 * u1 * sigm(g1); }
                if (f8out) { const float e[8] = {h0[0] * H8SCALE, h0[1] * H8SCALE, h0[2] * H8SCALE, h0[3] * H8SCALE, h1[0] * H8SCALE, h1[1] * H8SCALE, h1[2] * H8SCALE, h1[3] * H8SCALE}; *(u32x2*)((unsigned char*)hid + (size_t)row * DFF + col0) = pack8_fp8(e); }
                else *(u32x4*)(hid + (size_t)row * DFF + col0) = pack8(h0, h1); }
    }
};
struct EpiMoeDown {
    static constexpr bool PERM = true, AFTER_DRAIN = false;
    const int* rowtok; const float* roww; float* y; float oscale;
    __device__ __forceinline__ void operator()(ACC_T, const pg8::Unit& u, int wr, int wc, int fr, int fq) const {
        const int row0 = u.pm * 256 + wr * 64 + fr, col0 = u.pn * 256 + wc * 32 + 8 * fq;
#pragma unroll
        for (int ai = 0; ai < 2; ++ai)
#pragma unroll
            for (int m = 0; m < 4; ++m) { const int row = row0 + ai * 128 + m * 16; const int tk = rowtok[row];
                if (tk >= 0) { const float w = roww[row] * oscale; float* d = y + (size_t)(tk & 1) * NTOK * DM + (size_t)(tk >> 1) * DM + col0;
#pragma unroll
                    for (int bj = 0; bj < 2; ++bj) { *(f32x4*)(d + bj * 128) = acc[ai][bj][m][0] * w; *(f32x4*)(d + bj * 128 + 4) = acc[ai][bj][m][1] * w; } } }
    }
};

struct Args { const float* in[22]; float* out; unsigned char* ws; int ph_lo, ph_hi; };

__host__ __device__ __forceinline__ int win_src(int n) {
    if (n < 1536) return n;
    if (n < 2048) return 1544 + (n - 1536);
    if (n < 4096) return 2056 + (n - 2048);
    if (n < 4352) return 4104 + (n - 4096);
    if (n < 4608) return 4360 + (n - 4352);
    if (n < 4672) return 4616 + (n - 4608);
    if (n < 4680) return 1536 + (n - 4672);
    if (n < 4684) return 4680 + (n - 4680);
    if (n < 4864) return -1;
    return 4684 + (n - 4864);
}

__device__ __forceinline__ void conv_matrix(int map, const float* W0, const float* W1, int K, int Ns, int dstN, bf16_t* WT, const float* gain, LAS float* scr, int gw, int NGW, int lane, float f8scale = 0.f) {
    const int nblk = dstN >> 5, nit = (K >> 6) * nblk;
    for (int it = gw; it < nit; it += NGW) {
        const int kb = it / nblk, nb = it - kb * nblk, k0 = kb << 6, n0 = nb << 5;
        const float* src = W0; int sc;
        if (map == 0) sc = n0 + (lane & 31);
        else if (map == 1) sc = win_src(n0 + (lane & 31));
        else { const int t = nb >> 3, r = nb & 7; src = (r < 4) ? W0 : W1; sc = 128 * t + 32 * (r & 3) + (lane & 31); }
        const float* sp = src + (size_t)k0 * Ns + (sc < 0 ? 0 : sc);
        float tv[32];
#pragma unroll
        for (int i = 0; i < 32; ++i) tv[i] = sp[(size_t)(2 * i + (lane >> 5)) * Ns];
#pragma unroll
        for (int i = 0; i < 32; ++i) scr[(2 * i + (lane >> 5)) * 33 + (lane & 31)] = (sc < 0) ? 0.f : tv[i];
        LDS_WAIT(); asm volatile("" ::: "memory");
        const int c = lane & 7;
        f32x4 g0 = {1.f, 1.f, 1.f, 1.f}, g1 = {1.f, 1.f, 1.f, 1.f};
        if (gain) { g0 = *(const f32x4*)(gain + k0 + 8 * c); g1 = *(const f32x4*)(gain + k0 + 8 * c + 4); }
#pragma unroll
        for (int j = 0; j < 4; ++j) { const int n = (lane >> 3) + 8 * j; const LAS float* s = scr + (8 * c) * 33 + n;
            if (f8scale != 0.f) { const float e[8] = {s[0 * 33] * g0[0] * f8scale, s[1 * 33] * g0[1] * f8scale, s[2 * 33] * g0[2] * f8scale, s[3 * 33] * g0[3] * f8scale, s[4 * 33] * g1[0] * f8scale, s[5 * 33] * g1[1] * f8scale, s[6 * 33] * g1[2] * f8scale, s[7 * 33] * g1[3] * f8scale};
                *(u32x2*)((unsigned char*)WT + (size_t)(n0 + n) * K + k0 + 8 * c) = pack8_fp8(e); }
            else {
            u32x4 o; o.x = pk2(s[0 * 33] * g0[0], s[1 * 33] * g0[1]); o.y = pk2(s[2 * 33] * g0[2], s[3 * 33] * g0[3]); o.z = pk2(s[4 * 33] * g1[0], s[5 * 33] * g1[1]); o.w = pk2(s[6 * 33] * g1[2], s[7 * 33] * g1[3]);
            *(u32x4*)(WT + (size_t)(n0 + n) * K + k0 + 8 * c) = o; } }
        LDS_WAIT(); asm volatile("" ::: "memory");
    }
}

namespace att {
constexpr int SLOTB = 8192, L_K = 0, L_V = 2 * SLOTB, L_WS = 4 * SLOTB, L_CS = L_WS + 2048, L_LUT = L_CS + 512, L_OST = L_LUT + 512, L_END = L_OST + 8 * 4096;
typedef short s16x4 __attribute__((ext_vector_type(4)));
constexpr float SB_CUT = 256.f;
__device__ __forceinline__ int crow(int r, int hi) { return (r & 3) + 8 * (r >> 2) + 4 * hi; }
__device__ __forceinline__ void glds16(const void* gsrc, unsigned lds_dst) { unsigned keep;
    asm volatile("s_mov_b32 %0, m0\n\ts_mov_b32 m0, %2\n\ts_nop 0\n\tglobal_load_lds_dwordx4 %1, off\n\ts_mov_b32 m0, %0" : "=&s"(keep) : "v"(gsrc), "s"(lds_dst) : "memory"); }
__device__ __forceinline__ void glds4(const void* gsrc, unsigned lds_dst) { unsigned keep;
    asm volatile("s_mov_b32 %0, m0\n\ts_mov_b32 m0, %2\n\ts_nop 0\n\tglobal_load_lds_dword %1, off\n\ts_mov_b32 m0, %0" : "=&s"(keep) : "v"(gsrc), "s"(lds_dst) : "memory"); }
#define ATT_MFMA(a, b, c) __builtin_amdgcn_mfma_f32_32x32x16_bf16(a, b, c, 0, 0, 0)
__device__ __forceinline__ void qkt(f32x16& p0, f32x16& p1, const LAS unsigned char* Kslot, const bf16x8* qr, int r32, int hi) {
    const LAS unsigned char* kb = Kslot + hi * 1024 + r32 * 16;
#pragma unroll
    for (int r = 0; r < 16; ++r) { p0[r] = 0.f; p1[r] = 0.f; }
#pragma unroll
    for (int d0 = 0; d0 < 4; ++d0) { const bf16x8 b0 = *(const LAS bf16x8*)(kb + d0 * 2048), b1 = *(const LAS bf16x8*)(kb + d0 * 2048 + 512);
        p0 = ATT_MFMA(b0, qr[d0], p0); p1 = ATT_MFMA(b1, qr[d0], p1); }
}
__device__ __forceinline__ void pv(f32x16* o, int vb, bf16x8 pa0, bf16x8 pa1, bf16x8 pa2, bf16x8 pa3) {
#pragma unroll
    for (int d0 = 0; d0 < 2; ++d0) { s16x4 lo[4], hi[4];
#pragma unroll
        for (int ks = 0; ks < 4; ++ks) {
            asm volatile("ds_read_b64_tr_b16 %0,%1 offset:%c2" : "=&v"(lo[ks]) : "v"(vb), "i"(d0 * 4096 + ks * 1024) : "memory");
            asm volatile("ds_read_b64_tr_b16 %0,%1 offset:%c2" : "=&v"(hi[ks]) : "v"(vb), "i"(d0 * 4096 + ks * 1024 + 512) : "memory"); }
        asm volatile("s_waitcnt lgkmcnt(0)" ::: "memory"); __builtin_amdgcn_sched_barrier(0);
#define ATT_PK(k) (bf16x8){lo[k][0], lo[k][1], lo[k][2], lo[k][3], hi[k][0], hi[k][1], hi[k][2], hi[k][3]}
        o[d0] = ATT_MFMA(pa0, ATT_PK(0), o[d0]); o[d0] = ATT_MFMA(pa1, ATT_PK(1), o[d0]); o[d0] = ATT_MFMA(pa2, ATT_PK(2), o[d0]); o[d0] = ATT_MFMA(pa3, ATT_PK(3), o[d0]);
#undef ATT_PK
    }
}
__device__ __forceinline__ float hmax(float v) { const auto rr = __builtin_amdgcn_permlane32_swap(__float_as_uint(v), __float_as_uint(v), false, false); return fmaxf(__uint_as_float(rr[0]), __uint_as_float(rr[1])); }
__device__ __forceinline__ float hsum(float v) { const auto rr = __builtin_amdgcn_permlane32_swap(__float_as_uint(v), __float_as_uint(v), false, false); return __uint_as_float(rr[0]) + __uint_as_float(rr[1]); }

template <int VAR> __device__ __forceinline__ void attn_unit(LAS unsigned char* lds, int b, int h, int qb,
        const bf16_t* Q, const bf16_t* K, int pk, const bf16_t* V, int pv_, const float* c2f, const unsigned* mask, const float* relb, const bf16_t* ogate, bf16_t* O) {
    int tid = threadIdx.x; asm volatile("" : "+v"(tid));
    const int lane = tid & 63, r32 = lane & 31, hi = lane >> 5, wid = __builtin_amdgcn_readfirstlane(tid >> 6);
    const size_t rowbase = (size_t)b * SEQ; const int q0 = qb * 256, qrel = wid * 32 + r32, t = q0 + qrel;
    const unsigned lds0 = (unsigned)(uintptr_t)lds;
    LAS float* wsf = (LAS float*)(lds + L_WS) + wid * 64;
    const bf16_t* Kh = K + rowbase * pk + h * 64; const bf16_t* Vh = V + rowbase * pv_ + h * 64;
    const bf16_t* ksrc = Kh + (size_t)lane * pk + wid * 8;
    const bf16_t* vsrc = Vh + (size_t)(16 * (wid & 3) + (lane >> 2)) * pv_ + (wid >> 2) * 32 + (lane & 3) * 8;
    const unsigned kdst = lds0 + L_K + wid * 1024, vdst = lds0 + L_V + wid * 1024;
    const int vb0 = (int)(lds0 + L_V) + ((lane >> 4) & 1) * 32 + (lane & 3) * 8 + (4 * hi + ((lane & 15) >> 2)) * 64;
    const int NT = (q0 + 256) / 64;
    const float* c2h = c2f + ((size_t)b * NHEAD + h) * SEQ;
#define ATT_DMA(tile, slot) do { glds16(ksrc + (size_t)(tile) * 64 * pk, (unsigned)__builtin_amdgcn_readfirstlane(kdst + (slot) * SLOTB)); glds16(vsrc + (size_t)(tile) * 64 * pv_, (unsigned)__builtin_amdgcn_readfirstlane(vdst + (slot) * SLOTB)); \
        if (VAR == 0 && wid == 0) glds4(c2h + (tile) * 64 + lane, (unsigned)__builtin_amdgcn_readfirstlane(lds0 + L_CS + (slot) * 256)); } while (0)
    const int tile0 = (VAR == 1) ? NT - 1 : 0;
    ATT_DMA(tile0, 0);
    if (VAR == 2 && tid < 128) {
        int bk; if (tid < 16) bk = tid; else { bk = 16 + (int)(logf((float)tid / 16.0f) / 2.0794415416798357f * 16.0f); if (bk > 31) bk = 31; }
        ((LAS float*)(lds + L_LUT))[tid] = relb[bk * NHEAD + h] * LOG2E; }
    bf16x8 qr[4];
    { const bf16_t* Qw = Q + (rowbase + t) * 512 + h * 64;
#pragma unroll
      for (int d0 = 0; d0 < 4; ++d0) qr[d0] = *(const bf16x8*)(Qw + d0 * 16 + hi * 8); }
    float c2t = 0.f; if (VAR == 0) c2t = c2h[t];
    float mrun = -1.0e30f, lrun = 0.f, R = 0.f; bool wdone = false;
    LAS unsigned* votes = (LAS unsigned*)(lds + L_CS);
    f32x16 o[2];
#pragma unroll
    for (int r = 0; r < 16; ++r) { o[0][r] = 0.f; o[1][r] = 0.f; }
    u32x2 mwn = {0u, 0u}; if (VAR == 2) mwn = *(const u32x2*)(mask + (rowbase + t) * 64);
    asm volatile("s_waitcnt vmcnt(0) lgkmcnt(0)\n\ts_barrier" ::: "memory");
#pragma unroll 1
    for (int it = 0; it < NT; ++it) {
        const int tile = (VAR == 1) ? NT - 1 - it : it, slot = it & 1;
        if (it + 1 < NT) { const int ntile = (VAR == 1) ? NT - 2 - it : it + 1; ATT_DMA(ntile, slot ^ 1); }
        const u32x2 mw = mwn; if (VAR == 2 && it + 1 < NT) mwn = *(const u32x2*)(mask + (rowbase + t) * 64 + (it + 1) * 2);
        const bool active = (tile * 64 <= q0 + wid * 32 + 31) && !(VAR == 1 && wdone);
        if (active) {
        f32x16 p0, p1;
        qkt(p0, p1, lds + L_K + slot * SLOTB, qr, r32, hi);
        const int kv0 = tile * 64 + 4 * hi;
        const bool band = (tile * 64 + 63 > q0 + wid * 32);
        f32x16 pw0v, pw1v;
        if (VAR == 1) {
            f32x16 L0, L1;
#pragma unroll
            for (int r = 0; r < 16; ++r) { L0[r] = softplus2(p0[r]); L1[r] = softplus2(p1[r]); }
            if (band) {
#pragma unroll
                for (int r = 0; r < 16; ++r) { const int kv = kv0 + (r & 3) + 8 * (r >> 2); if (kv >= t) L0[r] = 0.f; if (kv + 32 >= t) L1[r] = 0.f; } }
            float G[8], T[8], S[8];
#pragma unroll
            for (int g = 0; g < 4; ++g) { G[g] = (L0[4 * g] + L0[4 * g + 1]) + (L0[4 * g + 2] + L0[4 * g + 3]); G[4 + g] = (L1[4 * g] + L1[4 * g + 1]) + (L1[4 * g + 2] + L1[4 * g + 3]); }
#pragma unroll
            for (int k = 0; k < 8; ++k) T[k] = hsum(G[k]);
            S[7] = 0.f;
#pragma unroll
            for (int k = 6; k >= 0; --k) S[k] = S[k + 1] + T[k + 1];
            const float tot = S[0] + T[0];
#pragma unroll
            for (int g = 0; g < 4; ++g) {
#pragma unroll
                for (int blk = 0; blk < 2; ++blk) { const int k = blk * 4 + g; const float off = R + S[k] + (hi == 0 ? T[k] - G[k] : 0.f);
                    f32x16& Lb = blk ? L1 : L0; f32x16& zb = blk ? p1 : p0; f32x16& ob = blk ? pw1v : pw0v;
                    const float e3 = Lb[4 * g + 3], e2 = e3 + Lb[4 * g + 2], e1 = e2 + Lb[4 * g + 1], e0 = e1 + Lb[4 * g];
                    ob[4 * g + 3] = __builtin_amdgcn_exp2f(zb[4 * g + 3] - (off + e3)); ob[4 * g + 2] = __builtin_amdgcn_exp2f(zb[4 * g + 2] - (off + e2));
                    ob[4 * g + 1] = __builtin_amdgcn_exp2f(zb[4 * g + 1] - (off + e1)); ob[4 * g] = __builtin_amdgcn_exp2f(zb[4 * g] - (off + e0)); } }
            if (band) {
#pragma unroll
                for (int r = 0; r < 16; ++r) { const int kv = kv0 + (r & 3) + 8 * (r >> 2); if (kv >= t) pw0v[r] = 0.f; if (kv + 32 >= t) pw1v[r] = 0.f; } }
            R += tot;
        } else {
            if (VAR == 0) {
                const LAS f32x4* cs = (const LAS f32x4*)(lds + L_CS + slot * 256 + 16 * hi);
#pragma unroll
                for (int g = 0; g < 4; ++g) { const f32x4 ca = cs[2 * g], cb = cs[8 + 2 * g];
#pragma unroll
                    for (int i = 0; i < 4; ++i) { p0[4 * g + i] += c2t - ca[i]; p1[4 * g + i] += c2t - cb[i]; } }
                if (band) {
#pragma unroll
                    for (int r = 0; r < 16; ++r) { const int kv = kv0 + (r & 3) + 8 * (r >> 2); if (kv > t) p0[r] = -INFINITY; if (kv + 32 > t) p1[r] = -INFINITY; } }
            } else {
                const LAS float* lut = (const LAS float*)(lds + L_LUT);
                if (tile * 64 + 63 + 113 <= q0 + wid * 32) {
                    const float bfar = lut[127];
#pragma unroll
                    for (int r = 0; r < 16; ++r) { p0[r] += bfar; p1[r] += bfar; }
                } else {
#pragma unroll
                    for (int r = 0; r < 16; ++r) { const int kv = kv0 + (r & 3) + 8 * (r >> 2); int d0 = t - kv, d1 = d0 - 32; d0 = d0 < 0 ? 0 : (d0 > 127 ? 127 : d0); d1 = d1 < 0 ? 0 : (d1 > 127 ? 127 : d1);
                        p0[r] += lut[d0]; p1[r] += lut[d1]; } }
#pragma unroll
                for (int r = 0; r < 16; ++r) { const int bit = (r & 3) + 8 * (r >> 2) + 4 * hi; if (!((mw.x >> bit) & 1u)) p0[r] = -INFINITY; if (!((mw.y >> bit) & 1u)) p1[r] = -INFINITY; }
            }
            float rm = fmaxf(p0[0], p1[0]);
#pragma unroll
            for (int r = 1; r < 16; ++r) rm = fmaxf(rm, fmaxf(p0[r], p1[r]));
            rm = hmax(rm);
            const float mnew = fmaxf(mrun, rm), f = __builtin_amdgcn_exp2f(mrun - mnew);
            if (__any(mnew > mrun)) {
                lrun *= f; if (hi == 0) wsf[r32] = f;
                asm volatile("s_waitcnt lgkmcnt(0)" ::: "memory");
#pragma unroll
                for (int r = 0; r < 16; ++r) { const float fr = wsf[crow(r, hi)]; o[0][r] *= fr; o[1][r] *= fr; }
            }
            mrun = mnew;
            float sacc = 0.f;
#pragma unroll
            for (int r = 0; r < 16; ++r) { pw0v[r] = __builtin_amdgcn_exp2f(p0[r] - mnew); pw1v[r] = __builtin_amdgcn_exp2f(p1[r] - mnew); sacc += pw0v[r] + pw1v[r]; }
            lrun += sacc;
        }
        u32x4 w0, w1, w2, w3;
        w0 = (u32x4){pk2(pw0v[0], pw0v[1]), pk2(pw0v[2], pw0v[3]), pk2(pw0v[4], pw0v[5]), pk2(pw0v[6], pw0v[7])}; w1 = (u32x4){pk2(pw0v[8], pw0v[9]), pk2(pw0v[10], pw0v[11]), pk2(pw0v[12], pw0v[13]), pk2(pw0v[14], pw0v[15])};
        w2 = (u32x4){pk2(pw1v[0], pw1v[1]), pk2(pw1v[2], pw1v[3]), pk2(pw1v[4], pw1v[5]), pk2(pw1v[6], pw1v[7])}; w3 = (u32x4){pk2(pw1v[8], pw1v[9]), pk2(pw1v[10], pw1v[11]), pk2(pw1v[12], pw1v[13]), pk2(pw1v[14], pw1v[15])};
        pv(o, vb0 + slot * SLOTB, __builtin_bit_cast(bf16x8, w0), __builtin_bit_cast(bf16x8, w1), __builtin_bit_cast(bf16x8, w2), __builtin_bit_cast(bf16x8, w3));
        if (VAR == 1) wdone = !__any(R <= SB_CUT);
        }
        if (VAR == 1 && lane == 0) votes[(it & 1) * 8 + wid] = wdone ? 1u : 0u;
        asm volatile("s_waitcnt vmcnt(0) lgkmcnt(0)\n\ts_barrier" ::: "memory");
        if (VAR == 1) { const LAS u32x4* vp = (const LAS u32x4*)(votes + (it & 1) * 8); const u32x4 va = vp[0], vb = vp[1]; if ((va.x & va.y & va.z & va.w & vb.x & vb.y & vb.z & vb.w) != 0u) break; }
    }
    float linv = 1.f;
    if (VAR != 1) { const float lt = hsum(lrun); linv = 1.0f / lt; }
    if (hi == 0) wsf[32 + r32] = linv; asm volatile("s_waitcnt lgkmcnt(0)" ::: "memory");
    { LAS bf16_t* stg = (LAS bf16_t*)(lds + L_OST) + wid * 2048;
#pragma unroll
      for (int r = 0; r < 16; ++r) { const int orow = crow(r, hi); const float li = wsf[32 + orow];
#pragma unroll
          for (int d0 = 0; d0 < 2; ++d0) stg[orow * 64 + d0 * 32 + r32] = (bf16_t)(pk2(o[d0][r] * li, 0.f) & 0xffffu); }
      asm volatile("s_waitcnt lgkmcnt(0)" ::: "memory");
      bf16_t* Ow = O + (rowbase + q0 + wid * 32) * 512 + h * 64;
#pragma unroll
      for (int i = 0; i < 4; ++i) { const int row = i * 8 + (lane >> 3), ch = lane & 7; u32x4 v = *(const LAS u32x4*)(stg + row * 64 + ch * 8);
          if (VAR == 0) { const u32x4 g = *(const u32x4*)(ogate + (rowbase + q0 + wid * 32 + row) * 512 + h * 64 + ch * 8);
              v.x = pk2(bflo(v.x) * bflo(g.x), bfhi(v.x) * bfhi(g.x)); v.y = pk2(bflo(v.y) * bflo(g.y), bfhi(v.y) * bfhi(g.y)); v.z = pk2(bflo(v.z) * bflo(g.z), bfhi(v.z) * bfhi(g.z)); v.w = pk2(bflo(v.w) * bflo(g.w), bfhi(v.w) * bfhi(g.w)); }
          *(u32x4*)(Ow + (size_t)row * 512 + ch * 8) = v; } }
    asm volatile("s_waitcnt vmcnt(0) lgkmcnt(0)\n\ts_barrier" ::: "memory");
#undef ATT_DMA
}
}

__device__ __forceinline__ void select_row(const float* sc_row, unsigned* mask_row, int t, int lane) {
    asm volatile("" : "+v"(lane));
    if (t < 256) { const int lo = 32 * lane; mask_row[lane] = (t >= lo + 31) ? 0xffffffffu : (t < lo ? 0u : ((2u << (t - lo)) - 1u)); return; }
    unsigned key[32];
#pragma unroll
    for (int j = 0; j < 32; ++j) { const int s = 64 * j + lane; const unsigned u = __float_as_uint(sc_row[s <= t ? s : t]); const unsigned k = (u & 0x80000000u) ? ~u : (u | 0x80000000u); key[j] = (s <= t) ? k : 0u; }
    unsigned T = 0u;
    for (int bit = 31; bit >= 0; --bit) { const unsigned cand = T | (1u << bit); int c = 0;
#pragma unroll
        for (int j = 0; j < 32; ++j) c += (key[j] >= cand) ? 1 : 0;
#pragma unroll
        for (int o = 1; o < 64; o <<= 1) c += __shfl_xor(c, o);
        if (c >= 256) T = cand; }
    int gt = 0;
#pragma unroll
    for (int j = 0; j < 32; ++j) gt += (key[j] > T) ? 1 : 0;
#pragma unroll
    for (int o = 1; o < 64; o <<= 1) gt += __shfl_xor(gt, o);
    const int need = 256 - gt; int run = 0; unsigned myw = 0u;
#pragma unroll
    for (int j = 0; j < 32; ++j) { const bool eq = key[j] == T; const unsigned long long beq = __ballot(eq);
        const int pre = run + (int)__builtin_amdgcn_mbcnt_hi((unsigned)(beq >> 32), __builtin_amdgcn_mbcnt_lo((unsigned)beq, 0u));
        const bool sel = (key[j] > T) || (eq && pre < need); run += __popcll(beq);
        const unsigned long long bs = __ballot(sel); myw = (lane == 2 * j) ? (unsigned)bs : myw; myw = (lane == 2 * j + 1) ? (unsigned)(bs >> 32) : myw; }
    mask_row[lane] = myw;
}

typedef __attribute__((address_space(4))) const char* kptr_t; typedef const float* cfp_t; typedef const __attribute__((address_space(4))) cfp_t* kslot_t;
__device__ __forceinline__ const float* arg_ptr(int i) { kptr_t ka = (kptr_t)__builtin_amdgcn_kernarg_segment_ptr(); asm volatile("" : "+s"(ka)); return *(kslot_t)(ka + 8 * i); }
__global__ void __launch_bounds__(512, 2) mk_fwd(Args args) {
    extern __shared__ __attribute__((aligned(16))) unsigned char lds_raw[];
    LAS unsigned char* lds = (LAS unsigned char*)lds_raw;
    volatile LAS unsigned* MISC = (volatile LAS unsigned*)(lds + MISC_OFF);
    const int G = gridDim.x, bid = blockIdx.x, NGW = G * 8;
    unsigned* ctl = (unsigned*)((unsigned char*)arg_ptr(23) + WS_CTL);
    for (int u = threadIdx.x; u < (LDS_BYTES - LDSCTL_OFF) / 4; u += 512) ((LAS unsigned*)(lds + LDSCTL_OFF))[u] = 0u;
#define SITE_PROLOG unsigned char* ws = (unsigned char*)arg_ptr(23); int tid = threadIdx.x; asm volatile("" : "+v"(tid)); \
    const int lane = tid & 63, wave = __builtin_amdgcn_readfirstlane(tid >> 6), gw = bid * 8 + wave; (void)ws; (void)lane; (void)gw;
    __syncthreads();
    const int lo = args.ph_lo & 0xff, hi = args.ph_hi, dry = args.ph_lo >> 8;
    XcdBarrier bar; bar.bar = ctl + CW_BAR; bar.x = 0; bar.st = nullptr;
    if (hi - lo > 1) bar = xcd_barrier_post(ctl + CW_BAR, MISC + 8);
#define x_in arg_ptr(0)
#define w_in arg_ptr(1)
#define b_forget arg_ptr(2)
#define q_norm arg_ptr(3)
#define k_norm arg_ptr(4)
#define kv_norm arg_ptr(5)
#define w_ukv arg_ptr(6)
#define w_br0 arg_ptr(7)
#define w_br1 arg_ptr(8)
#define w_br2 arg_ptr(9)
#define w_out arg_ptr(10)
#define rel_bias arg_ptr(11)
#define norm_mix arg_ptr(12)
#define norm_ffn arg_ptr(13)
#define w_fg arg_ptr(14)
#define w_fu arg_ptr(15)
#define w_fd arg_ptr(16)
#define w_router arg_ptr(17)
#define w_mg arg_ptr(18)
#define w_mu arg_ptr(19)
#define w_md arg_ptr(20)
#define norm_final arg_ptr(21)
#define X ((float*)arg_ptr(22))
#define WIN ((bf16_t*)(ws + WS_WIN))
#define WUKV ((bf16_t*)(ws + WS_WUKV))
#define WBR ((bf16_t*)(ws + WS_WBR))
#define WOUT ((bf16_t*)(ws + WS_WOUT))
#define WGU0 ((bf16_t*)(ws + WS_WGU0))
#define WD0 ((bf16_t*)(ws + WS_WD0))
#define WGUM ((bf16_t*)(ws + WS_WGUM))
#define WDM ((bf16_t*)(ws + WS_WDM))
#define RSTD ((float*)(ws + WS_RSTD))
#define SSP ((float*)(ws + WS_SSP))
#define XB ((bf16_t*)(ws + WS_XB))
#define Z8 ((bf16_t*)(ws + WS_Z8))
#define DLAT ((bf16_t*)(ws + WS_DLAT))
#define DIQ ((bf16_t*)(ws + WS_DIQ))
#define DIK ((bf16_t*)(ws + WS_DIK))
#define FFW ((float*)(ws + WS_FFW))
#define GATES ((bf16_t*)(ws + WS_GATES))
#define C2F ((float*)(ws + WS_C2F))
#define DKV ((bf16_t*)(ws + WS_DKV))
#define SC ((float*)(ws + WS_SC))
#define MASK ((unsigned*)(ws + WS_MASK))
#define YATT ((bf16_t*)(ws + WS_YATT))
#define MB ((bf16_t*)(ws + WS_M))
#define HID ((bf16_t*)(ws + WS_HID))
#define XG ((bf16_t*)(ws + WS_XG))
#define XB8 ((unsigned char*)(ws + WS_XB8))
#define HIDM ((bf16_t*)(ws + WS_HIDM))
#define Y ((float*)(ws + WS_Y))
#define ROWTOK ((int*)(ws + WS_ROWTOK))
#define ROWW ((float*)(ws + WS_ROWW))
#define RSTDG ((float*)(ws + WS_RSTDG))
#define TOKINFO ((int*)(ws + WS_TOKINFO))
#define TOKW ((float*)(ws + WS_TOKW))
#define WGCNT ((int*)(ws + WS_WGCNT))
#define META ((int*)(ws + WS_META))

    int step = 0;
#define STEP_IF if (step >= lo && step < hi)
#define STEP_END do { if (step >= lo && step + 1 < hi) xcd_barrier(bar); ++step; } while (0)

    if (SITE_ON(0)) STEP_IF { SITE_PROLOG
        LAS float* scr = (LAS float*)(lds + wave * 16384);
        for (int l = 0; l < 2; ++l) {
            conv_matrix(1, w_in + (size_t)l * DM * NIN, nullptr, DM, NIN, NINP, WIN + (size_t)l * NINP * DM, norm_mix + l * DM, scr, gw, NGW, lane);
            conv_matrix(0, w_ukv + (size_t)l * KVR * 1024, nullptr, KVR, 1024, 1024, WUKV + (size_t)l * 1024 * KVR, kv_norm + l * KVR, scr, gw, NGW, lane);
            conv_matrix(0, w_br0 + (size_t)l * WBR_W * DM, nullptr, WBR_W, DM, DM, WBR + (size_t)(l * 3 + 0) * DM * WBR_W, nullptr, scr, gw, NGW, lane);
            conv_matrix(0, w_br1 + (size_t)l * WBR_W * DM, nullptr, WBR_W, DM, DM, WBR + (size_t)(l * 3 + 1) * DM * WBR_W, nullptr, scr, gw, NGW, lane);
            conv_matrix(0, w_br2 + (size_t)l * WBR_W * DM, nullptr, WBR_W, DM, DM, WBR + (size_t)(l * 3 + 2) * DM * WBR_W, nullptr, scr, gw, NGW, lane);
            conv_matrix(0, w_out + (size_t)l * DM * DM, nullptr, DM, DM, DM, WOUT + (size_t)l * DM * DM, nullptr, scr, gw, NGW, lane);
        }
        conv_matrix(2, w_fg, w_fu, DM, DFF, 2 * DFF, WGU0, norm_ffn, scr, gw, NGW, lane);
        conv_matrix(0, w_fd, nullptr, DFF, DM, DM, WD0, nullptr, scr, gw, NGW, lane, WD8SCALE);
        for (int e = 0; e < NEXP; ++e) {
            conv_matrix(2, w_mg + (size_t)e * DM * DFF, w_mu + (size_t)e * DM * DFF, DM, DFF, 2 * DFF, (bf16_t*)((unsigned char*)WGUM + (size_t)e * 2 * DFF * DM), norm_ffn + DM, scr, gw, NGW, lane, W8SCALE);
            conv_matrix(0, w_md + (size_t)e * DFF * DM, nullptr, DFF, DM, DM, (bf16_t*)((unsigned char*)WDM + (size_t)e * DM * DFF), nullptr, scr, gw, NGW, lane, WD8SCALE);
        }
        for (int m = gw; m < NTOK; m += NGW) {
            const f32x4* xr = (const f32x4*)(x_in + (size_t)m * DM) + lane; f32x4 v[8]; float s = 0.f;
#pragma unroll
            for (int j = 0; j < 8; ++j) { v[j] = xr[64 * j]; s += (v[j][0] * v[j][0] + v[j][1] * v[j][1]) + (v[j][2] * v[j][2] + v[j][3] * v[j][3]); }
            s = wave_sum(s);
            u32x2* o = (u32x2*)(XB + (size_t)m * DM) + lane;
#pragma unroll
            for (int j = 0; j < 8; ++j) { u32x2 w; w.x = pk2(v[j][0], v[j][1]); w.y = pk2(v[j][2], v[j][3]); o[64 * j] = w; }
            if (lane == 0) RSTD[m] = 1.0f / sqrtf(s * (1.0f / DM) + EPS);
        }
    }
    STEP_END;

    for (int l = 0; l < 2; ++l) {
        if (SITE_ON(1)) STEP_IF { SITE_PROLOG
            pg8::PlainOrder S; S.init(NTOK / 256, NINP / 256, G, bid); S.A = (const char*)XB; S.ta = (size_t)256 * DM * 2; S.B = (const char*)(WIN + (size_t)l * NINP * DM); S.tb = (size_t)256 * DM * 2;
            EpiWin E{RSTD, Z8, DLAT, DIQ, DIK, FFW, GATES};
            pg8::gemm_phase<EpiWin, pg8::PlainOrder, true, true>(lds, pg8::Gemm{opq(DM)}, S, E);
        }
        STEP_END;
        if (SITE_ON(2)) STEP_IF { SITE_PROLOG
            for (int m = gw; m < NTOK; m += NGW) {
#pragma unroll
                for (int which = 0; which < 2; ++which) {
                    bf16_t* p = Z8 + (size_t)which * NTOK * 512 + (size_t)m * 512 + 8 * lane; const u32x4 w = *(const u32x4*)p;
                    float v[8] = {bflo(w.x), bfhi(w.x), bflo(w.y), bfhi(w.y), bflo(w.z), bfhi(w.z), bflo(w.w), bfhi(w.w)}; float ss = 0.f;
#pragma unroll
                    for (int i = 0; i < 8; ++i) ss += v[i] * v[i];
                    ss += __shfl_xor(ss, 1); ss += __shfl_xor(ss, 2); ss += __shfl_xor(ss, 4);
                    const float rs = (1.0f / sqrtf(ss * (1.0f / 64.0f) + EPS)) * (which == 0 ? C2 : 1.0f);
                    const float* gp = (which == 0 ? q_norm : k_norm) + l * HD + 8 * (lane & 7); const f32x4 g0 = *(const f32x4*)gp, g1 = *(const f32x4*)(gp + 4);
                    u32x4 o; o.x = pk2(v[0] * rs * g0[0], v[1] * rs * g0[1]); o.y = pk2(v[2] * rs * g0[2], v[3] * rs * g0[3]); o.z = pk2(v[4] * rs * g1[0], v[5] * rs * g1[1]); o.w = pk2(v[6] * rs * g1[2], v[7] * rs * g1[3]);
                    *(u32x4*)p = o;
                }
                { bf16_t* p = DLAT + (size_t)m * 256 + 4 * lane; const u32x2 w = *(const u32x2*)p; const float a0 = bflo(w.x), a1 = bfhi(w.x), a2 = bflo(w.y), a3 = bfhi(w.y);
                  const float ss = wave_sum((a0 * a0 + a1 * a1) + (a2 * a2 + a3 * a3)); const float rs = 1.0f / sqrtf(ss * (1.0f / 256.0f) + EPS);
                  u32x2 o; o.x = pk2(a0 * rs, a1 * rs); o.y = pk2(a2 * rs, a3 * rs); *(u32x2*)p = o; }
            }
            if (gw < NBATCH * NHEAD) {
                const int b = gw >> 3, h = gw & 7; const float bias = b_forget[l * NHEAD + h];
                const float* fp = FFW + ((size_t)b * SEQ + 32 * lane) * 16 + h; float tot = 0.f;
                for (int i = 0; i < 32; ++i) tot += -softplus2(-(fp[i * 16] + bias) * LOG2E);
                float inc = tot;
#pragma unroll
                for (int o = 1; o < 64; o <<= 1) { const float tv = __shfl_up(inc, o); if (lane >= o) inc += tv; }
                float run = inc - tot; float* cp = C2F + ((size_t)b * NHEAD + h) * SEQ + 32 * lane;
                for (int i = 0; i < 32; ++i) { run += -softplus2(-(fp[i * 16] + bias) * LOG2E); cp[i] = run; }
            }
        }
        STEP_END;
        if (SITE_ON(3)) STEP_IF { SITE_PROLOG
            { pg8::PlainOrder S; S.init(NTOK / 256, 4, G, bid); S.A = (const char*)DLAT; S.ta = (size_t)256 * KVR * 2; S.B = (const char*)(WUKV + (size_t)l * 1024 * KVR); S.tb = (size_t)256 * KVR * 2;
              EpiPlain E{DKV, 1024};
              pg8::gemm_phase<EpiPlain, pg8::PlainOrder, true, true>(lds, pg8::Gemm{opq(KVR)}, S, E); }
            if (wave < 5) {
                const int id = bid * 5 + wave, b = id / 160, rr = id - b * 160;
                int cch, tt; if (rr < 64) { cch = 0; tt = rr; } else if (rr < 112) { cch = 1; tt = 16 + (rr - 64); } else if (rr < 144) { cch = 2; tt = 32 + (rr - 112); } else { cch = 3; tt = 48 + (rr - 144); }
                if (b < NBATCH) {
                int ln = lane; asm volatile("" : "+v"(ln)); const int r32 = ln & 31, hh = ln >> 5; const size_t trow = (size_t)b * SEQ + tt * 32 + r32;
                bf16x8 bq[4][4];
#pragma unroll
                for (int h = 0; h < 4; ++h)
#pragma unroll
                    for (int d0 = 0; d0 < 4; ++d0) bq[h][d0] = *(const bf16x8*)(DIQ + trow * 256 + h * 64 + d0 * 16 + 8 * hh);
                const f32x4 wv = *(const f32x4*)(FFW + trow * 16 + 8) * 0.0625f;
                const int st0 = cch * 16, st1 = (st0 + 15 < tt) ? st0 + 15 : tt;
                bf16x8 ak[4], an[4];
                { const size_t srow = (size_t)b * SEQ + st0 * 32 + r32;
#pragma unroll
                  for (int d0 = 0; d0 < 4; ++d0) an[d0] = *(const bf16x8*)(DIK + srow * 64 + d0 * 16 + 8 * hh); }
                for (int st = st0; st <= st1; ++st) {
#pragma unroll
                    for (int d0 = 0; d0 < 4; ++d0) ak[d0] = an[d0];
                    { const int sn = (st < st1) ? st + 1 : st; const size_t srow = (size_t)b * SEQ + sn * 32 + r32;
#pragma unroll
                      for (int d0 = 0; d0 < 4; ++d0) an[d0] = *(const bf16x8*)(DIK + srow * 64 + d0 * 16 + 8 * hh); }
                    f32x16 sc;
#pragma unroll
                    for (int r = 0; r < 16; ++r) sc[r] = 0.f;
#pragma unroll
                    for (int h = 0; h < 4; ++h) { f32x16 a;
#pragma unroll
                        for (int r = 0; r < 16; ++r) a[r] = 0.f;
#pragma unroll
                        for (int d0 = 0; d0 < 4; ++d0) a = __builtin_amdgcn_mfma_f32_32x32x16_bf16(ak[d0], bq[h][d0], a, 0, 0, 0);
#pragma unroll
                        for (int r = 0; r < 16; ++r) sc[r] += fmaxf(a[r], 0.f) * wv[h]; }
                    float* sp = SC + trow * SEQ + st * 32 + 4 * hh;
#pragma unroll
                    for (int g = 0; g < 4; ++g) *(f32x4*)(sp + 8 * g) = (f32x4){sc[4 * g], sc[4 * g + 1], sc[4 * g + 2], sc[4 * g + 3]};
                }
                }
            }
        }
        STEP_END;
        if (SITE_ON(4)) STEP_IF { SITE_PROLOG
            for (int idx = gw; idx < NTOK; idx += NGW) { const int b = idx / SEQ, t0 = idx - b * SEQ, t = (b & 1) ? SEQ - 1 - t0 : t0; const size_t row = (size_t)b * SEQ + t;
                select_row(SC + row * SEQ, MASK + row * 64, t, lane); }
        }
        STEP_END;
        if (SITE_ON(5)) STEP_IF { SITE_PROLOG
            const int vcu = (bid & 7) * (G >> 3) + (bid >> 3);
            for (int i = 0; i < 6; ++i) { const int var = i >> 1, p = vcu & 255, bh = p >> 2, qb = (i & 1) ? 7 - (p & 3) : (p & 3), b = bh >> 3, h = bh & 7;
                if (var == 0) att::attn_unit<0>(lds, b, h, qb, Z8, Z8 + (size_t)1 * NTOK * 512, 512, Z8 + (size_t)2 * NTOK * 512, 512, C2F, nullptr, nullptr, Z8 + (size_t)3 * NTOK * 512, YATT);
                else if (var == 1) att::attn_unit<1>(lds, b, h, qb, Z8 + (size_t)4 * NTOK * 512, Z8 + (size_t)5 * NTOK * 512, 512, Z8 + (size_t)6 * NTOK * 512, 512, nullptr, nullptr, nullptr, nullptr, YATT + (size_t)NTOK * 512);
                else att::attn_unit<2>(lds, b, h, qb, Z8 + (size_t)7 * NTOK * 512, DKV, 1024, DKV + 512, 1024, nullptr, MASK, rel_bias, nullptr, YATT + (size_t)2 * NTOK * 512);
            }
        }
        STEP_END;
        if (SITE_ON(6)) STEP_IF { SITE_PROLOG
            pg8::BranchOrder S; S.init(NTOK / 256, DM / 256, G, bid); S.A = (const char*)YATT; S.ta = (size_t)256 * WBR_W * 2; S.za = (size_t)NTOK * WBR_W * 2;
            S.B = (const char*)(WBR + (size_t)l * 3 * DM * WBR_W); S.tb = (size_t)256 * WBR_W * 2; S.zb = (size_t)DM * WBR_W * 2;
            EpiBranch E{GATES, MB};
            pg8::gemm_phase<EpiBranch, pg8::BranchOrder, true, true>(lds, pg8::Gemm{opq(WBR_W)}, S, E);
        }
        STEP_END;
        if (SITE_ON(7)) STEP_IF { SITE_PROLOG
            pg8::PlainOrder S; S.init(NTOK / 256, DM / 256, G, bid); S.A = (const char*)MB; S.ta = (size_t)256 * DM * 2; S.B = (const char*)(WOUT + (size_t)l * DM * DM); S.tb = (size_t)256 * DM * 2;
            EpiResid E{l == 0 ? x_in : (const float*)X, X, XB, SSP, XB8, 1.0f};
            pg8::gemm_phase<EpiResid, pg8::PlainOrder, true, true>(lds, pg8::Gemm{opq(DM)}, S, E);
        }
        STEP_END;
        if (l == 0) {
            if (SITE_ON(8)) STEP_IF { SITE_PROLOG for (int r = bid * 512 + tid; r < NTOK; r += G * 512) { const f32x4* p = (const f32x4*)(SSP + (size_t)r * 32); float s = 0.f;
#pragma unroll
                    for (int j = 0; j < 8; ++j) { const f32x4 v = p[j]; s += (v[0] + v[1]) + (v[2] + v[3]); }
                    RSTD[r] = 1.0f / sqrtf(s * (1.0f / DM) + EPS); } }
            STEP_END;
            if (SITE_ON(9)) STEP_IF { SITE_PROLOG
                pg8::PlainOrder S; S.init(NTOK / 256, DFF / 128, G, bid); S.A = (const char*)XB; S.ta = (size_t)256 * DM * 2; S.B = (const char*)WGU0; S.tb = (size_t)256 * DM * 2;
                EpiSwiglu E{RSTD, HID, dry, 1.0f, 1};
                pg8::gemm_phase<EpiSwiglu, pg8::PlainOrder, true, true>(lds, pg8::Gemm{opq(DM)}, S, E);
            }
            STEP_END;
            if (SITE_ON(10)) STEP_IF { SITE_PROLOG
                pg8::PlainOrder S; S.init(NTOK / 256, DM / 256, G, bid); S.A = (const char*)HID; S.ta = (size_t)256 * DFF; S.B = (const char*)WD0; S.tb = (size_t)256 * DFF;
                EpiResid E{X, X, XB, SSP, nullptr, 1.0f / (WD8SCALE * H8SCALE)};
                pg8::gemm_phase8<EpiResid, pg8::PlainOrder, true, true>(lds, pg8::Gemm{opq(DFF / 2)}, S, E);
            }
            STEP_END;
            if (SITE_ON(11)) STEP_IF { SITE_PROLOG for (int r = bid * 512 + tid; r < NTOK; r += G * 512) { const f32x4* p = (const f32x4*)(SSP + (size_t)r * 32); float s = 0.f;
#pragma unroll
                    for (int j = 0; j < 8; ++j) { const f32x4 v = p[j]; s += (v[0] + v[1]) + (v[2] + v[3]); }
                    RSTD[r] = 1.0f / sqrtf(s * (1.0f / DM) + EPS); } }
            STEP_END;
        } else {
            if (SITE_ON(12)) STEP_IF { SITE_PROLOG
                LAS int* le = (LAS int*)lds;
                for (int wgi = bid; wgi < NTOK / 64; wgi += G) {
                    __syncthreads();
                    for (int i = 0; i < 8; ++i) { const int tl = wave * 8 + i, tok = wgi * 64 + tl;
                        const f32x4* xr = (const f32x4*)(X + (size_t)tok * DM) + lane; f32x4 v[8]; float s = 0.f;
#pragma unroll
                        for (int j = 0; j < 8; ++j) { v[j] = xr[64 * j]; s += (v[j][0] * v[j][0] + v[j][1] * v[j][1]) + (v[j][2] * v[j][2] + v[j][3] * v[j][3]); }
                        s = wave_sum(s); const float rs = 1.0f / sqrtf(s * (1.0f / DM) + EPS);
                        float lg[8];
#pragma unroll
                        for (int e = 0; e < 8; ++e) lg[e] = 0.f;
#pragma unroll
                        for (int j = 0; j < 8; ++j) { const int k0 = 256 * j + 4 * lane; const f32x4 gn = *(const f32x4*)(norm_ffn + DM + k0);
#pragma unroll
                            for (int c = 0; c < 4; ++c) { const float xg = v[j][c] * gn[c]; const f32x4 w0 = *(const f32x4*)(w_router + (size_t)(k0 + c) * 8), w1 = *(const f32x4*)(w_router + (size_t)(k0 + c) * 8 + 4);
                                lg[0] += xg * w0[0]; lg[1] += xg * w0[1]; lg[2] += xg * w0[2]; lg[3] += xg * w0[3]; lg[4] += xg * w1[0]; lg[5] += xg * w1[1]; lg[6] += xg * w1[2]; lg[7] += xg * w1[3]; } }
#pragma unroll
                        for (int e = 0; e < 8; ++e) lg[e] = wave_sum(lg[e]) * rs;
                        float v0 = lg[0]; int i0 = 0;
#pragma unroll
                        for (int e = 1; e < 8; ++e) if (lg[e] > v0) { v0 = lg[e]; i0 = e; }
                        float v1 = -INFINITY; int i1 = 0;
#pragma unroll
                        for (int e = 0; e < 8; ++e) if (e != i0 && lg[e] > v1) { v1 = lg[e]; i1 = e; }
                        const float ex = __expf(v1 - v0), w0 = 1.0f / (1.0f + ex), w1 = ex / (1.0f + ex);
                        if (lane == 0) { le[tl * 2] = i0; le[tl * 2 + 1] = i1; TOKW[(size_t)tok * 2] = w0; TOKW[(size_t)tok * 2 + 1] = w1; RSTD[tok] = rs; }
                    }
                    __syncthreads();
                    if (tid < 128) { const int e = le[tid]; int rk = 0; for (int j = 0; j < tid; ++j) rk += (le[j] == e); const int tok = wgi * 64 + (tid >> 1);
                        TOKINFO[((size_t)tok * 2 + (tid & 1)) * 2] = e; TOKINFO[((size_t)tok * 2 + (tid & 1)) * 2 + 1] = rk; }
                    if (tid >= 128 && tid < 136) { const int e = tid - 128; int c = 0; for (int j = 0; j < 128; ++j) c += (le[j] == e); WGCNT[wgi * 8 + e] = c; }
                }
            }
            STEP_END;
            if (SITE_ON(13)) STEP_IF { SITE_PROLOG
                LAS int* lc = (LAS int*)lds;
                for (int wgi = bid; wgi < NTOK / 64; wgi += G) {
                    __syncthreads();
                    { const int e = wave; int all = 0, before = 0;
#pragma unroll
                      for (int c = 0; c < 4; ++c) { const int w = 4 * lane + c; const int v = WGCNT[w * 8 + e]; all += v; before += (w < wgi) ? v : 0; }
#pragma unroll
                      for (int o = 1; o < 64; o <<= 1) { all += __shfl_xor(all, o); before += __shfl_xor(before, o); }
                      if (lane == 0) { lc[e] = all; lc[8 + e] = before; } }
                    __syncthreads();
                    if (tid == 0) { int tb = 0; for (int e = 0; e < 8; ++e) { lc[16 + e] = tb * 256; tb += (lc[e] + 255) >> 8; if (wgi == 0) META[e] = lc[16 + e] >> 8; } if (wgi == 0) META[8] = tb; }
                    __syncthreads();
                    for (int i = 0; i < 16; ++i) { const int p = wave * 16 + i, tok = wgi * 64 + (p >> 1), slot = p & 1;
                        const int e = TOKINFO[((size_t)tok * 2 + slot) * 2], rk = TOKINFO[((size_t)tok * 2 + slot) * 2 + 1]; const int r = lc[16 + e] + lc[8 + e] + rk;
                        const u32x4* sp = (const u32x4*)(XB8 + (size_t)tok * DM) + lane; u32x4* dp = (u32x4*)((unsigned char*)XG + (size_t)r * DM) + lane;
#pragma unroll
                        for (int c = 0; c < 2; ++c) dp[64 * c] = sp[64 * c];
                        if (lane == 0) { ROWTOK[r] = tok * 2 + slot; ROWW[r] = TOKW[(size_t)tok * 2 + slot]; RSTDG[r] = RSTD[tok]; } }
                    if (wgi < 8) { const int e = wgi, r0 = lc[16 + e] + lc[e], r1 = lc[16 + e] + (((lc[e] + 255) >> 8) << 8);
                        for (int r = r0 + wave; r < r1; r += 8) { u32x4* dp = (u32x4*)((unsigned char*)XG + (size_t)r * DM) + lane;
#pragma unroll
                            for (int c = 0; c < 2; ++c) dp[64 * c] = (u32x4){0u, 0u, 0u, 0u};
                            if (lane == 0) { ROWTOK[r] = -1; ROWW[r] = 0.f; RSTDG[r] = 0.f; } } }
                }
            }
            STEP_END;
            if (SITE_ON(14)) STEP_IF { SITE_PROLOG
                pg8::MoeOrder S; S.t1 = META[1]; S.t2 = META[2]; S.t3 = META[3]; S.t4 = META[4]; S.t5 = META[5]; S.t6 = META[6]; S.t7 = META[7];
                S.init(META[8], DFF / 128, G, bid); S.A = (const char*)XG; S.ta = (size_t)256 * DM; S.B = (const char*)WGUM; S.tb = (size_t)256 * DM; S.zb = SZ_WGU / 2;
                EpiSwiglu E{RSTDG, HIDM, dry, 1.0f / W8SCALE, 1};
                pg8::gemm_phase8<EpiSwiglu, pg8::MoeOrder, true, true>(lds, pg8::Gemm{opq(DM / 2)}, S, E);
            }
            STEP_END;
            if (SITE_ON(15)) STEP_IF { SITE_PROLOG
                pg8::MoeOrder S; S.t1 = META[1]; S.t2 = META[2]; S.t3 = META[3]; S.t4 = META[4]; S.t5 = META[5]; S.t6 = META[6]; S.t7 = META[7];
                S.init(META[8], DM / 256, G, bid); S.A = (const char*)HIDM; S.ta = (size_t)256 * DFF; S.B = (const char*)WDM; S.tb = (size_t)256 * DFF; S.zb = SZ_WD / 2;
                EpiMoeDown E{ROWTOK, ROWW, Y, 1.0f / (WD8SCALE * H8SCALE)};
                pg8::gemm_phase8<EpiMoeDown, pg8::MoeOrder, true, true>(lds, pg8::Gemm{opq(DFF / 2)}, S, E);
            }
            STEP_END;
            if (SITE_ON(16)) STEP_IF { SITE_PROLOG
                for (int m = gw; m < NTOK; m += NGW) {
                    f32x4* xr = (f32x4*)(X + (size_t)m * DM) + lane; const f32x4* y0 = (const f32x4*)(Y + (size_t)m * DM) + lane; const f32x4* y1 = (const f32x4*)(Y + (size_t)NTOK * DM + (size_t)m * DM) + lane;
                    f32x4 v[8]; float s = 0.f;
#pragma unroll
                    for (int j = 0; j < 8; ++j) { v[j] = xr[64 * j] + y0[64 * j] + y1[64 * j]; s += (v[j][0] * v[j][0] + v[j][1] * v[j][1]) + (v[j][2] * v[j][2] + v[j][3] * v[j][3]); }
                    s = wave_sum(s); const float rs = 1.0f / sqrtf(s * (1.0f / DM) + EPS);
#pragma unroll
                    for (int j = 0; j < 8; ++j) { const f32x4 g = *((const f32x4*)norm_final + lane + 64 * j); xr[64 * j] = v[j] * rs * g; }
                }
            }
            STEP_END;
        }
    }
#undef STEP_IF
#undef STEP_END
}


#ifndef DBG_STOP
#define DBG_STOP -1
#endif
#ifndef DBG_LO
#define DBG_LO WS_WIN
#endif
#if DBG_STOP >= 0
__global__ void dbg_dump(const unsigned short* ws16, size_t n16, const unsigned* xin, float* out, int with_x) {
    for (size_t i = (size_t)blockIdx.x * blockDim.x + threadIdx.x; i < (size_t)NTOK * DM; i += (size_t)gridDim.x * blockDim.x) {
        unsigned acc = 0; for (size_t off = i; off < n16; off += (size_t)NTOK * DM) acc += ws16[off];
        if (with_x) { const unsigned u = xin[i]; acc += (u & 0xffffu) + (u >> 16); }
        out[i] = (float)(acc & 0xfffffu);
    }
}
#endif

#if DBG_STOP == 100
__global__ void dbg_cmp3(const unsigned short* a0, const unsigned short* b0, const unsigned short* a1, const unsigned short* b1, const unsigned short* a2, const unsigned short* b2, unsigned* cnt) {
    unsigned c0 = 0, c1 = 0, c2 = 0;
    for (size_t i = (size_t)blockIdx.x * blockDim.x + threadIdx.x; i < (size_t)NTOK * DM; i += (size_t)gridDim.x * blockDim.x) { c0 += a0[i] != b0[i]; c1 += a1[i] != b1[i]; c2 += a2[i] != b2[i]; }
    if (c0) atomicAdd(cnt, c0); if (c1) atomicAdd(cnt + 1, c1); if (c2) atomicAdd(cnt + 2, c2);
}
__global__ void dbg_fill(float* out, const unsigned* cnt) {
    const float E = (cnt[0] ? 3.f : 0.f) + (cnt[1] ? 10.f : 0.f) + (cnt[2] ? 30.f : 0.f);
    for (size_t i = (size_t)blockIdx.x * blockDim.x + threadIdx.x; i < (size_t)NTOK * DM; i += (size_t)gridDim.x * blockDim.x) out[i] = E;
}
#endif

#if DBG_STOP == 200
__global__ void dbg_cksum(const unsigned long long* p, size_t nblk, unsigned long long* ck) {
    for (size_t b = (size_t)blockIdx.x * blockDim.x + threadIdx.x; b < nblk; b += (size_t)gridDim.x * blockDim.x) {
        unsigned long long h = 0x9E3779B97F4A7C15ull; const unsigned long long* q = p + b * 128;
        for (int i = 0; i < 128; ++i) { h ^= q[i]; h *= 0xBF58476D1CE4E5B9ull; h ^= h >> 29; }
        ck[b] = h; }
}
__global__ void dbg_ckcmp(const unsigned long long* a, const unsigned long long* b, size_t nblk, unsigned long long* first) {
    for (size_t i = (size_t)blockIdx.x * blockDim.x + threadIdx.x; i < nblk; i += (size_t)gridDim.x * blockDim.x) if (a[i] != b[i]) atomicMin(first, (unsigned long long)i);
}
__global__ void dbg_fill2(float* out, const unsigned long long* first) {
    const unsigned long long off = WS_RSTD + (*first) * 1024ull; int id = 0;
    if (*first != ~0ull) { id = 1; if (off >= WS_Z8) id = 2; if (off >= WS_DLAT) id = 3; if (off >= WS_DIQ) id = 4; if (off >= WS_DIK) id = 5; if (off >= WS_FFW) id = 6; if (off >= WS_GATES) id = 7; if (off >= WS_C2F) id = 8;
        if (off >= WS_DKV) id = 9; if (off >= WS_SC) id = 10; if (off >= WS_MASK) id = 11; if (off >= WS_YATT) id = 12; if (off >= WS_M) id = 13; }
    const float E = 3.f * id;
    for (size_t i = (size_t)blockIdx.x * blockDim.x + threadIdx.x; i < (size_t)NTOK * DM; i += (size_t)gridDim.x * blockDim.x) out[i] = E;
}
#endif
extern "C" void kernel_launch(void* const* d_in, const int* in_sizes, int n_in, void* d_out, int out_size, void* d_ws, size_t ws_size, hipStream_t stream) {
    static int grid = 0;
    if (grid == 0) {
        if (n_in != 22 || out_size != NTOK * DM || ws_size < WS_END) { fprintf(stderr, "kernel_launch: unexpected problem (n_in %d, out %d, ws %zu, need %zu)\n", n_in, out_size, ws_size, (size_t)WS_END); grid = -1; return; }
        int dev = 0, cus = 0;
        if (hipGetDevice(&dev) != hipSuccess || hipDeviceGetAttribute(&cus, hipDeviceAttributeMultiprocessorCount, dev) != hipSuccess) { grid = -1; return; }
        if (hipFuncSetAttribute((const void*)mk_fwd, hipFuncAttributeMaxDynamicSharedMemorySize, LDS_BYTES) != hipSuccess) { fprintf(stderr, "kernel_launch: hipFuncSetAttribute failed\n"); grid = -1; return; }
        int per_cu = 0;
        if (hipOccupancyMaxActiveBlocksPerMultiprocessor(&per_cu, (const void*)mk_fwd, 512, LDS_BYTES) != hipSuccess || per_cu < 1) fprintf(stderr, "kernel_launch: occupancy query says %d\n", per_cu);
        (void)hipGetLastError();
        grid = cus;
    }
    if (grid < 0) return;
    (void)hipMemsetAsync((char*)d_ws + WS_CTL, 0, CTL_ZERO_BYTES, stream);
    Args a{};
    for (int i = 0; i < 22; ++i) a.in[i] = (const float*)d_in[i];
    a.out = (float*)d_out; a.ws = (unsigned char*)d_ws;
#if DBG_STOP == 200
    for (int s = 0; s <= DBG_HI; ++s) { a.ph_lo = s; a.ph_hi = s + 1; hipLaunchKernelGGL(mk_fwd, dim3(grid), dim3(512), LDS_BYTES, stream, a); }
    { char* w = (char*)d_ws; const size_t nblk = (WS_R_END1 - WS_RSTD) / 1024; unsigned long long* ck0 = (unsigned long long*)(w + WS_R_END1); unsigned long long* ck1 = ck0 + nblk; unsigned long long* first = (unsigned long long*)(w + 4096);
#ifdef DBG_WARMFIRST
      for (int s = DBG_LOSTEP; s <= DBG_HI; ++s) { a.ph_lo = s; a.ph_hi = s + 1; hipLaunchKernelGGL(mk_fwd, dim3(grid), dim3(512), LDS_BYTES, stream, a); }
#endif
      hipLaunchKernelGGL(dbg_cksum, dim3(2048), dim3(256), 0, stream, (const unsigned long long*)(w + WS_RSTD), nblk, ck0);
      for (int s = DBG_LOSTEP; s <= DBG_HI; ++s) { a.ph_lo = s; a.ph_hi = s + 1; hipLaunchKernelGGL(mk_fwd, dim3(grid), dim3(512), LDS_BYTES, stream, a); }
      hipLaunchKernelGGL(dbg_cksum, dim3(2048), dim3(256), 0, stream, (const unsigned long long*)(w + WS_RSTD), nblk, ck1);
      (void)hipMemsetAsync(first, 0xFF, 8, stream);
      hipLaunchKernelGGL(dbg_ckcmp, dim3(1024), dim3(256), 0, stream, (const unsigned long long*)ck0, (const unsigned long long*)ck1, nblk, first);
      hipLaunchKernelGGL(dbg_fill2, dim3(2048), dim3(256), 0, stream, (float*)d_out, (const unsigned long long*)first); }
#elif DBG_STOP == 100
    for (int s = 0; s <= 6; ++s) { a.ph_lo = s; a.ph_hi = s + 1; hipLaunchKernelGGL(mk_fwd, dim3(grid), dim3(512), LDS_BYTES, stream, a); }
    { char* w = (char*)d_ws; const size_t SZ = (size_t)NTOK * DM * 2; char* cp = w + WS_R_END1;
      hipMemcpyAsync(cp, w + WS_M, SZ, hipMemcpyDeviceToDevice, stream); hipMemcpyAsync(cp + SZ, w + WS_SC, 2 * SZ, hipMemcpyDeviceToDevice, stream);
      a.ph_lo = 6; a.ph_hi = 7; hipLaunchKernelGGL(mk_fwd, dim3(grid), dim3(512), LDS_BYTES, stream, a);
      unsigned* cnt = (unsigned*)(w + 4096); hipMemsetAsync(cnt, 0, 64, stream);
      hipLaunchKernelGGL(dbg_cmp3, dim3(2048), dim3(256), 0, stream, (const unsigned short*)(w + WS_M), (const unsigned short*)cp, (const unsigned short*)(w + WS_SC), (const unsigned short*)(cp + SZ), (const unsigned short*)(w + WS_SC + SZ), (const unsigned short*)(cp + 2 * SZ), cnt);
      hipLaunchKernelGGL(dbg_fill, dim3(2048), dim3(256), 0, stream, (float*)d_out, (const unsigned*)cnt); }
#elif DBG_STOP >= 0
    for (int s = 0; s <= DBG_STOP; ++s) { a.ph_lo = s; a.ph_hi = s + 1; hipLaunchKernelGGL(mk_fwd, dim3(grid), dim3(512), LDS_BYTES, stream, a); }
#ifdef DBG_TWICE
    { a.ph_lo = DBG_STOP; a.ph_hi = DBG_STOP + 1; hipLaunchKernelGGL(mk_fwd, dim3(grid), dim3(512), LDS_BYTES, stream, a); }
#endif
    hipLaunchKernelGGL(dbg_dump, dim3(2048), dim3(256), 0, stream, (const unsigned short*)((const char*)d_ws + DBG_LO), (size_t)((WS_END - DBG_LO) / 2), (const unsigned*)d_out, (float*)d_out, DBG_STOP >= 7 ? 1 : 0);
#elif MK_ONE_LAUNCH
    a.ph_lo = 0; a.ph_hi = NSTEPS;
    hipLaunchKernelGGL(mk_fwd, dim3(grid), dim3(512), LDS_BYTES, stream, a);
#else
    for (int s = 0; s < NSTEPS; ++s) { a.ph_lo = s; a.ph_hi = s + 1; hipLaunchKernelGGL(mk_fwd, dim3(grid), dim3(512), LDS_BYTES, stream, a);
#ifdef DUP_MASK
        if ((DUP_MASK >> s) & 1u) { a.ph_lo = s | (DUP_DRY << 8); hipLaunchKernelGGL(mk_fwd, dim3(grid), dim3(512), LDS_BYTES, stream, a); }
#endif
    }
#endif
}
```

```cpp
#include <hip/hip_runtime.h>
#include <cstdio>
#include <cstdint>

#ifndef SITE_MASK
#define SITE_MASK 0xffffffffu
#endif
#define SITE_ON(i) (((SITE_MASK) >> (i)) & 1u)

#ifndef DUP_DRY
#define DUP_DRY 0
#endif
#ifndef DBG_STOP
#define DBG_STOP -1
#endif
#ifndef DBG_LO
#define DBG_LO WS_WIN
#endif
#ifndef MK_ONE_LAUNCH
#define MK_ONE_LAUNCH 1
#endif

namespace pg8 {
#define PG8_LAS __attribute__((address_space(3)))
typedef unsigned short bf16_t;
typedef short bf16x8 __attribute__((ext_vector_type(8)));
typedef float f32x4 __attribute__((ext_vector_type(4)));
typedef unsigned u32x4 __attribute__((ext_vector_type(4)));
constexpr int BM = 256, BK = 64, HALF = 128, HTB = HALF * BK * 2  , STAGE_BYTES = 8 * HTB, NXCD = 8, WGM = 8;

__host__ __device__ __forceinline__ int lds_byte(int r, int c) { const int st = (r >> 4) * 2 + (c >> 5), rr = r & 15, cc = c & 31, ob = rr * 64 + cc * 2; return st * 1024 + (ob ^ (((ob >> 9) & 1) << 5)); }
__host__ __device__ __forceinline__ void stage_rc(int b, int& R, int& C) { const int st = b / 1024, sb = b % 1024, swz = sb ^ (((sb >> 9) & 1) << 5); R = (st >> 1) * 16 + swz / 64; C = (st & 1) * 32 + (swz % 64) / 2; }
__host__ __device__ __forceinline__ int perm32(int rho) { const int n = rho >> 4, i = rho & 15; return 8 * (i >> 2) + 4 * n + (i & 3); }
struct Unit { int pm, pn, aux; const char* a; const char* b; };
struct Gemm { int K, P; };
__device__ __forceinline__ unsigned cvt_pk_bf16(float lo, float hi) { unsigned r; asm volatile("v_cvt_pk_bf16_f32 %0, %1, %2" : "=v"(r) : "v"(lo), "v"(hi)); return r; }
template <class Epi, class Sched, bool ALIGN_EPI = false, bool SP2 = false>
__device__ __forceinline__ void gemm_phase(PG8_LAS unsigned char* lds, const Gemm g, const Sched& S, const Epi& E) {
    int tid_ = threadIdx.x; asm volatile("" : "+v"(tid_)); const int tid = tid_, wid = __builtin_amdgcn_readfirstlane(tid >> 6), lane = tid & 63, wr = wid >> 2, wc = wid & 3, fr = lane & 15, fq = lane >> 4;
    const int K = g.K, nt = K / BK;
    unsigned voffA[2], voffB[2];
#pragma unroll
    for (int i = 0; i < 2; ++i) { int R, C; stage_rc(tid * 16 + i * 8192, R, C); const int Rb = Epi::PERM ? ((R & ~31) + perm32(R & 31)) : R;
        voffA[i] = (unsigned)(R * K + C) * 2u; voffB[i] = (unsigned)(Rb * K + C) * 2u; }
    const size_t kstep = (size_t)(BK * 2);
    const size_t hstep = (size_t)HALF * K * 2;
    const unsigned ldsw = (unsigned)wid * 1024u;
    const int aoff = lds_byte(wr * 64 + fr, fq * 8), boff = lds_byte(wc * 32 + fr, fq * 8);
#define PG8_SA(b, h) (((b) * 2 + (h)) * HTB)
#define PG8_SB(b, h) ((4 + (b) * 2 + (h)) * HTB)
#define PG8_STAGE(bufoff, gbase, voff) do { _Pragma("unroll") for (int _i = 0; _i < 2; ++_i) \
        __builtin_amdgcn_global_load_lds((const unsigned*)((const char*)(gbase) + (voff)[_i]), (PG8_LAS unsigned*)(lds + (bufoff) + ldsw + _i * 8192), 16, 0, 0); } while (0)
#define PG8_LDA(dst, b, h) do { _Pragma("unroll") for (int m = 0; m < 4; ++m) _Pragma("unroll") for (int k = 0; k < 2; ++k) dst[m][k] = *(const PG8_LAS bf16x8*)(lds + PG8_SA(b, h) + aoff + m * 2048 + k * 1024); } while (0)
#define PG8_LDB(dst, b, h) do { _Pragma("unroll") for (int n = 0; n < 2; ++n) _Pragma("unroll") for (int k = 0; k < 2; ++k) dst[n][k] = *(const PG8_LAS bf16x8*)(lds + PG8_SB(b, h) + boff + n * 2048 + k * 1024); } while (0)
#define PG8_MMA(ai, bj, At, Bt) do { __builtin_amdgcn_s_setprio(1); _Pragma("unroll") for (int m = 0; m < 4; ++m) _Pragma("unroll") for (int n = 0; n < 2; ++n) _Pragma("unroll") for (int k = 0; k < 2; ++k) \
        acc[ai][bj][m][n] = __builtin_amdgcn_mfma_f32_16x16x32_bf16(Bt[n][k], At[m][k], acc[ai][bj][m][n], 0, 0, 0); __builtin_amdgcn_s_setprio(0); } while (0)
#define PG8_WAIT_V(n) asm volatile("s_waitcnt vmcnt(" #n ")" ::: "memory")
#define PG8_WAIT_L(n) asm volatile("s_waitcnt lgkmcnt(" #n ")" ::: "memory")
#define PG8_BAR __builtin_amdgcn_s_barrier()
#define PG8_SCHED __builtin_amdgcn_sched_barrier(0)
    Unit cur, nxt; int ui = 0;
    if (!S.next(0, cur)) return;
    f32x4 acc[2][2][4][2];
#pragma unroll
    for (int a = 0; a < 2; ++a)
#pragma unroll
        for (int b = 0; b < 2; ++b)
#pragma unroll
            for (int m = 0; m < 4; ++m)
#pragma unroll
                for (int n = 0; n < 2; ++n) acc[a][b][m][n] = (f32x4){0.f, 0.f, 0.f, 0.f};
    bf16x8 At[4][2], B0[2][2], B1[2][2];
    const char* cA = cur.a; const char* cB = cur.b;
    S.a_ready(cur);
    if constexpr (SP2) {
        PG8_STAGE(PG8_SB(0, 0), cB, voffB); PG8_STAGE(PG8_SB(0, 1), cB + hstep, voffB); PG8_STAGE(PG8_SA(0, 0), cA, voffA); PG8_STAGE(PG8_SA(0, 1), cA + hstep, voffA);
        if (wr == 1) PG8_BAR;
        PG8_WAIT_V(2); PG8_BAR;
        PG8_STAGE(PG8_SB(1, 0), cB + kstep, voffB); PG8_STAGE(PG8_SA(1, 0), cA + kstep, voffA); PG8_STAGE(PG8_SB(1, 1), cB + hstep + kstep, voffB);
        PG8_WAIT_V(6); PG8_BAR;
    } else {
        PG8_STAGE(PG8_SB(0, 0), cB, voffB); PG8_STAGE(PG8_SA(0, 0), cA, voffA); PG8_STAGE(PG8_SB(0, 1), cB + hstep, voffB); PG8_STAGE(PG8_SA(0, 1), cA + hstep, voffA);
        if (wr == 1) PG8_BAR;
        PG8_WAIT_V(4); PG8_BAR;
        PG8_STAGE(PG8_SB(1, 0), cB + kstep, voffB); PG8_STAGE(PG8_SA(1, 0), cA + kstep, voffA); PG8_STAGE(PG8_SB(1, 1), cB + hstep + kstep, voffB);
        PG8_WAIT_V(6); PG8_BAR;
    }
    for (;;) {
        const bool has_next = S.next(ui + 1, nxt);
        const char* nA = has_next ? nxt.a : cA; const char* nB = has_next ? nxt.b : cB;
        for (int t = 0; t < nt; t += 2) {
            const bool last = (t == nt - 2);
            const char* a1 = cA + (size_t)(t + 1) * kstep;
            const char* a2 = last ? nA : cA + (size_t)(t + 2) * kstep; const char* b2 = last ? nB : cB + (size_t)(t + 2) * kstep;
            const char* a3 = a2 + kstep; const char* b3 = b2 + kstep;
            if (last && has_next) S.a_ready(nxt);
            if constexpr (SP2) {
            PG8_LDB(B0, 0, 0); PG8_LDB(B1, 0, 1); PG8_SCHED; PG8_LDA(At, 0, 0); PG8_STAGE(PG8_SA(1, 1), a1 + hstep, voffA);
            PG8_WAIT_V(8); PG8_WAIT_L(0); PG8_BAR; PG8_MMA(0, 0, At, B0); PG8_MMA(0, 1, At, B1); PG8_BAR; PG8_SCHED;
            PG8_LDA(At, 0, 1); PG8_STAGE(PG8_SB(0, 0), b2, voffB); PG8_STAGE(PG8_SB(0, 1), b2 + hstep, voffB); PG8_STAGE(PG8_SA(0, 0), a2, voffA);
            PG8_WAIT_V(8); PG8_WAIT_L(0); PG8_BAR; PG8_MMA(1, 0, At, B0); PG8_MMA(1, 1, At, B1); PG8_BAR; PG8_SCHED;
            PG8_LDB(B0, 1, 0); PG8_LDB(B1, 1, 1); PG8_SCHED; PG8_LDA(At, 1, 0); PG8_STAGE(PG8_SA(0, 1), a2 + hstep, voffA);
            PG8_WAIT_V(8); PG8_WAIT_L(0); PG8_BAR; PG8_MMA(0, 0, At, B0); PG8_MMA(0, 1, At, B1); PG8_BAR; PG8_SCHED;
            PG8_LDA(At, 1, 1); PG8_STAGE(PG8_SB(1, 0), b3, voffB); PG8_STAGE(PG8_SB(1, 1), b3 + hstep, voffB); PG8_STAGE(PG8_SA(1, 0), a3, voffA);
            PG8_WAIT_V(8); PG8_WAIT_L(0); PG8_BAR; PG8_MMA(1, 0, At, B0); PG8_MMA(1, 1, At, B1); PG8_BAR; PG8_SCHED;
            } else {
            PG8_LDB(B0, 0, 0); PG8_SCHED; PG8_LDA(At, 0, 0); PG8_STAGE(PG8_SA(1, 1), a1 + hstep, voffA);
            PG8_WAIT_L(8); PG8_BAR; PG8_WAIT_L(0); PG8_MMA(0, 0, At, B0); PG8_BAR; PG8_SCHED;
            PG8_LDB(B1, 0, 1); PG8_STAGE(PG8_SB(0, 0), b2, voffB);
            PG8_BAR; PG8_WAIT_L(0); PG8_MMA(0, 1, At, B1); PG8_BAR;
            PG8_LDA(At, 0, 1); PG8_STAGE(PG8_SA(0, 0), a2, voffA);
            PG8_BAR; PG8_WAIT_L(0); PG8_MMA(1, 0, At, B0); PG8_BAR; PG8_SCHED;
            PG8_STAGE(PG8_SB(0, 1), b2 + hstep, voffB);
            PG8_WAIT_V(6); PG8_BAR; PG8_MMA(1, 1, At, B1); PG8_BAR;
            PG8_LDB(B0, 1, 0); PG8_SCHED; PG8_LDA(At, 1, 0); PG8_STAGE(PG8_SA(0, 1), a2 + hstep, voffA);
            PG8_WAIT_L(8); PG8_BAR; PG8_WAIT_L(0); PG8_MMA(0, 0, At, B0); PG8_BAR; PG8_SCHED;
            PG8_LDB(B1, 1, 1); PG8_STAGE(PG8_SB(1, 0), b3, voffB);
            PG8_BAR; PG8_WAIT_L(0); PG8_MMA(0, 1, At, B1); PG8_BAR;
            PG8_LDA(At, 1, 1); PG8_STAGE(PG8_SA(1, 0), a3, voffA);
            PG8_BAR; PG8_WAIT_L(0); PG8_MMA(1, 0, At, B0); PG8_BAR; PG8_SCHED;
            PG8_STAGE(PG8_SB(1, 1), b3 + hstep, voffB);
            PG8_WAIT_V(6); PG8_BAR; PG8_MMA(1, 1, At, B1); PG8_BAR;
            }
        }
        if constexpr (ALIGN_EPI) { if (wr == 0) PG8_BAR; }
        if constexpr (!Epi::AFTER_DRAIN) { E(acc, cur, wr, wc, fr, fq); S.done(cur); }
        if (!has_next) break;
#pragma unroll
        for (int a = 0; a < 2; ++a)
#pragma unroll
            for (int b = 0; b < 2; ++b)
#pragma unroll
                for (int m = 0; m < 4; ++m)
#pragma unroll
                    for (int n = 0; n < 2; ++n) acc[a][b][m][n] = (f32x4){0.f, 0.f, 0.f, 0.f};
        cur = nxt; cA = nA; cB = nB; ++ui;
        if constexpr (ALIGN_EPI) { if (wr == 1) PG8_BAR; }
    }
    PG8_WAIT_V(0);
    if constexpr (!ALIGN_EPI) { if (wr == 0) PG8_BAR; }
    PG8_BAR;
    if constexpr (Epi::AFTER_DRAIN) { E.fused(acc, cur, wr, wc, fr, fq, lds, wid, lane); S.done(cur); }
#undef PG8_SA
#undef PG8_SB
#undef PG8_STAGE
#undef PG8_LDA
#undef PG8_LDB
#undef PG8_MMA
#undef PG8_WAIT_V
#undef PG8_WAIT_L
#undef PG8_BAR
#undef PG8_SCHED
}
template <class Epi, class Sched, bool ALIGN_EPI = false, bool SP2 = false>
__device__ __forceinline__ void gemm_phase_carry(PG8_LAS unsigned char* lds, const Gemm g, const Sched& S, const Epi& E) {
    int tid_ = threadIdx.x; asm volatile("" : "+v"(tid_)); const int tid = tid_, wid = __builtin_amdgcn_readfirstlane(tid >> 6), lane = tid & 63, wr = wid >> 2, wc = wid & 3, fr = lane & 15, fq = lane >> 4;
    const int K = g.K, nt = K / BK;
    unsigned voffA[2], voffB[2];
#pragma unroll
    for (int i = 0; i < 2; ++i) { int R, C; stage_rc(tid * 16 + i * 8192, R, C); const int Rb = Epi::PERM ? ((R & ~31) + perm32(R & 31)) : R;
        voffA[i] = (unsigned)(R * K + C) * 2u; voffB[i] = (unsigned)(Rb * K + C) * 2u; }
    const size_t kstep = (size_t)(BK * 2);
    const size_t hstep = (size_t)HALF * K * 2;
    const unsigned ldsw = (unsigned)wid * 1024u;
    const int aoff = lds_byte(wr * 64 + fr, fq * 8), boff = lds_byte(wc * 32 + fr, fq * 8);
#define PG8_SA(b, h) (((b) * 2 + (h)) * HTB)
#define PG8_SB(b, h) ((4 + (b) * 2 + (h)) * HTB)
#define PG8_STAGE(bufoff, gbase, voff) do { _Pragma("unroll") for (int _i = 0; _i < 2; ++_i) \
        __builtin_amdgcn_global_load_lds((const unsigned*)((const char*)(gbase) + (voff)[_i]), (PG8_LAS unsigned*)(lds + (bufoff) + ldsw + _i * 8192), 16, 0, 0); } while (0)
#define PG8_LDA(dst, b, h) do { _Pragma("unroll") for (int m = 0; m < 4; ++m) _Pragma("unroll") for (int k = 0; k < 2; ++k) dst[m][k] = *(const PG8_LAS bf16x8*)(lds + PG8_SA(b, h) + aoff + m * 2048 + k * 1024); } while (0)
#define PG8_LDB(dst, b, h) do { _Pragma("unroll") for (int n = 0; n < 2; ++n) _Pragma("unroll") for (int k = 0; k < 2; ++k) dst[n][k] = *(const PG8_LAS bf16x8*)(lds + PG8_SB(b, h) + boff + n * 2048 + k * 1024); } while (0)
#define PG8_MMA(ai, bj, At, Bt) do { __builtin_amdgcn_s_setprio(1); _Pragma("unroll") for (int m = 0; m < 4; ++m) _Pragma("unroll") for (int n = 0; n < 2; ++n) _Pragma("unroll") for (int k = 0; k < 2; ++k) \
        acc[ai][bj][m][n] = __builtin_amdgcn_mfma_f32_16x16x32_bf16(Bt[n][k], At[m][k], acc[ai][bj][m][n], 0, 0, 0); __builtin_amdgcn_s_setprio(0); } while (0)
#define PG8_WAIT_V(n) asm volatile("s_waitcnt vmcnt(" #n ")" ::: "memory")
#define PG8_WAIT_L(n) asm volatile("s_waitcnt lgkmcnt(" #n ")" ::: "memory")
#define PG8_BAR __builtin_amdgcn_s_barrier()
#define PG8_SCHED __builtin_amdgcn_sched_barrier(0)
    Unit cur, nxt; int ui = 0; bool kz = true;
    if (!S.next(0, cur)) return;
    f32x4 acc[2][2][4][2];
#pragma unroll
    for (int a = 0; a < 2; ++a)
#pragma unroll
        for (int b = 0; b < 2; ++b)
#pragma unroll
            for (int m = 0; m < 4; ++m)
#pragma unroll
                for (int n = 0; n < 2; ++n) if (kz) acc[a][b][m][n] = (f32x4){0.f, 0.f, 0.f, 0.f};
    bf16x8 At[4][2], B0[2][2], B1[2][2];
    const char* cA = cur.a; const char* cB = cur.b;
    S.a_ready(cur);
    if constexpr (SP2) {
        PG8_STAGE(PG8_SB(0, 0), cB, voffB); PG8_STAGE(PG8_SB(0, 1), cB + hstep, voffB); PG8_STAGE(PG8_SA(0, 0), cA, voffA); PG8_STAGE(PG8_SA(0, 1), cA + hstep, voffA);
        if (wr == 1) PG8_BAR;
        PG8_WAIT_V(2); PG8_BAR;
        PG8_STAGE(PG8_SB(1, 0), cB + kstep, voffB); PG8_STAGE(PG8_SA(1, 0), cA + kstep, voffA); PG8_STAGE(PG8_SB(1, 1), cB + hstep + kstep, voffB);
        PG8_WAIT_V(6); PG8_BAR;
    } else {
        PG8_STAGE(PG8_SB(0, 0), cB, voffB); PG8_STAGE(PG8_SA(0, 0), cA, voffA); PG8_STAGE(PG8_SB(0, 1), cB + hstep, voffB); PG8_STAGE(PG8_SA(0, 1), cA + hstep, voffA);
        if (wr == 1) PG8_BAR;
        PG8_WAIT_V(4); PG8_BAR;
        PG8_STAGE(PG8_SB(1, 0), cB + kstep, voffB); PG8_STAGE(PG8_SA(1, 0), cA + kstep, voffA); PG8_STAGE(PG8_SB(1, 1), cB + hstep + kstep, voffB);
        PG8_WAIT_V(6); PG8_BAR;
    }
    for (;;) {
        const bool has_next = S.next(ui + 1, nxt);
        const char* nA = has_next ? nxt.a : cA; const char* nB = has_next ? nxt.b : cB;
        for (int t = 0; t < nt; t += 2) {
            const bool last = (t == nt - 2);
            const char* a1 = cA + (size_t)(t + 1) * kstep;
            const char* a2 = last ? nA : cA + (size_t)(t + 2) * kstep; const char* b2 = last ? nB : cB + (size_t)(t + 2) * kstep;
            const char* a3 = a2 + kstep; const char* b3 = b2 + kstep;
            if (last && has_next) S.a_ready(nxt);
            if constexpr (SP2) {
            PG8_LDB(B0, 0, 0); PG8_LDB(B1, 0, 1); PG8_SCHED; PG8_LDA(At, 0, 0); PG8_STAGE(PG8_SA(1, 1), a1 + hstep, voffA);
            PG8_WAIT_V(8); PG8_WAIT_L(0); PG8_BAR; PG8_MMA(0, 0, At, B0); PG8_MMA(0, 1, At, B1); PG8_BAR; PG8_SCHED;
            PG8_LDA(At, 0, 1); PG8_STAGE(PG8_SB(0, 0), b2, voffB); PG8_STAGE(PG8_SB(0, 1), b2 + hstep, voffB); PG8_STAGE(PG8_SA(0, 0), a2, voffA);
            PG8_WAIT_V(8); PG8_WAIT_L(0); PG8_BAR; PG8_MMA(1, 0, At, B0); PG8_MMA(1, 1, At, B1); PG8_BAR; PG8_SCHED;
            PG8_LDB(B0, 1, 0); PG8_LDB(B1, 1, 1); PG8_SCHED; PG8_LDA(At, 1, 0); PG8_STAGE(PG8_SA(0, 1), a2 + hstep, voffA);
            PG8_WAIT_V(8); PG8_WAIT_L(0); PG8_BAR; PG8_MMA(0, 0, At, B0); PG8_MMA(0, 1, At, B1); PG8_BAR; PG8_SCHED;
            PG8_LDA(At, 1, 1); PG8_STAGE(PG8_SB(1, 0), b3, voffB); PG8_STAGE(PG8_SB(1, 1), b3 + hstep, voffB); PG8_STAGE(PG8_SA(1, 0), a3, voffA);
            PG8_WAIT_V(8); PG8_WAIT_L(0); PG8_BAR; PG8_MMA(1, 0, At, B0); PG8_MMA(1, 1, At, B1); PG8_BAR; PG8_SCHED;
            } else {
            PG8_LDB(B0, 0, 0); PG8_SCHED; PG8_LDA(At, 0, 0); PG8_STAGE(PG8_SA(1, 1), a1 + hstep, voffA);
            PG8_WAIT_L(8); PG8_BAR; PG8_WAIT_L(0); PG8_MMA(0, 0, At, B0); PG8_BAR; PG8_SCHED;
            PG8_LDB(B1, 0, 1); PG8_STAGE(PG8_SB(0, 0), b2, voffB);
            PG8_BAR; PG8_WAIT_L(0); PG8_MMA(0, 1, At, B1); PG8_BAR;
            PG8_LDA(At, 0, 1); PG8_STAGE(PG8_SA(0, 0), a2, voffA);
            PG8_BAR; PG8_WAIT_L(0); PG8_MMA(1, 0, At, B0); PG8_BAR; PG8_SCHED;
            PG8_STAGE(PG8_SB(0, 1), b2 + hstep, voffB);
            PG8_WAIT_V(6); PG8_BAR; PG8_MMA(1, 1, At, B1); PG8_BAR;
            PG8_LDB(B0, 1, 0); PG8_SCHED; PG8_LDA(At, 1, 0); PG8_STAGE(PG8_SA(0, 1), a2 + hstep, voffA);
            PG8_WAIT_L(8); PG8_BAR; PG8_WAIT_L(0); PG8_MMA(0, 0, At, B0); PG8_BAR; PG8_SCHED;
            PG8_LDB(B1, 1, 1); PG8_STAGE(PG8_SB(1, 0), b3, voffB);
            PG8_BAR; PG8_WAIT_L(0); PG8_MMA(0, 1, At, B1); PG8_BAR;
            PG8_LDA(At, 1, 1); PG8_STAGE(PG8_SA(1, 0), a3, voffA);
            PG8_BAR; PG8_WAIT_L(0); PG8_MMA(1, 0, At, B0); PG8_BAR; PG8_SCHED;
            PG8_STAGE(PG8_SB(1, 1), b3 + hstep, voffB);
            PG8_WAIT_V(6); PG8_BAR; PG8_MMA(1, 1, At, B1); PG8_BAR;
            }
        }
        if constexpr (ALIGN_EPI) { if (wr == 0) PG8_BAR; }
        if constexpr (!Epi::AFTER_DRAIN) { E(acc, cur, wr, wc, fr, fq); S.done(cur); }
        if (!has_next) break; kz = false;
#pragma unroll
        for (int a = 0; a < 2; ++a)
#pragma unroll
            for (int b = 0; b < 2; ++b)
#pragma unroll
                for (int m = 0; m < 4; ++m)
#pragma unroll
                    for (int n = 0; n < 2; ++n) if (kz) acc[a][b][m][n] = (f32x4){0.f, 0.f, 0.f, 0.f};
        cur = nxt; cA = nA; cB = nB; ++ui;
        if constexpr (ALIGN_EPI) { if (wr == 1) PG8_BAR; }
    }
    PG8_WAIT_V(0);
    if constexpr (!ALIGN_EPI) { if (wr == 0) PG8_BAR; }
    PG8_BAR;
    if constexpr (Epi::AFTER_DRAIN) { E.fused(acc, cur, wr, wc, fr, fq, lds, wid, lane); S.done(cur); }
#undef PG8_SA
#undef PG8_SB
#undef PG8_STAGE
#undef PG8_LDA
#undef PG8_LDB
#undef PG8_MMA
#undef PG8_WAIT_V
#undef PG8_WAIT_L
#undef PG8_BAR
#undef PG8_SCHED
}
typedef int i32x4v __attribute__((ext_vector_type(4))); typedef int i32x8v __attribute__((ext_vector_type(8)));
__device__ __forceinline__ f32x4 mma8(bf16x8 b0, bf16x8 b1, bf16x8 a0, bf16x8 a1, f32x4 c) {
    const i32x4v bl = __builtin_bit_cast(i32x4v, b0), bh = __builtin_bit_cast(i32x4v, b1), al = __builtin_bit_cast(i32x4v, a0), ah = __builtin_bit_cast(i32x4v, a1);
    const i32x8v B = __builtin_shufflevector(bl, bh, 0, 1, 2, 3, 4, 5, 6, 7), A = __builtin_shufflevector(al, ah, 0, 1, 2, 3, 4, 5, 6, 7);
    return __builtin_amdgcn_mfma_scale_f32_16x16x128_f8f6f4(B, A, c, 0, 0, 0, 0x7f7f7f7f, 0, 0x7f7f7f7f);
}
__device__ __forceinline__ f32x4 mma8v(const i32x8v& B, const i32x8v& A, f32x4 c) { const int one = 0x7f7f7f7f;
    asm volatile("v_mfma_scale_f32_16x16x128_f8f6f4 %0, %1, %2, %0, %3, %3 op_sel_hi:[0,0,0]" : "+v"(c) : "v"(B), "v"(A), "v"(one)); return c; }
template <class Epi, class Sched, bool ALIGN_EPI = false, bool SP2 = false>
__device__ __forceinline__ void gemm_phase8(PG8_LAS unsigned char* lds, const Gemm g, const Sched& S, const Epi& E) {
    int tid_ = threadIdx.x; asm volatile("" : "+v"(tid_)); const int tid = tid_, wid = __builtin_amdgcn_readfirstlane(tid >> 6), lane = tid & 63, wr = wid >> 2, wc = wid & 3, fr = lane & 15, fq = lane >> 4;
    const int K = g.P ? g.P : g.K, nt = g.K / BK;
    unsigned voffA[2], voffB[2];
#pragma unroll
    for (int i = 0; i < 2; ++i) { int R, C; stage_rc(tid * 16 + i * 8192, R, C); const int Rb = Epi::PERM ? ((R & ~31) + perm32(R & 31)) : R;
        voffA[i] = (unsigned)(R * K + C) * 2u; voffB[i] = (unsigned)(Rb * K + C) * 2u; }
    const size_t kstep = (size_t)(BK * 2);
    const size_t hstep = (size_t)HALF * K * 2;
    const unsigned ldsw = (unsigned)wid * 1024u;
    const int aoff = lds_byte(wr * 64 + fr, fq * 8), boff = lds_byte(wc * 32 + fr, fq * 8);
#define PG8_SA(b, h) (((b) * 2 + (h)) * HTB)
#define PG8_SB(b, h) ((4 + (b) * 2 + (h)) * HTB)
#define PG8_STAGE(bufoff, gbase, voff) do { _Pragma("unroll") for (int _i = 0; _i < 2; ++_i) \
        __builtin_amdgcn_global_load_lds((const unsigned*)((const char*)(gbase) + (voff)[_i]), (PG8_LAS unsigned*)(lds + (bufoff) + ldsw + _i * 8192), 16, 0, 0); } while (0)
#define PG8_LDA(dst, b, h) do { _Pragma("unroll") for (int m = 0; m < 4; ++m) { dst[m].lo = *(const PG8_LAS i32x4v*)(lds + PG8_SA(b, h) + aoff + m * 2048); dst[m].hi = *(const PG8_LAS i32x4v*)(lds + PG8_SA(b, h) + aoff + m * 2048 + 1024); } } while (0)
#define PG8_LDB(dst, b, h) do { _Pragma("unroll") for (int n = 0; n < 2; ++n) { dst[n].lo = *(const PG8_LAS i32x4v*)(lds + PG8_SB(b, h) + boff + n * 2048); dst[n].hi = *(const PG8_LAS i32x4v*)(lds + PG8_SB(b, h) + boff + n * 2048 + 1024); } } while (0)
#define PG8_MMA(ai, bj, At, Bt) do { __builtin_amdgcn_s_setprio(1); _Pragma("unroll") for (int m = 0; m < 4; ++m) _Pragma("unroll") for (int n = 0; n < 2; ++n) \
        acc[ai][bj][m][n] = mma8v(Bt[n], At[m], acc[ai][bj][m][n]); __builtin_amdgcn_s_setprio(0); } while (0)
#define PG8_WAIT_V(n) asm volatile("s_waitcnt vmcnt(" #n ")" ::: "memory")
#define PG8_WAIT_L(n) asm volatile("s_waitcnt lgkmcnt(" #n ")" ::: "memory")
#define PG8_BAR __builtin_amdgcn_s_barrier()
#define PG8_SCHED __builtin_amdgcn_sched_barrier(0)
    Unit cur, nxt; int ui = 0;
    if (!S.next(0, cur)) return;
    f32x4 acc[2][2][4][2];
#pragma unroll
    for (int a = 0; a < 2; ++a)
#pragma unroll
        for (int b = 0; b < 2; ++b)
#pragma unroll
            for (int m = 0; m < 4; ++m)
#pragma unroll
                for (int n = 0; n < 2; ++n) acc[a][b][m][n] = (f32x4){0.f, 0.f, 0.f, 0.f};
    i32x8v At[4], B0[2], B1[2];
    const char* cA = cur.a; const char* cB = cur.b;
    S.a_ready(cur);
    if constexpr (SP2) {
        PG8_STAGE(PG8_SB(0, 0), cB, voffB); PG8_STAGE(PG8_SB(0, 1), cB + hstep, voffB); PG8_STAGE(PG8_SA(0, 0), cA, voffA); PG8_STAGE(PG8_SA(0, 1), cA + hstep, voffA);
        if (wr == 1) PG8_BAR;
        PG8_WAIT_V(2); PG8_BAR;
        PG8_STAGE(PG8_SB(1, 0), cB + kstep, voffB); PG8_STAGE(PG8_SA(1, 0), cA + kstep, voffA); PG8_STAGE(PG8_SB(1, 1), cB + hstep + kstep, voffB);
        PG8_WAIT_V(6); PG8_BAR;
    } else {
        PG8_STAGE(PG8_SB(0, 0), cB, voffB); PG8_STAGE(PG8_SA(0, 0), cA, voffA); PG8_STAGE(PG8_SB(0, 1), cB + hstep, voffB); PG8_STAGE(PG8_SA(0, 1), cA + hstep, voffA);
        if (wr == 1) PG8_BAR;
        PG8_WAIT_V(4); PG8_BAR;
        PG8_STAGE(PG8_SB(1, 0), cB + kstep, voffB); PG8_STAGE(PG8_SA(1, 0), cA + kstep, voffA); PG8_STAGE(PG8_SB(1, 1), cB + hstep + kstep, voffB);
        PG8_WAIT_V(6); PG8_BAR;
    }
    for (;;) {
        const bool has_next = S.next(ui + 1, nxt);
        const char* nA = has_next ? nxt.a : cA; const char* nB = has_next ? nxt.b : cB;
        for (int t = 0; t < nt; t += 2) {
            const bool last = (t == nt - 2);
            const char* a1 = cA + (size_t)(t + 1) * kstep;
            const char* a2 = last ? nA : cA + (size_t)(t + 2) * kstep; const char* b2 = last ? nB : cB + (size_t)(t + 2) * kstep;
            const char* a3 = a2 + kstep; const char* b3 = b2 + kstep;
            if (last && has_next) S.a_ready(nxt);
            if constexpr (SP2) {
            PG8_LDB(B0, 0, 0); PG8_LDB(B1, 0, 1); PG8_SCHED; PG8_LDA(At, 0, 0); PG8_STAGE(PG8_SA(1, 1), a1 + hstep, voffA);
            PG8_WAIT_V(8); PG8_WAIT_L(0); PG8_BAR; PG8_MMA(0, 0, At, B0); PG8_MMA(0, 1, At, B1); PG8_BAR; PG8_SCHED;
            PG8_LDA(At, 0, 1); PG8_STAGE(PG8_SB(0, 0), b2, voffB); PG8_STAGE(PG8_SB(0, 1), b2 + hstep, voffB); PG8_STAGE(PG8_SA(0, 0), a2, voffA);
            PG8_WAIT_V(8); PG8_WAIT_L(0); PG8_BAR; PG8_MMA(1, 0, At, B0); PG8_MMA(1, 1, At, B1); PG8_BAR; PG8_SCHED;
            PG8_LDB(B0, 1, 0); PG8_LDB(B1, 1, 1); PG8_SCHED; PG8_LDA(At, 1, 0); PG8_STAGE(PG8_SA(0, 1), a2 + hstep, voffA);
            PG8_WAIT_V(8); PG8_WAIT_L(0); PG8_BAR; PG8_MMA(0, 0, At, B0); PG8_MMA(0, 1, At, B1); PG8_BAR; PG8_SCHED;
            PG8_LDA(At, 1, 1); PG8_STAGE(PG8_SB(1, 0), b3, voffB); PG8_STAGE(PG8_SB(1, 1), b3 + hstep, voffB); PG8_STAGE(PG8_SA(1, 0), a3, voffA);
            PG8_WAIT_V(8); PG8_WAIT_L(0); PG8_BAR; PG8_MMA(1, 0, At, B0); PG8_MMA(1, 1, At, B1); PG8_BAR; PG8_SCHED;
            } else {
            PG8_LDB(B0, 0, 0); PG8_SCHED; PG8_LDA(At, 0, 0); PG8_STAGE(PG8_SA(1, 1), a1 + hstep, voffA);
            PG8_WAIT_L(8); PG8_BAR; PG8_WAIT_L(0); PG8_MMA(0, 0, At, B0); PG8_BAR; PG8_SCHED;
            PG8_LDB(B1, 0, 1); PG8_STAGE(PG8_SB(0, 0), b2, voffB);
            PG8_BAR; PG8_WAIT_L(0); PG8_MMA(0, 1, At, B1); PG8_BAR;
            PG8_LDA(At, 0, 1); PG8_STAGE(PG8_SA(0, 0), a2, voffA);
            PG8_BAR; PG8_WAIT_L(0); PG8_MMA(1, 0, At, B0); PG8_BAR; PG8_SCHED;
            PG8_STAGE(PG8_SB(0, 1), b2 + hstep, voffB);
            PG8_WAIT_V(6); PG8_BAR; PG8_MMA(1, 1, At, B1); PG8_BAR;
            PG8_LDB(B0, 1, 0); PG8_SCHED; PG8_LDA(At, 1, 0); PG8_STAGE(PG8_SA(0, 1), a2 + hstep, voffA);
            PG8_WAIT_L(8); PG8_BAR; PG8_WAIT_L(0); PG8_MMA(0, 0, At, B0); PG8_BAR; PG8_SCHED;
            PG8_LDB(B1, 1, 1); PG8_STAGE(PG8_SB(1, 0), b3, voffB);
            PG8_BAR; PG8_WAIT_L(0); PG8_MMA(0, 1, At, B1); PG8_BAR;
            PG8_LDA(At, 1, 1); PG8_STAGE(PG8_SA(1, 0), a3, voffA);
            PG8_BAR; PG8_WAIT_L(0); PG8_MMA(1, 0, At, B0); PG8_BAR; PG8_SCHED;
            PG8_STAGE(PG8_SB(1, 1), b3 + hstep, voffB);
            PG8_WAIT_V(6); PG8_BAR; PG8_MMA(1, 1, At, B1); PG8_BAR;
            }
        }
        if constexpr (ALIGN_EPI) { if (wr == 0) PG8_BAR; }
        if constexpr (!Epi::AFTER_DRAIN) { E(acc, cur, wr, wc, fr, fq); S.done(cur); }
        if (!has_next) break;
#pragma unroll
        for (int a = 0; a < 2; ++a)
#pragma unroll
            for (int b = 0; b < 2; ++b)
#pragma unroll
                for (int m = 0; m < 4; ++m)
#pragma unroll
                    for (int n = 0; n < 2; ++n) acc[a][b][m][n] = (f32x4){0.f, 0.f, 0.f, 0.f};
        cur = nxt; cA = nA; cB = nB; ++ui;
        if constexpr (ALIGN_EPI) { if (wr == 1) PG8_BAR; }
    }
    PG8_WAIT_V(0);
    if constexpr (!ALIGN_EPI) { if (wr == 0) PG8_BAR; }
    PG8_BAR;
    if constexpr (Epi::AFTER_DRAIN) { E.fused(acc, cur, wr, wc, fr, fq, lds, wid, lane); S.done(cur); }
#undef PG8_SA
#undef PG8_SB
#undef PG8_STAGE
#undef PG8_LDA
#undef PG8_LDB
#undef PG8_MMA
#undef PG8_WAIT_V
#undef PG8_WAIT_L
#undef PG8_BAR
#undef PG8_SCHED
}
struct OrderBase {
    int nM, nN, nwg, G, c;
    __device__ __forceinline__ void init(int nM_, int nN_, int G_, int c_) { nM = nM_; nN = nN_; nwg = nM_ * nN_; G = G_; c = c_; }
    __device__ __forceinline__ bool map(int i, int& pm, int& pn) const {
        const long L = (long)i * G + c; if (L >= nwg) return false;
        int wgid = (int)L; { const int q = nwg / NXCD, r = nwg % NXCD, xcd = wgid % NXCD, off = wgid / NXCD; wgid = (xcd < r ? xcd * (q + 1) : r * (q + 1) + (xcd - r) * q) + off; }
        const int nig = WGM * nN, gid = wgid / nig, fm = gid * WGM, gsz = (nM - fm) < WGM ? (nM - fm) : WGM;
        pm = fm + ((wgid % nig) % gsz); pn = (wgid % nig) / gsz; return true;
    }
    __device__ __forceinline__ void a_ready(const Unit&) const {}
    __device__ __forceinline__ void done(const Unit&) const {}
};
struct PlainOrder : OrderBase {
    const char* A; const char* B; size_t ta, tb;
    __device__ __forceinline__ bool next(int i, Unit& u) const { int pm, pn; if (!map(i, pm, pn)) return false; u.pm = pm; u.pn = pn; u.aux = 0; u.a = A + (size_t)pm * ta; u.b = B + (size_t)pn * tb; return true; }
};
struct BranchOrder : OrderBase {
    const char* A; const char* B; size_t ta, tb, za, zb;
    __device__ __forceinline__ bool next(int i, Unit& u) const { const int ti = i / 3, br = i - 3 * ti; int pm, pn; if (!map(ti, pm, pn)) return false; u.pm = pm; u.pn = pn; u.aux = br;
        u.a = A + (size_t)br * za + (size_t)pm * ta; u.b = B + (size_t)br * zb + (size_t)pn * tb; return true; }
};
struct MoeOrder : OrderBase {
    const char* A; const char* B; size_t ta, tb, zb; int t1, t2, t3, t4, t5, t6, t7;
    __device__ __forceinline__ bool next(int i, Unit& u) const { int pm, pn; if (!map(i, pm, pn)) return false; u.pm = pm; u.pn = pn;
        const int e = (pm >= t1) + (pm >= t2) + (pm >= t3) + (pm >= t4) + (pm >= t5) + (pm >= t6) + (pm >= t7); u.aux = e;
        u.a = A + (size_t)pm * ta; u.b = B + (size_t)e * zb + (size_t)pn * tb; return true; }
};
struct TailOrder {
    int ntail, G, c; const char* A; const char* B; size_t ta, tb, zb, kq; int t1, t2, t3, t4, t5, t6, t7;
    __device__ __forceinline__ bool next(int i, Unit& u) const { const long L = (long)i * G + c; if (L >= ntail) return false; const int l = (int)L, q = l & 3, pn = (l >> 2) & 7, pm = 128 + (l >> 5);
        const int e = (pm >= t1) + (pm >= t2) + (pm >= t3) + (pm >= t4) + (pm >= t5) + (pm >= t6) + (pm >= t7); u.pm = pm; u.pn = pn; u.aux = q;
        u.a = A + (size_t)pm * ta + (size_t)q * kq; u.b = B + (size_t)e * zb + (size_t)pn * tb + (size_t)q * kq; return true; }
    __device__ __forceinline__ void a_ready(const Unit&) const {}
    __device__ __forceinline__ void done(const Unit&) const {}
};
}

constexpr int NTOK = 16384, DM = 2048, SEQ = 2048, NBATCH = 8, NHEAD = 8, HD = 64, DFF = 7168, NEXP = 8;
constexpr int NIN = 10828, NINP = 11008;
constexpr int WBR_W = 512, KVR = 256;
constexpr float EPS = 1e-6f, LOG2E = 1.4426950408889634f, C2 = 0.125f * LOG2E;
constexpr int MOE_ROWS = 2 * NTOK + NEXP * 256;
constexpr int NSTEPS = 24;
constexpr float W8SCALE = 64.f, WD8SCALE = 128.f, H8SCALE = 8.f;

constexpr size_t al256(size_t x) { return (x + 255) & ~(size_t)255; }
constexpr size_t WS_CTL = 0, CTL_ZERO_BYTES = 1u << 20;
constexpr size_t SZ_WIN = (size_t)NINP * DM * 2, SZ_WUKV = (size_t)1024 * KVR * 2, SZ_WBR = (size_t)DM * WBR_W * 2, SZ_WOUT = (size_t)DM * DM * 2;
constexpr size_t SZ_WGU = (size_t)2 * DFF * DM * 2, SZ_WD = (size_t)DM * DFF * 2;
constexpr size_t WS_WIN = CTL_ZERO_BYTES, WS_WUKV = WS_WIN + 2 * SZ_WIN, WS_WBR = WS_WUKV + 2 * SZ_WUKV, WS_WOUT = WS_WBR + 6 * SZ_WBR;
constexpr size_t WS_WGU0 = WS_WOUT + 2 * SZ_WOUT, WS_WD0 = WS_WGU0 + SZ_WGU, WS_WGUM = WS_WD0 + SZ_WD, WS_WDM = WS_WGUM + NEXP * SZ_WGU;
constexpr size_t WS_RSTD = WS_WDM + NEXP * SZ_WD, WS_SSP = WS_RSTD + (size_t)NTOK * 4, WS_XB = WS_SSP + (size_t)NTOK * 32 * 4;
constexpr size_t WS_R = WS_XB + (size_t)NTOK * DM * 2;
constexpr size_t WS_Z8 = WS_R, WS_DLAT = WS_Z8 + (size_t)8 * NTOK * 512 * 2, WS_DIQ = WS_DLAT + (size_t)NTOK * 256 * 2, WS_DIK = WS_DIQ + (size_t)NTOK * 256 * 2;
constexpr size_t WS_FFW = WS_DIK + (size_t)NTOK * 64 * 2, WS_GATES = WS_FFW + (size_t)NTOK * 16 * 4, WS_C2F = WS_GATES + (size_t)NTOK * 6144 * 2;
constexpr size_t WS_DKV = WS_C2F + (size_t)NBATCH * NHEAD * SEQ * 4, WS_SC = WS_DKV + (size_t)NTOK * 1024 * 2, WS_MASK = WS_SC + (size_t)NTOK * SEQ * 4;
constexpr size_t WS_YATT = WS_MASK + (size_t)NTOK * 64 * 4, WS_M = WS_YATT + (size_t)3 * NTOK * 512 * 2, WS_R_END1 = WS_M + (size_t)NTOK * DM * 2;
constexpr size_t WS_HID = WS_R;
constexpr size_t WS_XG = WS_R, WS_HIDM = WS_XG + (size_t)MOE_ROWS * DM * 2, WS_Y = WS_HIDM + (size_t)MOE_ROWS * DFF * 2, WS_ROWTOK = WS_Y + (size_t)2 * NTOK * DM * 4;
constexpr size_t WS_ROWW = WS_ROWTOK + (size_t)MOE_ROWS * 4, WS_RSTDG = WS_ROWW + (size_t)MOE_ROWS * 4, WS_TOKINFO = WS_RSTDG + (size_t)MOE_ROWS * 4;
constexpr size_t WS_TOKW = WS_TOKINFO + (size_t)2 * NTOK * 8, WS_WGCNT = WS_TOKW + (size_t)2 * NTOK * 4, WS_META = WS_WGCNT + 256 * 8 * 4, WS_R_END2 = WS_META + 256;
constexpr size_t WS_END = WS_R_END1 > WS_R_END2 ? WS_R_END1 : WS_R_END2;
constexpr size_t WS_XB8 = WS_WGUM + NEXP * SZ_WGU / 2;
constexpr size_t WS_WING8 = WS_XB8 + (size_t)NTOK * DM;
static_assert(WS_WING8 + (size_t)2 * 6144 * DM <= WS_WDM, "fp8 side buffers fit the freed half of the MoE gate/up region");
static_assert((size_t)2 * NTOK * DM * 2 + (size_t)4 * 2048 * DM * 2 + (size_t)2 * NTOK * 4 <= (size_t)2 * NTOK * DM * 4, "tail partials fit the slack of the Y region");
constexpr int CW_ATTQ = 65536;
constexpr int CW_BAR = 4096;

constexpr int RING_BYTES = 131072, LDSCTL_OFF = RING_BYTES, MISC_OFF = LDSCTL_OFF + 320, LDS_BYTES = 147456;

#define GAS __attribute__((address_space(1)))
#define LAS __attribute__((address_space(3)))
typedef unsigned short bf16_t;
typedef float f32x4 __attribute__((ext_vector_type(4)));
typedef unsigned u32x4 __attribute__((ext_vector_type(4)));
typedef unsigned u32x2 __attribute__((ext_vector_type(2)));
typedef short bf16x8 __attribute__((ext_vector_type(8)));
typedef float f32x16 __attribute__((ext_vector_type(16)));
#define LDS_WAIT() asm volatile("s_waitcnt lgkmcnt(0)" ::: "memory")
#define VM_WAIT() asm volatile("s_waitcnt vmcnt(0)" ::: "memory")
__device__ __forceinline__ float bflo(unsigned w) { return __uint_as_float(w << 16); }
__device__ __forceinline__ float bfhi(unsigned w) { return __uint_as_float(w & 0xffff0000u); }
typedef float f32x2_t __attribute__((ext_vector_type(2))); typedef __bf16 bf16x2_t __attribute__((ext_vector_type(2)));
__device__ __forceinline__ unsigned pk2(float lo, float hi) { f32x2_t v = {lo, hi}; bf16x2_t b = __builtin_convertvector(v, bf16x2_t); return __builtin_bit_cast(unsigned, b); }
__device__ __forceinline__ int opq(int v) { asm volatile("" : "+s"(v)); return v; }
__device__ __forceinline__ float wave_sum(float v) {
#pragma unroll
    for (int o = 1; o < 64; o <<= 1) v += __shfl_xor(v, o);
    return v;
}
__device__ __forceinline__ u32x2 pack8_fp8(const float (&e)[8]) {
    float c[8];
#pragma unroll
    for (int i = 0; i < 8; ++i) c[i] = __builtin_amdgcn_fmed3f(e[i], -448.f, 448.f);
    int w0 = __builtin_amdgcn_cvt_pk_fp8_f32(c[0], c[1], 0, false); w0 = __builtin_amdgcn_cvt_pk_fp8_f32(c[2], c[3], w0, true);
    int w1 = __builtin_amdgcn_cvt_pk_fp8_f32(c[4], c[5], 0, false); w1 = __builtin_amdgcn_cvt_pk_fp8_f32(c[6], c[7], w1, true);
    u32x2 r; r.x = (unsigned)w0; r.y = (unsigned)w1; return r; }
__device__ __forceinline__ float sigm(float v) { return __builtin_amdgcn_rcpf(1.f + __builtin_amdgcn_exp2f(-v * LOG2E)); }
__device__ __forceinline__ float softplus2(float z) { return fmaxf(z, 0.f) + __builtin_amdgcn_logf(1.f + __builtin_amdgcn_exp2f(-fabsf(z))); }

#define XB_TMO      128
#define XB_XCNT(j)  (256  + 64 * (j))
#define XB_XSUB(j)  (1280 + 64 * (j))
#define XB_XGEN(j)  (2304 + 64 * (j))
#define XB_TOP      3328
#define XB_TOPGEN   3392
#define XCD_BAR_WORDS 3456
#define XB_SPIN_CAP (1u << 18)

__device__ __forceinline__ unsigned xb_ld(unsigned* p)              { return __hip_atomic_load(p, __ATOMIC_RELAXED, __HIP_MEMORY_SCOPE_AGENT); }
__device__ __forceinline__ unsigned xb_add(unsigned* p, unsigned v) { return __hip_atomic_fetch_add(p, v, __ATOMIC_RELAXED, __HIP_MEMORY_SCOPE_AGENT); }
__device__ __forceinline__ unsigned xb_xcc_id() { return (unsigned)__builtin_amdgcn_s_getreg((3 << 11) | 20) & 0xFu; }
#define XB_SPIN(cond, bar) do { unsigned _sp = 0; while (cond) { __builtin_amdgcn_s_sleep(1); \
    if ((++_sp & 255u) == 0u) { if (xb_ld(&(bar)[XB_TMO])) break; if (_sp > XB_SPIN_CAP) { atomicAdd(&(bar)[XB_TMO], 1u); break; } } } } while (0)

struct XcdBarrier {
    unsigned* bar; unsigned x;
    volatile LAS unsigned* st;
};

__device__ __forceinline__ XcdBarrier xcd_barrier_post(unsigned* bar, volatile LAS unsigned* st) {
    XcdBarrier b; b.bar = bar; b.x = xb_xcc_id(); b.st = st;
    if (threadIdx.x == 0) (void)xb_add(&bar[XB_XCNT(b.x)], 1u);
    return b;
}
__device__ __forceinline__ void xcd_barrier_complete(unsigned* bar, unsigned x, unsigned& nloc, unsigned& nx) {
    const unsigned G = gridDim.x * gridDim.y * gridDim.z;
    unsigned sum, cnt, mine, sp = 0u;
    for (;;) {
        sum = 0u; cnt = 0u; mine = 0u;
#pragma unroll
        for (unsigned j = 0; j < 16; ++j) { const unsigned c = xb_ld(&bar[XB_XCNT(j)]); sum += c; cnt += (c > 0u) ? 1u : 0u; mine = (j == x) ? c : mine; }
        if (sum == G) break;
        __builtin_amdgcn_s_sleep(1);
        if ((++sp & 255u) == 0u) { if (xb_ld(&bar[XB_TMO])) break; if (sp > XB_SPIN_CAP) { atomicAdd(&bar[XB_TMO], 1u); break; } }
    }
    nloc = mine > 0u ? mine : 1u; nx = cnt > 0u ? cnt : 1u;
}

__device__ __attribute__((noinline)) void xcd_barrier_impl(GAS unsigned* bar_, unsigned x_, LAS unsigned* st_) { XcdBarrier b; b.bar = (unsigned*)bar_; b.x = x_; b.st = st_;
    asm volatile("s_waitcnt vmcnt(0)" ::: "memory");
    __syncthreads();
    if (threadIdx.x == 0) {
        unsigned* bar = b.bar;
        __builtin_amdgcn_s_waitcnt(0);
        unsigned nloc = b.st[0], nx = b.st[1];
        if (nloc == 0u) { xcd_barrier_complete(bar, b.x, nloc, nx); b.st[0] = nloc; b.st[1] = nx; }
        const unsigned old = xb_add(&bar[XB_XSUB(b.x)], 1u);
        const unsigned gen = old / nloc;
        if (old + 1u == (gen + 1u) * nloc) {
            __builtin_amdgcn_fence(__ATOMIC_RELEASE, "agent");
            asm volatile("s_waitcnt vmcnt(0)" ::: "memory");
            const unsigned og = xb_add(&bar[XB_TOP], 1u);
            const unsigned tg = og / nx;
            if (og + 1u == (tg + 1u) * nx) xb_add(&bar[XB_TOPGEN], 1u);
            else XB_SPIN(xb_ld(&bar[XB_TOPGEN]) == tg, bar);
            __builtin_amdgcn_fence(__ATOMIC_ACQUIRE, "agent");
            xb_add(&bar[XB_XGEN(b.x)], 1u);
            asm volatile("s_waitcnt vmcnt(0)" ::: "memory");
        } else {
            XB_SPIN(xb_ld(&bar[XB_XGEN(b.x)]) == gen, bar);
            __builtin_amdgcn_fence(__ATOMIC_ACQUIRE, "agent");
            asm volatile("s_waitcnt vmcnt(0)" ::: "memory");
        }
    }
    __syncthreads();
}
__device__ __forceinline__ void xcd_barrier(const XcdBarrier& b) { xcd_barrier_impl((GAS unsigned*)b.bar, b.x, (LAS unsigned*)b.st); }

#define ACC_T const pg8::f32x4 (&acc)[2][2][4][2]
__device__ __forceinline__ u32x4 pack8(f32x4 v0, f32x4 v1) { u32x4 w; w.x = pk2(v0[0], v0[1]); w.y = pk2(v0[2], v0[3]); w.z = pk2(v1[0], v1[1]); w.w = pk2(v1[2], v1[3]); return w; }
__device__ __forceinline__ f32x4 sigm4(f32x4 v) { f32x4 r; r[0] = sigm(v[0]); r[1] = sigm(v[1]); r[2] = sigm(v[2]); r[3] = sigm(v[3]); return r; }

struct EpiWin {
    static constexpr bool PERM = true, AFTER_DRAIN = false;
    const float* rstd; bf16_t* z8; bf16_t* dlat; bf16_t* diq; bf16_t* dik; float* ffw; bf16_t* gates;
    __device__ __forceinline__ void operator()(ACC_T, const pg8::Unit& u, int wr, int wc, int fr, int fq) const {
        const int row0 = u.pm * 256 + wr * 64 + fr, pn = u.pn, cl = wc * 32 + 8 * fq;
        float rsv[2][4];
#pragma unroll
        for (int ai = 0; ai < 2; ++ai)
#pragma unroll
            for (int m = 0; m < 4; ++m) rsv[ai][m] = rstd[row0 + ai * 128 + m * 16];
        if (pn == 18) {
#pragma unroll
            for (int ai = 0; ai < 2; ++ai)
#pragma unroll
                for (int m = 0; m < 4; ++m) { const int row = row0 + ai * 128 + m * 16; const float rs = rsv[ai][m];
                    const f32x4 v0 = acc[ai][0][m][0] * rs, v1 = acc[ai][0][m][1] * rs;
                    if (cl < 64) *(u32x4*)(dik + (size_t)row * 64 + cl) = pack8(v0, v1);
                    else if (cl == 64) { *(f32x4*)(ffw + (size_t)row * 16) = v0; *(f32x4*)(ffw + (size_t)row * 16 + 4) = v1; }
                    else if (cl == 72) { *(f32x4*)(ffw + (size_t)row * 16 + 8) = v0; } }
            return;
        }
        bf16_t* dst; int ldc, colbase; bool sg = false; float scale = 1.f;
        if (pn < 16) { const int idx = pn >> 1; dst = z8 + (size_t)idx * NTOK * 512; ldc = 512; colbase = (pn & 1) * 256; sg = (idx == 3); scale = (idx == 4 || idx == 7) ? C2 : 1.f; }
        else if (pn == 16) { dst = dlat; ldc = 256; colbase = 0; }
        else if (pn == 17) { dst = diq; ldc = 256; colbase = 0; }
        else { dst = gates; ldc = 6144; colbase = (pn - 19) * 256; sg = true; }
        if (sg) {
#pragma unroll
            for (int ai = 0; ai < 2; ++ai)
#pragma unroll
                for (int m = 0; m < 4; ++m) { const int row = row0 + ai * 128 + m * 16; const float rs = rsv[ai][m]; bf16_t* rowp = dst + (size_t)row * ldc + colbase + cl;
#pragma unroll
                    for (int bj = 0; bj < 2; ++bj) *(u32x4*)(rowp + bj * 128) = pack8(sigm4(acc[ai][bj][m][0] * rs), sigm4(acc[ai][bj][m][1] * rs)); }
        } else {
#pragma unroll
            for (int ai = 0; ai < 2; ++ai)
#pragma unroll
                for (int m = 0; m < 4; ++m) { const int row = row0 + ai * 128 + m * 16; const float rs = rsv[ai][m] * scale; bf16_t* rowp = dst + (size_t)row * ldc + colbase + cl;
#pragma unroll
                    for (int bj = 0; bj < 2; ++bj) *(u32x4*)(rowp + bj * 128) = pack8(acc[ai][bj][m][0] * rs, acc[ai][bj][m][1] * rs); }
        }
    }
};
struct EpiGate {
    static constexpr bool PERM = true, AFTER_DRAIN = false;
    const float* rstd; bf16_t* gates; float scale;
    __device__ __forceinline__ void operator()(ACC_T, const pg8::Unit& u, int wr, int wc, int fr, int fq) const {
        const int row0 = u.pm * 256 + wr * 64 + fr, col0 = u.pn * 256 + wc * 32 + 8 * fq;
        float rsv[2][4];
#pragma unroll
        for (int ai = 0; ai < 2; ++ai)
#pragma unroll
            for (int m = 0; m < 4; ++m) rsv[ai][m] = rstd[row0 + ai * 128 + m * 16];
#pragma unroll
        for (int ai = 0; ai < 2; ++ai)
#pragma unroll
            for (int m = 0; m < 4; ++m) { const int row = row0 + ai * 128 + m * 16; const float rs = rsv[ai][m] * scale; bf16_t* rowp = gates + (size_t)row * 6144 + col0;
#pragma unroll
                for (int bj = 0; bj < 2; ++bj) *(u32x4*)(rowp + bj * 128) = pack8(sigm4(acc[ai][bj][m][0] * rs), sigm4(acc[ai][bj][m][1] * rs)); }
    }
};
struct EpiPlain {
    static constexpr bool PERM = true, AFTER_DRAIN = false;
    bf16_t* O; int ldc;
    __device__ __forceinline__ void operator()(ACC_T, const pg8::Unit& u, int wr, int wc, int fr, int fq) const {
        const int row0 = u.pm * 256 + wr * 64 + fr, col0 = u.pn * 256 + wc * 32 + 8 * fq;
#pragma unroll
        for (int ai = 0; ai < 2; ++ai)
#pragma unroll
            for (int m = 0; m < 4; ++m) { bf16_t* rowp = O + (size_t)(row0 + ai * 128 + m * 16) * ldc + col0;
#pragma unroll
                for (int bj = 0; bj < 2; ++bj) *(u32x4*)(rowp + bj * 128) = pack8(acc[ai][bj][m][0], acc[ai][bj][m][1]); }
    }
};
struct EpiBranch {
    static constexpr bool PERM = true, AFTER_DRAIN = false;
    const bf16_t* gates; bf16_t* M;
    __device__ __forceinline__ void operator()(pg8::f32x4 (&acc)[2][2][4][2], const pg8::Unit& u, int wr, int wc, int fr, int fq) const {
        const int row0 = u.pm * 256 + wr * 64 + fr, col0 = u.pn * 256 + wc * 32 + 8 * fq, br = u.aux;
#pragma unroll
        for (int am = 0; am < 8; ++am) { const int ai = am >> 2, mb = am & 3;
            u32x4 gv[4][2], hv[4][2];
#pragma unroll
            for (int m = mb; m < mb + 1; ++m)
#pragma unroll
                for (int bj = 0; bj < 2; ++bj) { const int row = row0 + ai * 128 + m * 16, col = col0 + bj * 128;
                    gv[m][bj] = *(const u32x4*)(gates + (size_t)row * 6144 + br * 2048 + col);
                    hv[m][bj] = gv[m][bj]; if (br < 2) hv[m][bj] = *(const u32x4*)(gates + (size_t)row * 6144 + (br + 1) * 2048 + col); }
#pragma unroll
            for (int m = mb; m < mb + 1; ++m)
#pragma unroll
                for (int bj = 0; bj < 2; ++bj) { const int row = row0 + ai * 128 + m * 16, col = col0 + bj * 128; const u32x4 g = gv[m][bj], h = hv[m][bj];
                    float f[8] = {bflo(g.x), bfhi(g.x), bflo(g.y), bfhi(g.y), bflo(g.z), bfhi(g.z), bflo(g.w), bfhi(g.w)};
                    if (br < 2) { const float d[8] = {bflo(h.x), bfhi(h.x), bflo(h.y), bfhi(h.y), bflo(h.z), bfhi(h.z), bflo(h.w), bfhi(h.w)};
#pragma unroll
                        for (int i = 0; i < 8; ++i) f[i] = f[i] * __builtin_amdgcn_rcpf(fmaxf(d[i], 1.0e-20f)); }
                    pg8::f32x4& v0 = acc[ai][bj][m][0]; pg8::f32x4& v1 = acc[ai][bj][m][1];
                    v0[0] *= f[0]; v0[1] *= f[1]; v0[2] *= f[2]; v0[3] *= f[3]; v1[0] *= f[4]; v1[1] *= f[5]; v1[2] *= f[6]; v1[3] *= f[7];
                    if (br == 2) { *(u32x4*)(M + (size_t)row * DM + col) = pack8(v0, v1); v0 = (pg8::f32x4){0.f, 0.f, 0.f, 0.f}; v1 = (pg8::f32x4){0.f, 0.f, 0.f, 0.f}; } }
        }
    }
};
struct EpiResid {
    static constexpr bool PERM = true, AFTER_DRAIN = false;
    const float* xold; float* x; bf16_t* xb; float* ssp; unsigned char* xb8; float ascale;
    __device__ __forceinline__ void operator()(ACC_T, const pg8::Unit& u, int wr, int wc, int fr, int fq) const {
        const int row0 = u.pm * 256 + wr * 64 + fr, col0 = u.pn * 256 + wc * 32 + 8 * fq;
#pragma unroll
        for (int am = 0; am < 4; ++am) { const int ai = am >> 1, mb = (am & 1) * 2;
            f32x4 ov[4][2][2];
#pragma unroll
            for (int m = mb; m < mb + 2; ++m)
#pragma unroll
                for (int bj = 0; bj < 2; ++bj) { const size_t off = (size_t)(row0 + ai * 128 + m * 16) * DM + col0 + bj * 128; ov[m][bj][0] = *(const f32x4*)(xold + off); ov[m][bj][1] = *(const f32x4*)(xold + off + 4); }
#pragma unroll
            for (int m = mb; m < mb + 2; ++m) { const int row = row0 + ai * 128 + m * 16; float ss = 0.f;
#pragma unroll
                for (int bj = 0; bj < 2; ++bj) { const size_t off = (size_t)row * DM + col0 + bj * 128;
                    const f32x4 v0 = ov[m][bj][0] + acc[ai][bj][m][0] * ascale, v1 = ov[m][bj][1] + acc[ai][bj][m][1] * ascale;
                    *(f32x4*)(x + off) = v0; *(f32x4*)(x + off + 4) = v1; if (xb) *(u32x4*)(xb + off) = pack8(v0, v1);
                    if (xb8) { const float e[8] = {v0[0], v0[1], v0[2], v0[3], v1[0], v1[1], v1[2], v1[3]}; *(u32x2*)(xb8 + off) = pack8_fp8(e); }
                    ss += (v0[0] * v0[0] + v0[1] * v0[1]) + (v0[2] * v0[2] + v0[3] * v0[3]) + (v1[0] * v1[0] + v1[1] * v1[1]) + (v1[2] * v1[2] + v1[3] * v1[3]); }
                ss += __shfl_xor(ss, 16); ss += __shfl_xor(ss, 32);
                if (fq == 0) ssp[(size_t)row * 32 + u.pn * 4 + wc] = ss; }
        }
    }
};
struct EpiSwiglu {
    static constexpr bool PERM = true, AFTER_DRAIN = false;
    const float* rstd; bf16_t* hid; float oscale; int f8out;
    __device__ __forceinline__ void operator()(ACC_T, const pg8::Unit& u, int wr, int wc, int fr, int fq) const {
        const int row0 = u.pm * 256 + wr * 64 + fr, col0 = u.pn * 128 + wc * 32 + 8 * fq;
        float rsv[2][4];
#pragma unroll
        for (int ai = 0; ai < 2; ++ai)
#pragma unroll
            for (int m = 0; m < 4; ++m) rsv[ai][m] = rstd[row0 + ai * 128 + m * 16];
#pragma unroll
        for (int ai = 0; ai < 2; ++ai)
#pragma unroll
            for (int m = 0; m < 4; ++m) { const int row = row0 + ai * 128 + m * 16; const float rs = rsv[ai][m] * oscale;
                f32x4 h0, h1;
#pragma unroll
                for (int j = 0; j < 4; ++j) { const float g0 = acc[ai][0][m][0][j] * rs, u0 = acc[ai][1][m][0][j] * rs, g1 = acc[ai][0][m][1][j] * rs, u1 = acc[ai][1][m][1][j] * rs;
                    h0[j] = g0 * u0 * sigm(g0); h1[j] = g1 * u1 * sigm(g1); }
                if (f8out) { const float e[8] = {h0[0] * H8SCALE, h0[1] * H8SCALE, h0[2] * H8SCALE, h0[3] * H8SCALE, h1[0] * H8SCALE, h1[1] * H8SCALE, h1[2] * H8SCALE, h1[3] * H8SCALE}; *(u32x2*)((unsigned char*)hid + (size_t)row * DFF + col0) = pack8_fp8(e); }
                else *(u32x4*)(hid + (size_t)row * DFF + col0) = pack8(h0, h1); }
    }
};
struct EpiMoeDown {
    static constexpr bool PERM = true, AFTER_DRAIN = false;
    const int* rowtok; const float* roww; bf16_t* y; float oscale;
    __device__ __forceinline__ void operator()(ACC_T, const pg8::Unit& u, int wr, int wc, int fr, int fq) const {
        const int row0 = u.pm * 256 + wr * 64 + fr, col0 = u.pn * 256 + wc * 32 + 8 * fq;
        int tkv[2][4]; float wv[2][4];
#pragma unroll
        for (int ai = 0; ai < 2; ++ai)
#pragma unroll
            for (int m = 0; m < 4; ++m) { tkv[ai][m] = rowtok[row0 + ai * 128 + m * 16]; wv[ai][m] = roww[row0 + ai * 128 + m * 16]; }
#pragma unroll
        for (int ai = 0; ai < 2; ++ai)
#pragma unroll
            for (int m = 0; m < 4; ++m) { const int tk = tkv[ai][m];
                if (tk >= 0) { const float w = wv[ai][m] * oscale; bf16_t* d = y + (size_t)(tk & 1) * NTOK * DM + (size_t)(tk >> 1) * DM + col0;
#pragma unroll
                    for (int bj = 0; bj < 2; ++bj) *(u32x4*)(d + bj * 128) = pack8(acc[ai][bj][m][0] * w, acc[ai][bj][m][1] * w); } }
    }
};

struct EpiMoeTail {
    static constexpr bool PERM = true, AFTER_DRAIN = false;
    const int* rowtok; const float* roww; bf16_t* yp; float oscale;
    __device__ __forceinline__ void operator()(ACC_T, const pg8::Unit& u, int wr, int wc, int fr, int fq) const {
        const int row0 = u.pm * 256 + wr * 64 + fr, col0 = u.pn * 256 + wc * 32 + 8 * fq;
        int tkv[2][4]; float wv[2][4];
#pragma unroll
        for (int ai = 0; ai < 2; ++ai)
#pragma unroll
            for (int m = 0; m < 4; ++m) { tkv[ai][m] = rowtok[row0 + ai * 128 + m * 16]; wv[ai][m] = roww[row0 + ai * 128 + m * 16]; }
#pragma unroll
        for (int ai = 0; ai < 2; ++ai)
#pragma unroll
            for (int m = 0; m < 4; ++m) { const int row = row0 + ai * 128 + m * 16;
                if (tkv[ai][m] >= 0) { const float w = wv[ai][m] * oscale; bf16_t* d = yp + ((size_t)u.aux * 2048 + (size_t)(row - 32768)) * DM + col0;
#pragma unroll
                    for (int bj = 0; bj < 2; ++bj) *(u32x4*)(d + bj * 128) = pack8(acc[ai][bj][m][0] * w, acc[ai][bj][m][1] * w); } }
    }
};
struct Args { const float* in[22]; float* out; unsigned char* ws; int ph_lo, ph_hi; };

__host__ __device__ __forceinline__ int win_src(int n) {
    if (n < 1536) return n;
    if (n < 2048) return 1544 + (n - 1536);
    if (n < 4096) return 2056 + (n - 2048);
    if (n < 4352) return 4104 + (n - 4096);
    if (n < 4608) return 4360 + (n - 4352);
    if (n < 4672) return 4616 + (n - 4608);
    if (n < 4680) return 1536 + (n - 4672);
    if (n < 4684) return 4680 + (n - 4680);
    if (n < 4864) return -1;
    return 4684 + (n - 4864);
}

__device__ __forceinline__ void conv_item(int map, const float* W0, const float* W1, int K, int Ns, int dstN, bf16_t* WT, const float* gain, LAS float* scr, int it, int lane, float f8scale) {
    const int nblk = dstN >> 5, nit = (K >> 6) * nblk;
    if (it >= nit) return;
    {
        const int kb = it / nblk, nb = it - kb * nblk, k0 = kb << 6, n0 = nb << 5;
        const float* src = W0; int sc;
        if (map == 0) sc = n0 + (lane & 31);
        else if (map == 1) sc = win_src(n0 + (lane & 31));
        else { const int t = nb >> 3, r = nb & 7; src = (r < 4) ? W0 : W1; sc = 128 * t + 32 * (r & 3) + (lane & 31); }
        const float* sp = src + (size_t)k0 * Ns + (sc < 0 ? 0 : sc);
#pragma unroll
        for (int hh = 0; hh < 2; ++hh) { float tv[16];
#pragma unroll
            for (int i = 0; i < 16; ++i) tv[i] = __builtin_nontemporal_load(sp + (size_t)(2 * (16 * hh + i) + (lane >> 5)) * Ns);
#pragma unroll
            for (int i = 0; i < 16; ++i) scr[(2 * (16 * hh + i) + (lane >> 5)) * 33 + (lane & 31)] = (sc < 0) ? 0.f : tv[i]; }
        LDS_WAIT(); asm volatile("" ::: "memory");
        const int c = lane & 7;
        f32x4 g0 = {1.f, 1.f, 1.f, 1.f}, g1 = {1.f, 1.f, 1.f, 1.f};
        if (gain) { g0 = *(const f32x4*)(gain + k0 + 8 * c); g1 = *(const f32x4*)(gain + k0 + 8 * c + 4); }
#pragma unroll
        for (int j = 0; j < 4; ++j) { const int n = (lane >> 3) + 8 * j; const LAS float* s = scr + (8 * c) * 33 + n;
            if (f8scale != 0.f) { const float e[8] = {s[0 * 33] * g0[0] * f8scale, s[1 * 33] * g0[1] * f8scale, s[2 * 33] * g0[2] * f8scale, s[3 * 33] * g0[3] * f8scale, s[4 * 33] * g1[0] * f8scale, s[5 * 33] * g1[1] * f8scale, s[6 * 33] * g1[2] * f8scale, s[7 * 33] * g1[3] * f8scale};
                *(u32x2*)((unsigned char*)WT + (size_t)(n0 + n) * K + k0 + 8 * c) = pack8_fp8(e); }
            else {
            u32x4 o; o.x = pk2(s[0 * 33] * g0[0], s[1 * 33] * g0[1]); o.y = pk2(s[2 * 33] * g0[2], s[3 * 33] * g0[3]); o.z = pk2(s[4 * 33] * g1[0], s[5 * 33] * g1[1]); o.w = pk2(s[6 * 33] * g1[2], s[7 * 33] * g1[3]);
            *(u32x4*)(WT + (size_t)(n0 + n) * K + k0 + 8 * c) = o; } }
        LDS_WAIT(); asm volatile("" ::: "memory");
    }
}
__device__ __forceinline__ void conv_matrix(int map, const float* W0, const float* W1, int K, int Ns, int dstN, bf16_t* WT, const float* gain, LAS float* scr, int gw, int NGW, int lane, float f8scale = 0.f) {
    const int nit = (K >> 6) * (dstN >> 5);
    for (int it = gw; it < nit; it += NGW) conv_item(map, W0, W1, K, Ns, dstN, WT, gain, scr, it, lane, f8scale);
}

namespace att {
constexpr int NSLOT = 4, SLOTB = 8192, L_K = 0, L_V = NSLOT * SLOTB, L_WS = 2 * NSLOT * SLOTB, L_CS = L_WS + 2048, L_LUT = L_CS + NSLOT * 256, L_OST = L_LUT + 512, L_MW = L_OST + 8 * 4096, L_END = L_MW + 8 * NSLOT * 256;
static_assert(L_END <= 131072, "attention LDS image");
typedef short s16x4 __attribute__((ext_vector_type(4)));
constexpr float SB_CUT = 64.f;
__device__ __forceinline__ int crow(int r, int hi) { return (r & 3) + 8 * (r >> 2) + 4 * hi; }
__device__ __forceinline__ void glds16(const void* gsrc, unsigned lds_dst) { unsigned keep;
    asm volatile("s_mov_b32 %0, m0\n\ts_mov_b32 m0, %2\n\ts_nop 0\n\tglobal_load_lds_dwordx4 %1, off\n\ts_mov_b32 m0, %0" : "=&s"(keep) : "v"(gsrc), "s"(lds_dst) : "memory"); }
__device__ __forceinline__ void glds4(const void* gsrc, unsigned lds_dst) { unsigned keep;
    asm volatile("s_mov_b32 %0, m0\n\ts_mov_b32 m0, %2\n\ts_nop 0\n\tglobal_load_lds_dword %1, off\n\ts_mov_b32 m0, %0" : "=&s"(keep) : "v"(gsrc), "s"(lds_dst) : "memory"); }
#define ATT_MFMA(a, b, c) __builtin_amdgcn_mfma_f32_32x32x16_bf16(a, b, c, 0, 0, 0)
__device__ __forceinline__ void qkt(f32x16& p0, f32x16& p1, const LAS unsigned char* Kslot, const bf16x8* qr, int r32, int hi) {
    const LAS unsigned char* kb = Kslot + hi * 1024 + r32 * 16;
#pragma unroll
    for (int d0 = 0; d0 < 4; ++d0) { const bf16x8 b0 = *(const LAS bf16x8*)(kb + d0 * 2048), b1 = *(const LAS bf16x8*)(kb + d0 * 2048 + 512);
        p0 = ATT_MFMA(b0, qr[d0], p0); p1 = ATT_MFMA(b1, qr[d0], p1); }
}
__device__ __forceinline__ void pv(f32x16* o, int vb, bf16x8 pa0, bf16x8 pa1, bf16x8 pa2, bf16x8 pa3) {
#pragma unroll
    for (int d0 = 0; d0 < 2; ++d0) { s16x4 lo[4], hi[4];
#pragma unroll
        for (int ks = 0; ks < 4; ++ks) {
            asm volatile("ds_read_b64_tr_b16 %0,%1 offset:%c2" : "=&v"(lo[ks]) : "v"(vb), "i"(d0 * 4096 + ks * 1024) : "memory");
            asm volatile("ds_read_b64_tr_b16 %0,%1 offset:%c2" : "=&v"(hi[ks]) : "v"(vb), "i"(d0 * 4096 + ks * 1024 + 512) : "memory"); }
        asm volatile("s_waitcnt lgkmcnt(0)" ::: "memory"); __builtin_amdgcn_sched_barrier(0);
#define ATT_PK(k) (bf16x8){lo[k][0], lo[k][1], lo[k][2], lo[k][3], hi[k][0], hi[k][1], hi[k][2], hi[k][3]}
        o[d0] = ATT_MFMA(pa0, ATT_PK(0), o[d0]); o[d0] = ATT_MFMA(pa1, ATT_PK(1), o[d0]); o[d0] = ATT_MFMA(pa2, ATT_PK(2), o[d0]); o[d0] = ATT_MFMA(pa3, ATT_PK(3), o[d0]);
#undef ATT_PK
    }
}
__device__ __forceinline__ void kload(bf16x8 (&kf)[8], unsigned kaddr) {
#pragma unroll
    for (int d0 = 0; d0 < 4; ++d0) {
        asm volatile("ds_read_b128 %0, %1 offset:%c2" : "=&v"(kf[2 * d0]) : "v"(kaddr), "i"(d0 * 2048) : "memory");
        asm volatile("ds_read_b128 %0, %1 offset:%c2" : "=&v"(kf[2 * d0 + 1]) : "v"(kaddr), "i"(d0 * 2048 + 512) : "memory"); }
}
__device__ __forceinline__ void vload(s16x4 (&vf)[16], int vb) {
#pragma unroll
    for (int d0 = 0; d0 < 2; ++d0)
#pragma unroll
        for (int ks = 0; ks < 4; ++ks) {
            asm volatile("ds_read_b64_tr_b16 %0,%1 offset:%c2" : "=&v"(vf[d0 * 8 + ks * 2]) : "v"(vb), "i"(d0 * 4096 + ks * 1024) : "memory");
            asm volatile("ds_read_b64_tr_b16 %0,%1 offset:%c2" : "=&v"(vf[d0 * 8 + ks * 2 + 1]) : "v"(vb), "i"(d0 * 4096 + ks * 1024 + 512) : "memory"); }
}
__device__ __forceinline__ void pvmma(f32x16* o, s16x4 (&vf)[16], bf16x8 pa0, bf16x8 pa1, bf16x8 pa2, bf16x8 pa3) {
    asm volatile("s_waitcnt lgkmcnt(0)" : "+v"(vf[0]), "+v"(vf[1]), "+v"(vf[2]), "+v"(vf[3]), "+v"(vf[4]), "+v"(vf[5]), "+v"(vf[6]), "+v"(vf[7]),
                                          "+v"(vf[8]), "+v"(vf[9]), "+v"(vf[10]), "+v"(vf[11]), "+v"(vf[12]), "+v"(vf[13]), "+v"(vf[14]), "+v"(vf[15]) :: "memory");
#define ATT_PK(d, k) (bf16x8){vf[d * 8 + 2 * k][0], vf[d * 8 + 2 * k][1], vf[d * 8 + 2 * k][2], vf[d * 8 + 2 * k][3], vf[d * 8 + 2 * k + 1][0], vf[d * 8 + 2 * k + 1][1], vf[d * 8 + 2 * k + 1][2], vf[d * 8 + 2 * k + 1][3]}
    o[0] = ATT_MFMA(pa0, ATT_PK(0, 0), o[0]); o[1] = ATT_MFMA(pa0, ATT_PK(1, 0), o[1]); o[0] = ATT_MFMA(pa1, ATT_PK(0, 1), o[0]); o[1] = ATT_MFMA(pa1, ATT_PK(1, 1), o[1]);
    o[0] = ATT_MFMA(pa2, ATT_PK(0, 2), o[0]); o[1] = ATT_MFMA(pa2, ATT_PK(1, 2), o[1]); o[0] = ATT_MFMA(pa3, ATT_PK(0, 3), o[0]); o[1] = ATT_MFMA(pa3, ATT_PK(1, 3), o[1]);
#undef ATT_PK
}
__device__ __forceinline__ float hmax(float v) { const auto rr = __builtin_amdgcn_permlane32_swap(__float_as_uint(v), __float_as_uint(v), false, false); return fmaxf(__uint_as_float(rr[0]), __uint_as_float(rr[1])); }
__device__ __forceinline__ float hsum(float v) { const auto rr = __builtin_amdgcn_permlane32_swap(__float_as_uint(v), __float_as_uint(v), false, false); return __uint_as_float(rr[0]) + __uint_as_float(rr[1]); }

__device__ __forceinline__ void attn_begin(LAS unsigned char* lds, int var, int b, int h, int qb, const bf16_t* K, int pk, const bf16_t* V, int pv_, const float* c2f, const unsigned* mask) {
    int tid = threadIdx.x; asm volatile("" : "+v"(tid));
    const int lane = tid & 63, wid = __builtin_amdgcn_readfirstlane(tid >> 6);
    const size_t rowbase = (size_t)b * SEQ; const int q0 = qb * 256, NT = (q0 + 256) / 64;
    const unsigned lds0 = (unsigned)(uintptr_t)lds;
    const bf16_t* ksrc = K + rowbase * pk + h * 64 + (size_t)lane * pk + wid * 8;
    const bf16_t* vsrc = V + rowbase * pv_ + h * 64 + (size_t)(16 * (wid & 3) + (lane >> 2)) * pv_ + (wid >> 2) * 32 + (lane & 3) * 8;
#pragma unroll
    for (int i = 0; i < 2; ++i) { const int tile = (var == 1) ? NT - 1 - i : i;
        glds16(ksrc + (size_t)tile * 64 * pk, (unsigned)__builtin_amdgcn_readfirstlane(lds0 + L_K + wid * 1024 + i * SLOTB)); glds16(vsrc + (size_t)tile * 64 * pv_, (unsigned)__builtin_amdgcn_readfirstlane(lds0 + L_V + wid * 1024 + i * SLOTB));
        if (var == 0 && wid == 0) glds4(c2f + ((size_t)b * NHEAD + h) * SEQ + tile * 64 + lane, (unsigned)__builtin_amdgcn_readfirstlane(lds0 + L_CS + i * 256));
        if (var == 2) glds4(mask + (rowbase + q0 + wid * 32 + (lane >> 1)) * 64 + (lane & 1) + tile * 2, (unsigned)__builtin_amdgcn_readfirstlane(lds0 + L_MW + (wid * NSLOT + i) * 256)); }
}
template <int N> __device__ __forceinline__ void wait_bar() { asm volatile("s_waitcnt vmcnt(%0) lgkmcnt(0)\n\ts_barrier" :: "n"(N) : "memory"); }
template <int VAR, class Next> __device__ __forceinline__ void attn_unit(LAS unsigned char* lds, unsigned tnext, const Next& next, int b, int h, int qb,
        const bf16_t* Q, const bf16_t* K, int pk, const bf16_t* V, int pv_, const float* c2f, const unsigned* mask, const float* relb, const bf16_t* ogate, bf16_t* O) {
    int tid = threadIdx.x; asm volatile("" : "+v"(tid));
    const int lane = tid & 63, r32 = lane & 31, hi = lane >> 5, wid = __builtin_amdgcn_readfirstlane(tid >> 6);
    const size_t rowbase = (size_t)b * SEQ; const int q0 = qb * 256, qrel = wid * 32 + r32, t = q0 + qrel;
    const unsigned lds0 = (unsigned)(uintptr_t)lds;
    LAS float* wsf = (LAS float*)(lds + L_WS) + wid * 64;
    const bf16_t* Kh = K + rowbase * pk + h * 64; const bf16_t* Vh = V + rowbase * pv_ + h * 64;
    const bf16_t* ksrc = Kh + (size_t)lane * pk + wid * 8;
    const bf16_t* vsrc = Vh + (size_t)(16 * (wid & 3) + (lane >> 2)) * pv_ + (wid >> 2) * 32 + (lane & 3) * 8;
    const unsigned kdst = lds0 + L_K + wid * 1024, vdst = lds0 + L_V + wid * 1024;
    const int vb0 = (int)(lds0 + L_V) + ((lane >> 4) & 1) * 32 + (lane & 3) * 8 + (4 * hi + ((lane & 15) >> 2)) * 64;
    const int NT = (q0 + 256) / 64;
    const float* c2h = c2f + ((size_t)b * NHEAD + h) * SEQ;
#define ATT_DMA(tile, slot) do { glds16(ksrc + (size_t)(tile) * 64 * pk, (unsigned)__builtin_amdgcn_readfirstlane(kdst + (slot) * SLOTB)); glds16(vsrc + (size_t)(tile) * 64 * pv_, (unsigned)__builtin_amdgcn_readfirstlane(vdst + (slot) * SLOTB)); \
        if (VAR == 0 && wid == 0) glds4(c2h + (tile) * 64 + lane, (unsigned)__builtin_amdgcn_readfirstlane(lds0 + L_CS + (slot) * 256)); \
        if (VAR == 2) glds4(mrow + (tile) * 2, (unsigned)__builtin_amdgcn_readfirstlane(lds0 + L_MW + (wid * NSLOT + (slot)) * 256)); } while (0)
#define ATT_TILE(i) ((VAR == 1) ? NT - 1 - (i) : (i))
    const unsigned* mrow = nullptr; if (VAR == 2) mrow = mask + (rowbase + q0 + wid * 32 + (lane >> 1)) * 64 + (lane & 1);
    if (VAR == 2 && tid < 128) {
        int bk; if (tid < 16) bk = tid; else { bk = 16 + (int)(logf((float)tid / 16.0f) / 2.0794415416798357f * 16.0f); if (bk > 31) bk = 31; }
        ((LAS float*)(lds + L_LUT))[tid] = relb[bk * NHEAD + h] * LOG2E; }
    bf16x8 qr[4];
    { const bf16_t* Qw = Q + (rowbase + t) * 512 + h * 64;
#pragma unroll
      for (int d0 = 0; d0 < 4; ++d0) qr[d0] = *(const bf16x8*)(Qw + d0 * 16 + hi * 8); }
    float mrun = -1.0e30f, lrun = 0.f, R = 0.f; bool wdone = false;
    LAS unsigned* votes = (LAS unsigned*)(lds + L_CS);
    f32x16 o[2];
#pragma unroll
    for (int r = 0; r < 16; ++r) { o[0][r] = 0.f; o[1][r] = 0.f; }
    asm volatile("s_waitcnt vmcnt(0) lgkmcnt(0)\n\ts_barrier" ::: "memory");
#pragma unroll
    for (int d0 = 0; d0 < 4; ++d0) asm volatile("" : "+v"(qr[d0]));
#pragma unroll 1
    for (int it2 = 0; it2 < NT; it2 += 2) {
        if (it2 + 2 < NT) { ATT_DMA(ATT_TILE(it2 + 2), (it2 + 2) & (NSLOT - 1)); ATT_DMA(ATT_TILE(it2 + 3), (it2 + 3) & (NSLOT - 1)); }
#pragma unroll 1
        for (int it = it2; it < it2 + 2; ++it) {
        const int tile = ATT_TILE(it), slot = it & (NSLOT - 1);
        const bool active = (tile * 64 <= q0 + wid * 32 + 31) && !(VAR == 1 && wdone);
        if (active) {
        f32x16 p0, p1;
        if (VAR == 0) { const LAS f32x4* cs = (const LAS f32x4*)(lds + L_CS + slot * 256 + 16 * hi);
#pragma unroll
            for (int g = 0; g < 4; ++g) { const f32x4 ca = cs[2 * g], cb = cs[8 + 2 * g];
#pragma unroll
                for (int i = 0; i < 4; ++i) { p0[4 * g + i] = ca[i]; p1[4 * g + i] = cb[i]; } }
        } else {
#pragma unroll
            for (int r = 0; r < 16; ++r) { p0[r] = 0.f; p1[r] = 0.f; } }
        u32x2 mw = {0u, 0u}; float bfar = 0.f;
        if (VAR == 2) { mw = *(const LAS u32x2*)(lds + L_MW + (wid * NSLOT + slot) * 256 + r32 * 8); bfar = ((const LAS float*)(lds + L_LUT))[127]; }
        bf16x8 kf[8]; kload(kf, lds0 + L_K + slot * SLOTB + hi * 1024 + r32 * 16);
        asm volatile("s_waitcnt lgkmcnt(0)" : "+v"(kf[0]), "+v"(kf[1]), "+v"(kf[2]), "+v"(kf[3]), "+v"(kf[4]), "+v"(kf[5]), "+v"(kf[6]), "+v"(kf[7]), "+v"(mw.x), "+v"(mw.y), "+v"(bfar) :: "memory");
#pragma unroll
        for (int d0 = 0; d0 < 4; ++d0) { p0 = ATT_MFMA(kf[2 * d0], qr[d0], p0); p1 = ATT_MFMA(kf[2 * d0 + 1], qr[d0], p1); }
        s16x4 vf[16]; vload(vf, vb0 + slot * SLOTB);
        const int kv0 = tile * 64 + 4 * hi;
        const bool band = (tile * 64 + 63 > q0 + wid * 32);
        f32x16 pw0v, pw1v;
        if (VAR == 1) {
            f32x16 L0, L1;
#pragma unroll
            for (int r = 0; r < 16; ++r) { L0[r] = softplus2(p0[r]); L1[r] = softplus2(p1[r]); }
            if (band) {
#pragma unroll
                for (int r = 0; r < 16; ++r) { const int kv = kv0 + (r & 3) + 8 * (r >> 2); if (kv >= t) L0[r] = 0.f; if (kv + 32 >= t) L1[r] = 0.f; } }
            float G[8], T[8], S[8];
#pragma unroll
            for (int g = 0; g < 4; ++g) { G[g] = (L0[4 * g] + L0[4 * g + 1]) + (L0[4 * g + 2] + L0[4 * g + 3]); G[4 + g] = (L1[4 * g] + L1[4 * g + 1]) + (L1[4 * g + 2] + L1[4 * g + 3]); }
#pragma unroll
            for (int k = 0; k < 8; ++k) T[k] = hsum(G[k]);
            S[7] = 0.f;
#pragma unroll
            for (int k = 6; k >= 0; --k) S[k] = S[k + 1] + T[k + 1];
            const float tot = S[0] + T[0];
#pragma unroll
            for (int g = 0; g < 4; ++g) {
#pragma unroll
                for (int blk = 0; blk < 2; ++blk) { const int k = blk * 4 + g; const float off = R + S[k] + (hi == 0 ? T[k] - G[k] : 0.f);
                    f32x16& Lb = blk ? L1 : L0; f32x16& zb = blk ? p1 : p0; f32x16& ob = blk ? pw1v : pw0v;
                    const float e3 = Lb[4 * g + 3], e2 = e3 + Lb[4 * g + 2], e1 = e2 + Lb[4 * g + 1], e0 = e1 + Lb[4 * g];
                    ob[4 * g + 3] = __builtin_amdgcn_exp2f(zb[4 * g + 3] - (off + e3)); ob[4 * g + 2] = __builtin_amdgcn_exp2f(zb[4 * g + 2] - (off + e2));
                    ob[4 * g + 1] = __builtin_amdgcn_exp2f(zb[4 * g + 1] - (off + e1)); ob[4 * g] = __builtin_amdgcn_exp2f(zb[4 * g] - (off + e0)); } }
            if (band) {
#pragma unroll
                for (int r = 0; r < 16; ++r) { const int kv = kv0 + (r & 3) + 8 * (r >> 2); if (kv >= t) pw0v[r] = 0.f; if (kv + 32 >= t) pw1v[r] = 0.f; } }
            R += tot;
        } else {
            if (VAR == 0) {
                if (band) {
#pragma unroll
                    for (int r = 0; r < 16; ++r) { const int kv = kv0 + (r & 3) + 8 * (r >> 2); if (kv > t) p0[r] = -INFINITY; if (kv + 32 > t) p1[r] = -INFINITY; } }
            } else {
                const LAS float* lut = (const LAS float*)(lds + L_LUT);
                if (tile * 64 + 63 + 113 <= q0 + wid * 32) {
#pragma unroll
                    for (int r = 0; r < 16; ++r) { p0[r] += bfar; p1[r] += bfar; }
                } else {
#pragma unroll
                    for (int r = 0; r < 16; ++r) { const int kv = kv0 + (r & 3) + 8 * (r >> 2); int d0 = t - kv, d1 = d0 - 32; d0 = d0 < 0 ? 0 : (d0 > 127 ? 127 : d0); d1 = d1 < 0 ? 0 : (d1 > 127 ? 127 : d1);
                        p0[r] += lut[d0]; p1[r] += lut[d1]; } }
#pragma unroll
                for (int r = 0; r < 16; ++r) { const int bit = (r & 3) + 8 * (r >> 2) + 4 * hi; if (!((mw.x >> bit) & 1u)) p0[r] = -INFINITY; if (!((mw.y >> bit) & 1u)) p1[r] = -INFINITY; }
            }
            const float nmr = -mrun; f32x16 d0 = p0 + nmr, d1 = p1 + nmr;
            float rx = fmaxf(d0[0], d1[0]);
#pragma unroll
            for (int r = 1; r < 16; ++r) rx = fmaxf(rx, fmaxf(d0[r], d1[r]));
            rx = hmax(rx);
            if (__any(rx > 8.0f)) {
                float rm = fmaxf(p0[0], p1[0]);
#pragma unroll
                for (int r = 1; r < 16; ++r) rm = fmaxf(rm, fmaxf(p0[r], p1[r]));
                rm = hmax(rm);
                const float mnew = fmaxf(mrun, rm), f = __builtin_amdgcn_exp2f(mrun - mnew);
                lrun *= f; if (hi == 0) wsf[r32] = f;
                asm volatile("s_waitcnt lgkmcnt(0)" ::: "memory");
#pragma unroll
                for (int r = 0; r < 16; ++r) { const float fr = wsf[crow(r, hi)]; o[0][r] *= fr; o[1][r] *= fr; }
                mrun = mnew; const float nmn = -mnew; d0 = p0 + nmn; d1 = p1 + nmn;
            }
            float sacc = 0.f;
#pragma unroll
            for (int r = 0; r < 16; ++r) { pw0v[r] = __builtin_amdgcn_exp2f(d0[r]); pw1v[r] = __builtin_amdgcn_exp2f(d1[r]); sacc += pw0v[r] + pw1v[r]; }
            lrun += sacc;
        }
        u32x4 w0, w1, w2, w3;
        w0 = (u32x4){pk2(pw0v[0], pw0v[1]), pk2(pw0v[2], pw0v[3]), pk2(pw0v[4], pw0v[5]), pk2(pw0v[6], pw0v[7])}; w1 = (u32x4){pk2(pw0v[8], pw0v[9]), pk2(pw0v[10], pw0v[11]), pk2(pw0v[12], pw0v[13]), pk2(pw0v[14], pw0v[15])};
        w2 = (u32x4){pk2(pw1v[0], pw1v[1]), pk2(pw1v[2], pw1v[3]), pk2(pw1v[4], pw1v[5]), pk2(pw1v[6], pw1v[7])}; w3 = (u32x4){pk2(pw1v[8], pw1v[9]), pk2(pw1v[10], pw1v[11]), pk2(pw1v[12], pw1v[13]), pk2(pw1v[14], pw1v[15])};
        pvmma(o, vf, __builtin_bit_cast(bf16x8, w0), __builtin_bit_cast(bf16x8, w1), __builtin_bit_cast(bf16x8, w2), __builtin_bit_cast(bf16x8, w3));
        if (VAR == 1) wdone = !__any(R <= SB_CUT);
        }
        }
        const int vbank = (it2 >> 1) & 1;
        if (VAR == 1 && lane == 0) votes[vbank * 8 + wid] = wdone ? 1u : 0u;
        if (tid == 0) *(volatile LAS unsigned*)(lds + MISC_OFF + 260) = tnext;
        wait_bar<0>();
        if (VAR == 1) { const LAS u32x4* vp = (const LAS u32x4*)(votes + vbank * 8); const u32x4 va = vp[0], vb = vp[1]; if ((va.x & va.y & va.z & va.w & vb.x & vb.y & vb.z & vb.w) != 0u) break; }
    }
    if (VAR == 1) asm volatile("s_waitcnt vmcnt(0)\n\ts_barrier" ::: "memory");
    next();
    float linv = 1.f;
    if (VAR != 1) { const float lt = hsum(lrun); linv = 1.0f / lt; }
    if (hi == 0) wsf[32 + r32] = linv; asm volatile("s_waitcnt lgkmcnt(0)" ::: "memory");
    { LAS bf16_t* stg = (LAS bf16_t*)(lds + L_OST) + wid * 2048;
#pragma unroll
      for (int r = 0; r < 16; ++r) { const int orow = crow(r, hi); const float li = wsf[32 + orow];
#pragma unroll
          for (int d0 = 0; d0 < 2; ++d0) stg[orow * 64 + d0 * 32 + r32] = (bf16_t)(pk2(o[d0][r] * li, 0.f) & 0xffffu); }
      asm volatile("s_waitcnt lgkmcnt(0)" ::: "memory");
      bf16_t* Ow = O + (rowbase + q0 + wid * 32) * 512 + h * 64;
#pragma unroll
      for (int i = 0; i < 4; ++i) { const int row = i * 8 + (lane >> 3), ch = lane & 7; u32x4 v = *(const LAS u32x4*)(stg + row * 64 + ch * 8);
          if (VAR == 0) { const u32x4 g = *(const u32x4*)(ogate + (rowbase + q0 + wid * 32 + row) * 512 + h * 64 + ch * 8);
              v.x = pk2(bflo(v.x) * bflo(g.x), bfhi(v.x) * bfhi(g.x)); v.y = pk2(bflo(v.y) * bflo(g.y), bfhi(v.y) * bfhi(g.y)); v.z = pk2(bflo(v.z) * bflo(g.z), bfhi(v.z) * bfhi(g.z)); v.w = pk2(bflo(v.w) * bflo(g.w), bfhi(v.w) * bfhi(g.w)); }
          *(u32x4*)(Ow + (size_t)row * 512 + ch * 8) = v; } }
    asm volatile("s_waitcnt lgkmcnt(0)\n\ts_barrier" ::: "memory");
#undef ATT_DMA
#undef ATT_TILE
}
}

typedef __attribute__((address_space(4))) const char* kptr_t; typedef const float* cfp_t; typedef const __attribute__((address_space(4))) cfp_t* kslot_t;
__device__ __forceinline__ const float* arg_ptr(int i) { kptr_t ka = (kptr_t)__builtin_amdgcn_kernarg_segment_ptr(); asm volatile("" : "+s"(ka)); return *(kslot_t)(ka + 8 * i); }
#define x_in arg_ptr(0)
#define w_in arg_ptr(1)
#define b_forget arg_ptr(2)
#define q_norm arg_ptr(3)
#define k_norm arg_ptr(4)
#define kv_norm arg_ptr(5)
#define w_ukv arg_ptr(6)
#define w_br0 arg_ptr(7)
#define w_br1 arg_ptr(8)
#define w_br2 arg_ptr(9)
#define w_out arg_ptr(10)
#define rel_bias arg_ptr(11)
#define norm_mix arg_ptr(12)
#define norm_ffn arg_ptr(13)
#define w_fg arg_ptr(14)
#define w_fu arg_ptr(15)
#define w_fd arg_ptr(16)
#define w_router arg_ptr(17)
#define w_mg arg_ptr(18)
#define w_mu arg_ptr(19)
#define w_md arg_ptr(20)
#define norm_final arg_ptr(21)
#define X ((float*)arg_ptr(22))
#define WIN ((bf16_t*)(ws + WS_WIN))
#define WUKV ((bf16_t*)(ws + WS_WUKV))
#define WBR ((bf16_t*)(ws + WS_WBR))
#define WOUT ((bf16_t*)(ws + WS_WOUT))
#define WGU0 ((bf16_t*)(ws + WS_WGU0))
#define WD0 ((bf16_t*)(ws + WS_WD0))
#define WGUM ((bf16_t*)(ws + WS_WGUM))
#define WDM ((bf16_t*)(ws + WS_WDM))
#define RSTD ((float*)(ws + WS_RSTD))
#define SSP ((float*)(ws + WS_SSP))
#define XB ((bf16_t*)(ws + WS_XB))
#define Z8 ((bf16_t*)(ws + WS_Z8))
#define DLAT ((bf16_t*)(ws + WS_DLAT))
#define DIQ ((bf16_t*)(ws + WS_DIQ))
#define DIK ((bf16_t*)(ws + WS_DIK))
#define FFW ((float*)(ws + WS_FFW))
#define GATES ((bf16_t*)(ws + WS_GATES))
#define C2F ((float*)(ws + WS_C2F))
#define DKV ((bf16_t*)(ws + WS_DKV))
#define SC ((float*)(ws + WS_SC))
#define MASK ((unsigned*)(ws + WS_MASK))
#define YATT ((bf16_t*)(ws + WS_YATT))
#define MB ((bf16_t*)(ws + WS_M))
#define HID ((bf16_t*)(ws + WS_HID))
#define XG ((bf16_t*)(ws + WS_XG))
#define XB8 ((unsigned char*)(ws + WS_XB8))
#define WING8 ((unsigned char*)(ws + WS_WING8))
#define HIDM ((bf16_t*)(ws + WS_HIDM))
#define Y ((bf16_t*)(ws + WS_Y))
#define YP ((bf16_t*)(ws + WS_Y + (size_t)2 * NTOK * DM * 2))
#define POSR ((int*)(ws + WS_Y + (size_t)2 * NTOK * DM * 2 + (size_t)4 * 2048 * DM * 2))
#define ROWTOK ((int*)(ws + WS_ROWTOK))
#define ROWW ((float*)(ws + WS_ROWW))
#define RSTDG ((float*)(ws + WS_RSTDG))
#define TOKINFO ((int*)(ws + WS_TOKINFO))
#define TOKW ((float*)(ws + WS_TOKW))
#define WGCNT ((int*)(ws + WS_WGCNT))
#define META ((int*)(ws + WS_META))


struct Bg { unsigned char* ws; LAS float* scr; int l, gw, next, end, inflight; float tv[32]; f32x4 g0, g1; };
struct BgJob { int map, K, Ns, dstN, it; const float* W0; const float* W1; bf16_t* WT; const float* gain; float f8s; };
__device__ __forceinline__ BgJob bg_job(const Bg& B, int slot) {
    unsigned char* ws = B.ws; BgJob J; J.map = 0; J.K = DM; J.Ns = DM; J.dstN = DM; J.W0 = nullptr; J.W1 = nullptr; J.WT = nullptr; J.gain = nullptr; J.f8s = 0.f; int q = 0, es = -1, e = 0;
    if (B.l == 1) { e = 3 + slot / 11; es = slot - (slot / 11) * 11; }
    else if (slot >= 22) { e = (slot - 22) / 11; es = (slot - 22) - e * 11; }
    else if (slot < 7) { J.map = 2; J.W0 = w_fg; J.W1 = w_fu; J.K = DM; J.Ns = DFF; J.dstN = 2 * DFF; J.WT = WGU0; J.gain = norm_ffn; q = slot; }
    else if (slot < 11) { J.W0 = w_fd; J.K = DFF; J.Ns = DM; J.dstN = DM; J.WT = WD0; J.f8s = WD8SCALE; q = slot - 7; }
    else if (slot < 14) { J.map = 1; J.W0 = w_in + (size_t)DM * NIN; J.K = DM; J.Ns = NIN; J.dstN = 19 * 256; J.WT = WIN + (size_t)NINP * DM; J.gain = norm_mix + DM; q = slot - 11; }
    else if (slot < 17) { J.W0 = w_in + (size_t)DM * NIN + 4684; J.K = DM; J.Ns = NIN; J.dstN = 6144; J.WT = (bf16_t*)(WING8 + (size_t)6144 * DM); J.gain = norm_mix + DM; J.f8s = W8SCALE; q = slot - 14; }
    else if (slot == 17) { J.W0 = w_ukv + (size_t)KVR * 1024; J.K = KVR; J.Ns = 1024; J.dstN = 1024; J.WT = WUKV + (size_t)1024 * KVR; J.gain = kv_norm + KVR; }
    else if (slot < 21) { const int i = slot - 18; J.W0 = (i == 0 ? w_br0 : (i == 1 ? w_br1 : w_br2)) + (size_t)WBR_W * DM; J.K = WBR_W; J.Ns = DM; J.dstN = DM; J.WT = WBR + (size_t)(3 + i) * DM * WBR_W; }
    else { J.W0 = w_out + (size_t)DM * DM; J.K = DM; J.Ns = DM; J.dstN = DM; J.WT = WOUT + (size_t)DM * DM; }
    if (es >= 0) {
        if (es < 7) { J.map = 2; J.W0 = w_mg + (size_t)e * DM * DFF; J.W1 = w_mu + (size_t)e * DM * DFF; J.K = DM; J.Ns = DFF; J.dstN = 2 * DFF; J.WT = (bf16_t*)((unsigned char*)WGUM + (size_t)e * 2 * DFF * DM); J.gain = norm_ffn + DM; J.f8s = W8SCALE; q = es; }
        else { J.W0 = w_md + (size_t)e * DFF * DM; J.K = DFF; J.Ns = DM; J.dstN = DM; J.WT = (bf16_t*)((unsigned char*)WDM + (size_t)e * DM * DFF); J.f8s = WD8SCALE; q = es - 7; } }
    J.it = B.gw + q * 2048; return J;
}
__device__ __forceinline__ void bg_src(const BgJob& J, int lane, const char*& ub, unsigned& loff, int& sc, int& k0, int& n0) {
    const int nblk = J.dstN >> 5, kb = J.it / nblk, nb = J.it - kb * nblk; k0 = kb << 6; n0 = nb << 5; const float* src = J.W0; int scu;
    if (J.map == 0) { scu = n0; sc = n0 + (lane & 31); }
    else if (J.map == 1) { scu = 0; sc = win_src(n0 + (lane & 31)); }
    else { const int t = nb >> 3, r = nb & 7; src = (r < 4) ? J.W0 : J.W1; scu = 128 * t + 32 * (r & 3); sc = scu + (lane & 31); }
    ub = (const char*)(src + (size_t)k0 * J.Ns + scu); loff = (unsigned)(((lane >> 5) * J.Ns + ((sc < 0 ? 0 : sc) - scu)) * 4);
}
__device__ __forceinline__ bool bg_issue(Bg& B, int slot, bool want, int lane) {
    const BgJob J = bg_job(B, slot); const bool valid = want && J.it < (J.K >> 6) * (J.dstN >> 5);
    const char* ub; unsigned loff; int sc, k0, n0; bg_src(J, lane, ub, loff, sc, k0, n0); size_t rs2 = (size_t)J.Ns * 8;
    if (!valid) { ub = (const char*)norm_ffn; loff = (unsigned)(lane * 4); rs2 = 256; }
    B.g0 = (f32x4){1.f, 1.f, 1.f, 1.f}; B.g1 = B.g0; if (valid && J.gain) { B.g0 = *(const f32x4*)(J.gain + k0 + 8 * (lane & 7)); B.g1 = *(const f32x4*)(J.gain + k0 + 8 * (lane & 7) + 4); }
#pragma unroll
    for (int i = 0; i < 32; ++i) B.tv[i] = __builtin_nontemporal_load((const float*)(ub + (size_t)i * rs2 + loff));
    return valid;
}
__device__ __forceinline__ void bg_finish(Bg& B, int slot, int lane) {
    const BgJob J = bg_job(B, slot); const char* ub; unsigned loff; int sc, k0, n0; bg_src(J, lane, ub, loff, sc, k0, n0); LAS float* scr = B.scr; const int K = J.K;
#pragma unroll
    for (int i = 0; i < 32; ++i) scr[(2 * i + (lane >> 5)) * 33 + (lane & 31)] = (sc < 0) ? 0.f : B.tv[i];
    LDS_WAIT(); asm volatile("" ::: "memory");
    const int c = lane & 7; const float f8scale = J.f8s;
    const f32x4 g0 = B.g0, g1 = B.g1;
#pragma unroll
    for (int j = 0; j < 4; ++j) { const int n = (lane >> 3) + 8 * j; const LAS float* s = scr + (8 * c) * 33 + n;
        if (f8scale != 0.f) { const float e[8] = {s[0 * 33] * g0[0] * f8scale, s[1 * 33] * g0[1] * f8scale, s[2 * 33] * g0[2] * f8scale, s[3 * 33] * g0[3] * f8scale, s[4 * 33] * g1[0] * f8scale, s[5 * 33] * g1[1] * f8scale, s[6 * 33] * g1[2] * f8scale, s[7 * 33] * g1[3] * f8scale};
            __builtin_nontemporal_store(pack8_fp8(e), (u32x2*)((unsigned char*)J.WT + (size_t)(n0 + n) * K + k0 + 8 * c)); }
        else { u32x4 o; o.x = pk2(s[0 * 33] * g0[0], s[1 * 33] * g0[1]); o.y = pk2(s[2 * 33] * g0[2], s[3 * 33] * g0[3]); o.z = pk2(s[4 * 33] * g1[0], s[5 * 33] * g1[1]); o.w = pk2(s[6 * 33] * g1[2], s[7 * 33] * g1[3]);
            __builtin_nontemporal_store(o, (u32x4*)(J.WT + (size_t)(n0 + n) * K + k0 + 8 * c)); } }
    LDS_WAIT(); asm volatile("" ::: "memory");
}
__device__ __forceinline__ void bg_tick(Bg& B, int lane) {
    if (B.inflight >= 0) { bg_finish(B, B.inflight, lane); B.inflight = -1; }
    const bool want = B.next < B.end; const int slot = want ? B.next : B.end - 1;
    if (bg_issue(B, slot, want, lane)) B.inflight = slot;
    if (want) ++B.next;
}

template <int NJ> __device__ __forceinline__ void select_core(const float* sc_row, unsigned* mask_row, int t, int lane, LAS unsigned* hist, Bg& B) {
    unsigned key[NJ];
#pragma unroll
    for (int j = 0; j < NJ; ++j) { const int s = 64 * j + lane; const unsigned u = __float_as_uint(sc_row[s <= t ? s : t]); const unsigned k = (u & 0x80000000u) ? ~u : (u | 0x80000000u); key[j] = (s <= t) ? k : 0u; }
    unsigned prefix = 0u; int need = 256;
#pragma unroll
    for (int lv = 0; lv < 4; ++lv) { const int shift = 24 - 8 * lv; const unsigned pmask = (lv == 0) ? 0u : (0xffffffffu << (shift + 8));
        { unsigned zz = 0u; asm volatile("" : "+v"(zz)); *(LAS u32x4*)(hist + 4 * lane) = (u32x4){zz, zz, zz, zz}; }
#pragma unroll
        for (int j = 0; j < NJ; ++j) if (key[j] != 0u && (key[j] & pmask) == prefix) atomicAdd((unsigned*)(hist + ((key[j] >> shift) & 255u)), 1u);
        const u32x4 hv = *(const LAS u32x4*)(hist + 4 * lane);
        const int mys = (int)(hv.x + hv.y + hv.z + hv.w); int inc = mys;
#pragma unroll
        for (int o = 1; o < 64; o <<= 1) { const int tv = __shfl_down(inc, o); if (lane + o < 64) inc += tv; }
        const int c3 = inc - mys, c2 = c3 + (int)hv.w, c1 = c2 + (int)hv.z, c0 = c1 + (int)hv.y;
        int fd = -1, fc = 0;
        if (c3 < need && need <= c3 + (int)hv.w) { fd = 3; fc = c3; } else if (c2 < need && need <= c2 + (int)hv.z) { fd = 2; fc = c2; }
        else if (c1 < need && need <= c1 + (int)hv.y) { fd = 1; fc = c1; } else if (c0 < need && need <= c0 + (int)hv.x) { fd = 0; fc = c0; }
        const unsigned long long fb = __ballot(fd >= 0); const int src = (int)__builtin_ctzll(fb | (1ull << 63));
        const int D = __shfl(4 * lane + fd, src), CA = __shfl(fc, src);
        prefix |= (unsigned)D << shift; need -= CA;
        bg_tick(B, lane);
    }
    const unsigned T = prefix;
    int run = 0; unsigned myw = 0u;
#pragma unroll
    for (int j = 0; j < NJ; ++j) { const bool eq = key[j] == T; const unsigned long long beq = __ballot(eq);
        const int pre = run + (int)__builtin_amdgcn_mbcnt_hi((unsigned)(beq >> 32), __builtin_amdgcn_mbcnt_lo((unsigned)beq, 0u));
        const bool sel = (key[j] > T) || (eq && pre < need); run += __popcll(beq);
        const unsigned long long bs = __ballot(sel); myw = (lane == 2 * j) ? (unsigned)bs : myw; myw = (lane == 2 * j + 1) ? (unsigned)(bs >> 32) : myw; }
    mask_row[lane] = myw;
    bg_tick(B, lane);
}
__device__ __forceinline__ void select_row(const float* sc_row, unsigned* mask_row, int t, int lane, LAS unsigned* hist, Bg& B) {
    asm volatile("" : "+v"(lane));
    if (t < 256) { const int lo = 32 * lane; mask_row[lane] = (t >= lo + 31) ? 0xffffffffu : (t < lo ? 0u : ((2u << (t - lo)) - 1u)); return; }
    if (t < 512) select_core<8>(sc_row, mask_row, t, lane, hist, B);
    else if (t < 1024) select_core<16>(sc_row, mask_row, t, lane, hist, B);
    else if (t < 1536) select_core<24>(sc_row, mask_row, t, lane, hist, B);
    else select_core<32>(sc_row, mask_row, t, lane, hist, B);
}

__global__ void __launch_bounds__(512, 2) mk_fwd(Args args) {
    extern __shared__ __attribute__((aligned(16))) unsigned char lds_raw[];
    LAS unsigned char* lds = (LAS unsigned char*)lds_raw;
    volatile LAS unsigned* MISC = (volatile LAS unsigned*)(lds + MISC_OFF);
    constexpr int G = 256, NGW = G * 8;
    const int bid = blockIdx.x; __builtin_assume(bid >= 0 && bid < G);
    unsigned* ctl = (unsigned*)((unsigned char*)arg_ptr(23) + WS_CTL);
    for (int u = threadIdx.x; u < (LDS_BYTES - LDSCTL_OFF) / 4; u += 512) ((LAS unsigned*)(lds + LDSCTL_OFF))[u] = 0u;
#define SITE_PROLOG unsigned char* ws = (unsigned char*)arg_ptr(23); int tid = threadIdx.x; asm volatile("" : "+v"(tid)); \
    const int lane = tid & 63, wave = __builtin_amdgcn_readfirstlane(tid >> 6), gw = bid * 8 + wave; (void)ws; (void)lane; (void)gw;
    __syncthreads();
#if MK_ONE_LAUNCH && DBG_STOP < 0
    constexpr int lo = 0, hi = NSTEPS;
#else
    const int lo = args.ph_lo, hi = args.ph_hi;
#endif
    XcdBarrier bar; bar.bar = ctl + CW_BAR; bar.x = 0; bar.st = nullptr;
    if (hi - lo > 1) bar = xcd_barrier_post(ctl + CW_BAR, MISC + 8);
    int step = 0;
#define STEP_IF if (step >= lo && step < hi)
#ifndef PROBE_AMP
#define PROBE_AMP 1ull
#endif
#ifdef PROBE_MASK
    unsigned long long pr_prev = wall_clock64(), pr_acc = 0ull;
#define STEP_END do { if (step >= lo && step + 1 < hi) xcd_barrier(bar); { const unsigned long long pr_t = wall_clock64(); if ((PROBE_MASK >> step) & 1u) pr_acc += pr_t - pr_prev; pr_prev = pr_t; } ++step; } while (0)
#else
#define STEP_END do { if (step >= lo && step + 1 < hi) xcd_barrier(bar); ++step; } while (0)
#endif

    if (SITE_ON(0)) STEP_IF { SITE_PROLOG
        LAS float* scr = (LAS float*)(lds + wave * 16384);
        { const int l = 0;
            conv_matrix(1, w_in + (size_t)l * DM * NIN, nullptr, DM, NIN, 19 * 256, WIN + (size_t)l * NINP * DM, norm_mix + l * DM, scr, gw, NGW, lane);
            conv_matrix(0, w_in + (size_t)l * DM * NIN + 4684, nullptr, DM, NIN, 6144, (bf16_t*)(WING8 + (size_t)l * 6144 * DM), norm_mix + l * DM, scr, gw, NGW, lane, W8SCALE);
            conv_matrix(0, w_ukv + (size_t)l * KVR * 1024, nullptr, KVR, 1024, 1024, WUKV + (size_t)l * 1024 * KVR, kv_norm + l * KVR, scr, gw, NGW, lane);
            conv_matrix(0, w_br0 + (size_t)l * WBR_W * DM, nullptr, WBR_W, DM, DM, WBR + (size_t)(l * 3 + 0) * DM * WBR_W, nullptr, scr, gw, NGW, lane);
            conv_matrix(0, w_br1 + (size_t)l * WBR_W * DM, nullptr, WBR_W, DM, DM, WBR + (size_t)(l * 3 + 1) * DM * WBR_W, nullptr, scr, gw, NGW, lane);
            conv_matrix(0, w_br2 + (size_t)l * WBR_W * DM, nullptr, WBR_W, DM, DM, WBR + (size_t)(l * 3 + 2) * DM * WBR_W, nullptr, scr, gw, NGW, lane);
            conv_matrix(0, w_out + (size_t)l * DM * DM, nullptr, DM, DM, DM, WOUT + (size_t)l * DM * DM, nullptr, scr, gw, NGW, lane);
        }
        for (int m = gw; m < NTOK; m += NGW) {
            const f32x4* xr = (const f32x4*)(x_in + (size_t)m * DM) + lane; f32x4 v[8]; float s = 0.f;
#pragma unroll
            for (int j = 0; j < 8; ++j) { v[j] = xr[64 * j]; s += (v[j][0] * v[j][0] + v[j][1] * v[j][1]) + (v[j][2] * v[j][2] + v[j][3] * v[j][3]); }
            s = wave_sum(s);
            u32x2* o = (u32x2*)(XB + (size_t)m * DM) + lane;
#pragma unroll
            for (int j = 0; j < 8; ++j) { u32x2 w; w.x = pk2(v[j][0], v[j][1]); w.y = pk2(v[j][2], v[j][3]); o[64 * j] = w; }
            { unsigned* o8 = (unsigned*)(XB8 + (size_t)m * DM) + lane;
#pragma unroll
              for (int j = 0; j < 8; ++j) { const float c0 = __builtin_amdgcn_fmed3f(v[j][0], -448.f, 448.f), c1 = __builtin_amdgcn_fmed3f(v[j][1], -448.f, 448.f), c2 = __builtin_amdgcn_fmed3f(v[j][2], -448.f, 448.f), c3 = __builtin_amdgcn_fmed3f(v[j][3], -448.f, 448.f);
                  int w = __builtin_amdgcn_cvt_pk_fp8_f32(c0, c1, 0, false); w = __builtin_amdgcn_cvt_pk_fp8_f32(c2, c3, w, true); o8[64 * j] = (unsigned)w; } }
            if (lane == 0) RSTD[m] = 1.0f / sqrtf(s * (1.0f / DM) + EPS);
        }
    }
    STEP_END;

    for (int l = 0; l < 2; ++l) {
        if (SITE_ON(1)) STEP_IF { SITE_PROLOG
            { pg8::PlainOrder S; S.init(NTOK / 256, 19, G, bid); S.A = (const char*)XB; S.ta = (size_t)256 * DM * 2; S.B = (const char*)(WIN + (size_t)l * NINP * DM); S.tb = (size_t)256 * DM * 2;
              EpiWin E{RSTD, Z8, DLAT, DIQ, DIK, FFW, GATES};
              pg8::gemm_phase<EpiWin, pg8::PlainOrder, true, true>(lds, pg8::Gemm{opq(DM), 0}, S, E); }
            { pg8::PlainOrder S; S.init(NTOK / 256, 24, G, bid); S.A = (const char*)XB8; S.ta = (size_t)256 * DM; S.B = (const char*)(WING8 + (size_t)l * 6144 * DM); S.tb = (size_t)256 * DM;
              EpiGate E{RSTD, GATES, 1.0f / W8SCALE};
              pg8::gemm_phase8<EpiGate, pg8::PlainOrder, true, true>(lds, pg8::Gemm{opq(DM / 2), 0}, S, E); }
        }
        STEP_END;
        if (SITE_ON(2)) STEP_IF { SITE_PROLOG
            for (int m = gw; m < NTOK; m += NGW) {
#pragma unroll
                for (int which = 0; which < 2; ++which) {
                    bf16_t* p = Z8 + (size_t)which * NTOK * 512 + (size_t)m * 512 + 8 * lane; const u32x4 w = *(const u32x4*)p;
                    float v[8] = {bflo(w.x), bfhi(w.x), bflo(w.y), bfhi(w.y), bflo(w.z), bfhi(w.z), bflo(w.w), bfhi(w.w)}; float ss = 0.f;
#pragma unroll
                    for (int i = 0; i < 8; ++i) ss += v[i] * v[i];
                    ss += __shfl_xor(ss, 1); ss += __shfl_xor(ss, 2); ss += __shfl_xor(ss, 4);
                    const float rs = (1.0f / sqrtf(ss * (1.0f / 64.0f) + EPS)) * (which == 0 ? C2 : 1.0f);
                    const float* gp = (which == 0 ? q_norm : k_norm) + l * HD + 8 * (lane & 7); const f32x4 g0 = *(const f32x4*)gp, g1 = *(const f32x4*)(gp + 4);
                    u32x4 o; o.x = pk2(v[0] * rs * g0[0], v[1] * rs * g0[1]); o.y = pk2(v[2] * rs * g0[2], v[3] * rs * g0[3]); o.z = pk2(v[4] * rs * g1[0], v[5] * rs * g1[1]); o.w = pk2(v[6] * rs * g1[2], v[7] * rs * g1[3]);
                    *(u32x4*)p = o;
                }
                { bf16_t* p = DLAT + (size_t)m * 256 + 4 * lane; const u32x2 w = *(const u32x2*)p; const float a0 = bflo(w.x), a1 = bfhi(w.x), a2 = bflo(w.y), a3 = bfhi(w.y);
                  const float ss = wave_sum((a0 * a0 + a1 * a1) + (a2 * a2 + a3 * a3)); const float rs = 1.0f / sqrtf(ss * (1.0f / 256.0f) + EPS);
                  u32x2 o; o.x = pk2(a0 * rs, a1 * rs); o.y = pk2(a2 * rs, a3 * rs); *(u32x2*)p = o; }
            }
            if (bid < NBATCH * NHEAD) {
                const int b = bid >> 3, h = bid & 7; const float bias = b_forget[l * NHEAD + h]; LAS float* wt = (LAS float*)lds;
                const float* fp = FFW + ((size_t)b * SEQ + 4 * tid) * 16 + h; float v[4]; float tot = 0.f;
#pragma unroll
                for (int i = 0; i < 4; ++i) { tot += -softplus2(-(fp[i * 16] + bias) * LOG2E); v[i] = tot; }
                float inc = tot;
#pragma unroll
                for (int o = 1; o < 64; o <<= 1) { const float tv = __shfl_up(inc, o); if (lane >= o) inc += tv; }
                __syncthreads(); if (lane == 63) wt[wave] = inc; __syncthreads();
                float base = inc - tot;
                for (int w = 0; w < wave; ++w) base += wt[w];
                *(f32x4*)(C2F + ((size_t)b * NHEAD + h) * SEQ + 4 * tid) = (f32x4){-(base + v[0]), -(base + v[1]), -(base + v[2]), -(base + v[3])};
            }
            {
                const int id = bid * 8 + wave, b = id >> 8, rr = id & 255;
                int g, base; if (rr < 10) { g = 0; base = 0; } else if (rr < 30) { g = 1; base = 10; } else if (rr < 60) { g = 2; base = 30; } else if (rr < 100) { g = 3; base = 60; } else if (rr < 150) { g = 4; base = 100; } else if (rr < 210) { g = 5; base = 150; } else { g = 6; base = 210; }
                const int off = rr - base, tt = 10 * g + off / (g + 1), cch = off - (off / (g + 1)) * (g + 1);
                if (rr < 238) {
                int ln = lane; asm volatile("" : "+v"(ln)); const int r32 = ln & 31, hh = ln >> 5; const size_t trow = (size_t)b * SEQ + tt * 32 + r32;
                bf16x8 bq[4][4];
#pragma unroll
                for (int h = 0; h < 4; ++h)
#pragma unroll
                    for (int d0 = 0; d0 < 4; ++d0) bq[h][d0] = *(const bf16x8*)(DIQ + trow * 256 + h * 64 + d0 * 16 + 8 * hh);
                const f32x4 wv = *(const f32x4*)(FFW + trow * 16 + 8) * 0.0625f;
                const int st0 = cch * 10, st1 = (st0 + 9 < tt) ? st0 + 9 : tt;
                bf16x8 ak[4], an[4];
                { const size_t srow = (size_t)b * SEQ + st0 * 32 + r32;
#pragma unroll
                  for (int d0 = 0; d0 < 4; ++d0) an[d0] = *(const bf16x8*)(DIK + srow * 64 + d0 * 16 + 8 * hh); }
                for (int st = st0; st <= st1; ++st) {
#pragma unroll
                    for (int d0 = 0; d0 < 4; ++d0) ak[d0] = an[d0];
                    { const int sn = (st < st1) ? st + 1 : st; const size_t srow = (size_t)b * SEQ + sn * 32 + r32;
#pragma unroll
                      for (int d0 = 0; d0 < 4; ++d0) an[d0] = *(const bf16x8*)(DIK + srow * 64 + d0 * 16 + 8 * hh); }
                    f32x16 sc;
#pragma unroll
                    for (int r = 0; r < 16; ++r) sc[r] = 0.f;
#pragma unroll
                    for (int h = 0; h < 4; ++h) { f32x16 a;
#pragma unroll
                        for (int r = 0; r < 16; ++r) a[r] = 0.f;
#pragma unroll
                        for (int d0 = 0; d0 < 4; ++d0) a = __builtin_amdgcn_mfma_f32_32x32x16_bf16(ak[d0], bq[h][d0], a, 0, 0, 0);
#pragma unroll
                        for (int r = 0; r < 16; ++r) sc[r] += fmaxf(a[r], 0.f) * wv[h]; }
                    float* sp = SC + trow * SEQ + st * 32 + 4 * hh;
#pragma unroll
                    for (int g = 0; g < 4; ++g) *(f32x4*)(sp + 8 * g) = (f32x4){sc[4 * g], sc[4 * g + 1], sc[4 * g + 2], sc[4 * g + 3]};
                }
                }
            }
        }
        STEP_END;
        if (SITE_ON(3)) STEP_IF { SITE_PROLOG
            { pg8::PlainOrder S; S.init(NTOK / 256, 4, G, bid); S.A = (const char*)DLAT; S.ta = (size_t)256 * KVR * 2; S.B = (const char*)(WUKV + (size_t)l * 1024 * KVR); S.tb = (size_t)256 * KVR * 2;
              EpiPlain E{DKV, 1024};
              pg8::gemm_phase<EpiPlain, pg8::PlainOrder, true, true>(lds, pg8::Gemm{opq(KVR), 0}, S, E); }
        }
        STEP_END;
        if (SITE_ON(4)) STEP_IF { SITE_PROLOG
            Bg B; B.ws = ws; B.scr = (LAS float*)(lds + 16384 + wave * 8704); B.l = l; B.gw = gw; B.next = 0; B.end = 55; B.inflight = -1; B.g0 = (f32x4){1.f, 1.f, 1.f, 1.f}; B.g1 = B.g0;
#pragma unroll
            for (int i = 0; i < 32; ++i) B.tv[i] = 0.f;
            for (int k = 0; k < 8; ++k) { const int idx = gw + k * NGW; const int b = idx / SEQ, t0 = idx - b * SEQ, t = (b & 1) ? SEQ - 1 - t0 : t0; const size_t row = (size_t)b * SEQ + t;
                select_row(SC + row * SEQ, MASK + row * 64, t, lane, (LAS unsigned*)(lds + wave * 1024), B);
                const int upto = ((k + 1) * 55) >> 3;
                while (B.next < upto) bg_tick(B, lane); }
            while (B.inflight >= 0 || B.next < B.end) bg_tick(B, lane);
        }
        STEP_END;
        if (SITE_ON(5)) STEP_IF { SITE_PROLOG
            const int xq = bid & 7; unsigned* qctr = ctl + CW_ATTQ + (l * 8 + xq) * 32;
            unsigned ticket = 0u; if (tid == 0) ticket = __hip_atomic_fetch_add(qctr, 1u, __ATOMIC_RELAXED, __HIP_MEMORY_SCOPE_AGENT);
            if (tid == 0) MISC[65] = ticket;
            __syncthreads();
            unsigned u = MISC[65];
#define ATT_DECODE(uu, var, qb, hh) int var, qb, hh; if ((uu) < 64u) { var = 1; qb = 7 - (int)((uu) >> 3); hh = (int)((uu) & 7u); } else { const unsigned v_ = (uu) - 64u; qb = 7 - (int)(v_ >> 4); var = (v_ & 1u) ? 2 : 0; hh = (int)((v_ >> 1) & 7u); }
#define ATT_BEGIN(var, b, hh, qb) do { if (var == 0) att::attn_begin(lds, 0, b, hh, qb, Z8 + (size_t)1 * NTOK * 512, 512, Z8 + (size_t)2 * NTOK * 512, 512, C2F, nullptr); \
                else if (var == 1) att::attn_begin(lds, 1, b, hh, qb, Z8 + (size_t)5 * NTOK * 512, 512, Z8 + (size_t)6 * NTOK * 512, 512, nullptr, nullptr); \
                else att::attn_begin(lds, 2, b, hh, qb, DKV, 1024, DKV + 512, 1024, nullptr, MASK); } while (0)
            const int b = xq;
            if (u < 192u) { ATT_DECODE(u, var0, qb0, h0) ATT_BEGIN(var0, b, h0, qb0); }
            while (u < 192u) {
                ATT_DECODE(u, var, qb, h)
                if (tid == 0) ticket = __hip_atomic_fetch_add(qctr, 1u, __ATOMIC_RELAXED, __HIP_MEMORY_SCOPE_AGENT);
                unsigned unext = 192u;
                auto next = [&]() { unext = MISC[65]; if (unext < 192u) { ATT_DECODE(unext, varn, qbn, hn) ATT_BEGIN(varn, b, hn, qbn); } };
#ifdef ATT_PROBE_VAR
                const unsigned long long pa_t0 = wall_clock64();
#endif
                if (var == 0) att::attn_unit<0>(lds, ticket, next, b, h, qb, Z8, Z8 + (size_t)1 * NTOK * 512, 512, Z8 + (size_t)2 * NTOK * 512, 512, C2F, nullptr, nullptr, Z8 + (size_t)3 * NTOK * 512, YATT);
                else if (var == 1) att::attn_unit<1>(lds, ticket, next, b, h, qb, Z8 + (size_t)4 * NTOK * 512, Z8 + (size_t)5 * NTOK * 512, 512, Z8 + (size_t)6 * NTOK * 512, 512, nullptr, nullptr, nullptr, nullptr, YATT + (size_t)NTOK * 512);
                else att::attn_unit<2>(lds, ticket, next, b, h, qb, Z8 + (size_t)7 * NTOK * 512, DKV, 1024, DKV + 512, 1024, nullptr, MASK, rel_bias, nullptr, YATT + (size_t)2 * NTOK * 512);
#ifdef ATT_PROBE_VAR
                if (var == ATT_PROBE_VAR) pr_acc += wall_clock64() - pa_t0;
#endif
                u = unext;
            }
#undef ATT_DECODE
#undef ATT_BEGIN
        }
        STEP_END;
        if (SITE_ON(6)) STEP_IF { SITE_PROLOG
            pg8::BranchOrder S; S.init(NTOK / 256, DM / 256, G, bid); S.A = (const char*)YATT; S.ta = (size_t)256 * WBR_W * 2; S.za = (size_t)NTOK * WBR_W * 2;
            S.B = (const char*)(WBR + (size_t)l * 3 * DM * WBR_W); S.tb = (size_t)256 * WBR_W * 2; S.zb = (size_t)DM * WBR_W * 2;
            EpiBranch E{GATES, MB};
            pg8::gemm_phase_carry<EpiBranch, pg8::BranchOrder, true, true>(lds, pg8::Gemm{opq(WBR_W), 0}, S, E);
        }
        STEP_END;
        if (SITE_ON(7)) STEP_IF { SITE_PROLOG
            pg8::PlainOrder S; S.init(NTOK / 256, DM / 256, G, bid); S.A = (const char*)MB; S.ta = (size_t)256 * DM * 2; S.B = (const char*)(WOUT + (size_t)l * DM * DM); S.tb = (size_t)256 * DM * 2;
            EpiResid E{l == 0 ? x_in : (const float*)X, X, l == 0 ? XB : nullptr, SSP, l == 0 ? nullptr : XB8, 1.0f};
            pg8::gemm_phase<EpiResid, pg8::PlainOrder, true, true>(lds, pg8::Gemm{opq(DM), 0}, S, E);
        }
        STEP_END;
        if (l == 0) {
            if (SITE_ON(8)) STEP_IF { SITE_PROLOG for (int r = bid * 512 + tid; r < NTOK; r += G * 512) { const f32x4* p = (const f32x4*)(SSP + (size_t)r * 32); float s = 0.f;
#pragma unroll
                    for (int j = 0; j < 8; ++j) { const f32x4 v = p[j]; s += (v[0] + v[1]) + (v[2] + v[3]); }
                    RSTD[r] = 1.0f / sqrtf(s * (1.0f / DM) + EPS); } }
            STEP_END;
            if (SITE_ON(9)) STEP_IF { SITE_PROLOG
                pg8::PlainOrder S; S.init(NTOK / 256, DFF / 128, G, bid); S.A = (const char*)XB; S.ta = (size_t)256 * DM * 2; S.B = (const char*)WGU0; S.tb = (size_t)256 * DM * 2;
                EpiSwiglu E{RSTD, HID, 1.0f, 1};
                pg8::gemm_phase<EpiSwiglu, pg8::PlainOrder, true, true>(lds, pg8::Gemm{opq(DM), 0}, S, E);
            }
            STEP_END;
            if (SITE_ON(10)) STEP_IF { SITE_PROLOG
                pg8::PlainOrder S; S.init(NTOK / 256, DM / 256, G, bid); S.A = (const char*)HID; S.ta = (size_t)256 * DFF; S.B = (const char*)WD0; S.tb = (size_t)256 * DFF;
                EpiResid E{X, X, XB, SSP, XB8, 1.0f / (WD8SCALE * H8SCALE)};
                pg8::gemm_phase8<EpiResid, pg8::PlainOrder, true, true>(lds, pg8::Gemm{opq(DFF / 2), 0}, S, E);
            }
            STEP_END;
            if (SITE_ON(11)) STEP_IF { SITE_PROLOG for (int r = bid * 512 + tid; r < NTOK; r += G * 512) { const f32x4* p = (const f32x4*)(SSP + (size_t)r * 32); float s = 0.f;
#pragma unroll
                    for (int j = 0; j < 8; ++j) { const f32x4 v = p[j]; s += (v[0] + v[1]) + (v[2] + v[3]); }
                    RSTD[r] = 1.0f / sqrtf(s * (1.0f / DM) + EPS); } }
            STEP_END;
        } else {
            if (SITE_ON(12)) STEP_IF { SITE_PROLOG
                LAS int* le = (LAS int*)lds;
                for (int wgi = bid; wgi < NTOK / 64; wgi += G) {
                    __syncthreads();
                    {
                        const int tok = wgi * 64 + lane; const float* xr = X + (size_t)tok * DM + 256 * wave;
                        const float* gp = norm_ffn + DM + 256 * wave; const float* wp = w_router + (size_t)(256 * wave) * 8;
                        float lg[8]; float ss = 0.f;
#pragma unroll
                        for (int e = 0; e < 8; ++e) lg[e] = 0.f;
#pragma unroll 1
                        for (int k8 = 0; k8 < 8; ++k8) { f32x4 xv[8];
#pragma unroll
                            for (int j = 0; j < 8; ++j) xv[j] = *(const f32x4*)(xr + 32 * k8 + 4 * j);
#pragma unroll
                            for (int j = 0; j < 8; ++j)
#pragma unroll
                                for (int c = 0; c < 4; ++c) { const int k = 32 * k8 + 4 * j + c; const float xv1 = xv[j][c]; ss += xv1 * xv1; const float xg = xv1 * gp[k]; const float* wr = wp + k * 8;
#pragma unroll
                                    for (int e = 0; e < 8; ++e) lg[e] += xg * wr[e]; } }
                        LAS float* part = (LAS float*)(lds + 1024) + (wave * 64 + lane) * 9;
#pragma unroll
                        for (int e = 0; e < 8; ++e) part[e] = lg[e];
                        part[8] = ss;
                        __syncthreads();
                        if (wave == 0) { float L[8]; float S = 0.f;
#pragma unroll
                            for (int e = 0; e < 8; ++e) L[e] = 0.f;
                            for (int w = 0; w < 8; ++w) { const LAS float* pp = (const LAS float*)(lds + 1024) + (w * 64 + lane) * 9;
#pragma unroll
                                for (int e = 0; e < 8; ++e) L[e] += pp[e];
                                S += pp[8]; }
                            const float rs = 1.0f / sqrtf(S * (1.0f / DM) + EPS);
#pragma unroll
                            for (int e = 0; e < 8; ++e) L[e] *= rs;
                            float v0 = L[0]; int i0 = 0;
#pragma unroll
                            for (int e = 1; e < 8; ++e) if (L[e] > v0) { v0 = L[e]; i0 = e; }
                            float v1 = -INFINITY; int i1 = 0;
#pragma unroll
                            for (int e = 0; e < 8; ++e) if (e != i0 && L[e] > v1) { v1 = L[e]; i1 = e; }
                            const float ex = __expf(v1 - v0), w0 = 1.0f / (1.0f + ex), w1 = ex / (1.0f + ex);
                            le[lane * 2] = i0; le[lane * 2 + 1] = i1; TOKW[(size_t)tok * 2] = w0; TOKW[(size_t)tok * 2 + 1] = w1; RSTD[tok] = rs; }
                    }
                    __syncthreads();
                    if (tid < 128) { const int e = le[tid]; int rk = 0; for (int j = 0; j < tid; ++j) rk += (le[j] == e); const int tok = wgi * 64 + (tid >> 1);
                        TOKINFO[((size_t)tok * 2 + (tid & 1)) * 2] = e; TOKINFO[((size_t)tok * 2 + (tid & 1)) * 2 + 1] = rk; }
                    if (tid >= 128 && tid < 136) { const int e = tid - 128; int c = 0; for (int j = 0; j < 128; ++j) c += (le[j] == e); WGCNT[wgi * 8 + e] = c; }
                }
            }
            STEP_END;
            if (SITE_ON(13)) STEP_IF { SITE_PROLOG
                LAS int* lc = (LAS int*)lds;
                for (int wgi = bid; wgi < NTOK / 64; wgi += G) {
                    __syncthreads();
                    { const int e = wave; int all = 0, before = 0;
#pragma unroll
                      for (int c = 0; c < 4; ++c) { const int w = 4 * lane + c; const int v = WGCNT[w * 8 + e]; all += v; before += (w < wgi) ? v : 0; }
#pragma unroll
                      for (int o = 1; o < 64; o <<= 1) { all += __shfl_xor(all, o); before += __shfl_xor(before, o); }
                      if (lane == 0) { lc[e] = all; lc[8 + e] = before; } }
                    __syncthreads();
                    if (tid == 0) { int tb = 0; for (int e = 0; e < 8; ++e) { lc[16 + e] = tb * 256; tb += (lc[e] + 255) >> 8; if (wgi == 0) META[e] = lc[16 + e] >> 8; } if (wgi == 0) META[8] = tb; }
                    __syncthreads();
                    for (int hb = 0; hb < 2; ++hb) {
                        int rr[8]; u32x4 d0[8], d1[8];
#pragma unroll
                        for (int i = 0; i < 8; ++i) { const int p = wave * 16 + hb * 8 + i, tok = wgi * 64 + (p >> 1), slot = p & 1;
                            const int e = TOKINFO[((size_t)tok * 2 + slot) * 2], rk = TOKINFO[((size_t)tok * 2 + slot) * 2 + 1]; rr[i] = lc[16 + e] + lc[8 + e] + rk;
                            const u32x4* sp = (const u32x4*)(XB8 + (size_t)tok * DM) + lane; d0[i] = sp[0]; d1[i] = sp[64]; }
#pragma unroll
                        for (int i = 0; i < 8; ++i) { const int p = wave * 16 + hb * 8 + i, tok = wgi * 64 + (p >> 1), slot = p & 1; const int r = rr[i];
                            u32x4* dp = (u32x4*)((unsigned char*)XG + (size_t)r * DM) + lane; dp[0] = d0[i]; dp[64] = d1[i];
                            if (lane == 0) { POSR[tok * 2 + slot] = r; ROWTOK[r] = tok * 2 + slot; ROWW[r] = TOKW[(size_t)tok * 2 + slot]; RSTDG[r] = RSTD[tok]; } }
                    }
                    if (wgi < 8) { const int e = wgi, r0 = lc[16 + e] + lc[e], r1 = lc[16 + e] + (((lc[e] + 255) >> 8) << 8);
                        for (int r = r0 + wave; r < r1; r += 8) { u32x4* dp = (u32x4*)((unsigned char*)XG + (size_t)r * DM) + lane;
#pragma unroll
                            for (int c = 0; c < 2; ++c) dp[64 * c] = (u32x4){0u, 0u, 0u, 0u};
                            if (lane == 0) { ROWTOK[r] = -1; ROWW[r] = 0.f; RSTDG[r] = 0.f; } } }
                }
            }
            STEP_END;
            if (SITE_ON(14)) STEP_IF { SITE_PROLOG
                pg8::MoeOrder S; S.t1 = META[1]; S.t2 = META[2]; S.t3 = META[3]; S.t4 = META[4]; S.t5 = META[5]; S.t6 = META[6]; S.t7 = META[7];
                S.init(META[8], DFF / 128, G, bid); S.A = (const char*)XG; S.ta = (size_t)256 * DM; S.B = (const char*)WGUM; S.tb = (size_t)256 * DM; S.zb = SZ_WGU / 2;
                EpiSwiglu E{RSTDG, HIDM, 1.0f / W8SCALE, 1};
                pg8::gemm_phase8<EpiSwiglu, pg8::MoeOrder, true, true>(lds, pg8::Gemm{opq(DM / 2), 0}, S, E);
            }
            STEP_END;
            if (SITE_ON(15)) STEP_IF { SITE_PROLOG
                pg8::MoeOrder S; S.t1 = META[1]; S.t2 = META[2]; S.t3 = META[3]; S.t4 = META[4]; S.t5 = META[5]; S.t6 = META[6]; S.t7 = META[7];
                const int T = META[8], Tfull = T < 128 ? T : 128;
                S.init(Tfull, DM / 256, G, bid); S.A = (const char*)HIDM; S.ta = (size_t)256 * DFF; S.B = (const char*)WDM; S.tb = (size_t)256 * DFF; S.zb = SZ_WD / 2;
                EpiMoeDown E{ROWTOK, ROWW, Y, 1.0f / (WD8SCALE * H8SCALE)};
                pg8::gemm_phase8<EpiMoeDown, pg8::MoeOrder, true, true>(lds, pg8::Gemm{opq(DFF / 2), 0}, S, E);
                if (T > 128) {
                    pg8::TailOrder S2; S2.ntail = (T - 128) * 32; S2.G = G; S2.c = bid; S2.A = S.A; S2.B = S.B; S2.ta = S.ta; S2.tb = S.tb; S2.zb = S.zb; S2.kq = DFF / 4;
                    S2.t1 = S.t1; S2.t2 = S.t2; S2.t3 = S.t3; S2.t4 = S.t4; S2.t5 = S.t5; S2.t6 = S.t6; S2.t7 = S.t7;
                    EpiMoeTail E2{ROWTOK, ROWW, YP, 1.0f / (WD8SCALE * H8SCALE)};
                    pg8::gemm_phase8<EpiMoeTail, pg8::TailOrder, true, true>(lds, pg8::Gemm{opq(DFF / 8), DFF / 2}, S2, E2); }
            }
            STEP_END;
            if (SITE_ON(16)) STEP_IF { SITE_PROLOG
                for (int m = gw; m < NTOK; m += NGW) {
                    f32x4* xr = (f32x4*)(X + (size_t)m * DM) + lane; const u32x2* y0 = (const u32x2*)(Y + (size_t)m * DM) + lane; const u32x2* y1 = (const u32x2*)(Y + (size_t)NTOK * DM + (size_t)m * DM) + lane;
                    f32x4 v[8]; float s = 0.f; const int r0 = POSR[2 * m], r1 = POSR[2 * m + 1];
                    if (r0 >= 32768 || r1 >= 32768) {
#pragma unroll
                        for (int j = 0; j < 8; ++j) { f32x4 acc4 = xr[64 * j];
#pragma unroll
                            for (int sl = 0; sl < 2; ++sl) { const int r = sl ? r1 : r0;
                                if (r < 32768) { const u32x2 a = (sl ? y1 : y0)[64 * j]; acc4 += (f32x4){bflo(a.x), bfhi(a.x), bflo(a.y), bfhi(a.y)}; }
                                else { for (int q = 0; q < 4; ++q) { const u32x2 a = ((const u32x2*)(YP + ((size_t)q * 2048 + (size_t)(r - 32768)) * DM) + lane)[64 * j]; acc4 += (f32x4){bflo(a.x), bfhi(a.x), bflo(a.y), bfhi(a.y)}; } } }
                            v[j] = acc4; s += (v[j][0] * v[j][0] + v[j][1] * v[j][1]) + (v[j][2] * v[j][2] + v[j][3] * v[j][3]); }
                    } else
#pragma unroll
                    for (int j = 0; j < 8; ++j) { const u32x2 a = y0[64 * j], b = y1[64 * j]; v[j] = xr[64 * j] + (f32x4){bflo(a.x), bfhi(a.x), bflo(a.y), bfhi(a.y)} + (f32x4){bflo(b.x), bfhi(b.x), bflo(b.y), bfhi(b.y)}; s += (v[j][0] * v[j][0] + v[j][1] * v[j][1]) + (v[j][2] * v[j][2] + v[j][3] * v[j][3]); }
                    s = wave_sum(s); const float rs = 1.0f / sqrtf(s * (1.0f / DM) + EPS);
#pragma unroll
                    for (int j = 0; j < 8; ++j) { const f32x4 g = *((const f32x4*)norm_final + lane + 64 * j); xr[64 * j] = v[j] * rs * g; }
                }
            }
            STEP_END;
        }
    }
#ifdef PROBE_MASK
    if (bid == 0 && threadIdx.x == 0) { const unsigned long long pr_t0 = wall_clock64(); while (wall_clock64() - pr_t0 < pr_acc * PROBE_AMP) __builtin_amdgcn_s_sleep(8); }
#endif
#undef STEP_IF
#undef STEP_END
}


#if DBG_STOP >= 0
__global__ void dbg_dump(const unsigned short* ws16, size_t n16, const unsigned* xin, float* out, int with_x) {
    for (size_t i = (size_t)blockIdx.x * blockDim.x + threadIdx.x; i < (size_t)NTOK * DM; i += (size_t)gridDim.x * blockDim.x) {
        unsigned acc = 0; for (size_t off = i; off < n16; off += (size_t)NTOK * DM) acc += ws16[off];
        if (with_x) { const unsigned u = xin[i]; acc += (u & 0xffffu) + (u >> 16); }
        out[i] = (float)(acc & 0xfffffu);
    }
}
#endif

#if DBG_STOP == 100
__global__ void dbg_cmp3(const unsigned short* a0, const unsigned short* b0, const unsigned short* a1, const unsigned short* b1, const unsigned short* a2, const unsigned short* b2, unsigned* cnt) {
    unsigned c0 = 0, c1 = 0, c2 = 0;
    for (size_t i = (size_t)blockIdx.x * blockDim.x + threadIdx.x; i < (size_t)NTOK * DM; i += (size_t)gridDim.x * blockDim.x) { c0 += a0[i] != b0[i]; c1 += a1[i] != b1[i]; c2 += a2[i] != b2[i]; }
    if (c0) atomicAdd(cnt, c0); if (c1) atomicAdd(cnt + 1, c1); if (c2) atomicAdd(cnt + 2, c2);
}
__global__ void dbg_fill(float* out, const unsigned* cnt) {
    const float E = (cnt[0] ? 3.f : 0.f) + (cnt[1] ? 10.f : 0.f) + (cnt[2] ? 30.f : 0.f);
    for (size_t i = (size_t)blockIdx.x * blockDim.x + threadIdx.x; i < (size_t)NTOK * DM; i += (size_t)gridDim.x * blockDim.x) out[i] = E;
}
#endif

#if DBG_STOP == 200
__global__ void dbg_cksum(const unsigned long long* p, size_t nblk, unsigned long long* ck) {
    for (size_t b = (size_t)blockIdx.x * blockDim.x + threadIdx.x; b < nblk; b += (size_t)gridDim.x * blockDim.x) {
        unsigned long long h = 0x9E3779B97F4A7C15ull; const unsigned long long* q = p + b * 128;
        for (int i = 0; i < 128; ++i) { h ^= q[i]; h *= 0xBF58476D1CE4E5B9ull; h ^= h >> 29; }
        ck[b] = h; }
}
__global__ void dbg_ckcmp(const unsigned long long* a, const unsigned long long* b, size_t nblk, unsigned long long* first) {
    for (size_t i = (size_t)blockIdx.x * blockDim.x + threadIdx.x; i < nblk; i += (size_t)gridDim.x * blockDim.x) if (a[i] != b[i]) atomicMin(first, (unsigned long long)i);
}
__global__ void dbg_fill2(float* out, const unsigned long long* first) {
    const unsigned long long off = WS_RSTD + (*first) * 1024ull; int id = 0;
    if (*first != ~0ull) { id = 1; if (off >= WS_Z8) id = 2; if (off >= WS_DLAT) id = 3; if (off >= WS_DIQ) id = 4; if (off >= WS_DIK) id = 5; if (off >= WS_FFW) id = 6; if (off >= WS_GATES) id = 7; if (off >= WS_C2F) id = 8;
        if (off >= WS_DKV) id = 9; if (off >= WS_SC) id = 10; if (off >= WS_MASK) id = 11; if (off >= WS_YATT) id = 12; if (off >= WS_M) id = 13; }
    const float E = 3.f * id;
    for (size_t i = (size_t)blockIdx.x * blockDim.x + threadIdx.x; i < (size_t)NTOK * DM; i += (size_t)gridDim.x * blockDim.x) out[i] = E;
}
#endif
extern "C" void kernel_launch(void* const* d_in, const int* in_sizes, int n_in, void* d_out, int out_size, void* d_ws, size_t ws_size, hipStream_t stream) {
    static int grid = 0;
    if (grid == 0) {
        if (n_in != 22 || out_size != NTOK * DM || ws_size < WS_END) { fprintf(stderr, "kernel_launch: unexpected problem (n_in %d, out %d, ws %zu, need %zu)\n", n_in, out_size, ws_size, (size_t)WS_END); grid = -1; return; }
        int dev = 0, cus = 0;
        if (hipGetDevice(&dev) != hipSuccess || hipDeviceGetAttribute(&cus, hipDeviceAttributeMultiprocessorCount, dev) != hipSuccess) { grid = -1; return; }
        if (hipFuncSetAttribute((const void*)mk_fwd, hipFuncAttributeMaxDynamicSharedMemorySize, LDS_BYTES) != hipSuccess) { fprintf(stderr, "kernel_launch: hipFuncSetAttribute failed\n"); grid = -1; return; }
        int per_cu = 0;
        if (hipOccupancyMaxActiveBlocksPerMultiprocessor(&per_cu, (const void*)mk_fwd, 512, LDS_BYTES) != hipSuccess || per_cu < 1) fprintf(stderr, "kernel_launch: occupancy query says %d\n", per_cu);
        (void)hipGetLastError();
        if (cus != 256) { fprintf(stderr, "kernel_launch: built for a 256-CU device, found %d CUs\n", cus); grid = -1; return; }
        grid = cus;
    }
    if (grid < 0) return;
    (void)hipMemsetAsync((char*)d_ws + WS_CTL, 0, CTL_ZERO_BYTES, stream);
    Args a{};
    for (int i = 0; i < 22; ++i) a.in[i] = (const float*)d_in[i];
    a.out = (float*)d_out; a.ws = (unsigned char*)d_ws;
#if DBG_STOP == 200
    for (int s = 0; s <= DBG_HI; ++s) { a.ph_lo = s; a.ph_hi = s + 1; hipLaunchKernelGGL(mk_fwd, dim3(grid), dim3(512), LDS_BYTES, stream, a); }
    { char* w = (char*)d_ws; const size_t nblk = (WS_R_END1 - WS_RSTD) / 1024; unsigned long long* ck0 = (unsigned long long*)(w + WS_R_END1); unsigned long long* ck1 = ck0 + nblk; unsigned long long* first = (unsigned long long*)(w + 4096);
#ifdef DBG_WARMFIRST
      for (int s = DBG_LOSTEP; s <= DBG_HI; ++s) { a.ph_lo = s; a.ph_hi = s + 1; hipLaunchKernelGGL(mk_fwd, dim3(grid), dim3(512), LDS_BYTES, stream, a); }
#endif
      hipLaunchKernelGGL(dbg_cksum, dim3(2048), dim3(256), 0, stream, (const unsigned long long*)(w + WS_RSTD), nblk, ck0);
      for (int s = DBG_LOSTEP; s <= DBG_HI; ++s) { a.ph_lo = s; a.ph_hi = s + 1; hipLaunchKernelGGL(mk_fwd, dim3(grid), dim3(512), LDS_BYTES, stream, a); }
      hipLaunchKernelGGL(dbg_cksum, dim3(2048), dim3(256), 0, stream, (const unsigned long long*)(w + WS_RSTD), nblk, ck1);
      (void)hipMemsetAsync(first, 0xFF, 8, stream);
      hipLaunchKernelGGL(dbg_ckcmp, dim3(1024), dim3(256), 0, stream, (const unsigned long long*)ck0, (const unsigned long long*)ck1, nblk, first);
      hipLaunchKernelGGL(dbg_fill2, dim3(2048), dim3(256), 0, stream, (float*)d_out, (const unsigned long long*)first); }
#elif DBG_STOP == 100
    for (int s = 0; s <= 6; ++s) { a.ph_lo = s; a.ph_hi = s + 1; hipLaunchKernelGGL(mk_fwd, dim3(grid), dim3(512), LDS_BYTES, stream, a); }
    { char* w = (char*)d_ws; const size_t SZ = (size_t)NTOK * DM * 2; char* cp = w + WS_R_END1;
      hipMemcpyAsync(cp, w + WS_M, SZ, hipMemcpyDeviceToDevice, stream); hipMemcpyAsync(cp + SZ, w + WS_SC, 2 * SZ, hipMemcpyDeviceToDevice, stream);
      a.ph_lo = 6; a.ph_hi = 7; hipLaunchKernelGGL(mk_fwd, dim3(grid), dim3(512), LDS_BYTES, stream, a);
      unsigned* cnt = (unsigned*)(w + 4096); hipMemsetAsync(cnt, 0, 64, stream);
      hipLaunchKernelGGL(dbg_cmp3, dim3(2048), dim3(256), 0, stream, (const unsigned short*)(w + WS_M), (const unsigned short*)cp, (const unsigned short*)(w + WS_SC), (const unsigned short*)(cp + SZ), (const unsigned short*)(w + WS_SC + SZ), (const unsigned short*)(cp + 2 * SZ), cnt);
      hipLaunchKernelGGL(dbg_fill, dim3(2048), dim3(256), 0, stream, (float*)d_out, (const unsigned*)cnt); }
#elif DBG_STOP >= 0
    for (int s = 0; s <= DBG_STOP; ++s) { a.ph_lo = s; a.ph_hi = s + 1; hipLaunchKernelGGL(mk_fwd, dim3(grid), dim3(512), LDS_BYTES, stream, a); }
#ifdef DBG_TWICE
    { a.ph_lo = DBG_STOP; a.ph_hi = DBG_STOP + 1; hipLaunchKernelGGL(mk_fwd, dim3(grid), dim3(512), LDS_BYTES, stream, a); }
#endif
    hipLaunchKernelGGL(dbg_dump, dim3(2048), dim3(256), 0, stream, (const unsigned short*)((const char*)d_ws + DBG_LO), (size_t)((WS_END - DBG_LO) / 2), (const unsigned*)d_out, (float*)d_out, DBG_STOP >= 7 ? 1 : 0);
#elif MK_ONE_LAUNCH
    a.ph_lo = 0; a.ph_hi = NSTEPS;
    hipLaunchKernelGGL(mk_fwd, dim3(grid), dim3(512), LDS_BYTES, stream, a);
#else
    for (int s = 0; s < NSTEPS; ++s) { a.ph_lo = s; a.ph_hi = s + 1; hipLaunchKernelGGL(mk_fwd, dim3(grid), dim3(512), LDS_BYTES, stream, a);
#ifdef DUP_MASK
        if ((DUP_MASK >> s) & 1u) { hipLaunchKernelGGL(mk_fwd, dim3(grid), dim3(512), LDS_BYTES, stream, a); }
#endif
    }
#endif
}
```

```cpp
#include <hip/hip_runtime.h>
#include <cstdio>
#include <cstdint>

#ifndef SITE_MASK
#define SITE_MASK 0xffffffffu
#endif
#define SITE_ON(i) (((SITE_MASK) >> (i)) & 1u)

#ifndef DUP_DRY
#define DUP_DRY 0
#endif
#ifndef DBG_STOP
#define DBG_STOP -1
#endif
#ifndef DBG_LO
#define DBG_LO WS_WIN
#endif
#ifndef MK_ONE_LAUNCH
#define MK_ONE_LAUNCH 1
#endif

namespace pg8 {
#define PG8_LAS __attribute__((address_space(3)))
typedef unsigned short bf16_t;
typedef short bf16x8 __attribute__((ext_vector_type(8)));
typedef float f32x4 __attribute__((ext_vector_type(4)));
typedef unsigned u32x4 __attribute__((ext_vector_type(4)));
constexpr int BM = 256, BK = 64, HALF = 128, HTB = HALF * BK * 2  , STAGE_BYTES = 8 * HTB, NXCD = 8, WGM = 8;

__host__ __device__ __forceinline__ int lds_byte(int r, int c) { const int st = (r >> 4) * 2 + (c >> 5), rr = r & 15, cc = c & 31, ob = rr * 64 + cc * 2; return st * 1024 + (ob ^ (((ob >> 9) & 1) << 5)); }
__host__ __device__ __forceinline__ void stage_rc(int b, int& R, int& C) { const int st = b / 1024, sb = b % 1024, swz = sb ^ (((sb >> 9) & 1) << 5); R = (st >> 1) * 16 + swz / 64; C = (st & 1) * 32 + (swz % 64) / 2; }
__host__ __device__ __forceinline__ int perm32(int rho) { const int n = rho >> 4, i = rho & 15; return 8 * (i >> 2) + 4 * n + (i & 3); }
struct Unit { int pm, pn, aux; const char* a; const char* b; };
struct Gemm { int K, P; };
__device__ __forceinline__ unsigned cvt_pk_bf16(float lo, float hi) { unsigned r; asm volatile("v_cvt_pk_bf16_f32 %0, %1, %2" : "=v"(r) : "v"(lo), "v"(hi)); return r; }
template <class Epi, class Sched, bool ALIGN_EPI = false, bool SP2 = false>
__device__ __forceinline__ void gemm_phase(PG8_LAS unsigned char* lds, const Gemm g, const Sched& S, const Epi& E) {
    int tid_ = threadIdx.x; asm volatile("" : "+v"(tid_)); const int tid = tid_, wid = __builtin_amdgcn_readfirstlane(tid >> 6), lane = tid & 63, wr = wid >> 2, wc = wid & 3, fr = lane & 15, fq = lane >> 4;
    const int K = g.K, nt = K / BK;
    unsigned voffA[2], voffB[2];
#pragma unroll
    for (int i = 0; i < 2; ++i) { int R, C; stage_rc(tid * 16 + i * 8192, R, C); const int Rb = Epi::PERM ? ((R & ~31) + perm32(R & 31)) : R;
        voffA[i] = (unsigned)(R * K + C) * 2u; voffB[i] = (unsigned)(Rb * K + C) * 2u; }
    const size_t kstep = (size_t)(BK * 2);
    const size_t hstep = (size_t)HALF * K * 2;
    const unsigned ldsw = (unsigned)wid * 1024u;
    const int aoff = lds_byte(wr * 64 + fr, fq * 8), boff = lds_byte(wc * 32 + fr, fq * 8);
#define PG8_SA(b, h) (((b) * 2 + (h)) * HTB)
#define PG8_SB(b, h) ((4 + (b) * 2 + (h)) * HTB)
#define PG8_STAGE(bufoff, gbase, voff) do { _Pragma("unroll") for (int _i = 0; _i < 2; ++_i) \
        __builtin_amdgcn_global_load_lds((const unsigned*)((const char*)(gbase) + (voff)[_i]), (PG8_LAS unsigned*)(lds + (bufoff) + ldsw + _i * 8192), 16, 0, 0); } while (0)
#define PG8_LDA(dst, b, h) do { _Pragma("unroll") for (int m = 0; m < 4; ++m) _Pragma("unroll") for (int k = 0; k < 2; ++k) dst[m][k] = *(const PG8_LAS bf16x8*)(lds + PG8_SA(b, h) + aoff + m * 2048 + k * 1024); } while (0)
#define PG8_LDB(dst, b, h) do { _Pragma("unroll") for (int n = 0; n < 2; ++n) _Pragma("unroll") for (int k = 0; k < 2; ++k) dst[n][k] = *(const PG8_LAS bf16x8*)(lds + PG8_SB(b, h) + boff + n * 2048 + k * 1024); } while (0)
#define PG8_MMA(ai, bj, At, Bt) do { __builtin_amdgcn_s_setprio(1); _Pragma("unroll") for (int m = 0; m < 4; ++m) _Pragma("unroll") for (int n = 0; n < 2; ++n) _Pragma("unroll") for (int k = 0; k < 2; ++k) \
        acc[ai][bj][m][n] = __builtin_amdgcn_mfma_f32_16x16x32_bf16(Bt[n][k], At[m][k], acc[ai][bj][m][n], 0, 0, 0); __builtin_amdgcn_s_setprio(0); } while (0)
#define PG8_WAIT_V(n) asm volatile("s_waitcnt vmcnt(" #n ")" ::: "memory")
#define PG8_WAIT_L(n) asm volatile("s_waitcnt lgkmcnt(" #n ")" ::: "memory")
#define PG8_BAR __builtin_amdgcn_s_barrier()
#define PG8_SCHED __builtin_amdgcn_sched_barrier(0)
    Unit cur, nxt; int ui = 0;
    if (!S.next(0, cur)) return;
    f32x4 acc[2][2][4][2];
#pragma unroll
    for (int a = 0; a < 2; ++a)
#pragma unroll
        for (int b = 0; b < 2; ++b)
#pragma unroll
            for (int m = 0; m < 4; ++m)
#pragma unroll
                for (int n = 0; n < 2; ++n) acc[a][b][m][n] = (f32x4){0.f, 0.f, 0.f, 0.f};
    bf16x8 At[4][2], B0[2][2], B1[2][2];
    const char* cA = cur.a; const char* cB = cur.b;
    S.a_ready(cur);
    if constexpr (SP2) {
        PG8_STAGE(PG8_SB(0, 0), cB, voffB); PG8_STAGE(PG8_SB(0, 1), cB + hstep, voffB); PG8_STAGE(PG8_SA(0, 0), cA, voffA); PG8_STAGE(PG8_SA(0, 1), cA + hstep, voffA);
        if (wr == 1) PG8_BAR;
        PG8_WAIT_V(2); PG8_BAR;
        PG8_STAGE(PG8_SB(1, 0), cB + kstep, voffB); PG8_STAGE(PG8_SA(1, 0), cA + kstep, voffA); PG8_STAGE(PG8_SB(1, 1), cB + hstep + kstep, voffB);
        PG8_WAIT_V(6); PG8_BAR;
    } else {
        PG8_STAGE(PG8_SB(0, 0), cB, voffB); PG8_STAGE(PG8_SA(0, 0), cA, voffA); PG8_STAGE(PG8_SB(0, 1), cB + hstep, voffB); PG8_STAGE(PG8_SA(0, 1), cA + hstep, voffA);
        if (wr == 1) PG8_BAR;
        PG8_WAIT_V(4); PG8_BAR;
        PG8_STAGE(PG8_SB(1, 0), cB + kstep, voffB); PG8_STAGE(PG8_SA(1, 0), cA + kstep, voffA); PG8_STAGE(PG8_SB(1, 1), cB + hstep + kstep, voffB);
        PG8_WAIT_V(6); PG8_BAR;
    }
    for (;;) {
        const bool has_next = S.next(ui + 1, nxt);
        const char* nA = has_next ? nxt.a : cA; const char* nB = has_next ? nxt.b : cB;
        for (int t = 0; t < nt; t += 2) {
            const bool last = (t == nt - 2);
            const char* a1 = cA + (size_t)(t + 1) * kstep;
            const char* a2 = last ? nA : cA + (size_t)(t + 2) * kstep; const char* b2 = last ? nB : cB + (size_t)(t + 2) * kstep;
            const char* a3 = a2 + kstep; const char* b3 = b2 + kstep;
            if (last && has_next) S.a_ready(nxt);
            if constexpr (SP2) {
            PG8_LDB(B0, 0, 0); PG8_LDB(B1, 0, 1); PG8_SCHED; PG8_LDA(At, 0, 0); PG8_STAGE(PG8_SA(1, 1), a1 + hstep, voffA);
            PG8_WAIT_V(8); PG8_WAIT_L(0); PG8_BAR; PG8_MMA(0, 0, At, B0); PG8_MMA(0, 1, At, B1); PG8_BAR; PG8_SCHED;
            PG8_LDA(At, 0, 1); PG8_STAGE(PG8_SB(0, 0), b2, voffB); PG8_STAGE(PG8_SB(0, 1), b2 + hstep, voffB); PG8_STAGE(PG8_SA(0, 0), a2, voffA);
            PG8_WAIT_V(8); PG8_WAIT_L(0); PG8_BAR; PG8_MMA(1, 0, At, B0); PG8_MMA(1, 1, At, B1); PG8_BAR; PG8_SCHED;
            PG8_LDB(B0, 1, 0); PG8_LDB(B1, 1, 1); PG8_SCHED; PG8_LDA(At, 1, 0); PG8_STAGE(PG8_SA(0, 1), a2 + hstep, voffA);
            PG8_WAIT_V(8); PG8_WAIT_L(0); PG8_BAR; PG8_MMA(0, 0, At, B0); PG8_MMA(0, 1, At, B1); PG8_BAR; PG8_SCHED;
            PG8_LDA(At, 1, 1); PG8_STAGE(PG8_SB(1, 0), b3, voffB); PG8_STAGE(PG8_SB(1, 1), b3 + hstep, voffB); PG8_STAGE(PG8_SA(1, 0), a3, voffA);
            PG8_WAIT_V(8); PG8_WAIT_L(0); PG8_BAR; PG8_MMA(1, 0, At, B0); PG8_MMA(1, 1, At, B1); PG8_BAR; PG8_SCHED;
            } else {
            PG8_LDB(B0, 0, 0); PG8_SCHED; PG8_LDA(At, 0, 0); PG8_STAGE(PG8_SA(1, 1), a1 + hstep, voffA);
            PG8_WAIT_L(8); PG8_BAR; PG8_WAIT_L(0); PG8_MMA(0, 0, At, B0); PG8_BAR; PG8_SCHED;
            PG8_LDB(B1, 0, 1); PG8_STAGE(PG8_SB(0, 0), b2, voffB);
            PG8_BAR; PG8_WAIT_L(0); PG8_MMA(0, 1, At, B1); PG8_BAR;
            PG8_LDA(At, 0, 1); PG8_STAGE(PG8_SA(0, 0), a2, voffA);
            PG8_BAR; PG8_WAIT_L(0); PG8_MMA(1, 0, At, B0); PG8_BAR; PG8_SCHED;
            PG8_STAGE(PG8_SB(0, 1), b2 + hstep, voffB);
            PG8_WAIT_V(6); PG8_BAR; PG8_MMA(1, 1, At, B1); PG8_BAR;
            PG8_LDB(B0, 1, 0); PG8_SCHED; PG8_LDA(At, 1, 0); PG8_STAGE(PG8_SA(0, 1), a2 + hstep, voffA);
            PG8_WAIT_L(8); PG8_BAR; PG8_WAIT_L(0); PG8_MMA(0, 0, At, B0); PG8_BAR; PG8_SCHED;
            PG8_LDB(B1, 1, 1); PG8_STAGE(PG8_SB(1, 0), b3, voffB);
            PG8_BAR; PG8_WAIT_L(0); PG8_MMA(0, 1, At, B1); PG8_BAR;
            PG8_LDA(At, 1, 1); PG8_STAGE(PG8_SA(1, 0), a3, voffA);
            PG8_BAR; PG8_WAIT_L(0); PG8_MMA(1, 0, At, B0); PG8_BAR; PG8_SCHED;
            PG8_STAGE(PG8_SB(1, 1), b3 + hstep, voffB);
            PG8_WAIT_V(6); PG8_BAR; PG8_MMA(1, 1, At, B1); PG8_BAR;
            }
        }
        if constexpr (ALIGN_EPI) { if (wr == 0) PG8_BAR; }
        if constexpr (!Epi::AFTER_DRAIN) { E(acc, cur, wr, wc, fr, fq); S.done(cur); }
        if (!has_next) break;
#pragma unroll
        for (int a = 0; a < 2; ++a)
#pragma unroll
            for (int b = 0; b < 2; ++b)
#pragma unroll
                for (int m = 0; m < 4; ++m)
#pragma unroll
                    for (int n = 0; n < 2; ++n) acc[a][b][m][n] = (f32x4){0.f, 0.f, 0.f, 0.f};
        cur = nxt; cA = nA; cB = nB; ++ui;
        if constexpr (ALIGN_EPI) { if (wr == 1) PG8_BAR; }
    }
    PG8_WAIT_V(0);
    if constexpr (!ALIGN_EPI) { if (wr == 0) PG8_BAR; }
    PG8_BAR;
    if constexpr (Epi::AFTER_DRAIN) { E.fused(acc, cur, wr, wc, fr, fq, lds, wid, lane); S.done(cur); }
#undef PG8_SA
#undef PG8_SB
#undef PG8_STAGE
#undef PG8_LDA
#undef PG8_LDB
#undef PG8_MMA
#undef PG8_WAIT_V
#undef PG8_WAIT_L
#undef PG8_BAR
#undef PG8_SCHED
}
template <class Epi, class Sched, bool ALIGN_EPI = false, bool SP2 = false>
__device__ __forceinline__ void gemm_phase_carry(PG8_LAS unsigned char* lds, const Gemm g, const Sched& S, const Epi& E) {
    int tid_ = threadIdx.x; asm volatile("" : "+v"(tid_)); const int tid = tid_, wid = __builtin_amdgcn_readfirstlane(tid >> 6), lane = tid & 63, wr = wid >> 2, wc = wid & 3, fr = lane & 15, fq = lane >> 4;
    const int K = g.K, nt = K / BK;
    unsigned voffA[2], voffB[2];
#pragma unroll
    for (int i = 0; i < 2; ++i) { int R, C; stage_rc(tid * 16 + i * 8192, R, C); const int Rb = Epi::PERM ? ((R & ~31) + perm32(R & 31)) : R;
        voffA[i] = (unsigned)(R * K + C) * 2u; voffB[i] = (unsigned)(Rb * K + C) * 2u; }
    const size_t kstep = (size_t)(BK * 2);
    const size_t hstep = (size_t)HALF * K * 2;
    const unsigned ldsw = (unsigned)wid * 1024u;
    const int aoff = lds_byte(wr * 64 + fr, fq * 8), boff = lds_byte(wc * 32 + fr, fq * 8);
#define PG8_SA(b, h) (((b) * 2 + (h)) * HTB)
#define PG8_SB(b, h) ((4 + (b) * 2 + (h)) * HTB)
#define PG8_STAGE(bufoff, gbase, voff) do { _Pragma("unroll") for (int _i = 0; _i < 2; ++_i) \
        __builtin_amdgcn_global_load_lds((const unsigned*)((const char*)(gbase) + (voff)[_i]), (PG8_LAS unsigned*)(lds + (bufoff) + ldsw + _i * 8192), 16, 0, 0); } while (0)
#define PG8_LDA(dst, b, h) do { _Pragma("unroll") for (int m = 0; m < 4; ++m) _Pragma("unroll") for (int k = 0; k < 2; ++k) dst[m][k] = *(const PG8_LAS bf16x8*)(lds + PG8_SA(b, h) + aoff + m * 2048 + k * 1024); } while (0)
#define PG8_LDB(dst, b, h) do { _Pragma("unroll") for (int n = 0; n < 2; ++n) _Pragma("unroll") for (int k = 0; k < 2; ++k) dst[n][k] = *(const PG8_LAS bf16x8*)(lds + PG8_SB(b, h) + boff + n * 2048 + k * 1024); } while (0)
#define PG8_MMA(ai, bj, At, Bt) do { __builtin_amdgcn_s_setprio(1); _Pragma("unroll") for (int m = 0; m < 4; ++m) _Pragma("unroll") for (int n = 0; n < 2; ++n) _Pragma("unroll") for (int k = 0; k < 2; ++k) \
        acc[ai][bj][m][n] = __builtin_amdgcn_mfma_f32_16x16x32_bf16(Bt[n][k], At[m][k], acc[ai][bj][m][n], 0, 0, 0); __builtin_amdgcn_s_setprio(0); } while (0)
#define PG8_WAIT_V(n) asm volatile("s_waitcnt vmcnt(" #n ")" ::: "memory")
#define PG8_WAIT_L(n) asm volatile("s_waitcnt lgkmcnt(" #n ")" ::: "memory")
#define PG8_BAR __builtin_amdgcn_s_barrier()
#define PG8_SCHED __builtin_amdgcn_sched_barrier(0)
    Unit cur, nxt; int ui = 0; bool kz = true;
    if (!S.next(0, cur)) return;
    f32x4 acc[2][2][4][2];
#pragma unroll
    for (int a = 0; a < 2; ++a)
#pragma unroll
        for (int b = 0; b < 2; ++b)
#pragma unroll
            for (int m = 0; m < 4; ++m)
#pragma unroll
                for (int n = 0; n < 2; ++n) if (kz) acc[a][b][m][n] = (f32x4){0.f, 0.f, 0.f, 0.f};
    bf16x8 At[4][2], B0[2][2], B1[2][2];
    const char* cA = cur.a; const char* cB = cur.b;
    S.a_ready(cur);
    if constexpr (SP2) {
        PG8_STAGE(PG8_SB(0, 0), cB, voffB); PG8_STAGE(PG8_SB(0, 1), cB + hstep, voffB); PG8_STAGE(PG8_SA(0, 0), cA, voffA); PG8_STAGE(PG8_SA(0, 1), cA + hstep, voffA);
        if (wr == 1) PG8_BAR;
        PG8_WAIT_V(2); PG8_BAR;
        PG8_STAGE(PG8_SB(1, 0), cB + kstep, voffB); PG8_STAGE(PG8_SA(1, 0), cA + kstep, voffA); PG8_STAGE(PG8_SB(1, 1), cB + hstep + kstep, voffB);
        PG8_WAIT_V(6); PG8_BAR;
    } else {
        PG8_STAGE(PG8_SB(0, 0), cB, voffB); PG8_STAGE(PG8_SA(0, 0), cA, voffA); PG8_STAGE(PG8_SB(0, 1), cB + hstep, voffB); PG8_STAGE(PG8_SA(0, 1), cA + hstep, voffA);
        if (wr == 1) PG8_BAR;
        PG8_WAIT_V(4); PG8_BAR;
        PG8_STAGE(PG8_SB(1, 0), cB + kstep, voffB); PG8_STAGE(PG8_SA(1, 0), cA + kstep, voffA); PG8_STAGE(PG8_SB(1, 1), cB + hstep + kstep, voffB);
        PG8_WAIT_V(6); PG8_BAR;
    }
    for (;;) {
        const bool has_next = S.next(ui + 1, nxt);
        const char* nA = has_next ? nxt.a : cA; const char* nB = has_next ? nxt.b : cB;
        for (int t = 0; t < nt; t += 2) {
            const bool last = (t == nt - 2);
            const char* a1 = cA + (size_t)(t + 1) * kstep;
            const char* a2 = last ? nA : cA + (size_t)(t + 2) * kstep; const char* b2 = last ? nB : cB + (size_t)(t + 2) * kstep;
            const char* a3 = a2 + kstep; const char* b3 = b2 + kstep;
            if (last && has_next) S.a_ready(nxt);
            if constexpr (SP2) {
            PG8_LDB(B0, 0, 0); PG8_LDB(B1, 0, 1); PG8_SCHED; PG8_LDA(At, 0, 0); PG8_STAGE(PG8_SA(1, 1), a1 + hstep, voffA);
            PG8_WAIT_V(8); PG8_WAIT_L(0); PG8_BAR; PG8_MMA(0, 0, At, B0); PG8_MMA(0, 1, At, B1); PG8_BAR; PG8_SCHED;
            PG8_LDA(At, 0, 1); PG8_STAGE(PG8_SB(0, 0), b2, voffB); PG8_STAGE(PG8_SB(0, 1), b2 + hstep, voffB); PG8_STAGE(PG8_SA(0, 0), a2, voffA);
            PG8_WAIT_V(8); PG8_WAIT_L(0); PG8_BAR; PG8_MMA(1, 0, At, B0); PG8_MMA(1, 1, At, B1); PG8_BAR; PG8_SCHED;
            PG8_LDB(B0, 1, 0); PG8_LDB(B1, 1, 1); PG8_SCHED; PG8_LDA(At, 1, 0); PG8_STAGE(PG8_SA(0, 1), a2 + hstep, voffA);
            PG8_WAIT_V(8); PG8_WAIT_L(0); PG8_BAR; PG8_MMA(0, 0, At, B0); PG8_MMA(0, 1, At, B1); PG8_BAR; PG8_SCHED;
            PG8_LDA(At, 1, 1); PG8_STAGE(PG8_SB(1, 0), b3, voffB); PG8_STAGE(PG8_SB(1, 1), b3 + hstep, voffB); PG8_STAGE(PG8_SA(1, 0), a3, voffA);
            PG8_WAIT_V(8); PG8_WAIT_L(0); PG8_BAR; PG8_MMA(1, 0, At, B0); PG8_MMA(1, 1, At, B1); PG8_BAR; PG8_SCHED;
            } else {
            PG8_LDB(B0, 0, 0); PG8_SCHED; PG8_LDA(At, 0, 0); PG8_STAGE(PG8_SA(1, 1), a1 + hstep, voffA);
            PG8_WAIT_L(8); PG8_BAR; PG8_WAIT_L(0); PG8_MMA(0, 0, At, B0); PG8_BAR; PG8_SCHED;
            PG8_LDB(B1, 0, 1); PG8_STAGE(PG8_SB(0, 0), b2, voffB);
            PG8_BAR; PG8_WAIT_L(0); PG8_MMA(0, 1, At, B1); PG8_BAR;
            PG8_LDA(At, 0, 1); PG8_STAGE(PG8_SA(0, 0), a2, voffA);
            PG8_BAR; PG8_WAIT_L(0); PG8_MMA(1, 0, At, B0); PG8_BAR; PG8_SCHED;
            PG8_STAGE(PG8_SB(0, 1), b2 + hstep, voffB);
            PG8_WAIT_V(6); PG8_BAR; PG8_MMA(1, 1, At, B1); PG8_BAR;
            PG8_LDB(B0, 1, 0); PG8_SCHED; PG8_LDA(At, 1, 0); PG8_STAGE(PG8_SA(0, 1), a2 + hstep, voffA);
            PG8_WAIT_L(8); PG8_BAR; PG8_WAIT_L(0); PG8_MMA(0, 0, At, B0); PG8_BAR; PG8_SCHED;
            PG8_LDB(B1, 1, 1); PG8_STAGE(PG8_SB(1, 0), b3, voffB);
            PG8_BAR; PG8_WAIT_L(0); PG8_MMA(0, 1, At, B1); PG8_BAR;
            PG8_LDA(At, 1, 1); PG8_STAGE(PG8_SA(1, 0), a3, voffA);
            PG8_BAR; PG8_WAIT_L(0); PG8_MMA(1, 0, At, B0); PG8_BAR; PG8_SCHED;
            PG8_STAGE(PG8_SB(1, 1), b3 + hstep, voffB);
            PG8_WAIT_V(6); PG8_BAR; PG8_MMA(1, 1, At, B1); PG8_BAR;
            }
        }
        if constexpr (ALIGN_EPI) { if (wr == 0) PG8_BAR; }
        if constexpr (!Epi::AFTER_DRAIN) { E(acc, cur, wr, wc, fr, fq); S.done(cur); }
        if (!has_next) break; kz = false;
#pragma unroll
        for (int a = 0; a < 2; ++a)
#pragma unroll
            for (int b = 0; b < 2; ++b)
#pragma unroll
                for (int m = 0; m < 4; ++m)
#pragma unroll
                    for (int n = 0; n < 2; ++n) if (kz) acc[a][b][m][n] = (f32x4){0.f, 0.f, 0.f, 0.f};
        cur = nxt; cA = nA; cB = nB; ++ui;
        if constexpr (ALIGN_EPI) { if (wr == 1) PG8_BAR; }
    }
    PG8_WAIT_V(0);
    if constexpr (!ALIGN_EPI) { if (wr == 0) PG8_BAR; }
    PG8_BAR;
    if constexpr (Epi::AFTER_DRAIN) { E.fused(acc, cur, wr, wc, fr, fq, lds, wid, lane); S.done(cur); }
#undef PG8_SA
#undef PG8_SB
#undef PG8_STAGE
#undef PG8_LDA
#undef PG8_LDB
#undef PG8_MMA
#undef PG8_WAIT_V
#undef PG8_WAIT_L
#undef PG8_BAR
#undef PG8_SCHED
}
typedef int i32x4v __attribute__((ext_vector_type(4))); typedef int i32x8v __attribute__((ext_vector_type(8)));
__device__ __forceinline__ f32x4 mma8(bf16x8 b0, bf16x8 b1, bf16x8 a0, bf16x8 a1, f32x4 c) {
    const i32x4v bl = __builtin_bit_cast(i32x4v, b0), bh = __builtin_bit_cast(i32x4v, b1), al = __builtin_bit_cast(i32x4v, a0), ah = __builtin_bit_cast(i32x4v, a1);
    const i32x8v B = __builtin_shufflevector(bl, bh, 0, 1, 2, 3, 4, 5, 6, 7), A = __builtin_shufflevector(al, ah, 0, 1, 2, 3, 4, 5, 6, 7);
    return __builtin_amdgcn_mfma_scale_f32_16x16x128_f8f6f4(B, A, c, 0, 0, 0, 0x7f7f7f7f, 0, 0x7f7f7f7f);
}
__device__ __forceinline__ f32x4 mma8v(const i32x8v& B, const i32x8v& A, f32x4 c) { const int one = 0x7f7f7f7f;
    asm volatile("v_mfma_scale_f32_16x16x128_f8f6f4 %0, %1, %2, %0, %3, %3 op_sel_hi:[0,0,0]" : "+v"(c) : "v"(B), "v"(A), "v"(one)); return c; }
template <class Epi, class Sched, bool ALIGN_EPI = false, bool SP2 = false>
__device__ __forceinline__ void gemm_phase8(PG8_LAS unsigned char* lds, const Gemm g, const Sched& S, const Epi& E) {
    int tid_ = threadIdx.x; asm volatile("" : "+v"(tid_)); const int tid = tid_, wid = __builtin_amdgcn_readfirstlane(tid >> 6), lane = tid & 63, wr = wid >> 2, wc = wid & 3, fr = lane & 15, fq = lane >> 4;
    const int K = g.P ? g.P : g.K, nt = g.K / BK;
    unsigned voffA[2], voffB[2];
#pragma unroll
    for (int i = 0; i < 2; ++i) { int R, C; stage_rc(tid * 16 + i * 8192, R, C); const int Rb = Epi::PERM ? ((R & ~31) + perm32(R & 31)) : R;
        voffA[i] = (unsigned)(R * K + C) * 2u; voffB[i] = (unsigned)(Rb * K + C) * 2u; }
    const size_t kstep = (size_t)(BK * 2);
    const size_t hstep = (size_t)HALF * K * 2;
    const unsigned ldsw = (unsigned)wid * 1024u;
    const int aoff = lds_byte(wr * 64 + fr, fq * 8), boff = lds_byte(wc * 32 + fr, fq * 8);
#define PG8_SA(b, h) (((b) * 2 + (h)) * HTB)
#define PG8_SB(b, h) ((4 + (b) * 2 + (h)) * HTB)
#define PG8_STAGE(bufoff, gbase, voff) do { _Pragma("unroll") for (int _i = 0; _i < 2; ++_i) \
        __builtin_amdgcn_global_load_lds((const unsigned*)((const char*)(gbase) + (voff)[_i]), (PG8_LAS unsigned*)(lds + (bufoff) + ldsw + _i * 8192), 16, 0, 0); } while (0)
#define PG8_LDA(dst, b, h) do { _Pragma("unroll") for (int m = 0; m < 4; ++m) { dst[m].lo = *(const PG8_LAS i32x4v*)(lds + PG8_SA(b, h) + aoff + m * 2048); dst[m].hi = *(const PG8_LAS i32x4v*)(lds + PG8_SA(b, h) + aoff + m * 2048 + 1024); } } while (0)
#define PG8_LDB(dst, b, h) do { _Pragma("unroll") for (int n = 0; n < 2; ++n) { dst[n].lo = *(const PG8_LAS i32x4v*)(lds + PG8_SB(b, h) + boff + n * 2048); dst[n].hi = *(const PG8_LAS i32x4v*)(lds + PG8_SB(b, h) + boff + n * 2048 + 1024); } } while (0)
#define PG8_MMA(ai, bj, At, Bt) do { __builtin_amdgcn_s_setprio(1); _Pragma("unroll") for (int m = 0; m < 4; ++m) _Pragma("unroll") for (int n = 0; n < 2; ++n) \
        acc[ai][bj][m][n] = mma8v(Bt[n], At[m], acc[ai][bj][m][n]); __builtin_amdgcn_s_setprio(0); } while (0)
#define PG8_WAIT_V(n) asm volatile("s_waitcnt vmcnt(" #n ")" ::: "memory")
#define PG8_WAIT_L(n) asm volatile("s_waitcnt lgkmcnt(" #n ")" ::: "memory")
#define PG8_BAR __builtin_amdgcn_s_barrier()
#define PG8_SCHED __builtin_amdgcn_sched_barrier(0)
    Unit cur, nxt; int ui = 0;
    if (!S.next(0, cur)) return;
    f32x4 acc[2][2][4][2];
#pragma unroll
    for (int a = 0; a < 2; ++a)
#pragma unroll
        for (int b = 0; b < 2; ++b)
#pragma unroll
            for (int m = 0; m < 4; ++m)
#pragma unroll
                for (int n = 0; n < 2; ++n) acc[a][b][m][n] = (f32x4){0.f, 0.f, 0.f, 0.f};
    i32x8v At[4], B0[2], B1[2];
    const char* cA = cur.a; const char* cB = cur.b;
    S.a_ready(cur);
    if constexpr (SP2) {
        PG8_STAGE(PG8_SB(0, 0), cB, voffB); PG8_STAGE(PG8_SB(0, 1), cB + hstep, voffB); PG8_STAGE(PG8_SA(0, 0), cA, voffA); PG8_STAGE(PG8_SA(0, 1), cA + hstep, voffA);
        if (wr == 1) PG8_BAR;
        PG8_WAIT_V(2); PG8_BAR;
        PG8_STAGE(PG8_SB(1, 0), cB + kstep, voffB); PG8_STAGE(PG8_SA(1, 0), cA + kstep, voffA); PG8_STAGE(PG8_SB(1, 1), cB + hstep + kstep, voffB);
        PG8_WAIT_V(6); PG8_BAR;
    } else {
        PG8_STAGE(PG8_SB(0, 0), cB, voffB); PG8_STAGE(PG8_SA(0, 0), cA, voffA); PG8_STAGE(PG8_SB(0, 1), cB + hstep, voffB); PG8_STAGE(PG8_SA(0, 1), cA + hstep, voffA);
        if (wr == 1) PG8_BAR;
        PG8_WAIT_V(4); PG8_BAR;
        PG8_STAGE(PG8_SB(1, 0), cB + kstep, voffB); PG8_STAGE(PG8_SA(1, 0), cA + kstep, voffA); PG8_STAGE(PG8_SB(1, 1), cB + hstep + kstep, voffB);
        PG8_WAIT_V(6); PG8_BAR;
    }
    for (;;) {
        const bool has_next = S.next(ui + 1, nxt);
        const char* nA = has_next ? nxt.a : cA; const char* nB = has_next ? nxt.b : cB;
        for (int t = 0; t < nt; t += 2) {
            const bool last = (t == nt - 2);
            const char* a1 = cA + (size_t)(t + 1) * kstep;
            const char* a2 = last ? nA : cA + (size_t)(t + 2) * kstep; const char* b2 = last ? nB : cB + (size_t)(t + 2) * kstep;
            const char* a3 = a2 + kstep; const char* b3 = b2 + kstep;
            if (last && has_next) S.a_ready(nxt);
            if constexpr (SP2) {
            PG8_LDB(B0, 0, 0); PG8_LDB(B1, 0, 1); PG8_SCHED; PG8_LDA(At, 0, 0); PG8_STAGE(PG8_SA(1, 1), a1 + hstep, voffA);
            PG8_WAIT_V(8); PG8_WAIT_L(0); PG8_BAR; PG8_MMA(0, 0, At, B0); PG8_MMA(0, 1, At, B1); PG8_BAR; PG8_SCHED;
            PG8_LDA(At, 0, 1); PG8_STAGE(PG8_SB(0, 0), b2, voffB); PG8_STAGE(PG8_SB(0, 1), b2 + hstep, voffB); PG8_STAGE(PG8_SA(0, 0), a2, voffA);
            PG8_WAIT_V(8); PG8_WAIT_L(0); PG8_BAR; PG8_MMA(1, 0, At, B0); PG8_MMA(1, 1, At, B1); PG8_BAR; PG8_SCHED;
            PG8_LDB(B0, 1, 0); PG8_LDB(B1, 1, 1); PG8_SCHED; PG8_LDA(At, 1, 0); PG8_STAGE(PG8_SA(0, 1), a2 + hstep, voffA);
            PG8_WAIT_V(8); PG8_WAIT_L(0); PG8_BAR; PG8_MMA(0, 0, At, B0); PG8_MMA(0, 1, At, B1); PG8_BAR; PG8_SCHED;
            PG8_LDA(At, 1, 1); PG8_STAGE(PG8_SB(1, 0), b3, voffB); PG8_STAGE(PG8_SB(1, 1), b3 + hstep, voffB); PG8_STAGE(PG8_SA(1, 0), a3, voffA);
            PG8_WAIT_V(8); PG8_WAIT_L(0); PG8_BAR; PG8_MMA(1, 0, At, B0); PG8_MMA(1, 1, At, B1); PG8_BAR; PG8_SCHED;
            } else {
            PG8_LDB(B0, 0, 0); PG8_SCHED; PG8_LDA(At, 0, 0); PG8_STAGE(PG8_SA(1, 1), a1 + hstep, voffA);
            PG8_WAIT_L(8); PG8_BAR; PG8_WAIT_L(0); PG8_MMA(0, 0, At, B0); PG8_BAR; PG8_SCHED;
            PG8_LDB(B1, 0, 1); PG8_STAGE(PG8_SB(0, 0), b2, voffB);
            PG8_BAR; PG8_WAIT_L(0); PG8_MMA(0, 1, At, B1); PG8_BAR;
            PG8_LDA(At, 0, 1); PG8_STAGE(PG8_SA(0, 0), a2, voffA);
            PG8_BAR; PG8_WAIT_L(0); PG8_MMA(1, 0, At, B0); PG8_BAR; PG8_SCHED;
            PG8_STAGE(PG8_SB(0, 1), b2 + hstep, voffB);
            PG8_WAIT_V(6); PG8_BAR; PG8_MMA(1, 1, At, B1); PG8_BAR;
            PG8_LDB(B0, 1, 0); PG8_SCHED; PG8_LDA(At, 1, 0); PG8_STAGE(PG8_SA(0, 1), a2 + hstep, voffA);
            PG8_WAIT_L(8); PG8_BAR; PG8_WAIT_L(0); PG8_MMA(0, 0, At, B0); PG8_BAR; PG8_SCHED;
            PG8_LDB(B1, 1, 1); PG8_STAGE(PG8_SB(1, 0), b3, voffB);
            PG8_BAR; PG8_WAIT_L(0); PG8_MMA(0, 1, At, B1); PG8_BAR;
            PG8_LDA(At, 1, 1); PG8_STAGE(PG8_SA(1, 0), a3, voffA);
            PG8_BAR; PG8_WAIT_L(0); PG8_MMA(1, 0, At, B0); PG8_BAR; PG8_SCHED;
            PG8_STAGE(PG8_SB(1, 1), b3 + hstep, voffB);
            PG8_WAIT_V(6); PG8_BAR; PG8_MMA(1, 1, At, B1); PG8_BAR;
            }
        }
        if constexpr (ALIGN_EPI) { if (wr == 0) PG8_BAR; }
        if constexpr (!Epi::AFTER_DRAIN) { E(acc, cur, wr, wc, fr, fq); S.done(cur); }
        if (!has_next) break;
#pragma unroll
        for (int a = 0; a < 2; ++a)
#pragma unroll
            for (int b = 0; b < 2; ++b)
#pragma unroll
                for (int m = 0; m < 4; ++m)
#pragma unroll
                    for (int n = 0; n < 2; ++n) acc[a][b][m][n] = (f32x4){0.f, 0.f, 0.f, 0.f};
        cur = nxt; cA = nA; cB = nB; ++ui;
        if constexpr (ALIGN_EPI) { if (wr == 1) PG8_BAR; }
    }
    PG8_WAIT_V(0);
    if constexpr (!ALIGN_EPI) { if (wr == 0) PG8_BAR; }
    PG8_BAR;
    if constexpr (Epi::AFTER_DRAIN) { E.fused(acc, cur, wr, wc, fr, fq, lds, wid, lane); S.done(cur); }
#undef PG8_SA
#undef PG8_SB
#undef PG8_STAGE
#undef PG8_LDA
#undef PG8_LDB
#undef PG8_MMA
#undef PG8_WAIT_V
#undef PG8_WAIT_L
#undef PG8_BAR
#undef PG8_SCHED
}
struct OrderBase {
    int nM, nN, nwg, G, c;
    __device__ __forceinline__ void init(int nM_, int nN_, int G_, int c_) { nM = nM_; nN = nN_; nwg = nM_ * nN_; G = G_; c = c_; }
    __device__ __forceinline__ bool map(int i, int& pm, int& pn) const {
        const long L = (long)i * G + c; if (L >= nwg) return false;
        int wgid = (int)L; { const int q = nwg / NXCD, r = nwg % NXCD, xcd = wgid % NXCD, off = wgid / NXCD; wgid = (xcd < r ? xcd * (q + 1) : r * (q + 1) + (xcd - r) * q) + off; }
        const int nig = WGM * nN, gid = wgid / nig, fm = gid * WGM, gsz = (nM - fm) < WGM ? (nM - fm) : WGM;
        pm = fm + ((wgid % nig) % gsz); pn = (wgid % nig) / gsz; return true;
    }
    __device__ __forceinline__ void a_ready(const Unit&) const {}
    __device__ __forceinline__ void done(const Unit&) const {}
};
struct PlainOrder : OrderBase {
    const char* A; const char* B; size_t ta, tb;
    __device__ __forceinline__ bool next(int i, Unit& u) const { int pm, pn; if (!map(i, pm, pn)) return false; u.pm = pm; u.pn = pn; u.aux = 0; u.a = A + (size_t)pm * ta; u.b = B + (size_t)pn * tb; return true; }
};
struct BranchOrder : OrderBase {
    const char* A; const char* B; size_t ta, tb, za, zb;
    __device__ __forceinline__ bool next(int i, Unit& u) const { const int ti = i / 3, br = i - 3 * ti; int pm, pn; if (!map(ti, pm, pn)) return false; u.pm = pm; u.pn = pn; u.aux = br;
        u.a = A + (size_t)br * za + (size_t)pm * ta; u.b = B + (size_t)br * zb + (size_t)pn * tb; return true; }
};
struct MoeOrder : OrderBase {
    const char* A; const char* B; size_t ta, tb, zb; int t1, t2, t3, t4, t5, t6, t7;
    __device__ __forceinline__ bool next(int i, Unit& u) const { int pm, pn; if (!map(i, pm, pn)) return false; u.pm = pm; u.pn = pn;
        const int e = (pm >= t1) + (pm >= t2) + (pm >= t3) + (pm >= t4) + (pm >= t5) + (pm >= t6) + (pm >= t7); u.aux = e;
        u.a = A + (size_t)pm * ta; u.b = B + (size_t)e * zb + (size_t)pn * tb; return true; }
};
struct TailOrder {
    int ntail, G, c; const char* A; const char* B; size_t ta, tb, zb, kq; int t1, t2, t3, t4, t5, t6, t7;
    __device__ __forceinline__ bool next(int i, Unit& u) const { const long L = (long)i * G + c; if (L >= ntail) return false; const int l = (int)L, q = l & 3, pn = (l >> 2) & 7, pm = 128 + (l >> 5);
        const int e = (pm >= t1) + (pm >= t2) + (pm >= t3) + (pm >= t4) + (pm >= t5) + (pm >= t6) + (pm >= t7); u.pm = pm; u.pn = pn; u.aux = q;
        u.a = A + (size_t)pm * ta + (size_t)q * kq; u.b = B + (size_t)e * zb + (size_t)pn * tb + (size_t)q * kq; return true; }
    __device__ __forceinline__ void a_ready(const Unit&) const {}
    __device__ __forceinline__ void done(const Unit&) const {}
};
}

constexpr int NTOK = 16384, DM = 2048, SEQ = 2048, NBATCH = 8, NHEAD = 8, HD = 64, DFF = 7168, NEXP = 8;
constexpr int NIN = 10828, NINP = 11008;
constexpr int WBR_W = 512, KVR = 256;
constexpr float EPS = 1e-6f, LOG2E = 1.4426950408889634f, C2 = 0.125f * LOG2E;
constexpr int MOE_ROWS = 2 * NTOK + NEXP * 256;
constexpr int NSTEPS = 24;
constexpr float W8SCALE = 64.f, WD8SCALE = 128.f, H8SCALE = 8.f;

constexpr size_t al256(size_t x) { return (x + 255) & ~(size_t)255; }
constexpr size_t WS_CTL = 0, CTL_ZERO_BYTES = 1u << 20;
constexpr size_t SZ_WIN = (size_t)NINP * DM * 2, SZ_WUKV = (size_t)1024 * KVR * 2, SZ_WBR = (size_t)DM * WBR_W * 2, SZ_WOUT = (size_t)DM * DM * 2;
constexpr size_t SZ_WGU = (size_t)2 * DFF * DM * 2, SZ_WD = (size_t)DM * DFF * 2;
constexpr size_t WS_WIN = CTL_ZERO_BYTES, WS_WUKV = WS_WIN + 2 * SZ_WIN, WS_WBR = WS_WUKV + 2 * SZ_WUKV, WS_WOUT = WS_WBR + 6 * SZ_WBR;
constexpr size_t WS_WGU0 = WS_WOUT + 2 * SZ_WOUT, WS_WD0 = WS_WGU0 + SZ_WGU, WS_WGUM = WS_WD0 + SZ_WD, WS_WDM = WS_WGUM + NEXP * SZ_WGU;
constexpr size_t WS_RSTD = WS_WDM + NEXP * SZ_WD, WS_SSP = WS_RSTD + (size_t)NTOK * 4, WS_XB = WS_SSP + (size_t)NTOK * 32 * 4;
constexpr size_t WS_R = WS_XB + (size_t)NTOK * DM * 2;
constexpr size_t WS_Z8 = WS_R, WS_DLAT = WS_Z8 + (size_t)8 * NTOK * 512 * 2, WS_DIQ = WS_DLAT + (size_t)NTOK * 256 * 2, WS_DIK = WS_DIQ + (size_t)NTOK * 256 * 2;
constexpr size_t WS_FFW = WS_DIK + (size_t)NTOK * 64 * 2, WS_GATES = WS_FFW + (size_t)NTOK * 16 * 4, WS_C2F = WS_GATES + (size_t)NTOK * 6144 * 2;
constexpr size_t WS_DKV = WS_C2F + (size_t)NBATCH * NHEAD * SEQ * 4, WS_SC = WS_DKV + (size_t)NTOK * 1024 * 2, WS_MASK = WS_SC + (size_t)NTOK * SEQ * 4;
constexpr size_t WS_YATT = WS_MASK + (size_t)NTOK * 64 * 4, WS_M = WS_YATT + (size_t)3 * NTOK * 512 * 2, WS_R_END1 = WS_M + (size_t)NTOK * DM * 2;
constexpr size_t WS_HID = WS_R;
constexpr size_t WS_XG = WS_R, WS_HIDM = WS_XG + (size_t)MOE_ROWS * DM * 2, WS_Y = WS_HIDM + (size_t)MOE_ROWS * DFF * 2, WS_ROWTOK = WS_Y + (size_t)2 * NTOK * DM * 4;
constexpr size_t WS_ROWW = WS_ROWTOK + (size_t)MOE_ROWS * 4, WS_RSTDG = WS_ROWW + (size_t)MOE_ROWS * 4, WS_TOKINFO = WS_RSTDG + (size_t)MOE_ROWS * 4;
constexpr size_t WS_TOKW = WS_TOKINFO + (size_t)2 * NTOK * 8, WS_WGCNT = WS_TOKW + (size_t)2 * NTOK * 4, WS_META = WS_WGCNT + 256 * 8 * 4, WS_R_END2 = WS_META + 256;
constexpr size_t WS_END = WS_R_END1 > WS_R_END2 ? WS_R_END1 : WS_R_END2;
constexpr size_t WS_XB8 = WS_WGUM + NEXP * SZ_WGU / 2;
constexpr size_t WS_WING8 = WS_XB8 + (size_t)NTOK * DM;
static_assert(WS_WING8 + (size_t)2 * 6144 * DM <= WS_WDM, "fp8 side buffers fit the freed half of the MoE gate/up region");
static_assert((size_t)2 * NTOK * DM * 2 + (size_t)4 * 2048 * DM * 2 + (size_t)2 * NTOK * 4 <= (size_t)2 * NTOK * DM * 4, "tail partials fit the slack of the Y region");
constexpr int CW_ATTQ = 65536;
constexpr int CW_BAR = 4096;

constexpr int RING_BYTES = 131072, LDSCTL_OFF = RING_BYTES, MISC_OFF = LDSCTL_OFF + 320, LDS_BYTES = 147456;

#define GAS __attribute__((address_space(1)))
#define LAS __attribute__((address_space(3)))
typedef unsigned short bf16_t;
typedef float f32x4 __attribute__((ext_vector_type(4)));
typedef unsigned u32x4 __attribute__((ext_vector_type(4)));
typedef unsigned u32x2 __attribute__((ext_vector_type(2)));
typedef short bf16x8 __attribute__((ext_vector_type(8)));
typedef float f32x16 __attribute__((ext_vector_type(16)));
#define LDS_WAIT() asm volatile("s_waitcnt lgkmcnt(0)" ::: "memory")
#define VM_WAIT() asm volatile("s_waitcnt vmcnt(0)" ::: "memory")
__device__ __forceinline__ float bflo(unsigned w) { return __uint_as_float(w << 16); }
__device__ __forceinline__ float bfhi(unsigned w) { return __uint_as_float(w & 0xffff0000u); }
typedef float f32x2_t __attribute__((ext_vector_type(2))); typedef __bf16 bf16x2_t __attribute__((ext_vector_type(2)));
__device__ __forceinline__ unsigned pk2(float lo, float hi) { f32x2_t v = {lo, hi}; bf16x2_t b = __builtin_convertvector(v, bf16x2_t); return __builtin_bit_cast(unsigned, b); }
__device__ __forceinline__ int opq(int v) { asm volatile("" : "+s"(v)); return v; }
__device__ __forceinline__ float wave_sum(float v) {
#pragma unroll
    for (int o = 1; o < 64; o <<= 1) v += __shfl_xor(v, o);
    return v;
}
__device__ __forceinline__ u32x2 pack8_fp8(const float (&e)[8]) {
    float c[8];
#pragma unroll
    for (int i = 0; i < 8; ++i) c[i] = __builtin_amdgcn_fmed3f(e[i], -448.f, 448.f);
    int w0 = __builtin_amdgcn_cvt_pk_fp8_f32(c[0], c[1], 0, false); w0 = __builtin_amdgcn_cvt_pk_fp8_f32(c[2], c[3], w0, true);
    int w1 = __builtin_amdgcn_cvt_pk_fp8_f32(c[4], c[5], 0, false); w1 = __builtin_amdgcn_cvt_pk_fp8_f32(c[6], c[7], w1, true);
    u32x2 r; r.x = (unsigned)w0; r.y = (unsigned)w1; return r; }
__device__ __forceinline__ float sigm(float v) { return __builtin_amdgcn_rcpf(1.f + __builtin_amdgcn_exp2f(-v * LOG2E)); }
__device__ __forceinline__ float softplus2(float z) { return fmaxf(z, 0.f) + __builtin_amdgcn_logf(1.f + __builtin_amdgcn_exp2f(-fabsf(z))); }

#define XB_TMO      128
#define XB_XCNT(j)  (256  + 64 * (j))
#define XB_XSUB(j)  (1280 + 64 * (j))
#define XB_XGEN(j)  (2304 + 64 * (j))
#define XB_TOP      3328
#define XB_TOPGEN   3392
#define XCD_BAR_WORDS 3456
#define XB_SPIN_CAP (1u << 18)

__device__ __forceinline__ unsigned xb_ld(unsigned* p)              { return __hip_atomic_load(p, __ATOMIC_RELAXED, __HIP_MEMORY_SCOPE_AGENT); }
__device__ __forceinline__ unsigned xb_add(unsigned* p, unsigned v) { return __hip_atomic_fetch_add(p, v, __ATOMIC_RELAXED, __HIP_MEMORY_SCOPE_AGENT); }
__device__ __forceinline__ unsigned xb_xcc_id() { return (unsigned)__builtin_amdgcn_s_getreg((3 << 11) | 20) & 0xFu; }
#define XB_SPIN(cond, bar) do { unsigned _sp = 0; while (cond) { __builtin_amdgcn_s_sleep(1); \
    if ((++_sp & 255u) == 0u) { if (xb_ld(&(bar)[XB_TMO])) break; if (_sp > XB_SPIN_CAP) { atomicAdd(&(bar)[XB_TMO], 1u); break; } } } } while (0)

struct XcdBarrier {
    unsigned* bar; unsigned x;
    volatile LAS unsigned* st;
};

__device__ __forceinline__ XcdBarrier xcd_barrier_post(unsigned* bar, volatile LAS unsigned* st) {
    XcdBarrier b; b.bar = bar; b.x = xb_xcc_id(); b.st = st;
    if (threadIdx.x == 0) (void)xb_add(&bar[XB_XCNT(b.x)], 1u);
    return b;
}
__device__ __forceinline__ void xcd_barrier_complete(unsigned* bar, unsigned x, unsigned& nloc, unsigned& nx) {
    const unsigned G = gridDim.x * gridDim.y * gridDim.z;
    unsigned sum, cnt, mine, sp = 0u;
    for (;;) {
        sum = 0u; cnt = 0u; mine = 0u;
#pragma unroll
        for (unsigned j = 0; j < 16; ++j) { const unsigned c = xb_ld(&bar[XB_XCNT(j)]); sum += c; cnt += (c > 0u) ? 1u : 0u; mine = (j == x) ? c : mine; }
        if (sum == G) break;
        __builtin_amdgcn_s_sleep(1);
        if ((++sp & 255u) == 0u) { if (xb_ld(&bar[XB_TMO])) break; if (sp > XB_SPIN_CAP) { atomicAdd(&bar[XB_TMO], 1u); break; } }
    }
    nloc = mine > 0u ? mine : 1u; nx = cnt > 0u ? cnt : 1u;
}

__device__ __attribute__((noinline)) void xcd_barrier_impl(GAS unsigned* bar_, unsigned x_, LAS unsigned* st_) { XcdBarrier b; b.bar = (unsigned*)bar_; b.x = x_; b.st = st_;
    asm volatile("s_waitcnt vmcnt(0)" ::: "memory");
    __syncthreads();
    if (threadIdx.x == 0) {
        unsigned* bar = b.bar;
        __builtin_amdgcn_s_waitcnt(0);
        unsigned nloc = b.st[0], nx = b.st[1];
        if (nloc == 0u) { xcd_barrier_complete(bar, b.x, nloc, nx); b.st[0] = nloc; b.st[1] = nx; }
        const unsigned old = xb_add(&bar[XB_XSUB(b.x)], 1u);
        const unsigned gen = old / nloc;
        if (old + 1u == (gen + 1u) * nloc) {
            __builtin_amdgcn_fence(__ATOMIC_RELEASE, "agent");
            asm volatile("s_waitcnt vmcnt(0)" ::: "memory");
            const unsigned og = xb_add(&bar[XB_TOP], 1u);
            const unsigned tg = og / nx;
            if (og + 1u == (tg + 1u) * nx) xb_add(&bar[XB_TOPGEN], 1u);
            else XB_SPIN(xb_ld(&bar[XB_TOPGEN]) == tg, bar);
            __builtin_amdgcn_fence(__ATOMIC_ACQUIRE, "agent");
            xb_add(&bar[XB_XGEN(b.x)], 1u);
            asm volatile("s_waitcnt vmcnt(0)" ::: "memory");
        } else {
            XB_SPIN(xb_ld(&bar[XB_XGEN(b.x)]) == gen, bar);
            __builtin_amdgcn_fence(__ATOMIC_ACQUIRE, "agent");
            asm volatile("s_waitcnt vmcnt(0)" ::: "memory");
        }
    }
    __syncthreads();
}
__device__ __forceinline__ void xcd_barrier(const XcdBarrier& b) { xcd_barrier_impl((GAS unsigned*)b.bar, b.x, (LAS unsigned*)b.st); }

#define ACC_T const pg8::f32x4 (&acc)[2][2][4][2]
__device__ __forceinline__ u32x4 pack8(f32x4 v0, f32x4 v1) { u32x4 w; w.x = pk2(v0[0], v0[1]); w.y = pk2(v0[2], v0[3]); w.z = pk2(v1[0], v1[1]); w.w = pk2(v1[2], v1[3]); return w; }
__device__ __forceinline__ f32x4 sigm4(f32x4 v) { f32x4 r; r[0] = sigm(v[0]); r[1] = sigm(v[1]); r[2] = sigm(v[2]); r[3] = sigm(v[3]); return r; }

struct EpiWin {
    static constexpr bool PERM = true, AFTER_DRAIN = false;
    const float* rstd; bf16_t* z8; bf16_t* dlat; bf16_t* diq; bf16_t* dik; float* ffw; bf16_t* gates;
    __device__ __forceinline__ void operator()(ACC_T, const pg8::Unit& u, int wr, int wc, int fr, int fq) const {
        const int row0 = u.pm * 256 + wr * 64 + fr, pn = u.pn, cl = wc * 32 + 8 * fq;
        float rsv[2][4];
#pragma unroll
        for (int ai = 0; ai < 2; ++ai)
#pragma unroll
            for (int m = 0; m < 4; ++m) rsv[ai][m] = rstd[row0 + ai * 128 + m * 16];
        if (pn == 18) {
#pragma unroll
            for (int ai = 0; ai < 2; ++ai)
#pragma unroll
                for (int m = 0; m < 4; ++m) { const int row = row0 + ai * 128 + m * 16; const float rs = rsv[ai][m];
                    const f32x4 v0 = acc[ai][0][m][0] * rs, v1 = acc[ai][0][m][1] * rs;
                    if (cl < 64) *(u32x4*)(dik + (size_t)row * 64 + cl) = pack8(v0, v1);
                    else if (cl == 64) { *(f32x4*)(ffw + (size_t)row * 16) = v0; *(f32x4*)(ffw + (size_t)row * 16 + 4) = v1; }
                    else if (cl == 72) { *(f32x4*)(ffw + (size_t)row * 16 + 8) = v0; } }
            return;
        }
        bf16_t* dst; int ldc, colbase; bool sg = false; float scale = 1.f;
        if (pn < 16) { const int idx = pn >> 1; dst = z8 + (size_t)idx * NTOK * 512; ldc = 512; colbase = (pn & 1) * 256; sg = (idx == 3); scale = (idx == 4 || idx == 7) ? C2 : 1.f; }
        else if (pn == 16) { dst = dlat; ldc = 256; colbase = 0; }
        else if (pn == 17) { dst = diq; ldc = 256; colbase = 0; }
        else { dst = gates; ldc = 6144; colbase = (pn - 19) * 256; sg = true; }
        if (sg) {
#pragma unroll
            for (int ai = 0; ai < 2; ++ai)
#pragma unroll
                for (int m = 0; m < 4; ++m) { const int row = row0 + ai * 128 + m * 16; const float rs = rsv[ai][m]; bf16_t* rowp = dst + (size_t)row * ldc + colbase + cl;
#pragma unroll
                    for (int bj = 0; bj < 2; ++bj) *(u32x4*)(rowp + bj * 128) = pack8(sigm4(acc[ai][bj][m][0] * rs), sigm4(acc[ai][bj][m][1] * rs)); }
        } else {
#pragma unroll
            for (int ai = 0; ai < 2; ++ai)
#pragma unroll
                for (int m = 0; m < 4; ++m) { const int row = row0 + ai * 128 + m * 16; const float rs = rsv[ai][m] * scale; bf16_t* rowp = dst + (size_t)row * ldc + colbase + cl;
#pragma unroll
                    for (int bj = 0; bj < 2; ++bj) *(u32x4*)(rowp + bj * 128) = pack8(acc[ai][bj][m][0] * rs, acc[ai][bj][m][1] * rs); }
        }
    }
};
struct EpiGate {
    static constexpr bool PERM = true, AFTER_DRAIN = false;
    const float* rstd; bf16_t* gates; float scale;
    __device__ __forceinline__ void operator()(ACC_T, const pg8::Unit& u, int wr, int wc, int fr, int fq) const {
        const int row0 = u.pm * 256 + wr * 64 + fr, col0 = u.pn * 256 + wc * 32 + 8 * fq;
        float rsv[2][4];
#pragma unroll
        for (int ai = 0; ai < 2; ++ai)
#pragma unroll
            for (int m = 0; m < 4; ++m) rsv[ai][m] = rstd[row0 + ai * 128 + m * 16];
#pragma unroll
        for (int ai = 0; ai < 2; ++ai)
#pragma unroll
            for (int m = 0; m < 4; ++m) { const int row = row0 + ai * 128 + m * 16; const float rs = rsv[ai][m] * scale; bf16_t* rowp = gates + (size_t)row * 6144 + col0;
#pragma unroll
                for (int bj = 0; bj < 2; ++bj) *(u32x4*)(rowp + bj * 128) = pack8(sigm4(acc[ai][bj][m][0] * rs), sigm4(acc[ai][bj][m][1] * rs)); }
    }
};
struct EpiPlain {
    static constexpr bool PERM = true, AFTER_DRAIN = false;
    bf16_t* O; int ldc;
    __device__ __forceinline__ void operator()(ACC_T, const pg8::Unit& u, int wr, int wc, int fr, int fq) const {
        const int row0 = u.pm * 256 + wr * 64 + fr, col0 = u.pn * 256 + wc * 32 + 8 * fq;
#pragma unroll
        for (int ai = 0; ai < 2; ++ai)
#pragma unroll
            for (int m = 0; m < 4; ++m) { bf16_t* rowp = O + (size_t)(row0 + ai * 128 + m * 16) * ldc + col0;
#pragma unroll
                for (int bj = 0; bj < 2; ++bj) *(u32x4*)(rowp + bj * 128) = pack8(acc[ai][bj][m][0], acc[ai][bj][m][1]); }
    }
};
struct EpiBranch {
    static constexpr bool PERM = true, AFTER_DRAIN = false;
    const bf16_t* gates; bf16_t* M;
    __device__ __forceinline__ void operator()(pg8::f32x4 (&acc)[2][2][4][2], const pg8::Unit& u, int wr, int wc, int fr, int fq) const {
        const int row0 = u.pm * 256 + wr * 64 + fr, col0 = u.pn * 256 + wc * 32 + 8 * fq, br = u.aux;
#pragma unroll
        for (int am = 0; am < 8; ++am) { const int ai = am >> 2, mb = am & 3;
            u32x4 gv[4][2], hv[4][2];
#pragma unroll
            for (int m = mb; m < mb + 1; ++m)
#pragma unroll
                for (int bj = 0; bj < 2; ++bj) { const int row = row0 + ai * 128 + m * 16, col = col0 + bj * 128;
                    gv[m][bj] = *(const u32x4*)(gates + (size_t)row * 6144 + br * 2048 + col);
                    hv[m][bj] = gv[m][bj]; if (br < 2) hv[m][bj] = *(const u32x4*)(gates + (size_t)row * 6144 + (br + 1) * 2048 + col); }
#pragma unroll
            for (int m = mb; m < mb + 1; ++m)
#pragma unroll
                for (int bj = 0; bj < 2; ++bj) { const int row = row0 + ai * 128 + m * 16, col = col0 + bj * 128; const u32x4 g = gv[m][bj], h = hv[m][bj];
                    float f[8] = {bflo(g.x), bfhi(g.x), bflo(g.y), bfhi(g.y), bflo(g.z), bfhi(g.z), bflo(g.w), bfhi(g.w)};
                    if (br < 2) { const float d[8] = {bflo(h.x), bfhi(h.x), bflo(h.y), bfhi(h.y), bflo(h.z), bfhi(h.z), bflo(h.w), bfhi(h.w)};
#pragma unroll
                        for (int i = 0; i < 8; ++i) f[i] = f[i] * __builtin_amdgcn_rcpf(fmaxf(d[i], 1.0e-20f)); }
                    pg8::f32x4& v0 = acc[ai][bj][m][0]; pg8::f32x4& v1 = acc[ai][bj][m][1];
                    v0[0] *= f[0]; v0[1] *= f[1]; v0[2] *= f[2]; v0[3] *= f[3]; v1[0] *= f[4]; v1[1] *= f[5]; v1[2] *= f[6]; v1[3] *= f[7];
                    if (br == 2) { *(u32x4*)(M + (size_t)row * DM + col) = pack8(v0, v1); v0 = (pg8::f32x4){0.f, 0.f, 0.f, 0.f}; v1 = (pg8::f32x4){0.f, 0.f, 0.f, 0.f}; } }
        }
    }
};
struct EpiResid {
    static constexpr bool PERM = true, AFTER_DRAIN = false;
    const float* xold; float* x; bf16_t* xb; float* ssp; unsigned char* xb8; float ascale;
    __device__ __forceinline__ void operator()(ACC_T, const pg8::Unit& u, int wr, int wc, int fr, int fq) const {
        const int row0 = u.pm * 256 + wr * 64 + fr, col0 = u.pn * 256 + wc * 32 + 8 * fq;
#pragma unroll
        for (int am = 0; am < 4; ++am) { const int ai = am >> 1, mb = (am & 1) * 2;
            f32x4 ov[4][2][2];
#pragma unroll
            for (int m = mb; m < mb + 2; ++m)
#pragma unroll
                for (int bj = 0; bj < 2; ++bj) { const size_t off = (size_t)(row0 + ai * 128 + m * 16) * DM + col0 + bj * 128; ov[m][bj][0] = *(const f32x4*)(xold + off); ov[m][bj][1] = *(const f32x4*)(xold + off + 4); }
#pragma unroll
            for (int m = mb; m < mb + 2; ++m) { const int row = row0 + ai * 128 + m * 16; float ss = 0.f;
#pragma unroll
                for (int bj = 0; bj < 2; ++bj) { const size_t off = (size_t)row * DM + col0 + bj * 128;
                    const f32x4 v0 = ov[m][bj][0] + acc[ai][bj][m][0] * ascale, v1 = ov[m][bj][1] + acc[ai][bj][m][1] * ascale;
                    *(f32x4*)(x + off) = v0; *(f32x4*)(x + off + 4) = v1; if (xb) *(u32x4*)(xb + off) = pack8(v0, v1);
                    if (xb8) { const float e[8] = {v0[0], v0[1], v0[2], v0[3], v1[0], v1[1], v1[2], v1[3]}; *(u32x2*)(xb8 + off) = pack8_fp8(e); }
                    ss += (v0[0] * v0[0] + v0[1] * v0[1]) + (v0[2] * v0[2] + v0[3] * v0[3]) + (v1[0] * v1[0] + v1[1] * v1[1]) + (v1[2] * v1[2] + v1[3] * v1[3]); }
                ss += __shfl_xor(ss, 16); ss += __shfl_xor(ss, 32);
                if (fq == 0) ssp[(size_t)row * 32 + u.pn * 4 + wc] = ss; }
        }
    }
};
struct EpiSwiglu {
    static constexpr bool PERM = true, AFTER_DRAIN = false;
    const float* rstd; bf16_t* hid; float oscale; int f8out;
    __device__ __forceinline__ void operator()(ACC_T, const pg8::Unit& u, int wr, int wc, int fr, int fq) const {
        const int row0 = u.pm * 256 + wr * 64 + fr, col0 = u.pn * 128 + wc * 32 + 8 * fq;
        float rsv[2][4];
#pragma unroll
        for (int ai = 0; ai < 2; ++ai)
#pragma unroll
            for (int m = 0; m < 4; ++m) rsv[ai][m] = rstd[row0 + ai * 128 + m * 16];
#pragma unroll
        for (int ai = 0; ai < 2; ++ai)
#pragma unroll
            for (int m = 0; m < 4; ++m) { const int row = row0 + ai * 128 + m * 16; const float rs = rsv[ai][m] * oscale;
                f32x4 h0, h1;
#pragma unroll
                for (int j = 0; j < 4; ++j) { const float g0 = acc[ai][0][m][0][j] * rs, u0 = acc[ai][1][m][0][j] * rs, g1 = acc[ai][0][m][1][j] * rs, u1 = acc[ai][1][m][1][j] * rs;
                    h0[j] = g0 * u0 * sigm(g0); h1[j] = g1 * u1 * sigm(g1); }
                if (f8out) { const float e[8] = {h0[0] * H8SCALE, h0[1] * H8SCALE, h0[2] * H8SCALE, h0[3] * H8SCALE, h1[0] * H8SCALE, h1[1] * H8SCALE, h1[2] * H8SCALE, h1[3] * H8SCALE}; *(u32x2*)((unsigned char*)hid + (size_t)row * DFF + col0) = pack8_fp8(e); }
                else *(u32x4*)(hid + (size_t)row * DFF + col0) = pack8(h0, h1); }
    }
};
struct EpiMoeDown {
    static constexpr bool PERM = true, AFTER_DRAIN = false;
    const int* rowtok; const float* roww; bf16_t* y; float oscale;
    __device__ __forceinline__ void operator()(ACC_T, const pg8::Unit& u, int wr, int wc, int fr, int fq) const {
        const int row0 = u.pm * 256 + wr * 64 + fr, col0 = u.pn * 256 + wc * 32 + 8 * fq;
        int tkv[2][4]; float wv[2][4];
#pragma unroll
        for (int ai = 0; ai < 2; ++ai)
#pragma unroll
            for (int m = 0; m < 4; ++m) { tkv[ai][m] = rowtok[row0 + ai * 128 + m * 16]; wv[ai][m] = roww[row0 + ai * 128 + m * 16]; }
#pragma unroll
        for (int ai = 0; ai < 2; ++ai)
#pragma unroll
            for (int m = 0; m < 4; ++m) { const int tk = tkv[ai][m];
                if (tk >= 0) { const float w = wv[ai][m] * oscale; bf16_t* d = y + (size_t)(tk & 1) * NTOK * DM + (size_t)(tk >> 1) * DM + col0;
#pragma unroll
                    for (int bj = 0; bj < 2; ++bj) *(u32x4*)(d + bj * 128) = pack8(acc[ai][bj][m][0] * w, acc[ai][bj][m][1] * w); } }
    }
};

struct EpiMoeTail {
    static constexpr bool PERM = true, AFTER_DRAIN = false;
    const int* rowtok; const float* roww; bf16_t* yp; float oscale;
    __device__ __forceinline__ void operator()(ACC_T, const pg8::Unit& u, int wr, int wc, int fr, int fq) const {
        const int row0 = u.pm * 256 + wr * 64 + fr, col0 = u.pn * 256 + wc * 32 + 8 * fq;
        int tkv[2][4]; float wv[2][4];
#pragma unroll
        for (int ai = 0; ai < 2; ++ai)
#pragma unroll
            for (int m = 0; m < 4; ++m) { tkv[ai][m] = rowtok[row0 + ai * 128 + m * 16]; wv[ai][m] = roww[row0 + ai * 128 + m * 16]; }
#pragma unroll
        for (int ai = 0; ai < 2; ++ai)
#pragma unroll
            for (int m = 0; m < 4; ++m) { const int row = row0 + ai * 128 + m * 16;
                if (tkv[ai][m] >= 0) { const float w = wv[ai][m] * oscale; bf16_t* d = yp + ((size_t)u.aux * 2048 + (size_t)(row - 32768)) * DM + col0;
#pragma unroll
                    for (int bj = 0; bj < 2; ++bj) *(u32x4*)(d + bj * 128) = pack8(acc[ai][bj][m][0] * w, acc[ai][bj][m][1] * w); } }
    }
};
struct Args { const float* in[22]; float* out; unsigned char* ws; int ph_lo, ph_hi; };

__host__ __device__ __forceinline__ int win_src(int n) {
    if (n < 1536) return n;
    if (n < 2048) return 1544 + (n - 1536);
    if (n < 4096) return 2056 + (n - 2048);
    if (n < 4352) return 4104 + (n - 4096);
    if (n < 4608) return 4360 + (n - 4352);
    if (n < 4672) return 4616 + (n - 4608);
    if (n < 4680) return 1536 + (n - 4672);
    if (n < 4684) return 4680 + (n - 4680);
    if (n < 4864) return -1;
    return 4684 + (n - 4864);
}

__device__ __forceinline__ void conv_item(int map, const float* W0, const float* W1, int K, int Ns, int dstN, bf16_t* WT, const float* gain, LAS float* scr, int it, int lane, float f8scale) {
    const int nblk = dstN >> 5, nit = (K >> 6) * nblk;
    if (it >= nit) return;
    {
        const int kb = it / nblk, nb = it - kb * nblk, k0 = kb << 6, n0 = nb << 5;
        const float* src = W0; int sc;
        if (map == 0) sc = n0 + (lane & 31);
        else if (map == 1) sc = win_src(n0 + (lane & 31));
        else { const int t = nb >> 3, r = nb & 7; src = (r < 4) ? W0 : W1; sc = 128 * t + 32 * (r & 3) + (lane & 31); }
        const float* sp = src + (size_t)k0 * Ns + (sc < 0 ? 0 : sc);
#pragma unroll
        for (int hh = 0; hh < 2; ++hh) { float tv[16];
#pragma unroll
            for (int i = 0; i < 16; ++i) tv[i] = __builtin_nontemporal_load(sp + (size_t)(2 * (16 * hh + i) + (lane >> 5)) * Ns);
#pragma unroll
            for (int i = 0; i < 16; ++i) scr[(2 * (16 * hh + i) + (lane >> 5)) * 33 + (lane & 31)] = (sc < 0) ? 0.f : tv[i]; }
        LDS_WAIT(); asm volatile("" ::: "memory");
        const int c = lane & 7;
        f32x4 g0 = {1.f, 1.f, 1.f, 1.f}, g1 = {1.f, 1.f, 1.f, 1.f};
        if (gain) { g0 = *(const f32x4*)(gain + k0 + 8 * c); g1 = *(const f32x4*)(gain + k0 + 8 * c + 4); }
#pragma unroll
        for (int j = 0; j < 4; ++j) { const int n = (lane >> 3) + 8 * j; const LAS float* s = scr + (8 * c) * 33 + n;
            if (f8scale != 0.f) { const float e[8] = {s[0 * 33] * g0[0] * f8scale, s[1 * 33] * g0[1] * f8scale, s[2 * 33] * g0[2] * f8scale, s[3 * 33] * g0[3] * f8scale, s[4 * 33] * g1[0] * f8scale, s[5 * 33] * g1[1] * f8scale, s[6 * 33] * g1[2] * f8scale, s[7 * 33] * g1[3] * f8scale};
                *(u32x2*)((unsigned char*)WT + (size_t)(n0 + n) * K + k0 + 8 * c) = pack8_fp8(e); }
            else {
            u32x4 o; o.x = pk2(s[0 * 33] * g0[0], s[1 * 33] * g0[1]); o.y = pk2(s[2 * 33] * g0[2], s[3 * 33] * g0[3]); o.z = pk2(s[4 * 33] * g1[0], s[5 * 33] * g1[1]); o.w = pk2(s[6 * 33] * g1[2], s[7 * 33] * g1[3]);
            *(u32x4*)(WT + (size_t)(n0 + n) * K + k0 + 8 * c) = o; } }
        LDS_WAIT(); asm volatile("" ::: "memory");
    }
}
__device__ __forceinline__ void conv_matrix(int map, const float* W0, const float* W1, int K, int Ns, int dstN, bf16_t* WT, const float* gain, LAS float* scr, int gw, int NGW, int lane, float f8scale = 0.f) {
    const int nit = (K >> 6) * (dstN >> 5);
    for (int it = gw; it < nit; it += NGW) conv_item(map, W0, W1, K, Ns, dstN, WT, gain, scr, it, lane, f8scale);
}

namespace att {
constexpr int NSLOT = 4, SLOTB = 8192, L_K = 0, L_V = NSLOT * SLOTB, L_WS = 2 * NSLOT * SLOTB, L_CS = L_WS + 2048, L_LUT = L_CS + NSLOT * 256, L_OST = L_LUT + 512, L_MW = L_OST + 8 * 4096, L_END = L_MW + 8 * NSLOT * 256;
static_assert(L_END <= 131072, "attention LDS image");
typedef short s16x4 __attribute__((ext_vector_type(4)));
constexpr float SB_CUT = 64.f;
__device__ __forceinline__ int crow(int r, int hi) { return (r & 3) + 8 * (r >> 2) + 4 * hi; }
__device__ __forceinline__ void glds16(const void* gsrc, unsigned lds_dst) { unsigned keep;
    asm volatile("s_mov_b32 %0, m0\n\ts_mov_b32 m0, %2\n\ts_nop 0\n\tglobal_load_lds_dwordx4 %1, off\n\ts_mov_b32 m0, %0" : "=&s"(keep) : "v"(gsrc), "s"(lds_dst) : "memory"); }
__device__ __forceinline__ void glds4(const void* gsrc, unsigned lds_dst) { unsigned keep;
    asm volatile("s_mov_b32 %0, m0\n\ts_mov_b32 m0, %2\n\ts_nop 0\n\tglobal_load_lds_dword %1, off\n\ts_mov_b32 m0, %0" : "=&s"(keep) : "v"(gsrc), "s"(lds_dst) : "memory"); }
#define ATT_MFMA(a, b, c) __builtin_amdgcn_mfma_f32_32x32x16_bf16(a, b, c, 0, 0, 0)
__device__ __forceinline__ void qkt(f32x16& p0, f32x16& p1, const LAS unsigned char* Kslot, const bf16x8* qr, int r32, int hi) {
    const LAS unsigned char* kb = Kslot + hi * 1024 + r32 * 16;
#pragma unroll
    for (int d0 = 0; d0 < 4; ++d0) { const bf16x8 b0 = *(const LAS bf16x8*)(kb + d0 * 2048), b1 = *(const LAS bf16x8*)(kb + d0 * 2048 + 512);
        p0 = ATT_MFMA(b0, qr[d0], p0); p1 = ATT_MFMA(b1, qr[d0], p1); }
}
__device__ __forceinline__ void pv(f32x16* o, int vb, bf16x8 pa0, bf16x8 pa1, bf16x8 pa2, bf16x8 pa3) {
#pragma unroll
    for (int d0 = 0; d0 < 2; ++d0) { s16x4 lo[4], hi[4];
#pragma unroll
        for (int ks = 0; ks < 4; ++ks) {
            asm volatile("ds_read_b64_tr_b16 %0,%1 offset:%c2" : "=&v"(lo[ks]) : "v"(vb), "i"(d0 * 4096 + ks * 1024) : "memory");
            asm volatile("ds_read_b64_tr_b16 %0,%1 offset:%c2" : "=&v"(hi[ks]) : "v"(vb), "i"(d0 * 4096 + ks * 1024 + 512) : "memory"); }
        asm volatile("s_waitcnt lgkmcnt(0)" ::: "memory"); __builtin_amdgcn_sched_barrier(0);
#define ATT_PK(k) (bf16x8){lo[k][0], lo[k][1], lo[k][2], lo[k][3], hi[k][0], hi[k][1], hi[k][2], hi[k][3]}
        o[d0] = ATT_MFMA(pa0, ATT_PK(0), o[d0]); o[d0] = ATT_MFMA(pa1, ATT_PK(1), o[d0]); o[d0] = ATT_MFMA(pa2, ATT_PK(2), o[d0]); o[d0] = ATT_MFMA(pa3, ATT_PK(3), o[d0]);
#undef ATT_PK
    }
}
__device__ __forceinline__ void kload(bf16x8 (&kf)[8], unsigned kaddr) {
#pragma unroll
    for (int d0 = 0; d0 < 4; ++d0) {
        asm volatile("ds_read_b128 %0, %1 offset:%c2" : "=&v"(kf[2 * d0]) : "v"(kaddr), "i"(d0 * 2048) : "memory");
        asm volatile("ds_read_b128 %0, %1 offset:%c2" : "=&v"(kf[2 * d0 + 1]) : "v"(kaddr), "i"(d0 * 2048 + 512) : "memory"); }
}
__device__ __forceinline__ void vload(s16x4 (&vf)[16], int vb) {
#pragma unroll
    for (int d0 = 0; d0 < 2; ++d0)
#pragma unroll
        for (int ks = 0; ks < 4; ++ks) {
            asm volatile("ds_read_b64_tr_b16 %0,%1 offset:%c2" : "=&v"(vf[d0 * 8 + ks * 2]) : "v"(vb), "i"(d0 * 4096 + ks * 1024) : "memory");
            asm volatile("ds_read_b64_tr_b16 %0,%1 offset:%c2" : "=&v"(vf[d0 * 8 + ks * 2 + 1]) : "v"(vb), "i"(d0 * 4096 + ks * 1024 + 512) : "memory"); }
}
__device__ __forceinline__ void pvmma(f32x16* o, s16x4 (&vf)[16], bf16x8 pa0, bf16x8 pa1, bf16x8 pa2, bf16x8 pa3) {
    asm volatile("s_waitcnt lgkmcnt(0)" : "+v"(vf[0]), "+v"(vf[1]), "+v"(vf[2]), "+v"(vf[3]), "+v"(vf[4]), "+v"(vf[5]), "+v"(vf[6]), "+v"(vf[7]),
                                          "+v"(vf[8]), "+v"(vf[9]), "+v"(vf[10]), "+v"(vf[11]), "+v"(vf[12]), "+v"(vf[13]), "+v"(vf[14]), "+v"(vf[15]) :: "memory");
#define ATT_PK(d, k) (bf16x8){vf[d * 8 + 2 * k][0], vf[d * 8 + 2 * k][1], vf[d * 8 + 2 * k][2], vf[d * 8 + 2 * k][3], vf[d * 8 + 2 * k + 1][0], vf[d * 8 + 2 * k + 1][1], vf[d * 8 + 2 * k + 1][2], vf[d * 8 + 2 * k + 1][3]}
    o[0] = ATT_MFMA(pa0, ATT_PK(0, 0), o[0]); o[1] = ATT_MFMA(pa0, ATT_PK(1, 0), o[1]); o[0] = ATT_MFMA(pa1, ATT_PK(0, 1), o[0]); o[1] = ATT_MFMA(pa1, ATT_PK(1, 1), o[1]);
    o[0] = ATT_MFMA(pa2, ATT_PK(0, 2), o[0]); o[1] = ATT_MFMA(pa2, ATT_PK(1, 2), o[1]); o[0] = ATT_MFMA(pa3, ATT_PK(0, 3), o[0]); o[1] = ATT_MFMA(pa3, ATT_PK(1, 3), o[1]);
#undef ATT_PK
}
__device__ __forceinline__ float hmax(float v) { const auto rr = __builtin_amdgcn_permlane32_swap(__float_as_uint(v), __float_as_uint(v), false, false); return fmaxf(__uint_as_float(rr[0]), __uint_as_float(rr[1])); }
__device__ __forceinline__ float hsum(float v) { const auto rr = __builtin_amdgcn_permlane32_swap(__float_as_uint(v), __float_as_uint(v), false, false); return __uint_as_float(rr[0]) + __uint_as_float(rr[1]); }

__device__ __forceinline__ void attn_begin(LAS unsigned char* lds, int var, int b, int h, int qb, const bf16_t* K, int pk, const bf16_t* V, int pv_, const float* c2f, const unsigned* mask) {
    int tid = threadIdx.x; asm volatile("" : "+v"(tid));
    const int lane = tid & 63, wid = __builtin_amdgcn_readfirstlane(tid >> 6);
    const size_t rowbase = (size_t)b * SEQ; const int q0 = qb * 256, NT = (q0 + 256) / 64;
    const unsigned lds0 = (unsigned)(uintptr_t)lds;
    const bf16_t* ksrc = K + rowbase * pk + h * 64 + (size_t)lane * pk + wid * 8;
    const bf16_t* vsrc = V + rowbase * pv_ + h * 64 + (size_t)(16 * (wid & 3) + (lane >> 2)) * pv_ + (wid >> 2) * 32 + (lane & 3) * 8;
#pragma unroll
    for (int i = 0; i < 2; ++i) { const int tile = (var == 1) ? NT - 1 - i : i;
        glds16(ksrc + (size_t)tile * 64 * pk, (unsigned)__builtin_amdgcn_readfirstlane(lds0 + L_K + wid * 1024 + i * SLOTB)); glds16(vsrc + (size_t)tile * 64 * pv_, (unsigned)__builtin_amdgcn_readfirstlane(lds0 + L_V + wid * 1024 + i * SLOTB));
        if (var == 0 && wid == 0) glds4(c2f + ((size_t)b * NHEAD + h) * SEQ + tile * 64 + lane, (unsigned)__builtin_amdgcn_readfirstlane(lds0 + L_CS + i * 256));
        if (var == 2) glds4(mask + (rowbase + q0 + wid * 32 + (lane >> 1)) * 64 + (lane & 1) + tile * 2, (unsigned)__builtin_amdgcn_readfirstlane(lds0 + L_MW + (wid * NSLOT + i) * 256)); }
}
template <int N> __device__ __forceinline__ void wait_bar() { asm volatile("s_waitcnt vmcnt(%0) lgkmcnt(0)\n\ts_barrier" :: "n"(N) : "memory"); }
template <int VAR, class Next> __device__ __forceinline__ void attn_unit(LAS unsigned char* lds, unsigned tnext, const Next& next, int b, int h, int qb,
        const bf16_t* Q, const bf16_t* K, int pk, const bf16_t* V, int pv_, const float* c2f, const unsigned* mask, const float* relb, const bf16_t* ogate, bf16_t* O) {
    int tid = threadIdx.x; asm volatile("" : "+v"(tid));
    const int lane = tid & 63, r32 = lane & 31, hi = lane >> 5, wid = __builtin_amdgcn_readfirstlane(tid >> 6);
    const size_t rowbase = (size_t)b * SEQ; const int q0 = qb * 256, qrel = wid * 32 + r32, t = q0 + qrel;
    const unsigned lds0 = (unsigned)(uintptr_t)lds;
    LAS float* wsf = (LAS float*)(lds + L_WS) + wid * 64;
    const bf16_t* Kh = K + rowbase * pk + h * 64; const bf16_t* Vh = V + rowbase * pv_ + h * 64;
    const bf16_t* ksrc = Kh + (size_t)lane * pk + wid * 8;
    const bf16_t* vsrc = Vh + (size_t)(16 * (wid & 3) + (lane >> 2)) * pv_ + (wid >> 2) * 32 + (lane & 3) * 8;
    const unsigned kdst = lds0 + L_K + wid * 1024, vdst = lds0 + L_V + wid * 1024;
    const int vb0 = (int)(lds0 + L_V) + ((lane >> 4) & 1) * 32 + (lane & 3) * 8 + (4 * hi + ((lane & 15) >> 2)) * 64;
    const int NT = (q0 + 256) / 64;
    const float* c2h = c2f + ((size_t)b * NHEAD + h) * SEQ;
#define ATT_DMA(tile, slot) do { glds16(ksrc + (size_t)(tile) * 64 * pk, (unsigned)__builtin_amdgcn_readfirstlane(kdst + (slot) * SLOTB)); glds16(vsrc + (size_t)(tile) * 64 * pv_, (unsigned)__builtin_amdgcn_readfirstlane(vdst + (slot) * SLOTB)); \
        if (VAR == 0 && wid == 0) glds4(c2h + (tile) * 64 + lane, (unsigned)__builtin_amdgcn_readfirstlane(lds0 + L_CS + (slot) * 256)); \
        if (VAR == 2) glds4(mrow + (tile) * 2, (unsigned)__builtin_amdgcn_readfirstlane(lds0 + L_MW + (wid * NSLOT + (slot)) * 256)); } while (0)
#define ATT_TILE(i) ((VAR == 1) ? NT - 1 - (i) : (i))
    const unsigned* mrow = nullptr; if (VAR == 2) mrow = mask + (rowbase + q0 + wid * 32 + (lane >> 1)) * 64 + (lane & 1);
    if (VAR == 2 && tid < 128) {
        int bk; if (tid < 16) bk = tid; else { bk = 16 + (int)(logf((float)tid / 16.0f) / 2.0794415416798357f * 16.0f); if (bk > 31) bk = 31; }
        ((LAS float*)(lds + L_LUT))[tid] = relb[bk * NHEAD + h] * LOG2E; }
    bf16x8 qr[4];
    { const bf16_t* Qw = Q + (rowbase + t) * 512 + h * 64;
#pragma unroll
      for (int d0 = 0; d0 < 4; ++d0) qr[d0] = *(const bf16x8*)(Qw + d0 * 16 + hi * 8); }
    float mrun = -1.0e30f, lrun = 0.f, R = 0.f; bool wdone = false;
    LAS unsigned* votes = (LAS unsigned*)(lds + L_CS);
    f32x16 o[2];
#pragma unroll
    for (int r = 0; r < 16; ++r) { o[0][r] = 0.f; o[1][r] = 0.f; }
    asm volatile("s_waitcnt vmcnt(0) lgkmcnt(0)\n\ts_barrier" ::: "memory");
#pragma unroll
    for (int d0 = 0; d0 < 4; ++d0) asm volatile("" : "+v"(qr[d0]));
#pragma unroll 1
    for (int it2 = 0; it2 < NT; it2 += 2) {
        if (it2 + 2 < NT) { ATT_DMA(ATT_TILE(it2 + 2), (it2 + 2) & (NSLOT - 1)); ATT_DMA(ATT_TILE(it2 + 3), (it2 + 3) & (NSLOT - 1)); }
#pragma unroll 1
        for (int it = it2; it < it2 + 2; ++it) {
        const int tile = ATT_TILE(it), slot = it & (NSLOT - 1);
        const bool active = (tile * 64 <= q0 + wid * 32 + 31) && !(VAR == 1 && wdone);
        if (active) {
        f32x16 p0, p1;
        if (VAR == 0) { const LAS f32x4* cs = (const LAS f32x4*)(lds + L_CS + slot * 256 + 16 * hi);
#pragma unroll
            for (int g = 0; g < 4; ++g) { const f32x4 ca = cs[2 * g], cb = cs[8 + 2 * g];
#pragma unroll
                for (int i = 0; i < 4; ++i) { p0[4 * g + i] = ca[i]; p1[4 * g + i] = cb[i]; } }
        } else {
#pragma unroll
            for (int r = 0; r < 16; ++r) { p0[r] = 0.f; p1[r] = 0.f; } }
        u32x2 mw = {0u, 0u}; float bfar = 0.f;
        if (VAR == 2) { mw = *(const LAS u32x2*)(lds + L_MW + (wid * NSLOT + slot) * 256 + r32 * 8); bfar = ((const LAS float*)(lds + L_LUT))[127]; }
        bf16x8 kf[8]; kload(kf, lds0 + L_K + slot * SLOTB + hi * 1024 + r32 * 16);
        asm volatile("s_waitcnt lgkmcnt(0)" : "+v"(kf[0]), "+v"(kf[1]), "+v"(kf[2]), "+v"(kf[3]), "+v"(kf[4]), "+v"(kf[5]), "+v"(kf[6]), "+v"(kf[7]), "+v"(mw.x), "+v"(mw.y), "+v"(bfar) :: "memory");
#pragma unroll
        for (int d0 = 0; d0 < 4; ++d0) { p0 = ATT_MFMA(kf[2 * d0], qr[d0], p0); p1 = ATT_MFMA(kf[2 * d0 + 1], qr[d0], p1); }
        s16x4 vf[16]; vload(vf, vb0 + slot * SLOTB);
        const int kv0 = tile * 64 + 4 * hi;
        const bool band = (tile * 64 + 63 > q0 + wid * 32);
        f32x16 pw0v, pw1v;
        if (VAR == 1) {
            f32x16 L0, L1;
#pragma unroll
            for (int r = 0; r < 16; ++r) { L0[r] = softplus2(p0[r]); L1[r] = softplus2(p1[r]); }
            if (band) {
#pragma unroll
                for (int r = 0; r < 16; ++r) { const int kv = kv0 + (r & 3) + 8 * (r >> 2); if (kv >= t) L0[r] = 0.f; if (kv + 32 >= t) L1[r] = 0.f; } }
            float G[8], T[8], S[8];
#pragma unroll
            for (int g = 0; g < 4; ++g) { G[g] = (L0[4 * g] + L0[4 * g + 1]) + (L0[4 * g + 2] + L0[4 * g + 3]); G[4 + g] = (L1[4 * g] + L1[4 * g + 1]) + (L1[4 * g + 2] + L1[4 * g + 3]); }
#pragma unroll
            for (int k = 0; k < 8; ++k) T[k] = hsum(G[k]);
            S[7] = 0.f;
#pragma unroll
            for (int k = 6; k >= 0; --k) S[k] = S[k + 1] + T[k + 1];
            const float tot = S[0] + T[0];
#pragma unroll
            for (int g = 0; g < 4; ++g) {
#pragma unroll
                for (int blk = 0; blk < 2; ++blk) { const int k = blk * 4 + g; const float off = R + S[k] + (hi == 0 ? T[k] - G[k] : 0.f);
                    f32x16& Lb = blk ? L1 : L0; f32x16& zb = blk ? p1 : p0; f32x16& ob = blk ? pw1v : pw0v;
                    const float e3 = Lb[4 * g + 3], e2 = e3 + Lb[4 * g + 2], e1 = e2 + Lb[4 * g + 1], e0 = e1 + Lb[4 * g];
                    ob[4 * g + 3] = __builtin_amdgcn_exp2f(zb[4 * g + 3] - (off + e3)); ob[4 * g + 2] = __builtin_amdgcn_exp2f(zb[4 * g + 2] - (off + e2));
                    ob[4 * g + 1] = __builtin_amdgcn_exp2f(zb[4 * g + 1] - (off + e1)); ob[4 * g] = __builtin_amdgcn_exp2f(zb[4 * g] - (off + e0)); } }
            if (band) {
#pragma unroll
                for (int r = 0; r < 16; ++r) { const int kv = kv0 + (r & 3) + 8 * (r >> 2); if (kv >= t) pw0v[r] = 0.f; if (kv + 32 >= t) pw1v[r] = 0.f; } }
            R += tot;
        } else {
            if (VAR == 0) {
                if (band) {
#pragma unroll
                    for (int r = 0; r < 16; ++r) { const int kv = kv0 + (r & 3) + 8 * (r >> 2); if (kv > t) p0[r] = -INFINITY; if (kv + 32 > t) p1[r] = -INFINITY; } }
            } else {
                const LAS float* lut = (const LAS float*)(lds + L_LUT);
                if (tile * 64 + 63 + 113 <= q0 + wid * 32) {
#pragma unroll
                    for (int r = 0; r < 16; ++r) { p0[r] += bfar; p1[r] += bfar; }
                } else {
#pragma unroll
                    for (int r = 0; r < 16; ++r) { const int kv = kv0 + (r & 3) + 8 * (r >> 2); int d0 = t - kv, d1 = d0 - 32; d0 = d0 < 0 ? 0 : (d0 > 127 ? 127 : d0); d1 = d1 < 0 ? 0 : (d1 > 127 ? 127 : d1);
                        p0[r] += lut[d0]; p1[r] += lut[d1]; } }
#pragma unroll
                for (int r = 0; r < 16; ++r) { const int bit = (r & 3) + 8 * (r >> 2) + 4 * hi; if (!((mw.x >> bit) & 1u)) p0[r] = -INFINITY; if (!((mw.y >> bit) & 1u)) p1[r] = -INFINITY; }
            }
            const float nmr = -mrun; f32x16 d0 = p0 + nmr, d1 = p1 + nmr;
            float rx = fmaxf(d0[0], d1[0]);
#pragma unroll
            for (int r = 1; r < 16; ++r) rx = fmaxf(rx, fmaxf(d0[r], d1[r]));
            rx = hmax(rx);
            if (__any(rx > 8.0f)) {
                float rm = fmaxf(p0[0], p1[0]);
#pragma unroll
                for (int r = 1; r < 16; ++r) rm = fmaxf(rm, fmaxf(p0[r], p1[r]));
                rm = hmax(rm);
                const float mnew = fmaxf(mrun, rm), f = __builtin_amdgcn_exp2f(mrun - mnew);
                lrun *= f; if (hi == 0) wsf[r32] = f;
                asm volatile("s_waitcnt lgkmcnt(0)" ::: "memory");
#pragma unroll
                for (int r = 0; r < 16; ++r) { const float fr = wsf[crow(r, hi)]; o[0][r] *= fr; o[1][r] *= fr; }
                mrun = mnew; const float nmn = -mnew; d0 = p0 + nmn; d1 = p1 + nmn;
            }
            float sacc = 0.f;
#pragma unroll
            for (int r = 0; r < 16; ++r) { pw0v[r] = __builtin_amdgcn_exp2f(d0[r]); pw1v[r] = __builtin_amdgcn_exp2f(d1[r]); sacc += pw0v[r] + pw1v[r]; }
            lrun += sacc;
        }
        u32x4 w0, w1, w2, w3;
        w0 = (u32x4){pk2(pw0v[0], pw0v[1]), pk2(pw0v[2], pw0v[3]), pk2(pw0v[4], pw0v[5]), pk2(pw0v[6], pw0v[7])}; w1 = (u32x4){pk2(pw0v[8], pw0v[9]), pk2(pw0v[10], pw0v[11]), pk2(pw0v[12], pw0v[13]), pk2(pw0v[14], pw0v[15])};
        w2 = (u32x4){pk2(pw1v[0], pw1v[1]), pk2(pw1v[2], pw1v[3]), pk2(pw1v[4], pw1v[5]), pk2(pw1v[6], pw1v[7])}; w3 = (u32x4){pk2(pw1v[8], pw1v[9]), pk2(pw1v[10], pw1v[11]), pk2(pw1v[12], pw1v[13]), pk2(pw1v[14], pw1v[15])};
        pvmma(o, vf, __builtin_bit_cast(bf16x8, w0), __builtin_bit_cast(bf16x8, w1), __builtin_bit_cast(bf16x8, w2), __builtin_bit_cast(bf16x8, w3));
        if (VAR == 1) wdone = !__any(R <= SB_CUT);
        }
        }
        const int vbank = (it2 >> 1) & 1;
        if (VAR == 1 && lane == 0) votes[vbank * 8 + wid] = wdone ? 1u : 0u;
        if (tid == 0) *(volatile LAS unsigned*)(lds + MISC_OFF + 260) = tnext;
        wait_bar<0>();
        if (VAR == 1) { const LAS u32x4* vp = (const LAS u32x4*)(votes + vbank * 8); const u32x4 va = vp[0], vb = vp[1]; if ((va.x & va.y & va.z & va.w & vb.x & vb.y & vb.z & vb.w) != 0u) break; }
    }
    if (VAR == 1) asm volatile("s_waitcnt vmcnt(0)\n\ts_barrier" ::: "memory");
    next();
    float linv = 1.f;
    if (VAR != 1) { const float lt = hsum(lrun); linv = 1.0f / lt; }
    if (hi == 0) wsf[32 + r32] = linv; asm volatile("s_waitcnt lgkmcnt(0)" ::: "memory");
    { LAS bf16_t* stg = (LAS bf16_t*)(lds + L_OST) + wid * 2048;
#pragma unroll
      for (int r = 0; r < 16; ++r) { const int orow = crow(r, hi); const float li = wsf[32 + orow];
#pragma unroll
          for (int d0 = 0; d0 < 2; ++d0) stg[orow * 64 + d0 * 32 + r32] = (bf16_t)(pk2(o[d0][r] * li, 0.f) & 0xffffu); }
      asm volatile("s_waitcnt lgkmcnt(0)" ::: "memory");
      bf16_t* Ow = O + (rowbase + q0 + wid * 32) * 512 + h * 64;
#pragma unroll
      for (int i = 0; i < 4; ++i) { const int row = i * 8 + (lane >> 3), ch = lane & 7; u32x4 v = *(const LAS u32x4*)(stg + row * 64 + ch * 8);
          if (VAR == 0) { const u32x4 g = *(const u32x4*)(ogate + (rowbase + q0 + wid * 32 + row) * 512 + h * 64 + ch * 8);
              v.x = pk2(bflo(v.x) * bflo(g.x), bfhi(v.x) * bfhi(g.x)); v.y = pk2(bflo(v.y) * bflo(g.y), bfhi(v.y) * bfhi(g.y)); v.z = pk2(bflo(v.z) * bflo(g.z), bfhi(v.z) * bfhi(g.z)); v.w = pk2(bflo(v.w) * bflo(g.w), bfhi(v.w) * bfhi(g.w)); }
          *(u32x4*)(Ow + (size_t)row * 512 + ch * 8) = v; } }
    asm volatile("s_waitcnt lgkmcnt(0)\n\ts_barrier" ::: "memory");
#undef ATT_DMA
#undef ATT_TILE
}
}

typedef __attribute__((address_space(4))) const char* kptr_t; typedef const float* cfp_t; typedef const __attribute__((address_space(4))) cfp_t* kslot_t;
__device__ __forceinline__ const float* arg_ptr(int i) { kptr_t ka = (kptr_t)__builtin_amdgcn_kernarg_segment_ptr(); asm volatile("" : "+s"(ka)); return *(kslot_t)(ka + 8 * i); }
#define x_in arg_ptr(0)
#define w_in arg_ptr(1)
#define b_forget arg_ptr(2)
#define q_norm arg_ptr(3)
#define k_norm arg_ptr(4)
#define kv_norm arg_ptr(5)
#define w_ukv arg_ptr(6)
#define w_br0 arg_ptr(7)
#define w_br1 arg_ptr(8)
#define w_br2 arg_ptr(9)
#define w_out arg_ptr(10)
#define rel_bias arg_ptr(11)
#define norm_mix arg_ptr(12)
#define norm_ffn arg_ptr(13)
#define w_fg arg_ptr(14)
#define w_fu arg_ptr(15)
#define w_fd arg_ptr(16)
#define w_router arg_ptr(17)
#define w_mg arg_ptr(18)
#define w_mu arg_ptr(19)
#define w_md arg_ptr(20)
#define norm_final arg_ptr(21)
#define X ((float*)arg_ptr(22))
#define WIN ((bf16_t*)(ws + WS_WIN))
#define WUKV ((bf16_t*)(ws + WS_WUKV))
#define WBR ((bf16_t*)(ws + WS_WBR))
#define WOUT ((bf16_t*)(ws + WS_WOUT))
#define WGU0 ((bf16_t*)(ws + WS_WGU0))
#define WD0 ((bf16_t*)(ws + WS_WD0))
#define WGUM ((bf16_t*)(ws + WS_WGUM))
#define WDM ((bf16_t*)(ws + WS_WDM))
#define RSTD ((float*)(ws + WS_RSTD))
#define SSP ((float*)(ws + WS_SSP))
#define XB ((bf16_t*)(ws + WS_XB))
#define Z8 ((bf16_t*)(ws + WS_Z8))
#define DLAT ((bf16_t*)(ws + WS_DLAT))
#define DIQ ((bf16_t*)(ws + WS_DIQ))
#define DIK ((bf16_t*)(ws + WS_DIK))
#define FFW ((float*)(ws + WS_FFW))
#define GATES ((bf16_t*)(ws + WS_GATES))
#define C2F ((float*)(ws + WS_C2F))
#define DKV ((bf16_t*)(ws + WS_DKV))
#define SC ((float*)(ws + WS_SC))
#define MASK ((unsigned*)(ws + WS_MASK))
#define YATT ((bf16_t*)(ws + WS_YATT))
#define MB ((bf16_t*)(ws + WS_M))
#define HID ((bf16_t*)(ws + WS_HID))
#define XG ((bf16_t*)(ws + WS_XG))
#define XB8 ((unsigned char*)(ws + WS_XB8))
#define WING8 ((unsigned char*)(ws + WS_WING8))
#define HIDM ((bf16_t*)(ws + WS_HIDM))
#define Y ((bf16_t*)(ws + WS_Y))
#define YP ((bf16_t*)(ws + WS_Y + (size_t)2 * NTOK * DM * 2))
#define POSR ((int*)(ws + WS_Y + (size_t)2 * NTOK * DM * 2 + (size_t)4 * 2048 * DM * 2))
#define ROWTOK ((int*)(ws + WS_ROWTOK))
#define ROWW ((float*)(ws + WS_ROWW))
#define RSTDG ((float*)(ws + WS_RSTDG))
#define TOKINFO ((int*)(ws + WS_TOKINFO))
#define TOKW ((float*)(ws + WS_TOKW))
#define WGCNT ((int*)(ws + WS_WGCNT))
#define META ((int*)(ws + WS_META))


struct Bg { unsigned char* ws; LAS float* scr; int l, gw, next, end, inflight; float tv[32]; f32x4 g0, g1; };
struct BgJob { int map, K, Ns, dstN, it; const float* W0; const float* W1; bf16_t* WT; const float* gain; float f8s; };
__device__ __forceinline__ BgJob bg_job(const Bg& B, int slot) {
    unsigned char* ws = B.ws; BgJob J; J.map = 0; J.K = DM; J.Ns = DM; J.dstN = DM; J.W0 = nullptr; J.W1 = nullptr; J.WT = nullptr; J.gain = nullptr; J.f8s = 0.f; int q = 0, es = -1, e = 0;
    if (B.l == 1) { e = 3 + slot / 11; es = slot - (slot / 11) * 11; }
    else if (slot >= 22) { e = (slot - 22) / 11; es = (slot - 22) - e * 11; }
    else if (slot < 7) { J.map = 2; J.W0 = w_fg; J.W1 = w_fu; J.K = DM; J.Ns = DFF; J.dstN = 2 * DFF; J.WT = WGU0; J.gain = norm_ffn; q = slot; }
    else if (slot < 11) { J.W0 = w_fd; J.K = DFF; J.Ns = DM; J.dstN = DM; J.WT = WD0; J.f8s = WD8SCALE; q = slot - 7; }
    else if (slot < 14) { J.map = 1; J.W0 = w_in + (size_t)DM * NIN; J.K = DM; J.Ns = NIN; J.dstN = 19 * 256; J.WT = WIN + (size_t)NINP * DM; J.gain = norm_mix + DM; q = slot - 11; }
    else if (slot < 17) { J.W0 = w_in + (size_t)DM * NIN + 4684; J.K = DM; J.Ns = NIN; J.dstN = 6144; J.WT = (bf16_t*)(WING8 + (size_t)6144 * DM); J.gain = norm_mix + DM; J.f8s = W8SCALE; q = slot - 14; }
    else if (slot == 17) { J.W0 = w_ukv + (size_t)KVR * 1024; J.K = KVR; J.Ns = 1024; J.dstN = 1024; J.WT = WUKV + (size_t)1024 * KVR; J.gain = kv_norm + KVR; }
    else if (slot < 21) { const int i = slot - 18; J.W0 = (i == 0 ? w_br0 : (i == 1 ? w_br1 : w_br2)) + (size_t)WBR_W * DM; J.K = WBR_W; J.Ns = DM; J.dstN = DM; J.WT = WBR + (size_t)(3 + i) * DM * WBR_W; }
    else { J.W0 = w_out + (size_t)DM * DM; J.K = DM; J.Ns = DM; J.dstN = DM; J.WT = WOUT + (size_t)DM * DM; }
    if (es >= 0) {
        if (es < 7) { J.map = 2; J.W0 = w_mg + (size_t)e * DM * DFF; J.W1 = w_mu + (size_t)e * DM * DFF; J.K = DM; J.Ns = DFF; J.dstN = 2 * DFF; J.WT = (bf16_t*)((unsigned char*)WGUM + (size_t)e * 2 * DFF * DM); J.gain = norm_ffn + DM; J.f8s = W8SCALE; q = es; }
        else { J.W0 = w_md + (size_t)e * DFF * DM; J.K = DFF; J.Ns = DM; J.dstN = DM; J.WT = (bf16_t*)((unsigned char*)WDM + (size_t)e * DM * DFF); J.f8s = WD8SCALE; q = es - 7; } }
    J.it = B.gw + q * 2048; return J;
}
__device__ __forceinline__ void bg_src(const BgJob& J, int lane, const char*& ub, unsigned& loff, int& sc, int& k0, int& n0) {
    const int nblk = J.dstN >> 5, kb = J.it / nblk, nb = J.it - kb * nblk; k0 = kb << 6; n0 = nb << 5; const float* src = J.W0; int scu;
    if (J.map == 0) { scu = n0; sc = n0 + (lane & 31); }
    else if (J.map == 1) { scu = 0; sc = win_src(n0 + (lane & 31)); }
    else { const int t = nb >> 3, r = nb & 7; src = (r < 4) ? J.W0 : J.W1; scu = 128 * t + 32 * (r & 3); sc = scu + (lane & 31); }
    ub = (const char*)(src + (size_t)k0 * J.Ns + scu); loff = (unsigned)(((lane >> 5) * J.Ns + ((sc < 0 ? 0 : sc) - scu)) * 4);
}
__device__ __forceinline__ bool bg_issue(Bg& B, int slot, bool want, int lane) {
    const BgJob J = bg_job(B, slot); const bool valid = want && J.it < (J.K >> 6) * (J.dstN >> 5);
    const char* ub; unsigned loff; int sc, k0, n0; bg_src(J, lane, ub, loff, sc, k0, n0); size_t rs2 = (size_t)J.Ns * 8;
    if (!valid) { ub = (const char*)norm_ffn; loff = (unsigned)(lane * 4); rs2 = 256; }
    B.g0 = (f32x4){1.f, 1.f, 1.f, 1.f}; B.g1 = B.g0; if (valid && J.gain) { B.g0 = *(const f32x4*)(J.gain + k0 + 8 * (lane & 7)); B.g1 = *(const f32x4*)(J.gain + k0 + 8 * (lane & 7) + 4); }
#pragma unroll
    for (int i = 0; i < 32; ++i) B.tv[i] = __builtin_nontemporal_load((const float*)(ub + (size_t)i * rs2 + loff));
    return valid;
}
__device__ __forceinline__ void bg_finish(Bg& B, int slot, int lane) {
    const BgJob J = bg_job(B, slot); const char* ub; unsigned loff; int sc, k0, n0; bg_src(J, lane, ub, loff, sc, k0, n0); LAS float* scr = B.scr; const int K = J.K;
#pragma unroll
    for (int i = 0; i < 32; ++i) scr[(2 * i + (lane >> 5)) * 33 + (lane & 31)] = (sc < 0) ? 0.f : B.tv[i];
    LDS_WAIT(); asm volatile("" ::: "memory");
    const int c = lane & 7; const float f8scale = J.f8s;
    const f32x4 g0 = B.g0, g1 = B.g1;
#pragma unroll
    for (int j = 0; j < 4; ++j) { const int n = (lane >> 3) + 8 * j; const LAS float* s = scr + (8 * c) * 33 + n;
        if (f8scale != 0.f) { const float e[8] = {s[0 * 33] * g0[0] * f8scale, s[1 * 33] * g0[1] * f8scale, s[2 * 33] * g0[2] * f8scale, s[3 * 33] * g0[3] * f8scale, s[4 * 33] * g1[0] * f8scale, s[5 * 33] * g1[1] * f8scale, s[6 * 33] * g1[2] * f8scale, s[7 * 33] * g1[3] * f8scale};
            __builtin_nontemporal_store(pack8_fp8(e), (u32x2*)((unsigned char*)J.WT + (size_t)(n0 + n) * K + k0 + 8 * c)); }
        else { u32x4 o; o.x = pk2(s[0 * 33] * g0[0], s[1 * 33] * g0[1]); o.y = pk2(s[2 * 33] * g0[2], s[3 * 33] * g0[3]); o.z = pk2(s[4 * 33] * g1[0], s[5 * 33] * g1[1]); o.w = pk2(s[6 * 33] * g1[2], s[7 * 33] * g1[3]);
            __builtin_nontemporal_store(o, (u32x4*)(J.WT + (size_t)(n0 + n) * K + k0 + 8 * c)); } }
    LDS_WAIT(); asm volatile("" ::: "memory");
}
__device__ __forceinline__ void bg_tick(Bg& B, int lane) {
    if (B.inflight >= 0) { bg_finish(B, B.inflight, lane); B.inflight = -1; }
    const bool want = B.next < B.end; const int slot = want ? B.next : B.end - 1;
    if (bg_issue(B, slot, want, lane)) B.inflight = slot;
    if (want) ++B.next;
}

template <int NJ> __device__ __forceinline__ void select_core(const float* sc_row, unsigned* mask_row, int t, int lane, LAS unsigned* hist, Bg& B) {
    unsigned key[NJ];
#pragma unroll
    for (int j = 0; j < NJ; ++j) { const int s = 64 * j + lane; const unsigned u = __float_as_uint(sc_row[s <= t ? s : t]); const unsigned k = (u & 0x80000000u) ? ~u : (u | 0x80000000u); key[j] = (s <= t) ? k : 0u; }
    unsigned prefix = 0u; int need = 256;
#pragma unroll
    for (int lv = 0; lv < 4; ++lv) { const int shift = 24 - 8 * lv; const unsigned pmask = (lv == 0) ? 0u : (0xffffffffu << (shift + 8));
        { unsigned zz = 0u; asm volatile("" : "+v"(zz)); *(LAS u32x4*)(hist + 4 * lane) = (u32x4){zz, zz, zz, zz}; }
#pragma unroll
        for (int j = 0; j < NJ; ++j) if (key[j] != 0u && (key[j] & pmask) == prefix) atomicAdd((unsigned*)(hist + ((key[j] >> shift) & 255u)), 1u);
        const u32x4 hv = *(const LAS u32x4*)(hist + 4 * lane);
        const int mys = (int)(hv.x + hv.y + hv.z + hv.w); int inc = mys;
#pragma unroll
        for (int o = 1; o < 64; o <<= 1) { const int tv = __shfl_down(inc, o); if (lane + o < 64) inc += tv; }
        const int c3 = inc - mys, c2 = c3 + (int)hv.w, c1 = c2 + (int)hv.z, c0 = c1 + (int)hv.y;
        int fd = -1, fc = 0;
        if (c3 < need && need <= c3 + (int)hv.w) { fd = 3; fc = c3; } else if (c2 < need && need <= c2 + (int)hv.z) { fd = 2; fc = c2; }
        else if (c1 < need && need <= c1 + (int)hv.y) { fd = 1; fc = c1; } else if (c0 < need && need <= c0 + (int)hv.x) { fd = 0; fc = c0; }
        const unsigned long long fb = __ballot(fd >= 0); const int src = (int)__builtin_ctzll(fb | (1ull << 63));
        const int D = __shfl(4 * lane + fd, src), CA = __shfl(fc, src);
        prefix |= (unsigned)D << shift; need -= CA;
        bg_tick(B, lane);
    }
    const unsigned T = prefix;
    int run = 0; unsigned myw = 0u;
#pragma unroll
    for (int j = 0; j < NJ; ++j) { const bool eq = key[j] == T; const unsigned long long beq = __ballot(eq);
        const int pre = run + (int)__builtin_amdgcn_mbcnt_hi((unsigned)(beq >> 32), __builtin_amdgcn_mbcnt_lo((unsigned)beq, 0u));
        const bool sel = (key[j] > T) || (eq && pre < need); run += __popcll(beq);
        const unsigned long long bs = __ballot(sel); myw = (lane == 2 * j) ? (unsigned)bs : myw; myw = (lane == 2 * j + 1) ? (unsigned)(bs >> 32) : myw; }
    mask_row[lane] = myw;
    bg_tick(B, lane);
}
__device__ __forceinline__ void select_row(const float* sc_row, unsigned* mask_row, int t, int lane, LAS unsigned* hist, Bg& B) {
    asm volatile("" : "+v"(lane));
    if (t < 256) { const int lo = 32 * lane; mask_row[lane] = (t >= lo + 31) ? 0xffffffffu : (t < lo ? 0u : ((2u << (t - lo)) - 1u)); return; }
    if (t < 512) select_core<8>(sc_row, mask_row, t, lane, hist, B);
    else if (t < 1024) select_core<16>(sc_row, mask_row, t, lane, hist, B);
    else if (t < 1536) select_core<24>(sc_row, mask_row, t, lane, hist, B);
    else select_core<32>(sc_row, mask_row, t, lane, hist, B);
}

__global__ void __launch_bounds__(512, 2) mk_fwd(Args args) {
    extern __shared__ __attribute__((aligned(16))) unsigned char lds_raw[];
    LAS unsigned char* lds = (LAS unsigned char*)lds_raw;
    volatile LAS unsigned* MISC = (volatile LAS unsigned*)(lds + MISC_OFF);
    constexpr int G = 256, NGW = G * 8;
    const int bid = blockIdx.x; __builtin_assume(bid >= 0 && bid < G);
    unsigned* ctl = (unsigned*)((unsigned char*)arg_ptr(23) + WS_CTL);
    for (int u = threadIdx.x; u < (LDS_BYTES - LDSCTL_OFF) / 4; u += 512) ((LAS unsigned*)(lds + LDSCTL_OFF))[u] = 0u;
#define SITE_PROLOG unsigned char* ws = (unsigned char*)arg_ptr(23); int tid = threadIdx.x; asm volatile("" : "+v"(tid)); \
    const int lane = tid & 63, wave = __builtin_amdgcn_readfirstlane(tid >> 6), gw = bid * 8 + wave; (void)ws; (void)lane; (void)gw;
    __syncthreads();
#if MK_ONE_LAUNCH && DBG_STOP < 0
    constexpr int lo = 0, hi = NSTEPS;
#else
    const int lo = args.ph_lo, hi = args.ph_hi;
#endif
    XcdBarrier bar; bar.bar = ctl + CW_BAR; bar.x = 0; bar.st = nullptr;
    if (hi - lo > 1) bar = xcd_barrier_post(ctl + CW_BAR, MISC + 8);
    int step = 0;
#define STEP_IF if (step >= lo && step < hi)
#ifndef PROBE_AMP
#define PROBE_AMP 1ull
#endif
#ifdef PROBE_MASK
    unsigned long long pr_prev = wall_clock64(), pr_acc = 0ull;
#define STEP_END do { if (step >= lo && step + 1 < hi) xcd_barrier(bar); { const unsigned long long pr_t = wall_clock64(); if ((PROBE_MASK >> step) & 1u) pr_acc += pr_t - pr_prev; pr_prev = pr_t; } ++step; } while (0)
#else
#define STEP_END do { if (step >= lo && step + 1 < hi) xcd_barrier(bar); ++step; } while (0)
#endif

    if (SITE_ON(0)) STEP_IF { SITE_PROLOG
        LAS float* scr = (LAS float*)(lds + wave * 16384);
        { const int l = 0;
            conv_matrix(1, w_in + (size_t)l * DM * NIN, nullptr, DM, NIN, 19 * 256, WIN + (size_t)l * NINP * DM, norm_mix + l * DM, scr, gw, NGW, lane);
            conv_matrix(0, w_in + (size_t)l * DM * NIN + 4684, nullptr, DM, NIN, 6144, (bf16_t*)(WING8 + (size_t)l * 6144 * DM), norm_mix + l * DM, scr, gw, NGW, lane, W8SCALE);
            conv_matrix(0, w_ukv + (size_t)l * KVR * 1024, nullptr, KVR, 1024, 1024, WUKV + (size_t)l * 1024 * KVR, kv_norm + l * KVR, scr, gw, NGW, lane);
            conv_matrix(0, w_br0 + (size_t)l * WBR_W * DM, nullptr, WBR_W, DM, DM, WBR + (size_t)(l * 3 + 0) * DM * WBR_W, nullptr, scr, gw, NGW, lane);
            conv_matrix(0, w_br1 + (size_t)l * WBR_W * DM, nullptr, WBR_W, DM, DM, WBR + (size_t)(l * 3 + 1) * DM * WBR_W, nullptr, scr, gw, NGW, lane);
            conv_matrix(0, w_br2 + (size_t)l * WBR_W * DM, nullptr, WBR_W, DM, DM, WBR + (size_t)(l * 3 + 2) * DM * WBR_W, nullptr, scr, gw, NGW, lane);
            conv_matrix(0, w_out + (size_t)l * DM * DM, nullptr, DM, DM, DM, WOUT + (size_t)l * DM * DM, nullptr, scr, gw, NGW, lane);
        }
        for (int m = gw; m < NTOK; m += NGW) {
            const f32x4* xr = (const f32x4*)(x_in + (size_t)m * DM) + lane; f32x4 v[8]; float s = 0.f;
#pragma unroll
            for (int j = 0; j < 8; ++j) { v[j] = xr[64 * j]; s += (v[j][0] * v[j][0] + v[j][1] * v[j][1]) + (v[j][2] * v[j][2] + v[j][3] * v[j][3]); }
            s = wave_sum(s);
            u32x2* o = (u32x2*)(XB + (size_t)m * DM) + lane;
#pragma unroll
            for (int j = 0; j < 8; ++j) { u32x2 w; w.x = pk2(v[j][0], v[j][1]); w.y = pk2(v[j][2], v[j][3]); o[64 * j] = w; }
            { unsigned* o8 = (unsigned*)(XB8 + (size_t)m * DM) + lane;
#pragma unroll
              for (int j = 0; j < 8; ++j) { const float c0 = __builtin_amdgcn_fmed3f(v[j][0], -448.f, 448.f), c1 = __builtin_amdgcn_fmed3f(v[j][1], -448.f, 448.f), c2 = __builtin_amdgcn_fmed3f(v[j][2], -448.f, 448.f), c3 = __builtin_amdgcn_fmed3f(v[j][3], -448.f, 448.f);
                  int w = __builtin_amdgcn_cvt_pk_fp8_f32(c0, c1, 0, false); w = __builtin_amdgcn_cvt_pk_fp8_f32(c2, c3, w, true); o8[64 * j] = (unsigned)w; } }
            if (lane == 0) RSTD[m] = 1.0f / sqrtf(s * (1.0f / DM) + EPS);
        }
    }
    STEP_END;

    for (int l = 0; l < 2; ++l) {
        if (SITE_ON(1)) STEP_IF { SITE_PROLOG
            { pg8::PlainOrder S; S.init(NTOK / 256, 19, G, bid); S.A = (const char*)XB; S.ta = (size_t)256 * DM * 2; S.B = (const char*)(WIN + (size_t)l * NINP * DM); S.tb = (size_t)256 * DM * 2;
              EpiWin E{RSTD, Z8, DLAT, DIQ, DIK, FFW, GATES};
              pg8::gemm_phase<EpiWin, pg8::PlainOrder, true, true>(lds, pg8::Gemm{opq(DM), 0}, S, E); }
            { pg8::PlainOrder S; S.init(NTOK / 256, 24, G, bid); S.A = (const char*)XB8; S.ta = (size_t)256 * DM; S.B = (const char*)(WING8 + (size_t)l * 6144 * DM); S.tb = (size_t)256 * DM;
              EpiGate E{RSTD, GATES, 1.0f / W8SCALE};
              pg8::gemm_phase8<EpiGate, pg8::PlainOrder, true, true>(lds, pg8::Gemm{opq(DM / 2), 0}, S, E); }
        }
        STEP_END;
        if (SITE_ON(2)) STEP_IF { SITE_PROLOG
            {
                const float* gq = q_norm + l * HD + 8 * (lane & 7); const float* gk = k_norm + l * HD + 8 * (lane & 7);
                const f32x4 gq0 = *(const f32x4*)gq, gq1 = *(const f32x4*)(gq + 4), gk0 = *(const f32x4*)gk, gk1 = *(const f32x4*)(gk + 4);
                auto headnorm = [&](const u32x4 w, const f32x4 g0, const f32x4 g1, const float mul) -> u32x4 {
                    float v[8] = {bflo(w.x), bfhi(w.x), bflo(w.y), bfhi(w.y), bflo(w.z), bfhi(w.z), bflo(w.w), bfhi(w.w)}; float ss = 0.f;
#pragma unroll
                    for (int i = 0; i < 8; ++i) ss += v[i] * v[i];
                    ss += __shfl_xor(ss, 1); ss += __shfl_xor(ss, 2); ss += __shfl_xor(ss, 4);
                    const float rs = (1.0f / sqrtf(ss * (1.0f / 64.0f) + EPS)) * mul;
                    u32x4 o; o.x = pk2(v[0] * rs * g0[0], v[1] * rs * g0[1]); o.y = pk2(v[2] * rs * g0[2], v[3] * rs * g0[3]); o.z = pk2(v[4] * rs * g1[0], v[5] * rs * g1[1]); o.w = pk2(v[6] * rs * g1[2], v[7] * rs * g1[3]);
                    return o; };
#pragma unroll 1
                for (int mb = 0; mb < 8; mb += 4) { u32x4 wq[4], wk[4]; u32x2 wl[4];
#pragma unroll
                    for (int r = 0; r < 4; ++r) { const size_t m = (size_t)gw + (size_t)(mb + r) * NGW;
                        wq[r] = *(const u32x4*)(Z8 + m * 512 + 8 * lane); wk[r] = *(const u32x4*)(Z8 + (size_t)NTOK * 512 + m * 512 + 8 * lane); wl[r] = *(const u32x2*)(DLAT + m * 256 + 4 * lane); }
#pragma unroll
                    for (int r = 0; r < 4; ++r) { const size_t m = (size_t)gw + (size_t)(mb + r) * NGW;
                        const u32x4 oq = headnorm(wq[r], gq0, gq1, C2), ok = headnorm(wk[r], gk0, gk1, 1.0f);
                        const float a0 = bflo(wl[r].x), a1 = bfhi(wl[r].x), a2 = bflo(wl[r].y), a3 = bfhi(wl[r].y);
                        const float ss = wave_sum((a0 * a0 + a1 * a1) + (a2 * a2 + a3 * a3)); const float rs = 1.0f / sqrtf(ss * (1.0f / 256.0f) + EPS);
                        u32x2 ol; ol.x = pk2(a0 * rs, a1 * rs); ol.y = pk2(a2 * rs, a3 * rs);
                        *(u32x4*)(Z8 + m * 512 + 8 * lane) = oq; *(u32x4*)(Z8 + (size_t)NTOK * 512 + m * 512 + 8 * lane) = ok; *(u32x2*)(DLAT + m * 256 + 4 * lane) = ol; }
                }
            }
            if (bid < NBATCH * NHEAD) {
                const int b = bid >> 3, h = bid & 7; const float bias = b_forget[l * NHEAD + h]; LAS float* wt = (LAS float*)lds;
                const float* fp = FFW + ((size_t)b * SEQ + 4 * tid) * 16 + h; float v[4]; float tot = 0.f;
#pragma unroll
                for (int i = 0; i < 4; ++i) { tot += -softplus2(-(fp[i * 16] + bias) * LOG2E); v[i] = tot; }
                float inc = tot;
#pragma unroll
                for (int o = 1; o < 64; o <<= 1) { const float tv = __shfl_up(inc, o); if (lane >= o) inc += tv; }
                __syncthreads(); if (lane == 63) wt[wave] = inc; __syncthreads();
                float base = inc - tot;
                for (int w = 0; w < wave; ++w) base += wt[w];
                *(f32x4*)(C2F + ((size_t)b * NHEAD + h) * SEQ + 4 * tid) = (f32x4){-(base + v[0]), -(base + v[1]), -(base + v[2]), -(base + v[3])};
            }
            {
                const int id = bid * 8 + wave, b = id >> 8, rr = id & 255;
                int g, base; if (rr < 10) { g = 0; base = 0; } else if (rr < 30) { g = 1; base = 10; } else if (rr < 60) { g = 2; base = 30; } else if (rr < 100) { g = 3; base = 60; } else if (rr < 150) { g = 4; base = 100; } else if (rr < 210) { g = 5; base = 150; } else { g = 6; base = 210; }
                const int off = rr - base, tt = 10 * g + off / (g + 1), cch = off - (off / (g + 1)) * (g + 1);
                if (rr < 238) {
                int ln = lane; asm volatile("" : "+v"(ln)); const int r32 = ln & 31, hh = ln >> 5; const size_t trow = (size_t)b * SEQ + tt * 32 + r32;
                bf16x8 bq[4][4];
#pragma unroll
                for (int h = 0; h < 4; ++h)
#pragma unroll
                    for (int d0 = 0; d0 < 4; ++d0) bq[h][d0] = *(const bf16x8*)(DIQ + trow * 256 + h * 64 + d0 * 16 + 8 * hh);
                const f32x4 wv = *(const f32x4*)(FFW + trow * 16 + 8) * 0.0625f;
                const int st0 = cch * 10, st1 = (st0 + 9 < tt) ? st0 + 9 : tt;
                bf16x8 ak[4], an[4];
                { const size_t srow = (size_t)b * SEQ + st0 * 32 + r32;
#pragma unroll
                  for (int d0 = 0; d0 < 4; ++d0) an[d0] = *(const bf16x8*)(DIK + srow * 64 + d0 * 16 + 8 * hh); }
                for (int st = st0; st <= st1; ++st) {
#pragma unroll
                    for (int d0 = 0; d0 < 4; ++d0) ak[d0] = an[d0];
                    { const int sn = (st < st1) ? st + 1 : st; const size_t srow = (size_t)b * SEQ + sn * 32 + r32;
#pragma unroll
                      for (int d0 = 0; d0 < 4; ++d0) an[d0] = *(const bf16x8*)(DIK + srow * 64 + d0 * 16 + 8 * hh); }
                    f32x16 sc;
#pragma unroll
                    for (int r = 0; r < 16; ++r) sc[r] = 0.f;
#pragma unroll
                    for (int h = 0; h < 4; ++h) { f32x16 a;
#pragma unroll
                        for (int r = 0; r < 16; ++r) a[r] = 0.f;
#pragma unroll
                        for (int d0 = 0; d0 < 4; ++d0) a = __builtin_amdgcn_mfma_f32_32x32x16_bf16(ak[d0], bq[h][d0], a, 0, 0, 0);
#pragma unroll
                        for (int r = 0; r < 16; ++r) sc[r] += fmaxf(a[r], 0.f) * wv[h]; }
                    float* sp = SC + trow * SEQ + st * 32 + 4 * hh;
#pragma unroll
                    for (int g = 0; g < 4; ++g) *(f32x4*)(sp + 8 * g) = (f32x4){sc[4 * g], sc[4 * g + 1], sc[4 * g + 2], sc[4 * g + 3]};
                }
                }
            }
        }
        STEP_END;
        if (SITE_ON(3)) STEP_IF { SITE_PROLOG
            { pg8::PlainOrder S; S.init(NTOK / 256, 4, G, bid); S.A = (const char*)DLAT; S.ta = (size_t)256 * KVR * 2; S.B = (const char*)(WUKV + (size_t)l * 1024 * KVR); S.tb = (size_t)256 * KVR * 2;
              EpiPlain E{DKV, 1024};
              pg8::gemm_phase<EpiPlain, pg8::PlainOrder, true, true>(lds, pg8::Gemm{opq(KVR), 0}, S, E); }
        }
        STEP_END;
        if (SITE_ON(4)) STEP_IF { SITE_PROLOG
            Bg B; B.ws = ws; B.scr = (LAS float*)(lds + 16384 + wave * 8704); B.l = l; B.gw = gw; B.next = 0; B.end = 55; B.inflight = -1; B.g0 = (f32x4){1.f, 1.f, 1.f, 1.f}; B.g1 = B.g0;
#pragma unroll
            for (int i = 0; i < 32; ++i) B.tv[i] = 0.f;
            for (int k = 0; k < 8; ++k) { const int idx = gw + k * NGW; const int b = idx / SEQ, t0 = idx - b * SEQ, t = (b & 1) ? SEQ - 1 - t0 : t0; const size_t row = (size_t)b * SEQ + t;
                select_row(SC + row * SEQ, MASK + row * 64, t, lane, (LAS unsigned*)(lds + wave * 1024), B);
                const int upto = ((k + 1) * 55) >> 3;
                while (B.next < upto) bg_tick(B, lane); }
            while (B.inflight >= 0 || B.next < B.end) bg_tick(B, lane);
        }
        STEP_END;
        if (SITE_ON(5)) STEP_IF { SITE_PROLOG
            const int xq = bid & 7; unsigned* qctr = ctl + CW_ATTQ + (l * 8 + xq) * 32;
            unsigned ticket = 0u; if (tid == 0) ticket = __hip_atomic_fetch_add(qctr, 1u, __ATOMIC_RELAXED, __HIP_MEMORY_SCOPE_AGENT);
            if (tid == 0) MISC[65] = ticket;
            __syncthreads();
            unsigned u = MISC[65];
#define ATT_DECODE(uu, var, qb, hh) int var, qb, hh; if ((uu) < 64u) { var = 1; qb = 7 - (int)((uu) >> 3); hh = (int)((uu) & 7u); } else { const unsigned v_ = (uu) - 64u; qb = 7 - (int)(v_ >> 4); var = (v_ & 1u) ? 2 : 0; hh = (int)((v_ >> 1) & 7u); }
#define ATT_BEGIN(var, b, hh, qb) do { if (var == 0) att::attn_begin(lds, 0, b, hh, qb, Z8 + (size_t)1 * NTOK * 512, 512, Z8 + (size_t)2 * NTOK * 512, 512, C2F, nullptr); \
                else if (var == 1) att::attn_begin(lds, 1, b, hh, qb, Z8 + (size_t)5 * NTOK * 512, 512, Z8 + (size_t)6 * NTOK * 512, 512, nullptr, nullptr); \
                else att::attn_begin(lds, 2, b, hh, qb, DKV, 1024, DKV + 512, 1024, nullptr, MASK); } while (0)
            const int b = xq;
            if (u < 192u) { ATT_DECODE(u, var0, qb0, h0) ATT_BEGIN(var0, b, h0, qb0); }
            while (u < 192u) {
                ATT_DECODE(u, var, qb, h)
                if (tid == 0) ticket = __hip_atomic_fetch_add(qctr, 1u, __ATOMIC_RELAXED, __HIP_MEMORY_SCOPE_AGENT);
                unsigned unext = 192u;
                auto next = [&]() { unext = MISC[65]; if (unext < 192u) { ATT_DECODE(unext, varn, qbn, hn) ATT_BEGIN(varn, b, hn, qbn); } };
#ifdef ATT_PROBE_VAR
                const unsigned long long pa_t0 = wall_clock64();
#endif
                if (var == 0) att::attn_unit<0>(lds, ticket, next, b, h, qb, Z8, Z8 + (size_t)1 * NTOK * 512, 512, Z8 + (size_t)2 * NTOK * 512, 512, C2F, nullptr, nullptr, Z8 + (size_t)3 * NTOK * 512, YATT);
                else if (var == 1) att::attn_unit<1>(lds, ticket, next, b, h, qb, Z8 + (size_t)4 * NTOK * 512, Z8 + (size_t)5 * NTOK * 512, 512, Z8 + (size_t)6 * NTOK * 512, 512, nullptr, nullptr, nullptr, nullptr, YATT + (size_t)NTOK * 512);
                else att::attn_unit<2>(lds, ticket, next, b, h, qb, Z8 + (size_t)7 * NTOK * 512, DKV, 1024, DKV + 512, 1024, nullptr, MASK, rel_bias, nullptr, YATT + (size_t)2 * NTOK * 512);
#ifdef ATT_PROBE_VAR
                if (var == ATT_PROBE_VAR) pr_acc += wall_clock64() - pa_t0;
#endif
                u = unext;
            }
#undef ATT_DECODE
#undef ATT_BEGIN
        }
        STEP_END;
        if (SITE_ON(6)) STEP_IF { SITE_PROLOG
            pg8::BranchOrder S; S.init(NTOK / 256, DM / 256, G, bid); S.A = (const char*)YATT; S.ta = (size_t)256 * WBR_W * 2; S.za = (size_t)NTOK * WBR_W * 2;
            S.B = (const char*)(WBR + (size_t)l * 3 * DM * WBR_W); S.tb = (size_t)256 * WBR_W * 2; S.zb = (size_t)DM * WBR_W * 2;
            EpiBranch E{GATES, MB};
            pg8::gemm_phase_carry<EpiBranch, pg8::BranchOrder, true, true>(lds, pg8::Gemm{opq(WBR_W), 0}, S, E);
        }
        STEP_END;
        if (SITE_ON(7)) STEP_IF { SITE_PROLOG
            pg8::PlainOrder S; S.init(NTOK / 256, DM / 256, G, bid); S.A = (const char*)MB; S.ta = (size_t)256 * DM * 2; S.B = (const char*)(WOUT + (size_t)l * DM * DM); S.tb = (size_t)256 * DM * 2;
            EpiResid E{l == 0 ? x_in : (const float*)X, X, l == 0 ? XB : nullptr, SSP, l == 0 ? nullptr : XB8, 1.0f};
            pg8::gemm_phase<EpiResid, pg8::PlainOrder, true, true>(lds, pg8::Gemm{opq(DM), 0}, S, E);
        }
        STEP_END;
        if (l == 0) {
            if (SITE_ON(8)) STEP_IF { SITE_PROLOG for (int r = bid * 512 + tid; r < NTOK; r += G * 512) { const f32x4* p = (const f32x4*)(SSP + (size_t)r * 32); float s = 0.f;
#pragma unroll
                    for (int j = 0; j < 8; ++j) { const f32x4 v = p[j]; s += (v[0] + v[1]) + (v[2] + v[3]); }
                    RSTD[r] = 1.0f / sqrtf(s * (1.0f / DM) + EPS); } }
            STEP_END;
            if (SITE_ON(9)) STEP_IF { SITE_PROLOG
                pg8::PlainOrder S; S.init(NTOK / 256, DFF / 128, G, bid); S.A = (const char*)XB; S.ta = (size_t)256 * DM * 2; S.B = (const char*)WGU0; S.tb = (size_t)256 * DM * 2;
                EpiSwiglu E{RSTD, HID, 1.0f, 1};
                pg8::gemm_phase<EpiSwiglu, pg8::PlainOrder, true, true>(lds, pg8::Gemm{opq(DM), 0}, S, E);
            }
            STEP_END;
            if (SITE_ON(10)) STEP_IF { SITE_PROLOG
                pg8::PlainOrder S; S.init(NTOK / 256, DM / 256, G, bid); S.A = (const char*)HID; S.ta = (size_t)256 * DFF; S.B = (const char*)WD0; S.tb = (size_t)256 * DFF;
                EpiResid E{X, X, XB, SSP, XB8, 1.0f / (WD8SCALE * H8SCALE)};
                pg8::gemm_phase8<EpiResid, pg8::PlainOrder, true, true>(lds, pg8::Gemm{opq(DFF / 2), 0}, S, E);
            }
            STEP_END;
            if (SITE_ON(11)) STEP_IF { SITE_PROLOG for (int r = bid * 512 + tid; r < NTOK; r += G * 512) { const f32x4* p = (const f32x4*)(SSP + (size_t)r * 32); float s = 0.f;
#pragma unroll
                    for (int j = 0; j < 8; ++j) { const f32x4 v = p[j]; s += (v[0] + v[1]) + (v[2] + v[3]); }
                    RSTD[r] = 1.0f / sqrtf(s * (1.0f / DM) + EPS); } }
            STEP_END;
        } else {
            if (SITE_ON(12)) STEP_IF { SITE_PROLOG
                LAS int* le = (LAS int*)lds;
                for (int wgi = bid; wgi < NTOK / 64; wgi += G) {
                    __syncthreads();
                    {
                        const int tok = wgi * 64 + lane; const float* xr = X + (size_t)tok * DM + 256 * wave;
                        const float* gp = norm_ffn + DM + 256 * wave; const float* wp = w_router + (size_t)(256 * wave) * 8;
                        float lg[8]; float ss = 0.f;
#pragma unroll
                        for (int e = 0; e < 8; ++e) lg[e] = 0.f;
#pragma unroll 1
                        for (int k8 = 0; k8 < 8; ++k8) { f32x4 xv[8];
#pragma unroll
                            for (int j = 0; j < 8; ++j) xv[j] = *(const f32x4*)(xr + 32 * k8 + 4 * j);
#pragma unroll
                            for (int j = 0; j < 8; ++j)
#pragma unroll
                                for (int c = 0; c < 4; ++c) { const int k = 32 * k8 + 4 * j + c; const float xv1 = xv[j][c]; ss += xv1 * xv1; const float xg = xv1 * gp[k]; const float* wr = wp + k * 8;
#pragma unroll
                                    for (int e = 0; e < 8; ++e) lg[e] += xg * wr[e]; } }
                        LAS float* part = (LAS float*)(lds + 1024) + (wave * 64 + lane) * 9;
#pragma unroll
                        for (int e = 0; e < 8; ++e) part[e] = lg[e];
                        part[8] = ss;
                        __syncthreads();
                        if (wave == 0) { float L[8]; float S = 0.f;
#pragma unroll
                            for (int e = 0; e < 8; ++e) L[e] = 0.f;
                            for (int w = 0; w < 8; ++w) { const LAS float* pp = (const LAS float*)(lds + 1024) + (w * 64 + lane) * 9;
#pragma unroll
                                for (int e = 0; e < 8; ++e) L[e] += pp[e];
                                S += pp[8]; }
                            const float rs = 1.0f / sqrtf(S * (1.0f / DM) + EPS);
#pragma unroll
                            for (int e = 0; e < 8; ++e) L[e] *= rs;
                            float v0 = L[0]; int i0 = 0;
#pragma unroll
                            for (int e = 1; e < 8; ++e) if (L[e] > v0) { v0 = L[e]; i0 = e; }
                            float v1 = -INFINITY; int i1 = 0;
#pragma unroll
                            for (int e = 0; e < 8; ++e) if (e != i0 && L[e] > v1) { v1 = L[e]; i1 = e; }
                            const float ex = __expf(v1 - v0), w0 = 1.0f / (1.0f + ex), w1 = ex / (1.0f + ex);
                            le[lane * 2] = i0; le[lane * 2 + 1] = i1; TOKW[(size_t)tok * 2] = w0; TOKW[(size_t)tok * 2 + 1] = w1; RSTD[tok] = rs; }
                    }
                    __syncthreads();
                    if (tid < 128) { const int e = le[tid]; int rk = 0; for (int j = 0; j < tid; ++j) rk += (le[j] == e); const int tok = wgi * 64 + (tid >> 1);
                        TOKINFO[((size_t)tok * 2 + (tid & 1)) * 2] = e; TOKINFO[((size_t)tok * 2 + (tid & 1)) * 2 + 1] = rk; }
                    if (tid >= 128 && tid < 136) { const int e = tid - 128; int c = 0; for (int j = 0; j < 128; ++j) c += (le[j] == e); WGCNT[wgi * 8 + e] = c; }
                }
            }
            STEP_END;
            if (SITE_ON(13)) STEP_IF { SITE_PROLOG
                LAS int* lc = (LAS int*)lds;
                for (int wgi = bid; wgi < NTOK / 64; wgi += G) {
                    __syncthreads();
                    { const int e = wave; int all = 0, before = 0;
#pragma unroll
                      for (int c = 0; c < 4; ++c) { const int w = 4 * lane + c; const int v = WGCNT[w * 8 + e]; all += v; before += (w < wgi) ? v : 0; }
#pragma unroll
                      for (int o = 1; o < 64; o <<= 1) { all += __shfl_xor(all, o); before += __shfl_xor(before, o); }
                      if (lane == 0) { lc[e] = all; lc[8 + e] = before; } }
                    __syncthreads();
                    if (tid == 0) { int tb = 0; for (int e = 0; e < 8; ++e) { lc[16 + e] = tb * 256; tb += (lc[e] + 255) >> 8; if (wgi == 0) META[e] = lc[16 + e] >> 8; } if (wgi == 0) META[8] = tb; }
                    __syncthreads();
                    for (int hb = 0; hb < 2; ++hb) {
                        int rr[8]; u32x4 d0[8], d1[8];
#pragma unroll
                        for (int i = 0; i < 8; ++i) { const int p = wave * 16 + hb * 8 + i, tok = wgi * 64 + (p >> 1), slot = p & 1;
                            const int e = TOKINFO[((size_t)tok * 2 + slot) * 2], rk = TOKINFO[((size_t)tok * 2 + slot) * 2 + 1]; rr[i] = lc[16 + e] + lc[8 + e] + rk;
                            const u32x4* sp = (const u32x4*)(XB8 + (size_t)tok * DM) + lane; d0[i] = sp[0]; d1[i] = sp[64]; }
#pragma unroll
                        for (int i = 0; i < 8; ++i) { const int p = wave * 16 + hb * 8 + i, tok = wgi * 64 + (p >> 1), slot = p & 1; const int r = rr[i];
                            u32x4* dp = (u32x4*)((unsigned char*)XG + (size_t)r * DM) + lane; dp[0] = d0[i]; dp[64] = d1[i];
                            if (lane == 0) { POSR[tok * 2 + slot] = r; ROWTOK[r] = tok * 2 + slot; ROWW[r] = TOKW[(size_t)tok * 2 + slot]; RSTDG[r] = RSTD[tok]; } }
                    }
                    if (wgi < 8) { const int e = wgi, r0 = lc[16 + e] + lc[e], r1 = lc[16 + e] + (((lc[e] + 255) >> 8) << 8);
                        for (int r = r0 + wave; r < r1; r += 8) { u32x4* dp = (u32x4*)((unsigned char*)XG + (size_t)r * DM) + lane;
#pragma unroll
                            for (int c = 0; c < 2; ++c) dp[64 * c] = (u32x4){0u, 0u, 0u, 0u};
                            if (lane == 0) { ROWTOK[r] = -1; ROWW[r] = 0.f; RSTDG[r] = 0.f; } } }
                }
            }
            STEP_END;
            if (SITE_ON(14)) STEP_IF { SITE_PROLOG
                pg8::MoeOrder S; S.t1 = META[1]; S.t2 = META[2]; S.t3 = META[3]; S.t4 = META[4]; S.t5 = META[5]; S.t6 = META[6]; S.t7 = META[7];
                S.init(META[8], DFF / 128, G, bid); S.A = (const char*)XG; S.ta = (size_t)256 * DM; S.B = (const char*)WGUM; S.tb = (size_t)256 * DM; S.zb = SZ_WGU / 2;
                EpiSwiglu E{RSTDG, HIDM, 1.0f / W8SCALE, 1};
                pg8::gemm_phase8<EpiSwiglu, pg8::MoeOrder, true, true>(lds, pg8::Gemm{opq(DM / 2), 0}, S, E);
            }
            STEP_END;
            if (SITE_ON(15)) STEP_IF { SITE_PROLOG
                pg8::MoeOrder S; S.t1 = META[1]; S.t2 = META[2]; S.t3 = META[3]; S.t4 = META[4]; S.t5 = META[5]; S.t6 = META[6]; S.t7 = META[7];
                const int T = META[8], Tfull = T < 128 ? T : 128;
                S.init(Tfull, DM / 256, G, bid); S.A = (const char*)HIDM; S.ta = (size_t)256 * DFF; S.B = (const char*)WDM; S.tb = (size_t)256 * DFF; S.zb = SZ_WD / 2;
                EpiMoeDown E{ROWTOK, ROWW, Y, 1.0f / (WD8SCALE * H8SCALE)};
                pg8::gemm_phase8<EpiMoeDown, pg8::MoeOrder, true, true>(lds, pg8::Gemm{opq(DFF / 2), 0}, S, E);
                if (T > 128) {
                    pg8::TailOrder S2; S2.ntail = (T - 128) * 32; S2.G = G; S2.c = bid; S2.A = S.A; S2.B = S.B; S2.ta = S.ta; S2.tb = S.tb; S2.zb = S.zb; S2.kq = DFF / 4;
                    S2.t1 = S.t1; S2.t2 = S.t2; S2.t3 = S.t3; S2.t4 = S.t4; S2.t5 = S.t5; S2.t6 = S.t6; S2.t7 = S.t7;
                    EpiMoeTail E2{ROWTOK, ROWW, YP, 1.0f / (WD8SCALE * H8SCALE)};
                    pg8::gemm_phase8<EpiMoeTail, pg8::TailOrder, true, true>(lds, pg8::Gemm{opq(DFF / 8), DFF / 2}, S2, E2); }
            }
            STEP_END;
            if (SITE_ON(16)) STEP_IF { SITE_PROLOG
                for (int m = gw; m < NTOK; m += NGW) {
                    f32x4* xr = (f32x4*)(X + (size_t)m * DM) + lane; const u32x2* y0 = (const u32x2*)(Y + (size_t)m * DM) + lane; const u32x2* y1 = (const u32x2*)(Y + (size_t)NTOK * DM + (size_t)m * DM) + lane;
                    f32x4 v[8]; float s = 0.f; const int r0 = POSR[2 * m], r1 = POSR[2 * m + 1];
                    if (r0 >= 32768 || r1 >= 32768) {
#pragma unroll
                        for (int j = 0; j < 8; ++j) { f32x4 acc4 = xr[64 * j];
#pragma unroll
                            for (int sl = 0; sl < 2; ++sl) { const int r = sl ? r1 : r0;
                                if (r < 32768) { const u32x2 a = (sl ? y1 : y0)[64 * j]; acc4 += (f32x4){bflo(a.x), bfhi(a.x), bflo(a.y), bfhi(a.y)}; }
                                else { for (int q = 0; q < 4; ++q) { const u32x2 a = ((const u32x2*)(YP + ((size_t)q * 2048 + (size_t)(r - 32768)) * DM) + lane)[64 * j]; acc4 += (f32x4){bflo(a.x), bfhi(a.x), bflo(a.y), bfhi(a.y)}; } } }
                            v[j] = acc4; s += (v[j][0] * v[j][0] + v[j][1] * v[j][1]) + (v[j][2] * v[j][2] + v[j][3] * v[j][3]); }
                    } else
#pragma unroll
                    for (int j = 0; j < 8; ++j) { const u32x2 a = y0[64 * j], b = y1[64 * j]; v[j] = xr[64 * j] + (f32x4){bflo(a.x), bfhi(a.x), bflo(a.y), bfhi(a.y)} + (f32x4){bflo(b.x), bfhi(b.x), bflo(b.y), bfhi(b.y)}; s += (v[j][0] * v[j][0] + v[j][1] * v[j][1]) + (v[j][2] * v[j][2] + v[j][3] * v[j][3]); }
                    s = wave_sum(s); const float rs = 1.0f / sqrtf(s * (1.0f / DM) + EPS);
#pragma unroll
                    for (int j = 0; j < 8; ++j) { const f32x4 g = *((const f32x4*)norm_final + lane + 64 * j); xr[64 * j] = v[j] * rs * g; }
                }
            }
            STEP_END;
        }
    }
#ifdef PROBE_MASK
    if (bid == 0 && threadIdx.x == 0) { const unsigned long long pr_t0 = wall_clock64(); while (wall_clock64() - pr_t0 < pr_acc * PROBE_AMP) __builtin_amdgcn_s_sleep(8); }
#endif
#undef STEP_IF
#undef STEP_END
}


#if DBG_STOP >= 0
__global__ void dbg_dump(const unsigned short* ws16, size_t n16, const unsigned* xin, float* out, int with_x) {
    for (size_t i = (size_t)blockIdx.x * blockDim.x + threadIdx.x; i < (size_t)NTOK * DM; i += (size_t)gridDim.x * blockDim.x) {
        unsigned acc = 0; for (size_t off = i; off < n16; off += (size_t)NTOK * DM) acc += ws16[off];
        if (with_x) { const unsigned u = xin[i]; acc += (u & 0xffffu) + (u >> 16); }
        out[i] = (float)(acc & 0xfffffu);
    }
}
#endif

#if DBG_STOP == 100
__global__ void dbg_cmp3(const unsigned short* a0, const unsigned short* b0, const unsigned short* a1, const unsigned short* b1, const unsigned short* a2, const unsigned short* b2, unsigned* cnt) {
    unsigned c0 = 0, c1 = 0, c2 = 0;
    for (size_t i = (size_t)blockIdx.x * blockDim.x + threadIdx.x; i < (size_t)NTOK * DM; i += (size_t)gridDim.x * blockDim.x) { c0 += a0[i] != b0[i]; c1 += a1[i] != b1[i]; c2 += a2[i] != b2[i]; }
    if (c0) atomicAdd(cnt, c0); if (c1) atomicAdd(cnt + 1, c1); if (c2) atomicAdd(cnt + 2, c2);
}
__global__ void dbg_fill(float* out, const unsigned* cnt) {
    const float E = (cnt[0] ? 3.f : 0.f) + (cnt[1] ? 10.f : 0.f) + (cnt[2] ? 30.f : 0.f);
    for (size_t i = (size_t)blockIdx.x * blockDim.x + threadIdx.x; i < (size_t)NTOK * DM; i += (size_t)gridDim.x * blockDim.x) out[i] = E;
}
#endif

#if DBG_STOP == 200
__global__ void dbg_cksum(const unsigned long long* p, size_t nblk, unsigned long long* ck) {
    for (size_t b = (size_t)blockIdx.x * blockDim.x + threadIdx.x; b < nblk; b += (size_t)gridDim.x * blockDim.x) {
        unsigned long long h = 0x9E3779B97F4A7C15ull; const unsigned long long* q = p + b * 128;
        for (int i = 0; i < 128; ++i) { h ^= q[i]; h *= 0xBF58476D1CE4E5B9ull; h ^= h >> 29; }
        ck[b] = h; }
}
__global__ void dbg_ckcmp(const unsigned long long* a, const unsigned long long* b, size_t nblk, unsigned long long* first) {
    for (size_t i = (size_t)blockIdx.x * blockDim.x + threadIdx.x; i < nblk; i += (size_t)gridDim.x * blockDim.x) if (a[i] != b[i]) atomicMin(first, (unsigned long long)i);
}
__global__ void dbg_fill2(float* out, const unsigned long long* first) {
    const unsigned long long off = WS_RSTD + (*first) * 1024ull; int id = 0;
    if (*first != ~0ull) { id = 1; if (off >= WS_Z8) id = 2; if (off >= WS_DLAT) id = 3; if (off >= WS_DIQ) id = 4; if (off >= WS_DIK) id = 5; if (off >= WS_FFW) id = 6; if (off >= WS_GATES) id = 7; if (off >= WS_C2F) id = 8;
        if (off >= WS_DKV) id = 9; if (off >= WS_SC) id = 10; if (off >= WS_MASK) id = 11; if (off >= WS_YATT) id = 12; if (off >= WS_M) id = 13; }
    const float E = 3.f * id;
    for (size_t i = (size_t)blockIdx.x * blockDim.x + threadIdx.x; i < (size_t)NTOK * DM; i += (size_t)gridDim.x * blockDim.x) out[i] = E;
}
#endif
extern "C" void kernel_launch(void* const* d_in, const int* in_sizes, int n_in, void* d_out, int out_size, void* d_ws, size_t ws_size, hipStream_t stream) {
    static int grid = 0;
    if (grid == 0) {
        if (n_in != 22 || out_size != NTOK * DM || ws_size < WS_END) { fprintf(stderr, "kernel_launch: unexpected problem (n_in %d, out %d, ws %zu, need %zu)\n", n_in, out_size, ws_size, (size_t)WS_END); grid = -1; return; }
        int dev = 0, cus = 0;
        if (hipGetDevice(&dev) != hipSuccess || hipDeviceGetAttribute(&cus, hipDeviceAttributeMultiprocessorCount, dev) != hipSuccess) { grid = -1; return; }
        if (hipFuncSetAttribute((const void*)mk_fwd, hipFuncAttributeMaxDynamicSharedMemorySize, LDS_BYTES) != hipSuccess) { fprintf(stderr, "kernel_launch: hipFuncSetAttribute failed\n"); grid = -1; return; }
        int per_cu = 0;
        if (hipOccupancyMaxActiveBlocksPerMultiprocessor(&per_cu, (const void*)mk_fwd, 512, LDS_BYTES) != hipSuccess || per_cu < 1) fprintf(stderr, "kernel_launch: occupancy query says %d\n", per_cu);
        (void)hipGetLastError();
        if (cus != 256) { fprintf(stderr, "kernel_launch: built for a 256-CU device, found %d CUs\n", cus); grid = -1; return; }
        grid = cus;
    }
    if (grid < 0) return;
    (void)hipMemsetAsync((char*)d_ws + WS_CTL, 0, CTL_ZERO_BYTES, stream);
    Args a{};
    for (int i = 0; i < 22; ++i) a.in[i] = (const float*)d_in[i];
    a.out = (float*)d_out; a.ws = (unsigned char*)d_ws;
#if DBG_STOP == 200
    for (int s = 0; s <= DBG_HI; ++s) { a.ph_lo = s; a.ph_hi = s + 1; hipLaunchKernelGGL(mk_fwd, dim3(grid), dim3(512), LDS_BYTES, stream, a); }
    { char* w = (char*)d_ws; const size_t nblk = (WS_R_END1 - WS_RSTD) / 1024; unsigned long long* ck0 = (unsigned long long*)(w + WS_R_END1); unsigned long long* ck1 = ck0 + nblk; unsigned long long* first = (unsigned long long*)(w + 4096);
#ifdef DBG_WARMFIRST
      for (int s = DBG_LOSTEP; s <= DBG_HI; ++s) { a.ph_lo = s; a.ph_hi = s + 1; hipLaunchKernelGGL(mk_fwd, dim3(grid), dim3(512), LDS_BYTES, stream, a); }
#endif
      hipLaunchKernelGGL(dbg_cksum, dim3(2048), dim3(256), 0, stream, (const unsigned long long*)(w + WS_RSTD), nblk, ck0);
      for (int s = DBG_LOSTEP; s <= DBG_HI; ++s) { a.ph_lo = s; a.ph_hi = s + 1; hipLaunchKernelGGL(mk_fwd, dim3(grid), dim3(512), LDS_BYTES, stream, a); }
      hipLaunchKernelGGL(dbg_cksum, dim3(2048), dim3(256), 0, stream, (const unsigned long long*)(w + WS_RSTD), nblk, ck1);
      (void)hipMemsetAsync(first, 0xFF, 8, stream);
      hipLaunchKernelGGL(dbg_ckcmp, dim3(1024), dim3(256), 0, stream, (const unsigned long long*)ck0, (const unsigned long long*)ck1, nblk, first);
      hipLaunchKernelGGL(dbg_fill2, dim3(2048), dim3(256), 0, stream, (float*)d_out, (const unsigned long long*)first); }
#elif DBG_STOP == 100
    for (int s = 0; s <= 6; ++s) { a.ph_lo = s; a.ph_hi = s + 1; hipLaunchKernelGGL(mk_fwd, dim3(grid), dim3(512), LDS_BYTES, stream, a); }
    { char* w = (char*)d_ws; const size_t SZ = (size_t)NTOK * DM * 2; char* cp = w + WS_R_END1;
      hipMemcpyAsync(cp, w + WS_M, SZ, hipMemcpyDeviceToDevice, stream); hipMemcpyAsync(cp + SZ, w + WS_SC, 2 * SZ, hipMemcpyDeviceToDevice, stream);
      a.ph_lo = 6; a.ph_hi = 7; hipLaunchKernelGGL(mk_fwd, dim3(grid), dim3(512), LDS_BYTES, stream, a);
      unsigned* cnt = (unsigned*)(w + 4096); hipMemsetAsync(cnt, 0, 64, stream);
      hipLaunchKernelGGL(dbg_cmp3, dim3(2048), dim3(256), 0, stream, (const unsigned short*)(w + WS_M), (const unsigned short*)cp, (const unsigned short*)(w + WS_SC), (const unsigned short*)(cp + SZ), (const unsigned short*)(w + WS_SC + SZ), (const unsigned short*)(cp + 2 * SZ), cnt);
      hipLaunchKernelGGL(dbg_fill, dim3(2048), dim3(256), 0, stream, (float*)d_out, (const unsigned*)cnt); }
#elif DBG_STOP >= 0
    for (int s = 0; s <= DBG_STOP; ++s) { a.ph_lo = s; a.ph_hi = s + 1; hipLaunchKernelGGL(mk_fwd, dim3(grid), dim3(512), LDS_BYTES, stream, a); }
#ifdef DBG_TWICE
    { a.ph_lo = DBG_STOP; a.ph_hi = DBG_STOP + 1; hipLaunchKernelGGL(mk_fwd, dim3(grid), dim3(512), LDS_BYTES, stream, a); }
#endif
    hipLaunchKernelGGL(dbg_dump, dim3(2048), dim3(256), 0, stream, (const unsigned short*)((const char*)d_ws + DBG_LO), (size_t)((WS_END - DBG_LO) / 2), (const unsigned*)d_out, (float*)d_out, DBG_STOP >= 7 ? 1 : 0);
#elif MK_ONE_LAUNCH
    a.ph_lo = 0; a.ph_hi = NSTEPS;
    hipLaunchKernelGGL(mk_fwd, dim3(grid), dim3(512), LDS_BYTES, stream, a);
#else
    for (int s = 0; s < NSTEPS; ++s) { a.ph_lo = s; a.ph_hi = s + 1; hipLaunchKernelGGL(mk_fwd, dim3(grid), dim3(512), LDS_BYTES, stream, a);
#ifdef DUP_MASK
        if ((DUP_MASK >> s) & 1u) { hipLaunchKernelGGL(mk_fwd, dim3(grid), dim3(512), LDS_BYTES, stream, a); }
#endif
    }
#endif
}
```

```cpp
#include <hip/hip_runtime.h>
#include <cstdio>
#include <cstdint>

#ifndef SITE_MASK
#define SITE_MASK 0xffffffffu
#endif
#define SITE_ON(i) (((SITE_MASK) >> (i)) & 1u)

#ifndef DUP_DRY
#define DUP_DRY 0
#endif
#ifndef DBG_STOP
#define DBG_STOP -1
#endif
#ifndef DBG_LO
#define DBG_LO WS_WIN
#endif
#ifndef MK_ONE_LAUNCH
#define MK_ONE_LAUNCH 1
#endif

namespace pg8 {
#define PG8_LAS __attribute__((address_space(3)))
typedef unsigned short bf16_t;
typedef short bf16x8 __attribute__((ext_vector_type(8)));
typedef float f32x4 __attribute__((ext_vector_type(4)));
typedef unsigned u32x4 __attribute__((ext_vector_type(4)));
constexpr int BM = 256, BK = 64, HALF = 128, HTB = HALF * BK * 2  , STAGE_BYTES = 8 * HTB, NXCD = 8, WGM = 8;

__host__ __device__ __forceinline__ int lds_byte(int r, int c) { const int st = (r >> 4) * 2 + (c >> 5), rr = r & 15, cc = c & 31, ob = rr * 64 + cc * 2; return st * 1024 + (ob ^ (((ob >> 9) & 1) << 5)); }
__host__ __device__ __forceinline__ void stage_rc(int b, int& R, int& C) { const int st = b / 1024, sb = b % 1024, swz = sb ^ (((sb >> 9) & 1) << 5); R = (st >> 1) * 16 + swz / 64; C = (st & 1) * 32 + (swz % 64) / 2; }
__host__ __device__ __forceinline__ int perm32(int rho) { const int n = rho >> 4, i = rho & 15; return 8 * (i >> 2) + 4 * n + (i & 3); }
struct Unit { int pm, pn, aux; const char* a; const char* b; };
struct Gemm { int K, P; };
__device__ __forceinline__ unsigned cvt_pk_bf16(float lo, float hi) { unsigned r; asm volatile("v_cvt_pk_bf16_f32 %0, %1, %2" : "=v"(r) : "v"(lo), "v"(hi)); return r; }
template <class Epi, class Sched, bool ALIGN_EPI = false, bool SP2 = false>
__device__ __forceinline__ void gemm_phase(PG8_LAS unsigned char* lds, const Gemm g, const Sched& S, const Epi& E) {
    int tid_ = threadIdx.x; asm volatile("" : "+v"(tid_)); const int tid = tid_, wid = __builtin_amdgcn_readfirstlane(tid >> 6), lane = tid & 63, wr = wid >> 2, wc = wid & 3, fr = lane & 15, fq = lane >> 4;
    const int K = g.K, nt = K / BK;
    unsigned voffA[2], voffB[2];
#pragma unroll
    for (int i = 0; i < 2; ++i) { int R, C; stage_rc(tid * 16 + i * 8192, R, C); const int Rb = Epi::PERM ? ((R & ~31) + perm32(R & 31)) : R;
        voffA[i] = (unsigned)(R * K + C) * 2u; voffB[i] = (unsigned)(Rb * K + C) * 2u; }
    const size_t kstep = (size_t)(BK * 2);
    const size_t hstep = (size_t)HALF * K * 2;
    const unsigned ldsw = (unsigned)wid * 1024u;
    const int aoff = lds_byte(wr * 64 + fr, fq * 8), boff = lds_byte(wc * 32 + fr, fq * 8);
#define PG8_SA(b, h) (((b) * 2 + (h)) * HTB)
#define PG8_SB(b, h) ((4 + (b) * 2 + (h)) * HTB)
#define PG8_STAGE(bufoff, gbase, voff) do { _Pragma("unroll") for (int _i = 0; _i < 2; ++_i) \
        __builtin_amdgcn_global_load_lds((const unsigned*)((const char*)(gbase) + (voff)[_i]), (PG8_LAS unsigned*)(lds + (bufoff) + ldsw + _i * 8192), 16, 0, 0); } while (0)
#define PG8_LDA(dst, b, h) do { _Pragma("unroll") for (int m = 0; m < 4; ++m) _Pragma("unroll") for (int k = 0; k < 2; ++k) dst[m][k] = *(const PG8_LAS bf16x8*)(lds + PG8_SA(b, h) + aoff + m * 2048 + k * 1024); } while (0)
#define PG8_LDB(dst, b, h) do { _Pragma("unroll") for (int n = 0; n < 2; ++n) _Pragma("unroll") for (int k = 0; k < 2; ++k) dst[n][k] = *(const PG8_LAS bf16x8*)(lds + PG8_SB(b, h) + boff + n * 2048 + k * 1024); } while (0)
#define PG8_MMA(ai, bj, At, Bt) do { __builtin_amdgcn_s_setprio(1); _Pragma("unroll") for (int m = 0; m < 4; ++m) _Pragma("unroll") for (int n = 0; n < 2; ++n) _Pragma("unroll") for (int k = 0; k < 2; ++k) \
        acc[ai][bj][m][n] = __builtin_amdgcn_mfma_f32_16x16x32_bf16(Bt[n][k], At[m][k], acc[ai][bj][m][n], 0, 0, 0); __builtin_amdgcn_s_setprio(0); } while (0)
#define PG8_WAIT_V(n) asm volatile("s_waitcnt vmcnt(" #n ")" ::: "memory")
#define PG8_WAIT_L(n) asm volatile("s_waitcnt lgkmcnt(" #n ")" ::: "memory")
#define PG8_BAR __builtin_amdgcn_s_barrier()
#define PG8_SCHED __builtin_amdgcn_sched_barrier(0)
    Unit cur, nxt; int ui = 0;
    if (!S.next(0, cur)) return;
    f32x4 acc[2][2][4][2];
#pragma unroll
    for (int a = 0; a < 2; ++a)
#pragma unroll
        for (int b = 0; b < 2; ++b)
#pragma unroll
            for (int m = 0; m < 4; ++m)
#pragma unroll
                for (int n = 0; n < 2; ++n) acc[a][b][m][n] = (f32x4){0.f, 0.f, 0.f, 0.f};
    bf16x8 At[4][2], B0[2][2], B1[2][2];
    const char* cA = cur.a; const char* cB = cur.b;
    S.a_ready(cur);
    if constexpr (SP2) {
        PG8_STAGE(PG8_SB(0, 0), cB, voffB); PG8_STAGE(PG8_SB(0, 1), cB + hstep, voffB); PG8_STAGE(PG8_SA(0, 0), cA, voffA); PG8_STAGE(PG8_SA(0, 1), cA + hstep, voffA);
        if (wr == 1) PG8_BAR;
        PG8_WAIT_V(2); PG8_BAR;
        PG8_STAGE(PG8_SB(1, 0), cB + kstep, voffB); PG8_STAGE(PG8_SA(1, 0), cA + kstep, voffA); PG8_STAGE(PG8_SB(1, 1), cB + hstep + kstep, voffB);
        PG8_WAIT_V(6); PG8_BAR;
    } else {
        PG8_STAGE(PG8_SB(0, 0), cB, voffB); PG8_STAGE(PG8_SA(0, 0), cA, voffA); PG8_STAGE(PG8_SB(0, 1), cB + hstep, voffB); PG8_STAGE(PG8_SA(0, 1), cA + hstep, voffA);
        if (wr == 1) PG8_BAR;
        PG8_WAIT_V(4); PG8_BAR;
        PG8_STAGE(PG8_SB(1, 0), cB + kstep, voffB); PG8_STAGE(PG8_SA(1, 0), cA + kstep, voffA); PG8_STAGE(PG8_SB(1, 1), cB + hstep + kstep, voffB);
        PG8_WAIT_V(6); PG8_BAR;
    }
    for (;;) {
        const bool has_next = S.next(ui + 1, nxt);
        const char* nA = has_next ? nxt.a : cA; const char* nB = has_next ? nxt.b : cB;
        for (int t = 0; t < nt; t += 2) {
            const bool last = (t == nt - 2);
            const char* a1 = cA + (size_t)(t + 1) * kstep;
            const char* a2 = last ? nA : cA + (size_t)(t + 2) * kstep; const char* b2 = last ? nB : cB + (size_t)(t + 2) * kstep;
            const char* a3 = a2 + kstep; const char* b3 = b2 + kstep;
            if (last && has_next) S.a_ready(nxt);
            if constexpr (SP2) {
            PG8_LDB(B0, 0, 0); PG8_LDB(B1, 0, 1); PG8_SCHED; PG8_LDA(At, 0, 0); PG8_STAGE(PG8_SA(1, 1), a1 + hstep, voffA);
            PG8_WAIT_V(8); PG8_WAIT_L(0); PG8_BAR; PG8_MMA(0, 0, At, B0); PG8_MMA(0, 1, At, B1); PG8_BAR; PG8_SCHED;
            PG8_LDA(At, 0, 1); PG8_STAGE(PG8_SB(0, 0), b2, voffB); PG8_STAGE(PG8_SB(0, 1), b2 + hstep, voffB); PG8_STAGE(PG8_SA(0, 0), a2, voffA);
            PG8_WAIT_V(8); PG8_WAIT_L(0); PG8_BAR; PG8_MMA(1, 0, At, B0); PG8_MMA(1, 1, At, B1); PG8_BAR; PG8_SCHED;
            PG8_LDB(B0, 1, 0); PG8_LDB(B1, 1, 1); PG8_SCHED; PG8_LDA(At, 1, 0); PG8_STAGE(PG8_SA(0, 1), a2 + hstep, voffA);
            PG8_WAIT_V(8); PG8_WAIT_L(0); PG8_BAR; PG8_MMA(0, 0, At, B0); PG8_MMA(0, 1, At, B1); PG8_BAR; PG8_SCHED;
            PG8_LDA(At, 1, 1); PG8_STAGE(PG8_SB(1, 0), b3, voffB); PG8_STAGE(PG8_SB(1, 1), b3 + hstep, voffB); PG8_STAGE(PG8_SA(1, 0), a3, voffA);
            PG8_WAIT_V(8); PG8_WAIT_L(0); PG8_BAR; PG8_MMA(1, 0, At, B0); PG8_MMA(1, 1, At, B1); PG8_BAR; PG8_SCHED;
            } else {
            PG8_LDB(B0, 0, 0); PG8_SCHED; PG8_LDA(At, 0, 0); PG8_STAGE(PG8_SA(1, 1), a1 + hstep, voffA);
            PG8_WAIT_L(8); PG8_BAR; PG8_WAIT_L(0); PG8_MMA(0, 0, At, B0); PG8_BAR; PG8_SCHED;
            PG8_LDB(B1, 0, 1); PG8_STAGE(PG8_SB(0, 0), b2, voffB);
            PG8_BAR; PG8_WAIT_L(0); PG8_MMA(0, 1, At, B1); PG8_BAR;
            PG8_LDA(At, 0, 1); PG8_STAGE(PG8_SA(0, 0), a2, voffA);
            PG8_BAR; PG8_WAIT_L(0); PG8_MMA(1, 0, At, B0); PG8_BAR; PG8_SCHED;
            PG8_STAGE(PG8_SB(0, 1), b2 + hstep, voffB);
            PG8_WAIT_V(6); PG8_BAR; PG8_MMA(1, 1, At, B1); PG8_BAR;
            PG8_LDB(B0, 1, 0); PG8_SCHED; PG8_LDA(At, 1, 0); PG8_STAGE(PG8_SA(0, 1), a2 + hstep, voffA);
            PG8_WAIT_L(8); PG8_BAR; PG8_WAIT_L(0); PG8_MMA(0, 0, At, B0); PG8_BAR; PG8_SCHED;
            PG8_LDB(B1, 1, 1); PG8_STAGE(PG8_SB(1, 0), b3, voffB);
            PG8_BAR; PG8_WAIT_L(0); PG8_MMA(0, 1, At, B1); PG8_BAR;
            PG8_LDA(At, 1, 1); PG8_STAGE(PG8_SA(1, 0), a3, voffA);
            PG8_BAR; PG8_WAIT_L(0); PG8_MMA(1, 0, At, B0); PG8_BAR; PG8_SCHED;
            PG8_STAGE(PG8_SB(1, 1), b3 + hstep, voffB);
            PG8_WAIT_V(6); PG8_BAR; PG8_MMA(1, 1, At, B1); PG8_BAR;
            }
        }
        if constexpr (ALIGN_EPI) { if (wr == 0) PG8_BAR; }
        if constexpr (!Epi::AFTER_DRAIN) { E(acc, cur, wr, wc, fr, fq); S.done(cur); }
        if (!has_next) break;
#pragma unroll
        for (int a = 0; a < 2; ++a)
#pragma unroll
            for (int b = 0; b < 2; ++b)
#pragma unroll
                for (int m = 0; m < 4; ++m)
#pragma unroll
                    for (int n = 0; n < 2; ++n) acc[a][b][m][n] = (f32x4){0.f, 0.f, 0.f, 0.f};
        cur = nxt; cA = nA; cB = nB; ++ui;
        if constexpr (ALIGN_EPI) { if (wr == 1) PG8_BAR; }
    }
    PG8_WAIT_V(0);
    if constexpr (!ALIGN_EPI) { if (wr == 0) PG8_BAR; }
    PG8_BAR;
    if constexpr (Epi::AFTER_DRAIN) { E.fused(acc, cur, wr, wc, fr, fq, lds, wid, lane); S.done(cur); }
#undef PG8_SA
#undef PG8_SB
#undef PG8_STAGE
#undef PG8_LDA
#undef PG8_LDB
#undef PG8_MMA
#undef PG8_WAIT_V
#undef PG8_WAIT_L
#undef PG8_BAR
#undef PG8_SCHED
}
template <class Epi, class Sched, bool ALIGN_EPI = false, bool SP2 = false>
__device__ __forceinline__ void gemm_phase_carry(PG8_LAS unsigned char* lds, const Gemm g, const Sched& S, const Epi& E) {
    int tid_ = threadIdx.x; asm volatile("" : "+v"(tid_)); const int tid = tid_, wid = __builtin_amdgcn_readfirstlane(tid >> 6), lane = tid & 63, wr = wid >> 2, wc = wid & 3, fr = lane & 15, fq = lane >> 4;
    const int K = g.K, nt = K / BK;
    unsigned voffA[2], voffB[2];
#pragma unroll
    for (int i = 0; i < 2; ++i) { int R, C; stage_rc(tid * 16 + i * 8192, R, C); const int Rb = Epi::PERM ? ((R & ~31) + perm32(R & 31)) : R;
        voffA[i] = (unsigned)(R * K + C) * 2u; voffB[i] = (unsigned)(Rb * K + C) * 2u; }
    const size_t kstep = (size_t)(BK * 2);
    const size_t hstep = (size_t)HALF * K * 2;
    const unsigned ldsw = (unsigned)wid * 1024u;
    const int aoff = lds_byte(wr * 64 + fr, fq * 8), boff = lds_byte(wc * 32 + fr, fq * 8);
#define PG8_SA(b, h) (((b) * 2 + (h)) * HTB)
#define PG8_SB(b, h) ((4 + (b) * 2 + (h)) * HTB)
#define PG8_STAGE(bufoff, gbase, voff) do { _Pragma("unroll") for (int _i = 0; _i < 2; ++_i) \
        __builtin_amdgcn_global_load_lds((const unsigned*)((const char*)(gbase) + (voff)[_i]), (PG8_LAS unsigned*)(lds + (bufoff) + ldsw + _i * 8192), 16, 0, 0); } while (0)
#define PG8_LDA(dst, b, h) do { _Pragma("unroll") for (int m = 0; m < 4; ++m) _Pragma("unroll") for (int k = 0; k < 2; ++k) dst[m][k] = *(const PG8_LAS bf16x8*)(lds + PG8_SA(b, h) + aoff + m * 2048 + k * 1024); } while (0)
#define PG8_LDB(dst, b, h) do { _Pragma("unroll") for (int n = 0; n < 2; ++n) _Pragma("unroll") for (int k = 0; k < 2; ++k) dst[n][k] = *(const PG8_LAS bf16x8*)(lds + PG8_SB(b, h) + boff + n * 2048 + k * 1024); } while (0)
#define PG8_MMA(ai, bj, At, Bt) do { __builtin_amdgcn_s_setprio(1); _Pragma("unroll") for (int m = 0; m < 4; ++m) _Pragma("unroll") for (int n = 0; n < 2; ++n) _Pragma("unroll") for (int k = 0; k < 2; ++k) \
        acc[ai][bj][m][n] = __builtin_amdgcn_mfma_f32_16x16x32_bf16(Bt[n][k], At[m][k], acc[ai][bj][m][n], 0, 0, 0); __builtin_amdgcn_s_setprio(0); } while (0)
#define PG8_WAIT_V(n) asm volatile("s_waitcnt vmcnt(" #n ")" ::: "memory")
#define PG8_WAIT_L(n) asm volatile("s_waitcnt lgkmcnt(" #n ")" ::: "memory")
#define PG8_BAR __builtin_amdgcn_s_barrier()
#define PG8_SCHED __builtin_amdgcn_sched_barrier(0)
    Unit cur, nxt; int ui = 0; bool kz = true;
    if (!S.next(0, cur)) return;
    f32x4 acc[2][2][4][2];
#pragma unroll
    for (int a = 0; a < 2; ++a)
#pragma unroll
        for (int b = 0; b < 2; ++b)
#pragma unroll
            for (int m = 0; m < 4; ++m)
#pragma unroll
                for (int n = 0; n < 2; ++n) if (kz) acc[a][b][m][n] = (f32x4){0.f, 0.f, 0.f, 0.f};
    bf16x8 At[4][2], B0[2][2], B1[2][2];
    const char* cA = cur.a; const char* cB = cur.b;
    S.a_ready(cur);
    if constexpr (SP2) {
        PG8_STAGE(PG8_SB(0, 0), cB, voffB); PG8_STAGE(PG8_SB(0, 1), cB + hstep, voffB); PG8_STAGE(PG8_SA(0, 0), cA, voffA); PG8_STAGE(PG8_SA(0, 1), cA + hstep, voffA);
        if (wr == 1) PG8_BAR;
        PG8_WAIT_V(2); PG8_BAR;
        PG8_STAGE(PG8_SB(1, 0), cB + kstep, voffB); PG8_STAGE(PG8_SA(1, 0), cA + kstep, voffA); PG8_STAGE(PG8_SB(1, 1), cB + hstep + kstep, voffB);
        PG8_WAIT_V(6); PG8_BAR;
    } else {
        PG8_STAGE(PG8_SB(0, 0), cB, voffB); PG8_STAGE(PG8_SA(0, 0), cA, voffA); PG8_STAGE(PG8_SB(0, 1), cB + hstep, voffB); PG8_STAGE(PG8_SA(0, 1), cA + hstep, voffA);
        if (wr == 1) PG8_BAR;
        PG8_WAIT_V(4); PG8_BAR;
        PG8_STAGE(PG8_SB(1, 0), cB + kstep, voffB); PG8_STAGE(PG8_SA(1, 0), cA + kstep, voffA); PG8_STAGE(PG8_SB(1, 1), cB + hstep + kstep, voffB);
        PG8_WAIT_V(6); PG8_BAR;
    }
    for (;;) {
        const bool has_next = S.next(ui + 1, nxt);
        const char* nA = has_next ? nxt.a : cA; const char* nB = has_next ? nxt.b : cB;
        for (int t = 0; t < nt; t += 2) {
            const bool last = (t == nt - 2);
            const char* a1 = cA + (size_t)(t + 1) * kstep;
            const char* a2 = last ? nA : cA + (size_t)(t + 2) * kstep; const char* b2 = last ? nB : cB + (size_t)(t + 2) * kstep;
            const char* a3 = a2 + kstep; const char* b3 = b2 + kstep;
            if (last && has_next) S.a_ready(nxt);
            if constexpr (SP2) {
            PG8_LDB(B0, 0, 0); PG8_LDB(B1, 0, 1); PG8_SCHED; PG8_LDA(At, 0, 0); PG8_STAGE(PG8_SA(1, 1), a1 + hstep, voffA);
            PG8_WAIT_V(8); PG8_WAIT_L(0); PG8_BAR; PG8_MMA(0, 0, At, B0); PG8_MMA(0, 1, At, B1); PG8_BAR; PG8_SCHED;
            PG8_LDA(At, 0, 1); PG8_STAGE(PG8_SB(0, 0), b2, voffB); PG8_STAGE(PG8_SB(0, 1), b2 + hstep, voffB); PG8_STAGE(PG8_SA(0, 0), a2, voffA);
            PG8_WAIT_V(8); PG8_WAIT_L(0); PG8_BAR; PG8_MMA(1, 0, At, B0); PG8_MMA(1, 1, At, B1); PG8_BAR; PG8_SCHED;
            PG8_LDB(B0, 1, 0); PG8_LDB(B1, 1, 1); PG8_SCHED; PG8_LDA(At, 1, 0); PG8_STAGE(PG8_SA(0, 1), a2 + hstep, voffA);
            PG8_WAIT_V(8); PG8_WAIT_L(0); PG8_BAR; PG8_MMA(0, 0, At, B0); PG8_MMA(0, 1, At, B1); PG8_BAR; PG8_SCHED;
            PG8_LDA(At, 1, 1); PG8_STAGE(PG8_SB(1, 0), b3, voffB); PG8_STAGE(PG8_SB(1, 1), b3 + hstep, voffB); PG8_STAGE(PG8_SA(1, 0), a3, voffA);
            PG8_WAIT_V(8); PG8_WAIT_L(0); PG8_BAR; PG8_MMA(1, 0, At, B0); PG8_MMA(1, 1, At, B1); PG8_BAR; PG8_SCHED;
            } else {
            PG8_LDB(B0, 0, 0); PG8_SCHED; PG8_LDA(At, 0, 0); PG8_STAGE(PG8_SA(1, 1), a1 + hstep, voffA);
            PG8_WAIT_L(8); PG8_BAR; PG8_WAIT_L(0); PG8_MMA(0, 0, At, B0); PG8_BAR; PG8_SCHED;
            PG8_LDB(B1, 0, 1); PG8_STAGE(PG8_SB(0, 0), b2, voffB);
            PG8_BAR; PG8_WAIT_L(0); PG8_MMA(0, 1, At, B1); PG8_BAR;
            PG8_LDA(At, 0, 1); PG8_STAGE(PG8_SA(0, 0), a2, voffA);
            PG8_BAR; PG8_WAIT_L(0); PG8_MMA(1, 0, At, B0); PG8_BAR; PG8_SCHED;
            PG8_STAGE(PG8_SB(0, 1), b2 + hstep, voffB);
            PG8_WAIT_V(6); PG8_BAR; PG8_MMA(1, 1, At, B1); PG8_BAR;
            PG8_LDB(B0, 1, 0); PG8_SCHED; PG8_LDA(At, 1, 0); PG8_STAGE(PG8_SA(0, 1), a2 + hstep, voffA);
            PG8_WAIT_L(8); PG8_BAR; PG8_WAIT_L(0); PG8_MMA(0, 0, At, B0); PG8_BAR; PG8_SCHED;
            PG8_LDB(B1, 1, 1); PG8_STAGE(PG8_SB(1, 0), b3, voffB);
            PG8_BAR; PG8_WAIT_L(0); PG8_MMA(0, 1, At, B1); PG8_BAR;
            PG8_LDA(At, 1, 1); PG8_STAGE(PG8_SA(1, 0), a3, voffA);
            PG8_BAR; PG8_WAIT_L(0); PG8_MMA(1, 0, At, B0); PG8_BAR; PG8_SCHED;
            PG8_STAGE(PG8_SB(1, 1), b3 + hstep, voffB);
            PG8_WAIT_V(6); PG8_BAR; PG8_MMA(1, 1, At, B1); PG8_BAR;
            }
        }
        if constexpr (ALIGN_EPI) { if (wr == 0) PG8_BAR; }
        if constexpr (!Epi::AFTER_DRAIN) { E(acc, cur, wr, wc, fr, fq); S.done(cur); }
        if (!has_next) break; kz = false;
#pragma unroll
        for (int a = 0; a < 2; ++a)
#pragma unroll
            for (int b = 0; b < 2; ++b)
#pragma unroll
                for (int m = 0; m < 4; ++m)
#pragma unroll
                    for (int n = 0; n < 2; ++n) if (kz) acc[a][b][m][n] = (f32x4){0.f, 0.f, 0.f, 0.f};
        cur = nxt; cA = nA; cB = nB; ++ui;
        if constexpr (ALIGN_EPI) { if (wr == 1) PG8_BAR; }
    }
    PG8_WAIT_V(0);
    if constexpr (!ALIGN_EPI) { if (wr == 0) PG8_BAR; }
    PG8_BAR;
    if constexpr (Epi::AFTER_DRAIN) { E.fused(acc, cur, wr, wc, fr, fq, lds, wid, lane); S.done(cur); }
#undef PG8_SA
#undef PG8_SB
#undef PG8_STAGE
#undef PG8_LDA
#undef PG8_LDB
#undef PG8_MMA
#undef PG8_WAIT_V
#undef PG8_WAIT_L
#undef PG8_BAR
#undef PG8_SCHED
}
typedef int i32x4v __attribute__((ext_vector_type(4))); typedef int i32x8v __attribute__((ext_vector_type(8)));
__device__ __forceinline__ f32x4 mma8(bf16x8 b0, bf16x8 b1, bf16x8 a0, bf16x8 a1, f32x4 c) {
    const i32x4v bl = __builtin_bit_cast(i32x4v, b0), bh = __builtin_bit_cast(i32x4v, b1), al = __builtin_bit_cast(i32x4v, a0), ah = __builtin_bit_cast(i32x4v, a1);
    const i32x8v B = __builtin_shufflevector(bl, bh, 0, 1, 2, 3, 4, 5, 6, 7), A = __builtin_shufflevector(al, ah, 0, 1, 2, 3, 4, 5, 6, 7);
    return __builtin_amdgcn_mfma_scale_f32_16x16x128_f8f6f4(B, A, c, 0, 0, 0, 0x7f7f7f7f, 0, 0x7f7f7f7f);
}
__device__ __forceinline__ f32x4 mma8v(const i32x8v& B, const i32x8v& A, f32x4 c) { const int one = 0x7f7f7f7f;
    asm volatile("v_mfma_scale_f32_16x16x128_f8f6f4 %0, %1, %2, %0, %3, %3 op_sel_hi:[0,0,0]" : "+v"(c) : "v"(B), "v"(A), "v"(one)); return c; }
template <class Epi, class Sched, bool ALIGN_EPI = false, bool SP2 = false>
__device__ __forceinline__ void gemm_phase8(PG8_LAS unsigned char* lds, const Gemm g, const Sched& S, const Epi& E) {
    int tid_ = threadIdx.x; asm volatile("" : "+v"(tid_)); const int tid = tid_, wid = __builtin_amdgcn_readfirstlane(tid >> 6), lane = tid & 63, wr = wid >> 2, wc = wid & 3, fr = lane & 15, fq = lane >> 4;
    const int K = g.P ? g.P : g.K, nt = g.K / BK;
    unsigned voffA[2], voffB[2];
#pragma unroll
    for (int i = 0; i < 2; ++i) { int R, C; stage_rc(tid * 16 + i * 8192, R, C); const int Rb = Epi::PERM ? ((R & ~31) + perm32(R & 31)) : R;
        voffA[i] = (unsigned)(R * K + C) * 2u; voffB[i] = (unsigned)(Rb * K + C) * 2u; }
    const size_t kstep = (size_t)(BK * 2);
    const size_t hstep = (size_t)HALF * K * 2;
    const unsigned ldsw = (unsigned)wid * 1024u;
    const int aoff = lds_byte(wr * 64 + fr, fq * 8), boff = lds_byte(wc * 32 + fr, fq * 8);
#define PG8_SA(b, h) (((b) * 2 + (h)) * HTB)
#define PG8_SB(b, h) ((4 + (b) * 2 + (h)) * HTB)
#define PG8_STAGE(bufoff, gbase, voff) do { _Pragma("unroll") for (int _i = 0; _i < 2; ++_i) \
        __builtin_amdgcn_global_load_lds((const unsigned*)((const char*)(gbase) + (voff)[_i]), (PG8_LAS unsigned*)(lds + (bufoff) + ldsw + _i * 8192), 16, 0, 0); } while (0)
#define PG8_LDA(dst, b, h) do { _Pragma("unroll") for (int m = 0; m < 4; ++m) { dst[m].lo = *(const PG8_LAS i32x4v*)(lds + PG8_SA(b, h) + aoff + m * 2048); dst[m].hi = *(const PG8_LAS i32x4v*)(lds + PG8_SA(b, h) + aoff + m * 2048 + 1024); } } while (0)
#define PG8_LDB(dst, b, h) do { _Pragma("unroll") for (int n = 0; n < 2; ++n) { dst[n].lo = *(const PG8_LAS i32x4v*)(lds + PG8_SB(b, h) + boff + n * 2048); dst[n].hi = *(const PG8_LAS i32x4v*)(lds + PG8_SB(b, h) + boff + n * 2048 + 1024); } } while (0)
#define PG8_MMA(ai, bj, At, Bt) do { __builtin_amdgcn_s_setprio(1); _Pragma("unroll") for (int m = 0; m < 4; ++m) _Pragma("unroll") for (int n = 0; n < 2; ++n) \
        acc[ai][bj][m][n] = mma8v(Bt[n], At[m], acc[ai][bj][m][n]); __builtin_amdgcn_s_setprio(0); } while (0)
#define PG8_WAIT_V(n) asm volatile("s_waitcnt vmcnt(" #n ")" ::: "memory")
#define PG8_WAIT_L(n) asm volatile("s_waitcnt lgkmcnt(" #n ")" ::: "memory")
#define PG8_BAR __builtin_amdgcn_s_barrier()
#define PG8_SCHED __builtin_amdgcn_sched_barrier(0)
    Unit cur, nxt; int ui = 0;
    if (!S.next(0, cur)) return;
    f32x4 acc[2][2][4][2];
#pragma unroll
    for (int a = 0; a < 2; ++a)
#pragma unroll
        for (int b = 0; b < 2; ++b)
#pragma unroll
            for (int m = 0; m < 4; ++m)
#pragma unroll
                for (int n = 0; n < 2; ++n) acc[a][b][m][n] = (f32x4){0.f, 0.f, 0.f, 0.f};
    i32x8v At[4], B0[2], B1[2];
    const char* cA = cur.a; const char* cB = cur.b;
    S.a_ready(cur);
    if constexpr (SP2) {
        PG8_STAGE(PG8_SB(0, 0), cB, voffB); PG8_STAGE(PG8_SB(0, 1), cB + hstep, voffB); PG8_STAGE(PG8_SA(0, 0), cA, voffA); PG8_STAGE(PG8_SA(0, 1), cA + hstep, voffA);
        if (wr == 1) PG8_BAR;
        PG8_WAIT_V(2); PG8_BAR;
        PG8_STAGE(PG8_SB(1, 0), cB + kstep, voffB); PG8_STAGE(PG8_SA(1, 0), cA + kstep, voffA); PG8_STAGE(PG8_SB(1, 1), cB + hstep + kstep, voffB);
        PG8_WAIT_V(6); PG8_BAR;
    } else {
        PG8_STAGE(PG8_SB(0, 0), cB, voffB); PG8_STAGE(PG8_SA(0, 0), cA, voffA); PG8_STAGE(PG8_SB(0, 1), cB + hstep, voffB); PG8_STAGE(PG8_SA(0, 1), cA + hstep, voffA);
        if (wr == 1) PG8_BAR;
        PG8_WAIT_V(4); PG8_BAR;
        PG8_STAGE(PG8_SB(1, 0), cB + kstep, voffB); PG8_STAGE(PG8_SA(1, 0), cA + kstep, voffA); PG8_STAGE(PG8_SB(1, 1), cB + hstep + kstep, voffB);
        PG8_WAIT_V(6); PG8_BAR;
    }
    for (;;) {
        const bool has_next = S.next(ui + 1, nxt);
        const char* nA = has_next ? nxt.a : cA; const char* nB = has_next ? nxt.b : cB;
        for (int t = 0; t < nt; t += 2) {
            const bool last = (t == nt - 2);
            const char* a1 = cA + (size_t)(t + 1) * kstep;
            const char* a2 = last ? nA : cA + (size_t)(t + 2) * kstep; const char* b2 = last ? nB : cB + (size_t)(t + 2) * kstep;
            const char* a3 = a2 + kstep; const char* b3 = b2 + kstep;
            if (last && has_next) S.a_ready(nxt);
            if constexpr (SP2) {
            PG8_LDB(B0, 0, 0); PG8_LDB(B1, 0, 1); PG8_SCHED; PG8_LDA(At, 0, 0); PG8_STAGE(PG8_SA(1, 1), a1 + hstep, voffA);
            PG8_WAIT_V(8); PG8_WAIT_L(0); PG8_BAR; PG8_MMA(0, 0, At, B0); PG8_MMA(0, 1, At, B1); PG8_BAR; PG8_SCHED;
            PG8_LDA(At, 0, 1); PG8_STAGE(PG8_SB(0, 0), b2, voffB); PG8_STAGE(PG8_SB(0, 1), b2 + hstep, voffB); PG8_STAGE(PG8_SA(0, 0), a2, voffA);
            PG8_WAIT_V(8); PG8_WAIT_L(0); PG8_BAR; PG8_MMA(1, 0, At, B0); PG8_MMA(1, 1, At, B1); PG8_BAR; PG8_SCHED;
            PG8_LDB(B0, 1, 0); PG8_LDB(B1, 1, 1); PG8_SCHED; PG8_LDA(At, 1, 0); PG8_STAGE(PG8_SA(0, 1), a2 + hstep, voffA);
            PG8_WAIT_V(8); PG8_WAIT_L(0); PG8_BAR; PG8_MMA(0, 0, At, B0); PG8_MMA(0, 1, At, B1); PG8_BAR; PG8_SCHED;
            PG8_LDA(At, 1, 1); PG8_STAGE(PG8_SB(1, 0), b3, voffB); PG8_STAGE(PG8_SB(1, 1), b3 + hstep, voffB); PG8_STAGE(PG8_SA(1, 0), a3, voffA);
            PG8_WAIT_V(8); PG8_WAIT_L(0); PG8_BAR; PG8_MMA(1, 0, At, B0); PG8_MMA(1, 1, At, B1); PG8_BAR; PG8_SCHED;
            } else {
            PG8_LDB(B0, 0, 0); PG8_SCHED; PG8_LDA(At, 0, 0); PG8_STAGE(PG8_SA(1, 1), a1 + hstep, voffA);
            PG8_WAIT_L(8); PG8_BAR; PG8_WAIT_L(0); PG8_MMA(0, 0, At, B0); PG8_BAR; PG8_SCHED;
            PG8_LDB(B1, 0, 1); PG8_STAGE(PG8_SB(0, 0), b2, voffB);
            PG8_BAR; PG8_WAIT_L(0); PG8_MMA(0, 1, At, B1); PG8_BAR;
            PG8_LDA(At, 0, 1); PG8_STAGE(PG8_SA(0, 0), a2, voffA);
            PG8_BAR; PG8_WAIT_L(0); PG8_MMA(1, 0, At, B0); PG8_BAR; PG8_SCHED;
            PG8_STAGE(PG8_SB(0, 1), b2 + hstep, voffB);
            PG8_WAIT_V(6); PG8_BAR; PG8_MMA(1, 1, At, B1); PG8_BAR;
            PG8_LDB(B0, 1, 0); PG8_SCHED; PG8_LDA(At, 1, 0); PG8_STAGE(PG8_SA(0, 1), a2 + hstep, voffA);
            PG8_WAIT_L(8); PG8_BAR; PG8_WAIT_L(0); PG8_MMA(0, 0, At, B0); PG8_BAR; PG8_SCHED;
            PG8_LDB(B1, 1, 1); PG8_STAGE(PG8_SB(1, 0), b3, voffB);
            PG8_BAR; PG8_WAIT_L(0); PG8_MMA(0, 1, At, B1); PG8_BAR;
            PG8_LDA(At, 1, 1); PG8_STAGE(PG8_SA(1, 0), a3, voffA);
            PG8_BAR; PG8_WAIT_L(0); PG8_MMA(1, 0, At, B0); PG8_BAR; PG8_SCHED;
            PG8_STAGE(PG8_SB(1, 1), b3 + hstep, voffB);
            PG8_WAIT_V(6); PG8_BAR; PG8_MMA(1, 1, At, B1); PG8_BAR;
            }
        }
        if constexpr (ALIGN_EPI) { if (wr == 0) PG8_BAR; }
        if constexpr (!Epi::AFTER_DRAIN) { E(acc, cur, wr, wc, fr, fq); S.done(cur); }
        if (!has_next) break;
#pragma unroll
        for (int a = 0; a < 2; ++a)
#pragma unroll
            for (int b = 0; b < 2; ++b)
#pragma unroll
                for (int m = 0; m < 4; ++m)
#pragma unroll
                    for (int n = 0; n < 2; ++n) acc[a][b][m][n] = (f32x4){0.f, 0.f, 0.f, 0.f};
        cur = nxt; cA = nA; cB = nB; ++ui;
        if constexpr (ALIGN_EPI) { if (wr == 1) PG8_BAR; }
    }
    PG8_WAIT_V(0);
    if constexpr (!ALIGN_EPI) { if (wr == 0) PG8_BAR; }
    PG8_BAR;
    if constexpr (Epi::AFTER_DRAIN) { E.fused(acc, cur, wr, wc, fr, fq, lds, wid, lane); S.done(cur); }
#undef PG8_SA
#undef PG8_SB
#undef PG8_STAGE
#undef PG8_LDA
#undef PG8_LDB
#undef PG8_MMA
#undef PG8_WAIT_V
#undef PG8_WAIT_L
#undef PG8_BAR
#undef PG8_SCHED
}
struct OrderBase {
    int nM, nN, nwg, G, c;
    __device__ __forceinline__ void init(int nM_, int nN_, int G_, int c_) { nM = nM_; nN = nN_; nwg = nM_ * nN_; G = G_; c = c_; }
    __device__ __forceinline__ bool map(int i, int& pm, int& pn) const {
        const long L = (long)i * G + c; if (L >= nwg) return false;
        int wgid = (int)L; { const int q = nwg / NXCD, r = nwg % NXCD, xcd = wgid % NXCD, off = wgid / NXCD; wgid = (xcd < r ? xcd * (q + 1) : r * (q + 1) + (xcd - r) * q) + off; }
        const int nig = WGM * nN, gid = wgid / nig, fm = gid * WGM, gsz = (nM - fm) < WGM ? (nM - fm) : WGM;
        pm = fm + ((wgid % nig) % gsz); pn = (wgid % nig) / gsz; return true;
    }
    __device__ __forceinline__ void a_ready(const Unit&) const {}
    __device__ __forceinline__ void done(const Unit&) const {}
};
struct PlainOrder : OrderBase {
    const char* A; const char* B; size_t ta, tb;
    __device__ __forceinline__ bool next(int i, Unit& u) const { int pm, pn; if (!map(i, pm, pn)) return false; u.pm = pm; u.pn = pn; u.aux = 0; u.a = A + (size_t)pm * ta; u.b = B + (size_t)pn * tb; return true; }
};
struct BranchOrder : OrderBase {
    const char* A; const char* B; size_t ta, tb, za, zb;
    __device__ __forceinline__ bool next(int i, Unit& u) const { const int ti = i / 3, br = i - 3 * ti; int pm, pn; if (!map(ti, pm, pn)) return false; u.pm = pm; u.pn = pn; u.aux = br;
        u.a = A + (size_t)br * za + (size_t)pm * ta; u.b = B + (size_t)br * zb + (size_t)pn * tb; return true; }
};
struct MoeOrder : OrderBase {
    const char* A; const char* B; size_t ta, tb, zb; int t1, t2, t3, t4, t5, t6, t7;
    __device__ __forceinline__ bool next(int i, Unit& u) const { int pm, pn; if (!map(i, pm, pn)) return false; u.pm = pm; u.pn = pn;
        const int e = (pm >= t1) + (pm >= t2) + (pm >= t3) + (pm >= t4) + (pm >= t5) + (pm >= t6) + (pm >= t7); u.aux = e;
        u.a = A + (size_t)pm * ta; u.b = B + (size_t)e * zb + (size_t)pn * tb; return true; }
};
struct TailOrder {
    int ntail, G, c; const char* A; const char* B; size_t ta, tb, zb, kq; int t1, t2, t3, t4, t5, t6, t7;
    __device__ __forceinline__ bool next(int i, Unit& u) const { const long L = (long)i * G + c; if (L >= ntail) return false; const int l = (int)L, q = l & 3, pn = (l >> 2) & 7, pm = 128 + (l >> 5);
        const int e = (pm >= t1) + (pm >= t2) + (pm >= t3) + (pm >= t4) + (pm >= t5) + (pm >= t6) + (pm >= t7); u.pm = pm; u.pn = pn; u.aux = q;
        u.a = A + (size_t)pm * ta + (size_t)q * kq; u.b = B + (size_t)e * zb + (size_t)pn * tb + (size_t)q * kq; return true; }
    __device__ __forceinline__ void a_ready(const Unit&) const {}
    __device__ __forceinline__ void done(const Unit&) const {}
};
}

constexpr int NTOK = 16384, DM = 2048, SEQ = 2048, NBATCH = 8, NHEAD = 8, HD = 64, DFF = 7168, NEXP = 8;
constexpr int NIN = 10828, NINP = 11008;
constexpr int WBR_W = 512, KVR = 256;
constexpr float EPS = 1e-6f, LOG2E = 1.4426950408889634f, C2 = 0.125f * LOG2E;
constexpr int MOE_ROWS = 2 * NTOK + NEXP * 256;
constexpr int NSTEPS = 24;
constexpr float W8SCALE = 64.f, WD8SCALE = 128.f, H8SCALE = 8.f;

constexpr size_t al256(size_t x) { return (x + 255) & ~(size_t)255; }
constexpr size_t WS_CTL = 0, CTL_ZERO_BYTES = 1u << 20;
constexpr size_t SZ_WIN = (size_t)NINP * DM * 2, SZ_WUKV = (size_t)1024 * KVR * 2, SZ_WBR = (size_t)DM * WBR_W * 2, SZ_WOUT = (size_t)DM * DM * 2;
constexpr size_t SZ_WGU = (size_t)2 * DFF * DM * 2, SZ_WD = (size_t)DM * DFF * 2;
constexpr size_t WS_WIN = CTL_ZERO_BYTES, WS_WUKV = WS_WIN + 2 * SZ_WIN, WS_WBR = WS_WUKV + 2 * SZ_WUKV, WS_WOUT = WS_WBR + 6 * SZ_WBR;
constexpr size_t WS_WGU0 = WS_WOUT + 2 * SZ_WOUT, WS_WD0 = WS_WGU0 + SZ_WGU, WS_WGUM = WS_WD0 + SZ_WD, WS_WDM = WS_WGUM + NEXP * SZ_WGU;
constexpr size_t WS_RSTD = WS_WDM + NEXP * SZ_WD, WS_SSP = WS_RSTD + (size_t)NTOK * 4, WS_XB = WS_SSP + (size_t)NTOK * 32 * 4;
constexpr size_t WS_R = WS_XB + (size_t)NTOK * DM * 2;
constexpr size_t WS_Z8 = WS_R, WS_DLAT = WS_Z8 + (size_t)8 * NTOK * 512 * 2, WS_DIQ = WS_DLAT + (size_t)NTOK * 256 * 2, WS_DIK = WS_DIQ + (size_t)NTOK * 256 * 2;
constexpr size_t WS_FFW = WS_DIK + (size_t)NTOK * 64 * 2, WS_GATES = WS_FFW + (size_t)NTOK * 16 * 4, WS_C2F = WS_GATES + (size_t)NTOK * 6144 * 2;
constexpr size_t WS_DKV = WS_C2F + (size_t)NBATCH * NHEAD * SEQ * 4, WS_SC = WS_DKV + (size_t)NTOK * 1024 * 2, WS_MASK = WS_SC + (size_t)NTOK * SEQ * 4;
constexpr size_t WS_YATT = WS_MASK + (size_t)NTOK * 64 * 4, WS_M = WS_YATT + (size_t)3 * NTOK * 512 * 2, WS_R_END1 = WS_M + (size_t)NTOK * DM * 2;
constexpr size_t WS_HID = WS_R;
constexpr size_t WS_XG = WS_R, WS_HIDM = WS_XG + (size_t)MOE_ROWS * DM * 2, WS_Y = WS_HIDM + (size_t)MOE_ROWS * DFF * 2, WS_ROWTOK = WS_Y + (size_t)2 * NTOK * DM * 4;
constexpr size_t WS_ROWW = WS_ROWTOK + (size_t)MOE_ROWS * 4, WS_RSTDG = WS_ROWW + (size_t)MOE_ROWS * 4, WS_TOKINFO = WS_RSTDG + (size_t)MOE_ROWS * 4;
constexpr size_t WS_TOKW = WS_TOKINFO + (size_t)2 * NTOK * 8, WS_WGCNT = WS_TOKW + (size_t)2 * NTOK * 4, WS_META = WS_WGCNT + 256 * 8 * 4, WS_R_END2 = WS_META + 256;
constexpr size_t WS_END = WS_R_END1 > WS_R_END2 ? WS_R_END1 : WS_R_END2;
constexpr size_t WS_XB8 = WS_WGUM + NEXP * SZ_WGU / 2;
constexpr size_t WS_WING8 = WS_XB8 + (size_t)NTOK * DM;
static_assert(WS_WING8 + (size_t)2 * 6144 * DM <= WS_WDM, "fp8 side buffers fit the freed half of the MoE gate/up region");
static_assert((size_t)2 * NTOK * DM * 2 + (size_t)4 * 2048 * DM * 2 + (size_t)2 * NTOK * 4 <= (size_t)2 * NTOK * DM * 4, "tail partials fit the slack of the Y region");
constexpr int CW_ATTQ = 65536;
constexpr int CW_BAR = 4096;

constexpr int RING_BYTES = 131072, LDSCTL_OFF = RING_BYTES, MISC_OFF = LDSCTL_OFF + 320, LDS_BYTES = 147456;

#define GAS __attribute__((address_space(1)))
#define LAS __attribute__((address_space(3)))
typedef unsigned short bf16_t;
typedef float f32x4 __attribute__((ext_vector_type(4)));
typedef unsigned u32x4 __attribute__((ext_vector_type(4)));
typedef unsigned u32x2 __attribute__((ext_vector_type(2)));
typedef short bf16x8 __attribute__((ext_vector_type(8)));
typedef float f32x16 __attribute__((ext_vector_type(16)));
#define LDS_WAIT() asm volatile("s_waitcnt lgkmcnt(0)" ::: "memory")
#define VM_WAIT() asm volatile("s_waitcnt vmcnt(0)" ::: "memory")
__device__ __forceinline__ float bflo(unsigned w) { return __uint_as_float(w << 16); }
__device__ __forceinline__ float bfhi(unsigned w) { return __uint_as_float(w & 0xffff0000u); }
typedef float f32x2_t __attribute__((ext_vector_type(2))); typedef __bf16 bf16x2_t __attribute__((ext_vector_type(2)));
__device__ __forceinline__ unsigned pk2(float lo, float hi) { f32x2_t v = {lo, hi}; bf16x2_t b = __builtin_convertvector(v, bf16x2_t); return __builtin_bit_cast(unsigned, b); }
__device__ __forceinline__ int opq(int v) { asm volatile("" : "+s"(v)); return v; }
__device__ __forceinline__ float wave_sum(float v) {
#pragma unroll
    for (int o = 1; o < 64; o <<= 1) v += __shfl_xor(v, o);
    return v;
}
__device__ __forceinline__ u32x2 pack8_fp8(const float (&e)[8]) {
    float c[8];
#pragma unroll
    for (int i = 0; i < 8; ++i) c[i] = __builtin_amdgcn_fmed3f(e[i], -448.f, 448.f);
    int w0 = __builtin_amdgcn_cvt_pk_fp8_f32(c[0], c[1], 0, false); w0 = __builtin_amdgcn_cvt_pk_fp8_f32(c[2], c[3], w0, true);
    int w1 = __builtin_amdgcn_cvt_pk_fp8_f32(c[4], c[5], 0, false); w1 = __builtin_amdgcn_cvt_pk_fp8_f32(c[6], c[7], w1, true);
    u32x2 r; r.x = (unsigned)w0; r.y = (unsigned)w1; return r; }
__device__ __forceinline__ float sigm(float v) { return __builtin_amdgcn_rcpf(1.f + __builtin_amdgcn_exp2f(-v * LOG2E)); }
__device__ __forceinline__ float softplus2(float z) { return fmaxf(z, 0.f) + __builtin_amdgcn_logf(1.f + __builtin_amdgcn_exp2f(-fabsf(z))); }

#define XB_TMO      128
#define XB_XCNT(j)  (256  + 64 * (j))
#define XB_XSUB(j)  (1280 + 64 * (j))
#define XB_XGEN(j)  (2304 + 64 * (j))
#define XB_TOP      3328
#define XB_TOPGEN   3392
#define XCD_BAR_WORDS 3456
#define XB_SPIN_CAP (1u << 18)

__device__ __forceinline__ unsigned xb_ld(unsigned* p)              { return __hip_atomic_load(p, __ATOMIC_RELAXED, __HIP_MEMORY_SCOPE_AGENT); }
__device__ __forceinline__ unsigned xb_add(unsigned* p, unsigned v) { return __hip_atomic_fetch_add(p, v, __ATOMIC_RELAXED, __HIP_MEMORY_SCOPE_AGENT); }
__device__ __forceinline__ unsigned xb_xcc_id() { return (unsigned)__builtin_amdgcn_s_getreg((3 << 11) | 20) & 0xFu; }
#define XB_SPIN(cond, bar) do { unsigned _sp = 0; while (cond) { __builtin_amdgcn_s_sleep(1); \
    if ((++_sp & 255u) == 0u) { if (xb_ld(&(bar)[XB_TMO])) break; if (_sp > XB_SPIN_CAP) { atomicAdd(&(bar)[XB_TMO], 1u); break; } } } } while (0)

struct XcdBarrier {
    unsigned* bar; unsigned x;
    volatile LAS unsigned* st;
};

__device__ __forceinline__ XcdBarrier xcd_barrier_post(unsigned* bar, volatile LAS unsigned* st) {
    XcdBarrier b; b.bar = bar; b.x = xb_xcc_id(); b.st = st;
    if (threadIdx.x == 0) (void)xb_add(&bar[XB_XCNT(b.x)], 1u);
    return b;
}
__device__ __forceinline__ void xcd_barrier_complete(unsigned* bar, unsigned x, unsigned& nloc, unsigned& nx) {
    const unsigned G = gridDim.x * gridDim.y * gridDim.z;
    unsigned sum, cnt, mine, sp = 0u;
    for (;;) {
        sum = 0u; cnt = 0u; mine = 0u;
#pragma unroll
        for (unsigned j = 0; j < 16; ++j) { const unsigned c = xb_ld(&bar[XB_XCNT(j)]); sum += c; cnt += (c > 0u) ? 1u : 0u; mine = (j == x) ? c : mine; }
        if (sum == G) break;
        __builtin_amdgcn_s_sleep(1);
        if ((++sp & 255u) == 0u) { if (xb_ld(&bar[XB_TMO])) break; if (sp > XB_SPIN_CAP) { atomicAdd(&bar[XB_TMO], 1u); break; } }
    }
    nloc = mine > 0u ? mine : 1u; nx = cnt > 0u ? cnt : 1u;
}

__device__ __attribute__((noinline)) void xcd_barrier_impl(GAS unsigned* bar_, unsigned x_, LAS unsigned* st_) { XcdBarrier b; b.bar = (unsigned*)bar_; b.x = x_; b.st = st_;
    asm volatile("s_waitcnt vmcnt(0)" ::: "memory");
    __syncthreads();
    if (threadIdx.x == 0) {
        unsigned* bar = b.bar;
        __builtin_amdgcn_s_waitcnt(0);
        unsigned nloc = b.st[0], nx = b.st[1];
        if (nloc == 0u) { xcd_barrier_complete(bar, b.x, nloc, nx); b.st[0] = nloc; b.st[1] = nx; }
        const unsigned old = xb_add(&bar[XB_XSUB(b.x)], 1u);
        const unsigned gen = old / nloc;
        if (old + 1u == (gen + 1u) * nloc) {
            __builtin_amdgcn_fence(__ATOMIC_RELEASE, "agent");
            asm volatile("s_waitcnt vmcnt(0)" ::: "memory");
            const unsigned og = xb_add(&bar[XB_TOP], 1u);
            const unsigned tg = og / nx;
            if (og + 1u == (tg + 1u) * nx) xb_add(&bar[XB_TOPGEN], 1u);
            else XB_SPIN(xb_ld(&bar[XB_TOPGEN]) == tg, bar);
            __builtin_amdgcn_fence(__ATOMIC_ACQUIRE, "agent");
            xb_add(&bar[XB_XGEN(b.x)], 1u);
            asm volatile("s_waitcnt vmcnt(0)" ::: "memory");
        } else {
            XB_SPIN(xb_ld(&bar[XB_XGEN(b.x)]) == gen, bar);
            __builtin_amdgcn_fence(__ATOMIC_ACQUIRE, "agent");
            asm volatile("s_waitcnt vmcnt(0)" ::: "memory");
        }
    }
    __syncthreads();
}
__device__ __forceinline__ void xcd_barrier(const XcdBarrier& b) { xcd_barrier_impl((GAS unsigned*)b.bar, b.x, (LAS unsigned*)b.st); }

#define ACC_T const pg8::f32x4 (&acc)[2][2][4][2]
__device__ __forceinline__ u32x4 pack8(f32x4 v0, f32x4 v1) { u32x4 w; w.x = pk2(v0[0], v0[1]); w.y = pk2(v0[2], v0[3]); w.z = pk2(v1[0], v1[1]); w.w = pk2(v1[2], v1[3]); return w; }
__device__ __forceinline__ f32x4 sigm4(f32x4 v) { f32x4 r; r[0] = sigm(v[0]); r[1] = sigm(v[1]); r[2] = sigm(v[2]); r[3] = sigm(v[3]); return r; }

struct EpiWin {
    static constexpr bool PERM = true, AFTER_DRAIN = false;
    const float* rstd; bf16_t* z8; bf16_t* dlat; bf16_t* diq; bf16_t* dik; float* ffw; bf16_t* gates;
    __device__ __forceinline__ void operator()(ACC_T, const pg8::Unit& u, int wr, int wc, int fr, int fq) const {
        const int row0 = u.pm * 256 + wr * 64 + fr, pn = u.pn, cl = wc * 32 + 8 * fq;
        float rsv[2][4];
#pragma unroll
        for (int ai = 0; ai < 2; ++ai)
#pragma unroll
            for (int m = 0; m < 4; ++m) rsv[ai][m] = rstd[row0 + ai * 128 + m * 16];
        if (pn == 18) {
#pragma unroll
            for (int ai = 0; ai < 2; ++ai)
#pragma unroll
                for (int m = 0; m < 4; ++m) { const int row = row0 + ai * 128 + m * 16; const float rs = rsv[ai][m];
                    const f32x4 v0 = acc[ai][0][m][0] * rs, v1 = acc[ai][0][m][1] * rs;
                    if (cl < 64) *(u32x4*)(dik + (size_t)row * 64 + cl) = pack8(v0, v1);
                    else if (cl == 64) { *(f32x4*)(ffw + (size_t)row * 16) = v0; *(f32x4*)(ffw + (size_t)row * 16 + 4) = v1; }
                    else if (cl == 72) { *(f32x4*)(ffw + (size_t)row * 16 + 8) = v0; } }
            return;
        }
        bf16_t* dst; int ldc, colbase; bool sg = false; float scale = 1.f;
        if (pn < 16) { const int idx = pn >> 1; dst = z8 + (size_t)idx * NTOK * 512; ldc = 512; colbase = (pn & 1) * 256; sg = (idx == 3); scale = (idx == 4 || idx == 7) ? C2 : 1.f; }
        else if (pn == 16) { dst = dlat; ldc = 256; colbase = 0; }
        else if (pn == 17) { dst = diq; ldc = 256; colbase = 0; }
        else { dst = gates; ldc = 6144; colbase = (pn - 19) * 256; sg = true; }
        if (sg) {
#pragma unroll
            for (int ai = 0; ai < 2; ++ai)
#pragma unroll
                for (int m = 0; m < 4; ++m) { const int row = row0 + ai * 128 + m * 16; const float rs = rsv[ai][m]; bf16_t* rowp = dst + (size_t)row * ldc + colbase + cl;
#pragma unroll
                    for (int bj = 0; bj < 2; ++bj) *(u32x4*)(rowp + bj * 128) = pack8(sigm4(acc[ai][bj][m][0] * rs), sigm4(acc[ai][bj][m][1] * rs)); }
        } else {
#pragma unroll
            for (int ai = 0; ai < 2; ++ai)
#pragma unroll
                for (int m = 0; m < 4; ++m) { const int row = row0 + ai * 128 + m * 16; const float rs = rsv[ai][m] * scale; bf16_t* rowp = dst + (size_t)row * ldc + colbase + cl;
#pragma unroll
                    for (int bj = 0; bj < 2; ++bj) *(u32x4*)(rowp + bj * 128) = pack8(acc[ai][bj][m][0] * rs, acc[ai][bj][m][1] * rs); }
        }
    }
};
struct EpiGate {
    static constexpr bool PERM = true, AFTER_DRAIN = false;
    const float* rstd; bf16_t* gates; float scale;
    __device__ __forceinline__ void operator()(ACC_T, const pg8::Unit& u, int wr, int wc, int fr, int fq) const {
        const int row0 = u.pm * 256 + wr * 64 + fr, col0 = u.pn * 256 + wc * 32 + 8 * fq;
        float rsv[2][4];
#pragma unroll
        for (int ai = 0; ai < 2; ++ai)
#pragma unroll
            for (int m = 0; m < 4; ++m) rsv[ai][m] = rstd[row0 + ai * 128 + m * 16];
#pragma unroll
        for (int ai = 0; ai < 2; ++ai)
#pragma unroll
            for (int m = 0; m < 4; ++m) { const int row = row0 + ai * 128 + m * 16; const float rs = rsv[ai][m] * scale; bf16_t* rowp = gates + (size_t)row * 6144 + col0;
#pragma unroll
                for (int bj = 0; bj < 2; ++bj) *(u32x4*)(rowp + bj * 128) = pack8(sigm4(acc[ai][bj][m][0] * rs), sigm4(acc[ai][bj][m][1] * rs)); }
    }
};
struct EpiPlain {
    static constexpr bool PERM = true, AFTER_DRAIN = false;
    bf16_t* O; int ldc;
    __device__ __forceinline__ void operator()(ACC_T, const pg8::Unit& u, int wr, int wc, int fr, int fq) const {
        const int row0 = u.pm * 256 + wr * 64 + fr, col0 = u.pn * 256 + wc * 32 + 8 * fq;
#pragma unroll
        for (int ai = 0; ai < 2; ++ai)
#pragma unroll
            for (int m = 0; m < 4; ++m) { bf16_t* rowp = O + (size_t)(row0 + ai * 128 + m * 16) * ldc + col0;
#pragma unroll
                for (int bj = 0; bj < 2; ++bj) *(u32x4*)(rowp + bj * 128) = pack8(acc[ai][bj][m][0], acc[ai][bj][m][1]); }
    }
};
struct EpiBranch {
    static constexpr bool PERM = true, AFTER_DRAIN = false;
    const bf16_t* gates; bf16_t* M;
    __device__ __forceinline__ void operator()(pg8::f32x4 (&acc)[2][2][4][2], const pg8::Unit& u, int wr, int wc, int fr, int fq) const {
        const int row0 = u.pm * 256 + wr * 64 + fr, col0 = u.pn * 256 + wc * 32 + 8 * fq, br = u.aux;
#pragma unroll
        for (int am = 0; am < 8; ++am) { const int ai = am >> 2, mb = am & 3;
            u32x4 gv[4][2], hv[4][2];
#pragma unroll
            for (int m = mb; m < mb + 1; ++m)
#pragma unroll
                for (int bj = 0; bj < 2; ++bj) { const int row = row0 + ai * 128 + m * 16, col = col0 + bj * 128;
                    gv[m][bj] = *(const u32x4*)(gates + (size_t)row * 6144 + br * 2048 + col);
                    hv[m][bj] = gv[m][bj]; if (br < 2) hv[m][bj] = *(const u32x4*)(gates + (size_t)row * 6144 + (br + 1) * 2048 + col); }
#pragma unroll
            for (int m = mb; m < mb + 1; ++m)
#pragma unroll
                for (int bj = 0; bj < 2; ++bj) { const int row = row0 + ai * 128 + m * 16, col = col0 + bj * 128; const u32x4 g = gv[m][bj], h = hv[m][bj];
                    float f[8] = {bflo(g.x), bfhi(g.x), bflo(g.y), bfhi(g.y), bflo(g.z), bfhi(g.z), bflo(g.w), bfhi(g.w)};
                    if (br < 2) { const float d[8] = {bflo(h.x), bfhi(h.x), bflo(h.y), bfhi(h.y), bflo(h.z), bfhi(h.z), bflo(h.w), bfhi(h.w)};
#pragma unroll
                        for (int i = 0; i < 8; ++i) f[i] = f[i] * __builtin_amdgcn_rcpf(fmaxf(d[i], 1.0e-20f)); }
                    pg8::f32x4& v0 = acc[ai][bj][m][0]; pg8::f32x4& v1 = acc[ai][bj][m][1];
                    v0[0] *= f[0]; v0[1] *= f[1]; v0[2] *= f[2]; v0[3] *= f[3]; v1[0] *= f[4]; v1[1] *= f[5]; v1[2] *= f[6]; v1[3] *= f[7];
                    if (br == 2) { *(u32x4*)(M + (size_t)row * DM + col) = pack8(v0, v1); v0 = (pg8::f32x4){0.f, 0.f, 0.f, 0.f}; v1 = (pg8::f32x4){0.f, 0.f, 0.f, 0.f}; } }
        }
    }
};
struct EpiResid {
    static constexpr bool PERM = true, AFTER_DRAIN = false;
    const float* xold; float* x; bf16_t* xb; float* ssp; unsigned char* xb8; float ascale;
    __device__ __forceinline__ void operator()(ACC_T, const pg8::Unit& u, int wr, int wc, int fr, int fq) const {
        const int row0 = u.pm * 256 + wr * 64 + fr, col0 = u.pn * 256 + wc * 32 + 8 * fq;
#pragma unroll
        for (int am = 0; am < 4; ++am) { const int ai = am >> 1, mb = (am & 1) * 2;
            f32x4 ov[4][2][2];
#pragma unroll
            for (int m = mb; m < mb + 2; ++m)
#pragma unroll
                for (int bj = 0; bj < 2; ++bj) { const size_t off = (size_t)(row0 + ai * 128 + m * 16) * DM + col0 + bj * 128; ov[m][bj][0] = *(const f32x4*)(xold + off); ov[m][bj][1] = *(const f32x4*)(xold + off + 4); }
#pragma unroll
            for (int m = mb; m < mb + 2; ++m) { const int row = row0 + ai * 128 + m * 16; float ss = 0.f;
#pragma unroll
                for (int bj = 0; bj < 2; ++bj) { const size_t off = (size_t)row * DM + col0 + bj * 128;
                    const f32x4 v0 = ov[m][bj][0] + acc[ai][bj][m][0] * ascale, v1 = ov[m][bj][1] + acc[ai][bj][m][1] * ascale;
                    *(f32x4*)(x + off) = v0; *(f32x4*)(x + off + 4) = v1; if (xb) *(u32x4*)(xb + off) = pack8(v0, v1);
                    if (xb8) { const float e[8] = {v0[0], v0[1], v0[2], v0[3], v1[0], v1[1], v1[2], v1[3]}; *(u32x2*)(xb8 + off) = pack8_fp8(e); }
                    ss += (v0[0] * v0[0] + v0[1] * v0[1]) + (v0[2] * v0[2] + v0[3] * v0[3]) + (v1[0] * v1[0] + v1[1] * v1[1]) + (v1[2] * v1[2] + v1[3] * v1[3]); }
                ss += __shfl_xor(ss, 16); ss += __shfl_xor(ss, 32);
                if (fq == 0) ssp[(size_t)row * 32 + u.pn * 4 + wc] = ss; }
        }
    }
};
struct EpiSwiglu {
    static constexpr bool PERM = true, AFTER_DRAIN = false;
    const float* rstd; bf16_t* hid; float oscale; int f8out;
    __device__ __forceinline__ void operator()(ACC_T, const pg8::Unit& u, int wr, int wc, int fr, int fq) const {
        const int row0 = u.pm * 256 + wr * 64 + fr, col0 = u.pn * 128 + wc * 32 + 8 * fq;
        float rsv[2][4];
#pragma unroll
        for (int ai = 0; ai < 2; ++ai)
#pragma unroll
            for (int m = 0; m < 4; ++m) rsv[ai][m] = rstd[row0 + ai * 128 + m * 16];
#pragma unroll
        for (int ai = 0; ai < 2; ++ai)
#pragma unroll
            for (int m = 0; m < 4; ++m) { const int row = row0 + ai * 128 + m * 16; const float rs = rsv[ai][m] * oscale;
                f32x4 h0, h1;
#pragma unroll
                for (int j = 0; j < 4; ++j) { const float g0 = acc[ai][0][m][0][j] * rs, u0 = acc[ai][1][m][0][j] * rs, g1 = acc[ai][0][m][1][j] * rs, u1 = acc[ai][1][m][1][j] * rs;
                    h0[j] = g0 * u0 * sigm(g0); h1[j] = g1 * u1 * sigm(g1); }
                if (f8out) { const float e[8] = {h0[0] * H8SCALE, h0[1] * H8SCALE, h0[2] * H8SCALE, h0[3] * H8SCALE, h1[0] * H8SCALE, h1[1] * H8SCALE, h1[2] * H8SCALE, h1[3] * H8SCALE}; *(u32x2*)((unsigned char*)hid + (size_t)row * DFF + col0) = pack8_fp8(e); }
                else *(u32x4*)(hid + (size_t)row * DFF + col0) = pack8(h0, h1); }
    }
};
struct EpiMoeDown {
    static constexpr bool PERM = true, AFTER_DRAIN = false;
    const int* rowtok; const float* roww; bf16_t* y; float oscale;
    __device__ __forceinline__ void operator()(ACC_T, const pg8::Unit& u, int wr, int wc, int fr, int fq) const {
        const int row0 = u.pm * 256 + wr * 64 + fr, col0 = u.pn * 256 + wc * 32 + 8 * fq;
        int tkv[2][4]; float wv[2][4];
#pragma unroll
        for (int ai = 0; ai < 2; ++ai)
#pragma unroll
            for (int m = 0; m < 4; ++m) { tkv[ai][m] = rowtok[row0 + ai * 128 + m * 16]; wv[ai][m] = roww[row0 + ai * 128 + m * 16]; }
#pragma unroll
        for (int ai = 0; ai < 2; ++ai)
#pragma unroll
            for (int m = 0; m < 4; ++m) { const int tk = tkv[ai][m];
                if (tk >= 0) { const float w = wv[ai][m] * oscale; bf16_t* d = y + (size_t)(tk & 1) * NTOK * DM + (size_t)(tk >> 1) * DM + col0;
#pragma unroll
                    for (int bj = 0; bj < 2; ++bj) *(u32x4*)(d + bj * 128) = pack8(acc[ai][bj][m][0] * w, acc[ai][bj][m][1] * w); } }
    }
};

struct EpiMoeTail {
    static constexpr bool PERM = true, AFTER_DRAIN = false;
    const int* rowtok; const float* roww; bf16_t* yp; float oscale;
    __device__ __forceinline__ void operator()(ACC_T, const pg8::Unit& u, int wr, int wc, int fr, int fq) const {
        const int row0 = u.pm * 256 + wr * 64 + fr, col0 = u.pn * 256 + wc * 32 + 8 * fq;
        int tkv[2][4]; float wv[2][4];
#pragma unroll
        for (int ai = 0; ai < 2; ++ai)
#pragma unroll
            for (int m = 0; m < 4; ++m) { tkv[ai][m] = rowtok[row0 + ai * 128 + m * 16]; wv[ai][m] = roww[row0 + ai * 128 + m * 16]; }
#pragma unroll
        for (int ai = 0; ai < 2; ++ai)
#pragma unroll
            for (int m = 0; m < 4; ++m) { const int row = row0 + ai * 128 + m * 16;
                if (tkv[ai][m] >= 0) { const float w = wv[ai][m] * oscale; bf16_t* d = yp + ((size_t)u.aux * 2048 + (size_t)(row - 32768)) * DM + col0;
#pragma unroll
                    for (int bj = 0; bj < 2; ++bj) *(u32x4*)(d + bj * 128) = pack8(acc[ai][bj][m][0] * w, acc[ai][bj][m][1] * w); } }
    }
};
struct Args { const float* in[22]; float* out; unsigned char* ws; int ph_lo, ph_hi; };

__host__ __device__ __forceinline__ int win_src(int n) {
    if (n < 1536) return n;
    if (n < 2048) return 1544 + (n - 1536);
    if (n < 4096) return 2056 + (n - 2048);
    if (n < 4352) return 4104 + (n - 4096);
    if (n < 4608) return 4360 + (n - 4352);
    if (n < 4672) return 4616 + (n - 4608);
    if (n < 4680) return 1536 + (n - 4672);
    if (n < 4684) return 4680 + (n - 4680);
    if (n < 4864) return -1;
    return 4684 + (n - 4864);
}

__device__ __forceinline__ void conv_item(int map, const float* W0, const float* W1, int K, int Ns, int dstN, bf16_t* WT, const float* gain, LAS float* scr, int it, int lane, float f8scale) {
    const int nblk = dstN >> 5, nit = (K >> 6) * nblk;
    if (it >= nit) return;
    {
        const int kb = it / nblk, nb = it - kb * nblk, k0 = kb << 6, n0 = nb << 5;
        const float* src = W0; int sc;
        if (map == 0) sc = n0 + (lane & 31);
        else if (map == 1) sc = win_src(n0 + (lane & 31));
        else { const int t = nb >> 3, r = nb & 7; src = (r < 4) ? W0 : W1; sc = 128 * t + 32 * (r & 3) + (lane & 31); }
        const float* sp = src + (size_t)k0 * Ns + (sc < 0 ? 0 : sc);
#pragma unroll
        for (int hh = 0; hh < 2; ++hh) { float tv[16];
#pragma unroll
            for (int i = 0; i < 16; ++i) tv[i] = __builtin_nontemporal_load(sp + (size_t)(2 * (16 * hh + i) + (lane >> 5)) * Ns);
#pragma unroll
            for (int i = 0; i < 16; ++i) scr[(2 * (16 * hh + i) + (lane >> 5)) * 33 + (lane & 31)] = (sc < 0) ? 0.f : tv[i]; }
        LDS_WAIT(); asm volatile("" ::: "memory");
        const int c = lane & 7;
        f32x4 g0 = {1.f, 1.f, 1.f, 1.f}, g1 = {1.f, 1.f, 1.f, 1.f};
        if (gain) { g0 = *(const f32x4*)(gain + k0 + 8 * c); g1 = *(const f32x4*)(gain + k0 + 8 * c + 4); }
#pragma unroll
        for (int j = 0; j < 4; ++j) { const int n = (lane >> 3) + 8 * j; const LAS float* s = scr + (8 * c) * 33 + n;
            if (f8scale != 0.f) { const float e[8] = {s[0 * 33] * g0[0] * f8scale, s[1 * 33] * g0[1] * f8scale, s[2 * 33] * g0[2] * f8scale, s[3 * 33] * g0[3] * f8scale, s[4 * 33] * g1[0] * f8scale, s[5 * 33] * g1[1] * f8scale, s[6 * 33] * g1[2] * f8scale, s[7 * 33] * g1[3] * f8scale};
                *(u32x2*)((unsigned char*)WT + (size_t)(n0 + n) * K + k0 + 8 * c) = pack8_fp8(e); }
            else {
            u32x4 o; o.x = pk2(s[0 * 33] * g0[0], s[1 * 33] * g0[1]); o.y = pk2(s[2 * 33] * g0[2], s[3 * 33] * g0[3]); o.z = pk2(s[4 * 33] * g1[0], s[5 * 33] * g1[1]); o.w = pk2(s[6 * 33] * g1[2], s[7 * 33] * g1[3]);
            *(u32x4*)(WT + (size_t)(n0 + n) * K + k0 + 8 * c) = o; } }
        LDS_WAIT(); asm volatile("" ::: "memory");
    }
}
__device__ __forceinline__ void conv_matrix(int map, const float* W0, const float* W1, int K, int Ns, int dstN, bf16_t* WT, const float* gain, LAS float* scr, int gw, int NGW, int lane, float f8scale = 0.f) {
    const int nit = (K >> 6) * (dstN >> 5);
    for (int it = gw; it < nit; it += NGW) conv_item(map, W0, W1, K, Ns, dstN, WT, gain, scr, it, lane, f8scale);
}

namespace att {
constexpr int NSLOT = 4, SLOTB = 8192, L_K = 0, L_V = NSLOT * SLOTB, L_WS = 2 * NSLOT * SLOTB, L_CS = L_WS + 2048, L_LUT = L_CS + NSLOT * 256, L_OST = L_LUT + 512, L_MW = L_OST + 8 * 4096, L_END = L_MW + 8 * NSLOT * 256;
static_assert(L_END <= 131072, "attention LDS image");
typedef short s16x4 __attribute__((ext_vector_type(4)));
constexpr float SB_CUT = 64.f;
__device__ __forceinline__ int crow(int r, int hi) { return (r & 3) + 8 * (r >> 2) + 4 * hi; }
__device__ __forceinline__ void glds16(const void* gsrc, unsigned lds_dst) { unsigned keep;
    asm volatile("s_mov_b32 %0, m0\n\ts_mov_b32 m0, %2\n\ts_nop 0\n\tglobal_load_lds_dwordx4 %1, off\n\ts_mov_b32 m0, %0" : "=&s"(keep) : "v"(gsrc), "s"(lds_dst) : "memory"); }
__device__ __forceinline__ void glds4(const void* gsrc, unsigned lds_dst) { unsigned keep;
    asm volatile("s_mov_b32 %0, m0\n\ts_mov_b32 m0, %2\n\ts_nop 0\n\tglobal_load_lds_dword %1, off\n\ts_mov_b32 m0, %0" : "=&s"(keep) : "v"(gsrc), "s"(lds_dst) : "memory"); }
#define ATT_MFMA(a, b, c) __builtin_amdgcn_mfma_f32_32x32x16_bf16(a, b, c, 0, 0, 0)
__device__ __forceinline__ void qkt(f32x16& p0, f32x16& p1, const LAS unsigned char* Kslot, const bf16x8* qr, int r32, int hi) {
    const LAS unsigned char* kb = Kslot + hi * 1024 + r32 * 16;
#pragma unroll
    for (int d0 = 0; d0 < 4; ++d0) { const bf16x8 b0 = *(const LAS bf16x8*)(kb + d0 * 2048), b1 = *(const LAS bf16x8*)(kb + d0 * 2048 + 512);
        p0 = ATT_MFMA(b0, qr[d0], p0); p1 = ATT_MFMA(b1, qr[d0], p1); }
}
__device__ __forceinline__ void pv(f32x16* o, int vb, bf16x8 pa0, bf16x8 pa1, bf16x8 pa2, bf16x8 pa3) {
#pragma unroll
    for (int d0 = 0; d0 < 2; ++d0) { s16x4 lo[4], hi[4];
#pragma unroll
        for (int ks = 0; ks < 4; ++ks) {
            asm volatile("ds_read_b64_tr_b16 %0,%1 offset:%c2" : "=&v"(lo[ks]) : "v"(vb), "i"(d0 * 4096 + ks * 1024) : "memory");
            asm volatile("ds_read_b64_tr_b16 %0,%1 offset:%c2" : "=&v"(hi[ks]) : "v"(vb), "i"(d0 * 4096 + ks * 1024 + 512) : "memory"); }
        asm volatile("s_waitcnt lgkmcnt(0)" ::: "memory"); __builtin_amdgcn_sched_barrier(0);
#define ATT_PK(k) (bf16x8){lo[k][0], lo[k][1], lo[k][2], lo[k][3], hi[k][0], hi[k][1], hi[k][2], hi[k][3]}
        o[d0] = ATT_MFMA(pa0, ATT_PK(0), o[d0]); o[d0] = ATT_MFMA(pa1, ATT_PK(1), o[d0]); o[d0] = ATT_MFMA(pa2, ATT_PK(2), o[d0]); o[d0] = ATT_MFMA(pa3, ATT_PK(3), o[d0]);
#undef ATT_PK
    }
}
__device__ __forceinline__ void kload(bf16x8 (&kf)[8], unsigned kaddr) {
#pragma unroll
    for (int d0 = 0; d0 < 4; ++d0) {
        asm volatile("ds_read_b128 %0, %1 offset:%c2" : "=&v"(kf[2 * d0]) : "v"(kaddr), "i"(d0 * 2048) : "memory");
        asm volatile("ds_read_b128 %0, %1 offset:%c2" : "=&v"(kf[2 * d0 + 1]) : "v"(kaddr), "i"(d0 * 2048 + 512) : "memory"); }
}
__device__ __forceinline__ void vload(s16x4 (&vf)[16], int vb) {
#pragma unroll
    for (int d0 = 0; d0 < 2; ++d0)
#pragma unroll
        for (int ks = 0; ks < 4; ++ks) {
            asm volatile("ds_read_b64_tr_b16 %0,%1 offset:%c2" : "=&v"(vf[d0 * 8 + ks * 2]) : "v"(vb), "i"(d0 * 4096 + ks * 1024) : "memory");
            asm volatile("ds_read_b64_tr_b16 %0,%1 offset:%c2" : "=&v"(vf[d0 * 8 + ks * 2 + 1]) : "v"(vb), "i"(d0 * 4096 + ks * 1024 + 512) : "memory"); }
}
__device__ __forceinline__ void pvmma(f32x16* o, s16x4 (&vf)[16], bf16x8 pa0, bf16x8 pa1, bf16x8 pa2, bf16x8 pa3) {
    asm volatile("s_waitcnt lgkmcnt(0)" : "+v"(vf[0]), "+v"(vf[1]), "+v"(vf[2]), "+v"(vf[3]), "+v"(vf[4]), "+v"(vf[5]), "+v"(vf[6]), "+v"(vf[7]),
                                          "+v"(vf[8]), "+v"(vf[9]), "+v"(vf[10]), "+v"(vf[11]), "+v"(vf[12]), "+v"(vf[13]), "+v"(vf[14]), "+v"(vf[15]) :: "memory");
#define ATT_PK(d, k) (bf16x8){vf[d * 8 + 2 * k][0], vf[d * 8 + 2 * k][1], vf[d * 8 + 2 * k][2], vf[d * 8 + 2 * k][3], vf[d * 8 + 2 * k + 1][0], vf[d * 8 + 2 * k + 1][1], vf[d * 8 + 2 * k + 1][2], vf[d * 8 + 2 * k + 1][3]}
    o[0] = ATT_MFMA(pa0, ATT_PK(0, 0), o[0]); o[1] = ATT_MFMA(pa0, ATT_PK(1, 0), o[1]); o[0] = ATT_MFMA(pa1, ATT_PK(0, 1), o[0]); o[1] = ATT_MFMA(pa1, ATT_PK(1, 1), o[1]);
    o[0] = ATT_MFMA(pa2, ATT_PK(0, 2), o[0]); o[1] = ATT_MFMA(pa2, ATT_PK(1, 2), o[1]); o[0] = ATT_MFMA(pa3, ATT_PK(0, 3), o[0]); o[1] = ATT_MFMA(pa3, ATT_PK(1, 3), o[1]);
#undef ATT_PK
}
__device__ __forceinline__ float hmax(float v) { const auto rr = __builtin_amdgcn_permlane32_swap(__float_as_uint(v), __float_as_uint(v), false, false); return fmaxf(__uint_as_float(rr[0]), __uint_as_float(rr[1])); }
__device__ __forceinline__ float hsum(float v) { const auto rr = __builtin_amdgcn_permlane32_swap(__float_as_uint(v), __float_as_uint(v), false, false); return __uint_as_float(rr[0]) + __uint_as_float(rr[1]); }

__device__ __forceinline__ void attn_begin(LAS unsigned char* lds, int var, int b, int h, int qb, const bf16_t* K, int pk, const bf16_t* V, int pv_, const float* c2f, const unsigned* mask) {
    int tid = threadIdx.x; asm volatile("" : "+v"(tid));
    const int lane = tid & 63, wid = __builtin_amdgcn_readfirstlane(tid >> 6);
    const size_t rowbase = (size_t)b * SEQ; const int q0 = qb * 256, NT = (q0 + 256) / 64;
    const unsigned lds0 = (unsigned)(uintptr_t)lds;
    const bf16_t* ksrc = K + rowbase * pk + h * 64 + (size_t)lane * pk + wid * 8;
    const bf16_t* vsrc = V + rowbase * pv_ + h * 64 + (size_t)(16 * (wid & 3) + (lane >> 2)) * pv_ + (wid >> 2) * 32 + (lane & 3) * 8;
#pragma unroll
    for (int i = 0; i < 2; ++i) { const int tile = (var == 1) ? NT - 1 - i : i;
        glds16(ksrc + (size_t)tile * 64 * pk, (unsigned)__builtin_amdgcn_readfirstlane(lds0 + L_K + wid * 1024 + i * SLOTB)); glds16(vsrc + (size_t)tile * 64 * pv_, (unsigned)__builtin_amdgcn_readfirstlane(lds0 + L_V + wid * 1024 + i * SLOTB));
        if (var == 0 && wid == 0) glds4(c2f + ((size_t)b * NHEAD + h) * SEQ + tile * 64 + lane, (unsigned)__builtin_amdgcn_readfirstlane(lds0 + L_CS + i * 256));
        if (var == 2) glds4(mask + (rowbase + q0 + wid * 32 + (lane >> 1)) * 64 + (lane & 1) + tile * 2, (unsigned)__builtin_amdgcn_readfirstlane(lds0 + L_MW + (wid * NSLOT + i) * 256)); }
}
template <int N> __device__ __forceinline__ void wait_bar() { asm volatile("s_waitcnt vmcnt(%0) lgkmcnt(0)\n\ts_barrier" :: "n"(N) : "memory"); }
template <int VAR, class Next> __device__ __forceinline__ void attn_unit(LAS unsigned char* lds, unsigned tnext, const Next& next, int b, int h, int qb,
        const bf16_t* Q, const bf16_t* K, int pk, const bf16_t* V, int pv_, const float* c2f, const unsigned* mask, const float* relb, const bf16_t* ogate, bf16_t* O) {
    int tid = threadIdx.x; asm volatile("" : "+v"(tid));
    const int lane = tid & 63, r32 = lane & 31, hi = lane >> 5, wid = __builtin_amdgcn_readfirstlane(tid >> 6);
    const size_t rowbase = (size_t)b * SEQ; const int q0 = qb * 256, qrel = wid * 32 + r32, t = q0 + qrel;
    const unsigned lds0 = (unsigned)(uintptr_t)lds;
    LAS float* wsf = (LAS float*)(lds + L_WS) + wid * 64;
    const bf16_t* Kh = K + rowbase * pk + h * 64; const bf16_t* Vh = V + rowbase * pv_ + h * 64;
    const bf16_t* ksrc = Kh + (size_t)lane * pk + wid * 8;
    const bf16_t* vsrc = Vh + (size_t)(16 * (wid & 3) + (lane >> 2)) * pv_ + (wid >> 2) * 32 + (lane & 3) * 8;
    const unsigned kdst = lds0 + L_K + wid * 1024, vdst = lds0 + L_V + wid * 1024;
    const int vb0 = (int)(lds0 + L_V) + ((lane >> 4) & 1) * 32 + (lane & 3) * 8 + (4 * hi + ((lane & 15) >> 2)) * 64;
    const int NT = (q0 + 256) / 64;
    const float* c2h = c2f + ((size_t)b * NHEAD + h) * SEQ;
#define ATT_DMA(tile, slot) do { glds16(ksrc + (size_t)(tile) * 64 * pk, (unsigned)__builtin_amdgcn_readfirstlane(kdst + (slot) * SLOTB)); glds16(vsrc + (size_t)(tile) * 64 * pv_, (unsigned)__builtin_amdgcn_readfirstlane(vdst + (slot) * SLOTB)); \
        if (VAR == 0 && wid == 0) glds4(c2h + (tile) * 64 + lane, (unsigned)__builtin_amdgcn_readfirstlane(lds0 + L_CS + (slot) * 256)); \
        if (VAR == 2) glds4(mrow + (tile) * 2, (unsigned)__builtin_amdgcn_readfirstlane(lds0 + L_MW + (wid * NSLOT + (slot)) * 256)); } while (0)
#define ATT_TILE(i) ((VAR == 1) ? NT - 1 - (i) : (i))
    const unsigned* mrow = nullptr; if (VAR == 2) mrow = mask + (rowbase + q0 + wid * 32 + (lane >> 1)) * 64 + (lane & 1);
    if (VAR == 2 && tid < 128) {
        int bk; if (tid < 16) bk = tid; else { bk = 16 + (int)(logf((float)tid / 16.0f) / 2.0794415416798357f * 16.0f); if (bk > 31) bk = 31; }
        ((LAS float*)(lds + L_LUT))[tid] = relb[bk * NHEAD + h] * LOG2E; }
    bf16x8 qr[4];
    { const bf16_t* Qw = Q + (rowbase + t) * 512 + h * 64;
#pragma unroll
      for (int d0 = 0; d0 < 4; ++d0) qr[d0] = *(const bf16x8*)(Qw + d0 * 16 + hi * 8); }
    float mrun = -1.0e30f, lrun = 0.f, R = 0.f; bool wdone = false;
    LAS unsigned* votes = (LAS unsigned*)(lds + L_CS);
    f32x16 o[2];
#pragma unroll
    for (int r = 0; r < 16; ++r) { o[0][r] = 0.f; o[1][r] = 0.f; }
    asm volatile("s_waitcnt vmcnt(0) lgkmcnt(0)\n\ts_barrier" ::: "memory");
#pragma unroll
    for (int d0 = 0; d0 < 4; ++d0) asm volatile("" : "+v"(qr[d0]));
#pragma unroll 1
    for (int it2 = 0; it2 < NT; it2 += 2) {
        if (it2 + 2 < NT) { ATT_DMA(ATT_TILE(it2 + 2), (it2 + 2) & (NSLOT - 1)); ATT_DMA(ATT_TILE(it2 + 3), (it2 + 3) & (NSLOT - 1)); }
#pragma unroll 1
        for (int it = it2; it < it2 + 2; ++it) {
        const int tile = ATT_TILE(it), slot = it & (NSLOT - 1);
        const bool active = (tile * 64 <= q0 + wid * 32 + 31) && !(VAR == 1 && wdone);
        if (active) {
        f32x16 p0, p1;
        if (VAR == 0) { const LAS f32x4* cs = (const LAS f32x4*)(lds + L_CS + slot * 256 + 16 * hi);
#pragma unroll
            for (int g = 0; g < 4; ++g) { const f32x4 ca = cs[2 * g], cb = cs[8 + 2 * g];
#pragma unroll
                for (int i = 0; i < 4; ++i) { p0[4 * g + i] = ca[i]; p1[4 * g + i] = cb[i]; } }
        } else {
#pragma unroll
            for (int r = 0; r < 16; ++r) { p0[r] = 0.f; p1[r] = 0.f; } }
        u32x2 mw = {0u, 0u}; float bfar = 0.f;
        if (VAR == 2) { mw = *(const LAS u32x2*)(lds + L_MW + (wid * NSLOT + slot) * 256 + r32 * 8); bfar = ((const LAS float*)(lds + L_LUT))[127]; }
        bf16x8 kf[8]; kload(kf, lds0 + L_K + slot * SLOTB + hi * 1024 + r32 * 16);
        asm volatile("s_waitcnt lgkmcnt(0)" : "+v"(kf[0]), "+v"(kf[1]), "+v"(kf[2]), "+v"(kf[3]), "+v"(kf[4]), "+v"(kf[5]), "+v"(kf[6]), "+v"(kf[7]), "+v"(mw.x), "+v"(mw.y), "+v"(bfar) :: "memory");
#pragma unroll
        for (int d0 = 0; d0 < 4; ++d0) { p0 = ATT_MFMA(kf[2 * d0], qr[d0], p0); p1 = ATT_MFMA(kf[2 * d0 + 1], qr[d0], p1); }
        s16x4 vf[16]; vload(vf, vb0 + slot * SLOTB);
        const int kv0 = tile * 64 + 4 * hi;
        const bool band = (tile * 64 + 63 > q0 + wid * 32);
        f32x16 pw0v, pw1v;
        if (VAR == 1) {
            f32x16 L0, L1;
#pragma unroll
            for (int r = 0; r < 16; ++r) { L0[r] = softplus2(p0[r]); L1[r] = softplus2(p1[r]); }
            if (band) {
#pragma unroll
                for (int r = 0; r < 16; ++r) { const int kv = kv0 + (r & 3) + 8 * (r >> 2); if (kv >= t) L0[r] = 0.f; if (kv + 32 >= t) L1[r] = 0.f; } }
            float G[8], T[8], S[8];
#pragma unroll
            for (int g = 0; g < 4; ++g) { G[g] = (L0[4 * g] + L0[4 * g + 1]) + (L0[4 * g + 2] + L0[4 * g + 3]); G[4 + g] = (L1[4 * g] + L1[4 * g + 1]) + (L1[4 * g + 2] + L1[4 * g + 3]); }
#pragma unroll
            for (int k = 0; k < 8; ++k) T[k] = hsum(G[k]);
            S[7] = 0.f;
#pragma unroll
            for (int k = 6; k >= 0; --k) S[k] = S[k + 1] + T[k + 1];
            const float tot = S[0] + T[0];
#pragma unroll
            for (int g = 0; g < 4; ++g) {
#pragma unroll
                for (int blk = 0; blk < 2; ++blk) { const int k = blk * 4 + g; const float off = R + S[k] + (hi == 0 ? T[k] - G[k] : 0.f);
                    f32x16& Lb = blk ? L1 : L0; f32x16& zb = blk ? p1 : p0; f32x16& ob = blk ? pw1v : pw0v;
                    const float e3 = Lb[4 * g + 3], e2 = e3 + Lb[4 * g + 2], e1 = e2 + Lb[4 * g + 1], e0 = e1 + Lb[4 * g];
                    ob[4 * g + 3] = __builtin_amdgcn_exp2f(zb[4 * g + 3] - (off + e3)); ob[4 * g + 2] = __builtin_amdgcn_exp2f(zb[4 * g + 2] - (off + e2));
                    ob[4 * g + 1] = __builtin_amdgcn_exp2f(zb[4 * g + 1] - (off + e1)); ob[4 * g] = __builtin_amdgcn_exp2f(zb[4 * g] - (off + e0)); } }
            if (band) {
#pragma unroll
                for (int r = 0; r < 16; ++r) { const int kv = kv0 + (r & 3) + 8 * (r >> 2); if (kv >= t) pw0v[r] = 0.f; if (kv + 32 >= t) pw1v[r] = 0.f; } }
            R += tot;
        } else {
            if (VAR == 0) {
                if (band) {
#pragma unroll
                    for (int r = 0; r < 16; ++r) { const int kv = kv0 + (r & 3) + 8 * (r >> 2); if (kv > t) p0[r] = -INFINITY; if (kv + 32 > t) p1[r] = -INFINITY; } }
            } else {
                const LAS float* lut = (const LAS float*)(lds + L_LUT);
                if (tile * 64 + 63 + 113 <= q0 + wid * 32) {
#pragma unroll
                    for (int r = 0; r < 16; ++r) { p0[r] += bfar; p1[r] += bfar; }
                } else {
#pragma unroll
                    for (int r = 0; r < 16; ++r) { const int kv = kv0 + (r & 3) + 8 * (r >> 2); int d0 = t - kv, d1 = d0 - 32; d0 = d0 < 0 ? 0 : (d0 > 127 ? 127 : d0); d1 = d1 < 0 ? 0 : (d1 > 127 ? 127 : d1);
                        p0[r] += lut[d0]; p1[r] += lut[d1]; } }
#pragma unroll
                for (int r = 0; r < 16; ++r) { const int bit = (r & 3) + 8 * (r >> 2) + 4 * hi; if (!((mw.x >> bit) & 1u)) p0[r] = -INFINITY; if (!((mw.y >> bit) & 1u)) p1[r] = -INFINITY; }
            }
            const float nmr = -mrun; f32x16 d0 = p0 + nmr, d1 = p1 + nmr;
            float rx = fmaxf(d0[0], d1[0]);
#pragma unroll
            for (int r = 1; r < 16; ++r) rx = fmaxf(rx, fmaxf(d0[r], d1[r]));
            rx = hmax(rx);
            if (__any(rx > 8.0f)) {
                float rm = fmaxf(p0[0], p1[0]);
#pragma unroll
                for (int r = 1; r < 16; ++r) rm = fmaxf(rm, fmaxf(p0[r], p1[r]));
                rm = hmax(rm);
                const float mnew = fmaxf(mrun, rm), f = __builtin_amdgcn_exp2f(mrun - mnew);
                lrun *= f; if (hi == 0) wsf[r32] = f;
                asm volatile("s_waitcnt lgkmcnt(0)" ::: "memory");
#pragma unroll
                for (int r = 0; r < 16; ++r) { const float fr = wsf[crow(r, hi)]; o[0][r] *= fr; o[1][r] *= fr; }
                mrun = mnew; const float nmn = -mnew; d0 = p0 + nmn; d1 = p1 + nmn;
            }
            float sacc = 0.f;
#pragma unroll
            for (int r = 0; r < 16; ++r) { pw0v[r] = __builtin_amdgcn_exp2f(d0[r]); pw1v[r] = __builtin_amdgcn_exp2f(d1[r]); sacc += pw0v[r] + pw1v[r]; }
            lrun += sacc;
        }
        u32x4 w0, w1, w2, w3;
        w0 = (u32x4){pk2(pw0v[0], pw0v[1]), pk2(pw0v[2], pw0v[3]), pk2(pw0v[4], pw0v[5]), pk2(pw0v[6], pw0v[7])}; w1 = (u32x4){pk2(pw0v[8], pw0v[9]), pk2(pw0v[10], pw0v[11]), pk2(pw0v[12], pw0v[13]), pk2(pw0v[14], pw0v[15])};
        w2 = (u32x4){pk2(pw1v[0], pw1v[1]), pk2(pw1v[2], pw1v[3]), pk2(pw1v[4], pw1v[5]), pk2(pw1v[6], pw1v[7])}; w3 = (u32x4){pk2(pw1v[8], pw1v[9]), pk2(pw1v[10], pw1v[11]), pk2(pw1v[12], pw1v[13]), pk2(pw1v[14], pw1v[15])};
        pvmma(o, vf, __builtin_bit_cast(bf16x8, w0), __builtin_bit_cast(bf16x8, w1), __builtin_bit_cast(bf16x8, w2), __builtin_bit_cast(bf16x8, w3));
        if (VAR == 1) wdone = !__any(R <= SB_CUT);
        }
        }
        const int vbank = (it2 >> 1) & 1;
        if (VAR == 1 && lane == 0) votes[vbank * 8 + wid] = wdone ? 1u : 0u;
        if (tid == 0) *(volatile LAS unsigned*)(lds + MISC_OFF + 260) = tnext;
        wait_bar<0>();
        if (VAR == 1) { const LAS u32x4* vp = (const LAS u32x4*)(votes + vbank * 8); const u32x4 va = vp[0], vb = vp[1]; if ((va.x & va.y & va.z & va.w & vb.x & vb.y & vb.z & vb.w) != 0u) break; }
    }
    if (VAR == 1) asm volatile("s_waitcnt vmcnt(0)\n\ts_barrier" ::: "memory");
    next();
    float linv = 1.f;
    if (VAR != 1) { const float lt = hsum(lrun); linv = 1.0f / lt; }
    if (hi == 0) wsf[32 + r32] = linv; asm volatile("s_waitcnt lgkmcnt(0)" ::: "memory");
    { LAS bf16_t* stg = (LAS bf16_t*)(lds + L_OST) + wid * 2048;
#pragma unroll
      for (int r = 0; r < 16; ++r) { const int orow = crow(r, hi); const float li = wsf[32 + orow];
#pragma unroll
          for (int d0 = 0; d0 < 2; ++d0) stg[orow * 64 + d0 * 32 + r32] = (bf16_t)(pk2(o[d0][r] * li, 0.f) & 0xffffu); }
      asm volatile("s_waitcnt lgkmcnt(0)" ::: "memory");
      bf16_t* Ow = O + (rowbase + q0 + wid * 32) * 512 + h * 64;
#pragma unroll
      for (int i = 0; i < 4; ++i) { const int row = i * 8 + (lane >> 3), ch = lane & 7; u32x4 v = *(const LAS u32x4*)(stg + row * 64 + ch * 8);
          if (VAR == 0) { const u32x4 g = *(const u32x4*)(ogate + (rowbase + q0 + wid * 32 + row) * 512 + h * 64 + ch * 8);
              v.x = pk2(bflo(v.x) * bflo(g.x), bfhi(v.x) * bfhi(g.x)); v.y = pk2(bflo(v.y) * bflo(g.y), bfhi(v.y) * bfhi(g.y)); v.z = pk2(bflo(v.z) * bflo(g.z), bfhi(v.z) * bfhi(g.z)); v.w = pk2(bflo(v.w) * bflo(g.w), bfhi(v.w) * bfhi(g.w)); }
          *(u32x4*)(Ow + (size_t)row * 512 + ch * 8) = v; } }
    asm volatile("s_waitcnt lgkmcnt(0)\n\ts_barrier" ::: "memory");
#undef ATT_DMA
#undef ATT_TILE
}
}

typedef __attribute__((address_space(4))) const char* kptr_t; typedef const float* cfp_t; typedef const __attribute__((address_space(4))) cfp_t* kslot_t;
__device__ __forceinline__ const float* arg_ptr(int i) { kptr_t ka = (kptr_t)__builtin_amdgcn_kernarg_segment_ptr(); asm volatile("" : "+s"(ka)); return *(kslot_t)(ka + 8 * i); }
#define x_in arg_ptr(0)
#define w_in arg_ptr(1)
#define b_forget arg_ptr(2)
#define q_norm arg_ptr(3)
#define k_norm arg_ptr(4)
#define kv_norm arg_ptr(5)
#define w_ukv arg_ptr(6)
#define w_br0 arg_ptr(7)
#define w_br1 arg_ptr(8)
#define w_br2 arg_ptr(9)
#define w_out arg_ptr(10)
#define rel_bias arg_ptr(11)
#define norm_mix arg_ptr(12)
#define norm_ffn arg_ptr(13)
#define w_fg arg_ptr(14)
#define w_fu arg_ptr(15)
#define w_fd arg_ptr(16)
#define w_router arg_ptr(17)
#define w_mg arg_ptr(18)
#define w_mu arg_ptr(19)
#define w_md arg_ptr(20)
#define norm_final arg_ptr(21)
#define X ((float*)arg_ptr(22))
#define WIN ((bf16_t*)(ws + WS_WIN))
#define WUKV ((bf16_t*)(ws + WS_WUKV))
#define WBR ((bf16_t*)(ws + WS_WBR))
#define WOUT ((bf16_t*)(ws + WS_WOUT))
#define WGU0 ((bf16_t*)(ws + WS_WGU0))
#define WD0 ((bf16_t*)(ws + WS_WD0))
#define WGUM ((bf16_t*)(ws + WS_WGUM))
#define WDM ((bf16_t*)(ws + WS_WDM))
#define RSTD ((float*)(ws + WS_RSTD))
#define SSP ((float*)(ws + WS_SSP))
#define XB ((bf16_t*)(ws + WS_XB))
#define Z8 ((bf16_t*)(ws + WS_Z8))
#define DLAT ((bf16_t*)(ws + WS_DLAT))
#define DIQ ((bf16_t*)(ws + WS_DIQ))
#define DIK ((bf16_t*)(ws + WS_DIK))
#define FFW ((float*)(ws + WS_FFW))
#define GATES ((bf16_t*)(ws + WS_GATES))
#define C2F ((float*)(ws + WS_C2F))
#define DKV ((bf16_t*)(ws + WS_DKV))
#define SC ((float*)(ws + WS_SC))
#define MASK ((unsigned*)(ws + WS_MASK))
#define YATT ((bf16_t*)(ws + WS_YATT))
#define MB ((bf16_t*)(ws + WS_M))
#define HID ((bf16_t*)(ws + WS_HID))
#define XG ((bf16_t*)(ws + WS_XG))
#define XB8 ((unsigned char*)(ws + WS_XB8))
#define WING8 ((unsigned char*)(ws + WS_WING8))
#define HIDM ((bf16_t*)(ws + WS_HIDM))
#define Y ((bf16_t*)(ws + WS_Y))
#define YP ((bf16_t*)(ws + WS_Y + (size_t)2 * NTOK * DM * 2))
#define POSR ((int*)(ws + WS_Y + (size_t)2 * NTOK * DM * 2 + (size_t)4 * 2048 * DM * 2))
#define ROWTOK ((int*)(ws + WS_ROWTOK))
#define ROWW ((float*)(ws + WS_ROWW))
#define RSTDG ((float*)(ws + WS_RSTDG))
#define TOKINFO ((int*)(ws + WS_TOKINFO))
#define TOKW ((float*)(ws + WS_TOKW))
#define WGCNT ((int*)(ws + WS_WGCNT))
#define META ((int*)(ws + WS_META))


struct Bg { unsigned char* ws; LAS float* scr; int l, gw, next, end, inflight; float tv[32]; f32x4 g0, g1; };
struct BgJob { int map, K, Ns, dstN, it; const float* W0; const float* W1; bf16_t* WT; const float* gain; float f8s; };
__device__ __forceinline__ BgJob bg_job(const Bg& B, int slot) {
    unsigned char* ws = B.ws; BgJob J; J.map = 0; J.K = DM; J.Ns = DM; J.dstN = DM; J.W0 = nullptr; J.W1 = nullptr; J.WT = nullptr; J.gain = nullptr; J.f8s = 0.f; int q = 0, es = -1, e = 0;
    if (B.l == 1) { e = 3 + slot / 11; es = slot - (slot / 11) * 11; }
    else if (slot >= 22) { e = (slot - 22) / 11; es = (slot - 22) - e * 11; }
    else if (slot < 7) { J.map = 2; J.W0 = w_fg; J.W1 = w_fu; J.K = DM; J.Ns = DFF; J.dstN = 2 * DFF; J.WT = WGU0; J.gain = norm_ffn; q = slot; }
    else if (slot < 11) { J.W0 = w_fd; J.K = DFF; J.Ns = DM; J.dstN = DM; J.WT = WD0; J.f8s = WD8SCALE; q = slot - 7; }
    else if (slot < 14) { J.map = 1; J.W0 = w_in + (size_t)DM * NIN; J.K = DM; J.Ns = NIN; J.dstN = 19 * 256; J.WT = WIN + (size_t)NINP * DM; J.gain = norm_mix + DM; q = slot - 11; }
    else if (slot < 17) { J.W0 = w_in + (size_t)DM * NIN + 4684; J.K = DM; J.Ns = NIN; J.dstN = 6144; J.WT = (bf16_t*)(WING8 + (size_t)6144 * DM); J.gain = norm_mix + DM; J.f8s = W8SCALE; q = slot - 14; }
    else if (slot == 17) { J.W0 = w_ukv + (size_t)KVR * 1024; J.K = KVR; J.Ns = 1024; J.dstN = 1024; J.WT = WUKV + (size_t)1024 * KVR; J.gain = kv_norm + KVR; }
    else if (slot < 21) { const int i = slot - 18; J.W0 = (i == 0 ? w_br0 : (i == 1 ? w_br1 : w_br2)) + (size_t)WBR_W * DM; J.K = WBR_W; J.Ns = DM; J.dstN = DM; J.WT = WBR + (size_t)(3 + i) * DM * WBR_W; }
    else { J.W0 = w_out + (size_t)DM * DM; J.K = DM; J.Ns = DM; J.dstN = DM; J.WT = WOUT + (size_t)DM * DM; }
    if (es >= 0) {
        if (es < 7) { J.map = 2; J.W0 = w_mg + (size_t)e * DM * DFF; J.W1 = w_mu + (size_t)e * DM * DFF; J.K = DM; J.Ns = DFF; J.dstN = 2 * DFF; J.WT = (bf16_t*)((unsigned char*)WGUM + (size_t)e * 2 * DFF * DM); J.gain = norm_ffn + DM; J.f8s = W8SCALE; q = es; }
        else { J.W0 = w_md + (size_t)e * DFF * DM; J.K = DFF; J.Ns = DM; J.dstN = DM; J.WT = (bf16_t*)((unsigned char*)WDM + (size_t)e * DM * DFF); J.f8s = WD8SCALE; q = es - 7; } }
    J.it = B.gw + q * 2048; return J;
}
__device__ __forceinline__ void bg_src(const BgJob& J, int lane, const char*& ub, unsigned& loff, int& sc, int& k0, int& n0) {
    const int nblk = J.dstN >> 5, kb = J.it / nblk, nb = J.it - kb * nblk; k0 = kb << 6; n0 = nb << 5; const float* src = J.W0; int scu;
    if (J.map == 0) { scu = n0; sc = n0 + (lane & 31); }
    else if (J.map == 1) { scu = 0; sc = win_src(n0 + (lane & 31)); }
    else { const int t = nb >> 3, r = nb & 7; src = (r < 4) ? J.W0 : J.W1; scu = 128 * t + 32 * (r & 3); sc = scu + (lane & 31); }
    ub = (const char*)(src + (size_t)k0 * J.Ns + scu); loff = (unsigned)(((lane >> 5) * J.Ns + ((sc < 0 ? 0 : sc) - scu)) * 4);
}
__device__ __forceinline__ bool bg_issue(Bg& B, int slot, bool want, int lane) {
    const BgJob J = bg_job(B, slot); const bool valid = want && J.it < (J.K >> 6) * (J.dstN >> 5);
    const char* ub; unsigned loff; int sc, k0, n0; bg_src(J, lane, ub, loff, sc, k0, n0); size_t rs2 = (size_t)J.Ns * 8;
    if (!valid) { ub = (const char*)norm_ffn; loff = (unsigned)(lane * 4); rs2 = 256; }
    B.g0 = (f32x4){1.f, 1.f, 1.f, 1.f}; B.g1 = B.g0; if (valid && J.gain) { B.g0 = *(const f32x4*)(J.gain + k0 + 8 * (lane & 7)); B.g1 = *(const f32x4*)(J.gain + k0 + 8 * (lane & 7) + 4); }
#pragma unroll
    for (int i = 0; i < 32; ++i) B.tv[i] = __builtin_nontemporal_load((const float*)(ub + (size_t)i * rs2 + loff));
    return valid;
}
__device__ __forceinline__ void bg_finish(Bg& B, int slot, int lane) {
    const BgJob J = bg_job(B, slot); const char* ub; unsigned loff; int sc, k0, n0; bg_src(J, lane, ub, loff, sc, k0, n0); LAS float* scr = B.scr; const int K = J.K;
#pragma unroll
    for (int i = 0; i < 32; ++i) scr[(2 * i + (lane >> 5)) * 33 + (lane & 31)] = (sc < 0) ? 0.f : B.tv[i];
    LDS_WAIT(); asm volatile("" ::: "memory");
    const int c = lane & 7; const float f8scale = J.f8s;
    const f32x4 g0 = B.g0, g1 = B.g1;
#pragma unroll
    for (int j = 0; j < 4; ++j) { const int n = (lane >> 3) + 8 * j; const LAS float* s = scr + (8 * c) * 33 + n;
        if (f8scale != 0.f) { const float e[8] = {s[0 * 33] * g0[0] * f8scale, s[1 * 33] * g0[1] * f8scale, s[2 * 33] * g0[2] * f8scale, s[3 * 33] * g0[3] * f8scale, s[4 * 33] * g1[0] * f8scale, s[5 * 33] * g1[1] * f8scale, s[6 * 33] * g1[2] * f8scale, s[7 * 33] * g1[3] * f8scale};
            __builtin_nontemporal_store(pack8_fp8(e), (u32x2*)((unsigned char*)J.WT + (size_t)(n0 + n) * K + k0 + 8 * c)); }
        else { u32x4 o; o.x = pk2(s[0 * 33] * g0[0], s[1 * 33] * g0[1]); o.y = pk2(s[2 * 33] * g0[2], s[3 * 33] * g0[3]); o.z = pk2(s[4 * 33] * g1[0], s[5 * 33] * g1[1]); o.w = pk2(s[6 * 33] * g1[2], s[7 * 33] * g1[3]);
            __builtin_nontemporal_store(o, (u32x4*)(J.WT + (size_t)(n0 + n) * K + k0 + 8 * c)); } }
    LDS_WAIT(); asm volatile("" ::: "memory");
}
__device__ __forceinline__ void bg_tick(Bg& B, int lane) {
    if (B.inflight >= 0) { bg_finish(B, B.inflight, lane); B.inflight = -1; }
    const bool want = B.next < B.end; const int slot = want ? B.next : B.end - 1;
    if (bg_issue(B, slot, want, lane)) B.inflight = slot;
    if (want) ++B.next;
}

template <int NJ> __device__ __forceinline__ void select_core(const float* sc_row, unsigned* mask_row, int t, int lane, LAS unsigned* hist, Bg& B) {
    unsigned key[NJ];
#pragma unroll
    for (int j = 0; j < NJ; ++j) { const int s = 64 * j + lane; const unsigned u = __float_as_uint(sc_row[s <= t ? s : t]); const unsigned k = (u & 0x80000000u) ? ~u : (u | 0x80000000u); key[j] = (s <= t) ? k : 0u; }
    unsigned prefix = 0u; int need = 256;
#pragma unroll
    for (int lv = 0; lv < 4; ++lv) { const int shift = 24 - 8 * lv; const unsigned pmask = (lv == 0) ? 0u : (0xffffffffu << (shift + 8));
        { unsigned zz = 0u; asm volatile("" : "+v"(zz)); *(LAS u32x4*)(hist + 4 * lane) = (u32x4){zz, zz, zz, zz}; }
#pragma unroll
        for (int j = 0; j < NJ; ++j) if (key[j] != 0u && (key[j] & pmask) == prefix) atomicAdd((unsigned*)(hist + ((key[j] >> shift) & 255u)), 1u);
        const u32x4 hv = *(const LAS u32x4*)(hist + 4 * lane);
        const int mys = (int)(hv.x + hv.y + hv.z + hv.w); int inc = mys;
#pragma unroll
        for (int o = 1; o < 64; o <<= 1) { const int tv = __shfl_down(inc, o); if (lane + o < 64) inc += tv; }
        const int c3 = inc - mys, c2 = c3 + (int)hv.w, c1 = c2 + (int)hv.z, c0 = c1 + (int)hv.y;
        int fd = -1, fc = 0;
        if (c3 < need && need <= c3 + (int)hv.w) { fd = 3; fc = c3; } else if (c2 < need && need <= c2 + (int)hv.z) { fd = 2; fc = c2; }
        else if (c1 < need && need <= c1 + (int)hv.y) { fd = 1; fc = c1; } else if (c0 < need && need <= c0 + (int)hv.x) { fd = 0; fc = c0; }
        const unsigned long long fb = __ballot(fd >= 0); const int src = (int)__builtin_ctzll(fb | (1ull << 63));
        const int D = __shfl(4 * lane + fd, src), CA = __shfl(fc, src);
        prefix |= (unsigned)D << shift; need -= CA;
        bg_tick(B, lane);
    }
    const unsigned T = prefix;
    int run = 0; unsigned myw = 0u;
#pragma unroll
    for (int j = 0; j < NJ; ++j) { const bool eq = key[j] == T; const unsigned long long beq = __ballot(eq);
        const int pre = run + (int)__builtin_amdgcn_mbcnt_hi((unsigned)(beq >> 32), __builtin_amdgcn_mbcnt_lo((unsigned)beq, 0u));
        const bool sel = (key[j] > T) || (eq && pre < need); run += __popcll(beq);
        const unsigned long long bs = __ballot(sel); myw = (lane == 2 * j) ? (unsigned)bs : myw; myw = (lane == 2 * j + 1) ? (unsigned)(bs >> 32) : myw; }
    mask_row[lane] = myw;
    bg_tick(B, lane);
}
__device__ __forceinline__ void select_row(const float* sc_row, unsigned* mask_row, int t, int lane, LAS unsigned* hist, Bg& B) {
    asm volatile("" : "+v"(lane));
    if (t < 256) { const int lo = 32 * lane; mask_row[lane] = (t >= lo + 31) ? 0xffffffffu : (t < lo ? 0u : ((2u << (t - lo)) - 1u)); return; }
    if (t < 512) select_core<8>(sc_row, mask_row, t, lane, hist, B);
    else if (t < 1024) select_core<16>(sc_row, mask_row, t, lane, hist, B);
    else if (t < 1536) select_core<24>(sc_row, mask_row, t, lane, hist, B);
    else select_core<32>(sc_row, mask_row, t, lane, hist, B);
}

__global__ void __launch_bounds__(512, 2) mk_fwd(Args args) {
    extern __shared__ __attribute__((aligned(16))) unsigned char lds_raw[];
    LAS unsigned char* lds = (LAS unsigned char*)lds_raw;
    volatile LAS unsigned* MISC = (volatile LAS unsigned*)(lds + MISC_OFF);
    constexpr int G = 256, NGW = G * 8;
    const int bid = blockIdx.x; __builtin_assume(bid >= 0 && bid < G);
    unsigned* ctl = (unsigned*)((unsigned char*)arg_ptr(23) + WS_CTL);
    for (int u = threadIdx.x; u < (LDS_BYTES - LDSCTL_OFF) / 4; u += 512) ((LAS unsigned*)(lds + LDSCTL_OFF))[u] = 0u;
#define SITE_PROLOG unsigned char* ws = (unsigned char*)arg_ptr(23); int tid = threadIdx.x; asm volatile("" : "+v"(tid)); \
    const int lane = tid & 63, wave = __builtin_amdgcn_readfirstlane(tid >> 6), gw = bid * 8 + wave; (void)ws; (void)lane; (void)gw;
    __syncthreads();
#if MK_ONE_LAUNCH && DBG_STOP < 0
    constexpr int lo = 0, hi = NSTEPS;
#else
    const int lo = args.ph_lo, hi = args.ph_hi;
#endif
    XcdBarrier bar; bar.bar = ctl + CW_BAR; bar.x = 0; bar.st = nullptr;
    if (hi - lo > 1) bar = xcd_barrier_post(ctl + CW_BAR, MISC + 8);
    int step = 0;
#define STEP_IF if (step >= lo && step < hi)
#ifndef PROBE_AMP
#define PROBE_AMP 1ull
#endif
#ifdef PROBE_MASK
    unsigned long long pr_prev = wall_clock64(), pr_acc = 0ull;
#define STEP_END do { if (step >= lo && step + 1 < hi) xcd_barrier(bar); { const unsigned long long pr_t = wall_clock64(); if ((PROBE_MASK >> step) & 1u) pr_acc += pr_t - pr_prev; pr_prev = pr_t; } ++step; } while (0)
#else
#define STEP_END do { if (step >= lo && step + 1 < hi) xcd_barrier(bar); ++step; } while (0)
#endif

    if (SITE_ON(0)) STEP_IF { SITE_PROLOG
        LAS float* scr = (LAS float*)(lds + wave * 16384);
        { const int l = 0;
            conv_matrix(1, w_in + (size_t)l * DM * NIN, nullptr, DM, NIN, 19 * 256, WIN + (size_t)l * NINP * DM, norm_mix + l * DM, scr, gw, NGW, lane);
            conv_matrix(0, w_in + (size_t)l * DM * NIN + 4684, nullptr, DM, NIN, 6144, (bf16_t*)(WING8 + (size_t)l * 6144 * DM), norm_mix + l * DM, scr, gw, NGW, lane, W8SCALE);
            conv_matrix(0, w_ukv + (size_t)l * KVR * 1024, nullptr, KVR, 1024, 1024, WUKV + (size_t)l * 1024 * KVR, kv_norm + l * KVR, scr, gw, NGW, lane);
            conv_matrix(0, w_br0 + (size_t)l * WBR_W * DM, nullptr, WBR_W, DM, DM, WBR + (size_t)(l * 3 + 0) * DM * WBR_W, nullptr, scr, gw, NGW, lane);
            conv_matrix(0, w_br1 + (size_t)l * WBR_W * DM, nullptr, WBR_W, DM, DM, WBR + (size_t)(l * 3 + 1) * DM * WBR_W, nullptr, scr, gw, NGW, lane);
            conv_matrix(0, w_br2 + (size_t)l * WBR_W * DM, nullptr, WBR_W, DM, DM, WBR + (size_t)(l * 3 + 2) * DM * WBR_W, nullptr, scr, gw, NGW, lane);
            conv_matrix(0, w_out + (size_t)l * DM * DM, nullptr, DM, DM, DM, WOUT + (size_t)l * DM * DM, nullptr, scr, gw, NGW, lane);
        }
        for (int m = gw; m < NTOK; m += NGW) {
            const f32x4* xr = (const f32x4*)(x_in + (size_t)m * DM) + lane; f32x4 v[8]; float s = 0.f;
#pragma unroll
            for (int j = 0; j < 8; ++j) { v[j] = xr[64 * j]; s += (v[j][0] * v[j][0] + v[j][1] * v[j][1]) + (v[j][2] * v[j][2] + v[j][3] * v[j][3]); }
            s = wave_sum(s);
            u32x2* o = (u32x2*)(XB + (size_t)m * DM) + lane;
#pragma unroll
            for (int j = 0; j < 8; ++j) { u32x2 w; w.x = pk2(v[j][0], v[j][1]); w.y = pk2(v[j][2], v[j][3]); o[64 * j] = w; }
            { unsigned* o8 = (unsigned*)(XB8 + (size_t)m * DM) + lane;
#pragma unroll
              for (int j = 0; j < 8; ++j) { const float c0 = __builtin_amdgcn_fmed3f(v[j][0], -448.f, 448.f), c1 = __builtin_amdgcn_fmed3f(v[j][1], -448.f, 448.f), c2 = __builtin_amdgcn_fmed3f(v[j][2], -448.f, 448.f), c3 = __builtin_amdgcn_fmed3f(v[j][3], -448.f, 448.f);
                  int w = __builtin_amdgcn_cvt_pk_fp8_f32(c0, c1, 0, false); w = __builtin_amdgcn_cvt_pk_fp8_f32(c2, c3, w, true); o8[64 * j] = (unsigned)w; } }
            if (lane == 0) RSTD[m] = 1.0f / sqrtf(s * (1.0f / DM) + EPS);
        }
    }
    STEP_END;

    for (int l = 0; l < 2; ++l) {
        if (SITE_ON(1)) STEP_IF { SITE_PROLOG
            { pg8::PlainOrder S; S.init(NTOK / 256, 19, G, bid); S.A = (const char*)XB; S.ta = (size_t)256 * DM * 2; S.B = (const char*)(WIN + (size_t)l * NINP * DM); S.tb = (size_t)256 * DM * 2;
              EpiWin E{RSTD, Z8, DLAT, DIQ, DIK, FFW, GATES};
              pg8::gemm_phase<EpiWin, pg8::PlainOrder, true, true>(lds, pg8::Gemm{opq(DM), 0}, S, E); }
            { pg8::PlainOrder S; S.init(NTOK / 256, 24, G, bid); S.A = (const char*)XB8; S.ta = (size_t)256 * DM; S.B = (const char*)(WING8 + (size_t)l * 6144 * DM); S.tb = (size_t)256 * DM;
              EpiGate E{RSTD, GATES, 1.0f / W8SCALE};
              pg8::gemm_phase8<EpiGate, pg8::PlainOrder, true, true>(lds, pg8::Gemm{opq(DM / 2), 0}, S, E); }
        }
        STEP_END;
        if (SITE_ON(2)) STEP_IF { SITE_PROLOG
            {
                const float* gq = q_norm + l * HD + 8 * (lane & 7); const float* gk = k_norm + l * HD + 8 * (lane & 7);
                const f32x4 gq0 = *(const f32x4*)gq, gq1 = *(const f32x4*)(gq + 4), gk0 = *(const f32x4*)gk, gk1 = *(const f32x4*)(gk + 4);
                auto headnorm = [&](const u32x4 w, const f32x4 g0, const f32x4 g1, const float mul) -> u32x4 {
                    float v[8] = {bflo(w.x), bfhi(w.x), bflo(w.y), bfhi(w.y), bflo(w.z), bfhi(w.z), bflo(w.w), bfhi(w.w)}; float ss = 0.f;
#pragma unroll
                    for (int i = 0; i < 8; ++i) ss += v[i] * v[i];
                    ss += __shfl_xor(ss, 1); ss += __shfl_xor(ss, 2); ss += __shfl_xor(ss, 4);
                    const float rs = (1.0f / sqrtf(ss * (1.0f / 64.0f) + EPS)) * mul;
                    u32x4 o; o.x = pk2(v[0] * rs * g0[0], v[1] * rs * g0[1]); o.y = pk2(v[2] * rs * g0[2], v[3] * rs * g0[3]); o.z = pk2(v[4] * rs * g1[0], v[5] * rs * g1[1]); o.w = pk2(v[6] * rs * g1[2], v[7] * rs * g1[3]);
                    return o; };
#pragma unroll 1
                for (int mb = 0; mb < 8; mb += 4) { u32x4 wq[4], wk[4]; u32x2 wl[4];
#pragma unroll
                    for (int r = 0; r < 4; ++r) { const size_t m = (size_t)gw + (size_t)(mb + r) * NGW;
                        wq[r] = *(const u32x4*)(Z8 + m * 512 + 8 * lane); wk[r] = *(const u32x4*)(Z8 + (size_t)NTOK * 512 + m * 512 + 8 * lane); wl[r] = *(const u32x2*)(DLAT + m * 256 + 4 * lane); }
#pragma unroll
                    for (int r = 0; r < 4; ++r) { const size_t m = (size_t)gw + (size_t)(mb + r) * NGW;
                        const u32x4 oq = headnorm(wq[r], gq0, gq1, C2), ok = headnorm(wk[r], gk0, gk1, 1.0f);
                        const float a0 = bflo(wl[r].x), a1 = bfhi(wl[r].x), a2 = bflo(wl[r].y), a3 = bfhi(wl[r].y);
                        const float ss = wave_sum((a0 * a0 + a1 * a1) + (a2 * a2 + a3 * a3)); const float rs = 1.0f / sqrtf(ss * (1.0f / 256.0f) + EPS);
                        u32x2 ol; ol.x = pk2(a0 * rs, a1 * rs); ol.y = pk2(a2 * rs, a3 * rs);
                        *(u32x4*)(Z8 + m * 512 + 8 * lane) = oq; *(u32x4*)(Z8 + (size_t)NTOK * 512 + m * 512 + 8 * lane) = ok; *(u32x2*)(DLAT + m * 256 + 4 * lane) = ol; }
                }
            }
            if (bid < NBATCH * NHEAD) {
                const int b = bid >> 3, h = bid & 7; const float bias = b_forget[l * NHEAD + h]; LAS float* wt = (LAS float*)lds;
                const float* fp = FFW + ((size_t)b * SEQ + 4 * tid) * 16 + h; float v[4]; float tot = 0.f;
#pragma unroll
                for (int i = 0; i < 4; ++i) { tot += -softplus2(-(fp[i * 16] + bias) * LOG2E); v[i] = tot; }
                float inc = tot;
#pragma unroll
                for (int o = 1; o < 64; o <<= 1) { const float tv = __shfl_up(inc, o); if (lane >= o) inc += tv; }
                __syncthreads(); if (lane == 63) wt[wave] = inc; __syncthreads();
                float base = inc - tot;
                for (int w = 0; w < wave; ++w) base += wt[w];
                *(f32x4*)(C2F + ((size_t)b * NHEAD + h) * SEQ + 4 * tid) = (f32x4){-(base + v[0]), -(base + v[1]), -(base + v[2]), -(base + v[3])};
            }
            {
                const int id = bid * 8 + wave, b = id >> 8, rr = id & 255;
                int g, base; if (rr < 10) { g = 0; base = 0; } else if (rr < 30) { g = 1; base = 10; } else if (rr < 60) { g = 2; base = 30; } else if (rr < 100) { g = 3; base = 60; } else if (rr < 150) { g = 4; base = 100; } else if (rr < 210) { g = 5; base = 150; } else { g = 6; base = 210; }
                const int off = rr - base, tt = 10 * g + off / (g + 1), cch = off - (off / (g + 1)) * (g + 1);
                if (rr < 238) {
                int ln = lane; asm volatile("" : "+v"(ln)); const int r32 = ln & 31, hh = ln >> 5; const size_t trow = (size_t)b * SEQ + tt * 32 + r32;
                bf16x8 bq[4][4];
#pragma unroll
                for (int h = 0; h < 4; ++h)
#pragma unroll
                    for (int d0 = 0; d0 < 4; ++d0) bq[h][d0] = *(const bf16x8*)(DIQ + trow * 256 + h * 64 + d0 * 16 + 8 * hh);
                const f32x4 wv = *(const f32x4*)(FFW + trow * 16 + 8) * 0.0625f;
                const int st0 = cch * 10, st1 = (st0 + 9 < tt) ? st0 + 9 : tt;
                bf16x8 ak[4], an[4];
                { const size_t srow = (size_t)b * SEQ + st0 * 32 + r32;
#pragma unroll
                  for (int d0 = 0; d0 < 4; ++d0) an[d0] = *(const bf16x8*)(DIK + srow * 64 + d0 * 16 + 8 * hh); }
                for (int st = st0; st <= st1; ++st) {
#pragma unroll
                    for (int d0 = 0; d0 < 4; ++d0) ak[d0] = an[d0];
                    { const int sn = (st < st1) ? st + 1 : st; const size_t srow = (size_t)b * SEQ + sn * 32 + r32;
#pragma unroll
                      for (int d0 = 0; d0 < 4; ++d0) an[d0] = *(const bf16x8*)(DIK + srow * 64 + d0 * 16 + 8 * hh); }
                    f32x16 sc;
#pragma unroll
                    for (int r = 0; r < 16; ++r) sc[r] = 0.f;
#pragma unroll
                    for (int h = 0; h < 4; ++h) { f32x16 a;
#pragma unroll
                        for (int r = 0; r < 16; ++r) a[r] = 0.f;
#pragma unroll
                        for (int d0 = 0; d0 < 4; ++d0) a = __builtin_amdgcn_mfma_f32_32x32x16_bf16(ak[d0], bq[h][d0], a, 0, 0, 0);
#pragma unroll
                        for (int r = 0; r < 16; ++r) sc[r] += fmaxf(a[r], 0.f) * wv[h]; }
                    float* sp = SC + trow * SEQ + st * 32 + 4 * hh;
#pragma unroll
                    for (int g = 0; g < 4; ++g) *(f32x4*)(sp + 8 * g) = (f32x4){sc[4 * g], sc[4 * g + 1], sc[4 * g + 2], sc[4 * g + 3]};
                }
                }
            }
        }
        STEP_END;
        if (SITE_ON(3)) STEP_IF { SITE_PROLOG
            { pg8::PlainOrder S; S.init(NTOK / 256, 4, G, bid); S.A = (const char*)DLAT; S.ta = (size_t)256 * KVR * 2; S.B = (const char*)(WUKV + (size_t)l * 1024 * KVR); S.tb = (size_t)256 * KVR * 2;
              EpiPlain E{DKV, 1024};
              pg8::gemm_phase<EpiPlain, pg8::PlainOrder, true, true>(lds, pg8::Gemm{opq(KVR), 0}, S, E); }
        }
        STEP_END;
        if (SITE_ON(4)) STEP_IF { SITE_PROLOG
            Bg B; B.ws = ws; B.scr = (LAS float*)(lds + 16384 + wave * 8704); B.l = l; B.gw = gw; B.next = 0; B.end = 55; B.inflight = -1; B.g0 = (f32x4){1.f, 1.f, 1.f, 1.f}; B.g1 = B.g0;
#pragma unroll
            for (int i = 0; i < 32; ++i) B.tv[i] = 0.f;
            for (int k = 0; k < 8; ++k) { const int idx = gw + k * NGW; const int b = idx / SEQ, t0 = idx - b * SEQ, t = (b & 1) ? SEQ - 1 - t0 : t0; const size_t row = (size_t)b * SEQ + t;
                select_row(SC + row * SEQ, MASK + row * 64, t, lane, (LAS unsigned*)(lds + wave * 1024), B);
                const int upto = ((k + 1) * 55) >> 3;
                while (B.next < upto) bg_tick(B, lane); }
            while (B.inflight >= 0 || B.next < B.end) bg_tick(B, lane);
        }
        STEP_END;
        if (SITE_ON(5)) STEP_IF { SITE_PROLOG
            const int xq = bid & 7; unsigned* qctr = ctl + CW_ATTQ + (l * 8 + xq) * 32;
            unsigned ticket = 0u; if (tid == 0) ticket = __hip_atomic_fetch_add(qctr, 1u, __ATOMIC_RELAXED, __HIP_MEMORY_SCOPE_AGENT);
            if (tid == 0) MISC[65] = ticket;
            __syncthreads();
            unsigned u = MISC[65];
#define ATT_DECODE(uu, var, qb, hh) int var, qb, hh; if ((uu) < 64u) { var = 1; qb = 7 - (int)((uu) >> 3); hh = (int)((uu) & 7u); } else { const unsigned v_ = (uu) - 64u; qb = 7 - (int)(v_ >> 4); var = (v_ & 1u) ? 2 : 0; hh = (int)((v_ >> 1) & 7u); }
#define ATT_BEGIN(var, b, hh, qb) do { if (var == 0) att::attn_begin(lds, 0, b, hh, qb, Z8 + (size_t)1 * NTOK * 512, 512, Z8 + (size_t)2 * NTOK * 512, 512, C2F, nullptr); \
                else if (var == 1) att::attn_begin(lds, 1, b, hh, qb, Z8 + (size_t)5 * NTOK * 512, 512, Z8 + (size_t)6 * NTOK * 512, 512, nullptr, nullptr); \
                else att::attn_begin(lds, 2, b, hh, qb, DKV, 1024, DKV + 512, 1024, nullptr, MASK); } while (0)
            const int b = xq;
            if (u < 192u) { ATT_DECODE(u, var0, qb0, h0) ATT_BEGIN(var0, b, h0, qb0); }
            while (u < 192u) {
                ATT_DECODE(u, var, qb, h)
                if (tid == 0) ticket = __hip_atomic_fetch_add(qctr, 1u, __ATOMIC_RELAXED, __HIP_MEMORY_SCOPE_AGENT);
                unsigned unext = 192u;
                auto next = [&]() { unext = MISC[65]; if (unext < 192u) { ATT_DECODE(unext, varn, qbn, hn) ATT_BEGIN(varn, b, hn, qbn); } };
#ifdef ATT_PROBE_VAR
                const unsigned long long pa_t0 = wall_clock64();
#endif
                if (var == 0) att::attn_unit<0>(lds, ticket, next, b, h, qb, Z8, Z8 + (size_t)1 * NTOK * 512, 512, Z8 + (size_t)2 * NTOK * 512, 512, C2F, nullptr, nullptr, Z8 + (size_t)3 * NTOK * 512, YATT);
                else if (var == 1) att::attn_unit<1>(lds, ticket, next, b, h, qb, Z8 + (size_t)4 * NTOK * 512, Z8 + (size_t)5 * NTOK * 512, 512, Z8 + (size_t)6 * NTOK * 512, 512, nullptr, nullptr, nullptr, nullptr, YATT + (size_t)NTOK * 512);
                else att::attn_unit<2>(lds, ticket, next, b, h, qb, Z8 + (size_t)7 * NTOK * 512, DKV, 1024, DKV + 512, 1024, nullptr, MASK, rel_bias, nullptr, YATT + (size_t)2 * NTOK * 512);
#ifdef ATT_PROBE_VAR
                if (var == ATT_PROBE_VAR) pr_acc += wall_clock64() - pa_t0;
#endif
                u = unext;
            }
#undef ATT_DECODE
#undef ATT_BEGIN
        }
        STEP_END;
        if (SITE_ON(6)) STEP_IF { SITE_PROLOG
            pg8::BranchOrder S; S.init(NTOK / 256, DM / 256, G, bid); S.A = (const char*)YATT; S.ta = (size_t)256 * WBR_W * 2; S.za = (size_t)NTOK * WBR_W * 2;
            S.B = (const char*)(WBR + (size_t)l * 3 * DM * WBR_W); S.tb = (size_t)256 * WBR_W * 2; S.zb = (size_t)DM * WBR_W * 2;
            EpiBranch E{GATES, MB};
            pg8::gemm_phase_carry<EpiBranch, pg8::BranchOrder, true, true>(lds, pg8::Gemm{opq(WBR_W), 0}, S, E);
        }
        STEP_END;
        if (SITE_ON(7)) STEP_IF { SITE_PROLOG
            pg8::PlainOrder S; S.init(NTOK / 256, DM / 256, G, bid); S.A = (const char*)MB; S.ta = (size_t)256 * DM * 2; S.B = (const char*)(WOUT + (size_t)l * DM * DM); S.tb = (size_t)256 * DM * 2;
            EpiResid E{l == 0 ? x_in : (const float*)X, X, l == 0 ? XB : nullptr, SSP, l == 0 ? nullptr : XB8, 1.0f};
            pg8::gemm_phase<EpiResid, pg8::PlainOrder, true, true>(lds, pg8::Gemm{opq(DM), 0}, S, E);
        }
        STEP_END;
        if (l == 0) {
            if (SITE_ON(8)) STEP_IF { SITE_PROLOG for (int r = bid * 512 + tid; r < NTOK; r += G * 512) { const f32x4* p = (const f32x4*)(SSP + (size_t)r * 32); float s = 0.f;
#pragma unroll
                    for (int j = 0; j < 8; ++j) { const f32x4 v = p[j]; s += (v[0] + v[1]) + (v[2] + v[3]); }
                    RSTD[r] = 1.0f / sqrtf(s * (1.0f / DM) + EPS); } }
            STEP_END;
            if (SITE_ON(9)) STEP_IF { SITE_PROLOG
                pg8::PlainOrder S; S.init(NTOK / 256, DFF / 128, G, bid); S.A = (const char*)XB; S.ta = (size_t)256 * DM * 2; S.B = (const char*)WGU0; S.tb = (size_t)256 * DM * 2;
                EpiSwiglu E{RSTD, HID, 1.0f, 1};
                pg8::gemm_phase<EpiSwiglu, pg8::PlainOrder, true, true>(lds, pg8::Gemm{opq(DM), 0}, S, E);
            }
            STEP_END;
            if (SITE_ON(10)) STEP_IF { SITE_PROLOG
                pg8::PlainOrder S; S.init(NTOK / 256, DM / 256, G, bid); S.A = (const char*)HID; S.ta = (size_t)256 * DFF; S.B = (const char*)WD0; S.tb = (size_t)256 * DFF;
                EpiResid E{X, X, XB, SSP, XB8, 1.0f / (WD8SCALE * H8SCALE)};
                pg8::gemm_phase8<EpiResid, pg8::PlainOrder, true, true>(lds, pg8::Gemm{opq(DFF / 2), 0}, S, E);
            }
            STEP_END;
            if (SITE_ON(11)) STEP_IF { SITE_PROLOG for (int r = bid * 512 + tid; r < NTOK; r += G * 512) { const f32x4* p = (const f32x4*)(SSP + (size_t)r * 32); float s = 0.f;
#pragma unroll
                    for (int j = 0; j < 8; ++j) { const f32x4 v = p[j]; s += (v[0] + v[1]) + (v[2] + v[3]); }
                    RSTD[r] = 1.0f / sqrtf(s * (1.0f / DM) + EPS); } }
            STEP_END;
        } else {
            if (SITE_ON(12)) STEP_IF { SITE_PROLOG
                LAS int* le = (LAS int*)lds;
                for (int wgi = bid; wgi < NTOK / 64; wgi += G) {
                    __syncthreads();
                    {
                        const int tok = wgi * 64 + lane; const float* xr = X + (size_t)tok * DM + 256 * wave;
                        const float* gp = norm_ffn + DM + 256 * wave; const float* wp = w_router + (size_t)(256 * wave) * 8;
                        float lg[8]; float ss = 0.f;
#pragma unroll
                        for (int e = 0; e < 8; ++e) lg[e] = 0.f;
#pragma unroll 1
                        for (int k8 = 0; k8 < 8; ++k8) { f32x4 xv[8];
#pragma unroll
                            for (int j = 0; j < 8; ++j) xv[j] = *(const f32x4*)(xr + 32 * k8 + 4 * j);
#pragma unroll
                            for (int j = 0; j < 8; ++j)
#pragma unroll
                                for (int c = 0; c < 4; ++c) { const int k = 32 * k8 + 4 * j + c; const float xv1 = xv[j][c]; ss += xv1 * xv1; const float xg = xv1 * gp[k]; const float* wr = wp + k * 8;
#pragma unroll
                                    for (int e = 0; e < 8; ++e) lg[e] += xg * wr[e]; } }
                        LAS float* part = (LAS float*)(lds + 1024) + (wave * 64 + lane) * 9;
#pragma unroll
                        for (int e = 0; e < 8; ++e) part[e] = lg[e];
                        part[8] = ss;
                        __syncthreads();
                        if (wave == 0) { float L[8]; float S = 0.f;
#pragma unroll
                            for (int e = 0; e < 8; ++e) L[e] = 0.f;
                            for (int w = 0; w < 8; ++w) { const LAS float* pp = (const LAS float*)(lds + 1024) + (w * 64 + lane) * 9;
#pragma unroll
                                for (int e = 0; e < 8; ++e) L[e] += pp[e];
                                S += pp[8]; }
                            const float rs = 1.0f / sqrtf(S * (1.0f / DM) + EPS);
#pragma unroll
                            for (int e = 0; e < 8; ++e) L[e] *= rs;
                            float v0 = L[0]; int i0 = 0;
#pragma unroll
                            for (int e = 1; e < 8; ++e) if (L[e] > v0) { v0 = L[e]; i0 = e; }
                            float v1 = -INFINITY; int i1 = 0;
#pragma unroll
                            for (int e = 0; e < 8; ++e) if (e != i0 && L[e] > v1) { v1 = L[e]; i1 = e; }
                            const float ex = __expf(v1 - v0), w0 = 1.0f / (1.0f + ex), w1 = ex / (1.0f + ex);
                            le[lane * 2] = i0; le[lane * 2 + 1] = i1; TOKW[(size_t)tok * 2] = w0; TOKW[(size_t)tok * 2 + 1] = w1; RSTD[tok] = rs; }
                    }
                    __syncthreads();
                    if (tid < 128) { const int e = le[tid]; int rk = 0; for (int j = 0; j < tid; ++j) rk += (le[j] == e); const int tok = wgi * 64 + (tid >> 1);
                        TOKINFO[((size_t)tok * 2 + (tid & 1)) * 2] = e; TOKINFO[((size_t)tok * 2 + (tid & 1)) * 2 + 1] = rk; }
                    if (tid >= 128 && tid < 136) { const int e = tid - 128; int c = 0; for (int j = 0; j < 128; ++j) c += (le[j] == e); WGCNT[wgi * 8 + e] = c; }
                }
            }
            STEP_END;
            if (SITE_ON(13)) STEP_IF { SITE_PROLOG
                LAS int* lc = (LAS int*)lds;
                for (int wgi = bid; wgi < NTOK / 64; wgi += G) {
                    __syncthreads();
                    { const int e = wave; int all = 0, before = 0;
#pragma unroll
                      for (int c = 0; c < 4; ++c) { const int w = 4 * lane + c; const int v = WGCNT[w * 8 + e]; all += v; before += (w < wgi) ? v : 0; }
#pragma unroll
                      for (int o = 1; o < 64; o <<= 1) { all += __shfl_xor(all, o); before += __shfl_xor(before, o); }
                      if (lane == 0) { lc[e] = all; lc[8 + e] = before; } }
                    __syncthreads();
                    if (tid == 0) { int tb = 0; for (int e = 0; e < 8; ++e) { lc[16 + e] = tb * 256; tb += (lc[e] + 255) >> 8; if (wgi == 0) META[e] = lc[16 + e] >> 8; } if (wgi == 0) META[8] = tb; }
                    __syncthreads();
                    for (int hb = 0; hb < 2; ++hb) {
                        int rr[8]; u32x4 d0[8], d1[8];
#pragma unroll
                        for (int i = 0; i < 8; ++i) { const int p = wave * 16 + hb * 8 + i, tok = wgi * 64 + (p >> 1), slot = p & 1;
                            const int e = TOKINFO[((size_t)tok * 2 + slot) * 2], rk = TOKINFO[((size_t)tok * 2 + slot) * 2 + 1]; rr[i] = lc[16 + e] + lc[8 + e] + rk;
                            const u32x4* sp = (const u32x4*)(XB8 + (size_t)tok * DM) + lane; d0[i] = sp[0]; d1[i] = sp[64]; }
#pragma unroll
                        for (int i = 0; i < 8; ++i) { const int p = wave * 16 + hb * 8 + i, tok = wgi * 64 + (p >> 1), slot = p & 1; const int r = rr[i];
                            u32x4* dp = (u32x4*)((unsigned char*)XG + (size_t)r * DM) + lane; dp[0] = d0[i]; dp[64] = d1[i];
                            if (lane == 0) { POSR[tok * 2 + slot] = r; ROWTOK[r] = tok * 2 + slot; ROWW[r] = TOKW[(size_t)tok * 2 + slot]; RSTDG[r] = RSTD[tok]; } }
                    }
                    if (wgi < 8) { const int e = wgi, r0 = lc[16 + e] + lc[e], r1 = lc[16 + e] + (((lc[e] + 255) >> 8) << 8);
                        for (int r = r0 + wave; r < r1; r += 8) { u32x4* dp = (u32x4*)((unsigned char*)XG + (size_t)r * DM) + lane;
#pragma unroll
                            for (int c = 0; c < 2; ++c) dp[64 * c] = (u32x4){0u, 0u, 0u, 0u};
                            if (lane == 0) { ROWTOK[r] = -1; ROWW[r] = 0.f; RSTDG[r] = 0.f; } } }
                }
            }
            STEP_END;
            if (SITE_ON(14)) STEP_IF { SITE_PROLOG
                pg8::MoeOrder S; S.t1 = META[1]; S.t2 = META[2]; S.t3 = META[3]; S.t4 = META[4]; S.t5 = META[5]; S.t6 = META[6]; S.t7 = META[7];
                S.init(META[8], DFF / 128, G, bid); S.A = (const char*)XG; S.ta = (size_t)256 * DM; S.B = (const char*)WGUM; S.tb = (size_t)256 * DM; S.zb = SZ_WGU / 2;
                EpiSwiglu E{RSTDG, HIDM, 1.0f / W8SCALE, 1};
                pg8::gemm_phase8<EpiSwiglu, pg8::MoeOrder, true, true>(lds, pg8::Gemm{opq(DM / 2), 0}, S, E);
            }
            STEP_END;
            if (SITE_ON(15)) STEP_IF { SITE_PROLOG
                pg8::MoeOrder S; S.t1 = META[1]; S.t2 = META[2]; S.t3 = META[3]; S.t4 = META[4]; S.t5 = META[5]; S.t6 = META[6]; S.t7 = META[7];
                const int T = META[8], Tfull = T < 128 ? T : 128;
                S.init(Tfull, DM / 256, G, bid); S.A = (const char*)HIDM; S.ta = (size_t)256 * DFF; S.B = (const char*)WDM; S.tb = (size_t)256 * DFF; S.zb = SZ_WD / 2;
                EpiMoeDown E{ROWTOK, ROWW, Y, 1.0f / (WD8SCALE * H8SCALE)};
                pg8::gemm_phase8<EpiMoeDown, pg8::MoeOrder, true, true>(lds, pg8::Gemm{opq(DFF / 2), 0}, S, E);
                if (T > 128) {
                    pg8::TailOrder S2; S2.ntail = (T - 128) * 32; S2.G = G; S2.c = bid; S2.A = S.A; S2.B = S.B; S2.ta = S.ta; S2.tb = S.tb; S2.zb = S.zb; S2.kq = DFF / 4;
                    S2.t1 = S.t1; S2.t2 = S.t2; S2.t3 = S.t3; S2.t4 = S.t4; S2.t5 = S.t5; S2.t6 = S.t6; S2.t7 = S.t7;
                    EpiMoeTail E2{ROWTOK, ROWW, YP, 1.0f / (WD8SCALE * H8SCALE)};
                    pg8::gemm_phase8<EpiMoeTail, pg8::TailOrder, true, true>(lds, pg8::Gemm{opq(DFF / 8), DFF / 2}, S2, E2); }
            }
            STEP_END;
            if (SITE_ON(16)) STEP_IF { SITE_PROLOG
                f32x4 gfin[8];
#pragma unroll
                for (int j = 0; j < 8; ++j) gfin[j] = *((const f32x4*)norm_final + lane + 64 * j);
                int r0n = POSR[2 * gw], r1n = POSR[2 * gw + 1];
                for (int m = gw; m < NTOK; m += NGW) {
                    f32x4* xr = (f32x4*)(X + (size_t)m * DM) + lane; const u32x2* y0 = (const u32x2*)(Y + (size_t)m * DM) + lane; const u32x2* y1 = (const u32x2*)(Y + (size_t)NTOK * DM + (size_t)m * DM) + lane;
                    f32x4 v[8]; float s = 0.f; const int r0 = r0n, r1 = r1n;
                    { const int mn = (m + NGW < NTOK) ? m + NGW : m; r0n = POSR[2 * mn]; r1n = POSR[2 * mn + 1]; }
                    if (r0 >= 32768 || r1 >= 32768) {
#pragma unroll
                        for (int j = 0; j < 8; ++j) { f32x4 acc4 = xr[64 * j];
#pragma unroll
                            for (int sl = 0; sl < 2; ++sl) { const int r = sl ? r1 : r0;
                                if (r < 32768) { const u32x2 a = (sl ? y1 : y0)[64 * j]; acc4 += (f32x4){bflo(a.x), bfhi(a.x), bflo(a.y), bfhi(a.y)}; }
                                else { for (int q = 0; q < 4; ++q) { const u32x2 a = ((const u32x2*)(YP + ((size_t)q * 2048 + (size_t)(r - 32768)) * DM) + lane)[64 * j]; acc4 += (f32x4){bflo(a.x), bfhi(a.x), bflo(a.y), bfhi(a.y)}; } } }
                            v[j] = acc4; s += (v[j][0] * v[j][0] + v[j][1] * v[j][1]) + (v[j][2] * v[j][2] + v[j][3] * v[j][3]); }
                    } else
#pragma unroll
                    for (int j = 0; j < 8; ++j) { const u32x2 a = y0[64 * j], b = y1[64 * j]; v[j] = xr[64 * j] + (f32x4){bflo(a.x), bfhi(a.x), bflo(a.y), bfhi(a.y)} + (f32x4){bflo(b.x), bfhi(b.x), bflo(b.y), bfhi(b.y)}; s += (v[j][0] * v[j][0] + v[j][1] * v[j][1]) + (v[j][2] * v[j][2] + v[j][3] * v[j][3]); }
                    s = wave_sum(s); const float rs = 1.0f / sqrtf(s * (1.0f / DM) + EPS);
#pragma unroll
                    for (int j = 0; j < 8; ++j) xr[64 * j] = v[j] * rs * gfin[j];
                }
            }
            STEP_END;
        }
    }
#ifdef PROBE_MASK
    if (bid == 0 && threadIdx.x == 0) { const unsigned long long pr_t0 = wall_clock64(); while (wall_clock64() - pr_t0 < pr_acc * PROBE_AMP) __builtin_amdgcn_s_sleep(8); }
#endif
#undef STEP_IF
#undef STEP_END
}


#if DBG_STOP >= 0
__global__ void dbg_dump(const unsigned short* ws16, size_t n16, const unsigned* xin, float* out, int with_x) {
    for (size_t i = (size_t)blockIdx.x * blockDim.x + threadIdx.x; i < (size_t)NTOK * DM; i += (size_t)gridDim.x * blockDim.x) {
        unsigned acc = 0; for (size_t off = i; off < n16; off += (size_t)NTOK * DM) acc += ws16[off];
        if (with_x) { const unsigned u = xin[i]; acc += (u & 0xffffu) + (u >> 16); }
        out[i] = (float)(acc & 0xfffffu);
    }
}
#endif

#if DBG_STOP == 100
__global__ void dbg_cmp3(const unsigned short* a0, const unsigned short* b0, const unsigned short* a1, const unsigned short* b1, const unsigned short* a2, const unsigned short* b2, unsigned* cnt) {
    unsigned c0 = 0, c1 = 0, c2 = 0;
    for (size_t i = (size_t)blockIdx.x * blockDim.x + threadIdx.x; i < (size_t)NTOK * DM; i += (size_t)gridDim.x * blockDim.x) { c0 += a0[i] != b0[i]; c1 += a1[i] != b1[i]; c2 += a2[i] != b2[i]; }
    if (c0) atomicAdd(cnt, c0); if (c1) atomicAdd(cnt + 1, c1); if (c2) atomicAdd(cnt + 2, c2);
}
__global__ void dbg_fill(float* out, const unsigned* cnt) {
    const float E = (cnt[0] ? 3.f : 0.f) + (cnt[1] ? 10.f : 0.f) + (cnt[2] ? 30.f : 0.f);
    for (size_t i = (size_t)blockIdx.x * blockDim.x + threadIdx.x; i < (size_t)NTOK * DM; i += (size_t)gridDim.x * blockDim.x) out[i] = E;
}
#endif

#if DBG_STOP == 200
__global__ void dbg_cksum(const unsigned long long* p, size_t nblk, unsigned long long* ck) {
    for (size_t b = (size_t)blockIdx.x * blockDim.x + threadIdx.x; b < nblk; b += (size_t)gridDim.x * blockDim.x) {
        unsigned long long h = 0x9E3779B97F4A7C15ull; const unsigned long long* q = p + b * 128;
        for (int i = 0; i < 128; ++i) { h ^= q[i]; h *= 0xBF58476D1CE4E5B9ull; h ^= h >> 29; }
        ck[b] = h; }
}
__global__ void dbg_ckcmp(const unsigned long long* a, const unsigned long long* b, size_t nblk, unsigned long long* first) {
    for (size_t i = (size_t)blockIdx.x * blockDim.x + threadIdx.x; i < nblk; i += (size_t)gridDim.x * blockDim.x) if (a[i] != b[i]) atomicMin(first, (unsigned long long)i);
}
__global__ void dbg_fill2(float* out, const unsigned long long* first) {
    const unsigned long long off = WS_RSTD + (*first) * 1024ull; int id = 0;
    if (*first != ~0ull) { id = 1; if (off >= WS_Z8) id = 2; if (off >= WS_DLAT) id = 3; if (off >= WS_DIQ) id = 4; if (off >= WS_DIK) id = 5; if (off >= WS_FFW) id = 6; if (off >= WS_GATES) id = 7; if (off >= WS_C2F) id = 8;
        if (off >= WS_DKV) id = 9; if (off >= WS_SC) id = 10; if (off >= WS_MASK) id = 11; if (off >= WS_YATT) id = 12; if (off >= WS_M) id = 13; }
    const float E = 3.f * id;
    for (size_t i = (size_t)blockIdx.x * blockDim.x + threadIdx.x; i < (size_t)NTOK * DM; i += (size_t)gridDim.x * blockDim.x) out[i] = E;
}
#endif
extern "C" void kernel_launch(void* const* d_in, const int* in_sizes, int n_in, void* d_out, int out_size, void* d_ws, size_t ws_size, hipStream_t stream) {
    static int grid = 0;
    if (grid == 0) {
        if (n_in != 22 || out_size != NTOK * DM || ws_size < WS_END) { fprintf(stderr, "kernel_launch: unexpected problem (n_in %d, out %d, ws %zu, need %zu)\n", n_in, out_size, ws_size, (size_t)WS_END); grid = -1; return; }
        int dev = 0, cus = 0;
        if (hipGetDevice(&dev) != hipSuccess || hipDeviceGetAttribute(&cus, hipDeviceAttributeMultiprocessorCount, dev) != hipSuccess) { grid = -1; return; }
        if (hipFuncSetAttribute((const void*)mk_fwd, hipFuncAttributeMaxDynamicSharedMemorySize, LDS_BYTES) != hipSuccess) { fprintf(stderr, "kernel_launch: hipFuncSetAttribute failed\n"); grid = -1; return; }
        int per_cu = 0;
        if (hipOccupancyMaxActiveBlocksPerMultiprocessor(&per_cu, (const void*)mk_fwd, 512, LDS_BYTES) != hipSuccess || per_cu < 1) fprintf(stderr, "kernel_launch: occupancy query says %d\n", per_cu);
        (void)hipGetLastError();
        if (cus != 256) { fprintf(stderr, "kernel_launch: built for a 256-CU device, found %d CUs\n", cus); grid = -1; return; }
        grid = cus;
    }
    if (grid < 0) return;
    (void)hipMemsetAsync((char*)d_ws + WS_CTL, 0, CTL_ZERO_BYTES, stream);
    Args a{};
    for (int i = 0; i < 22; ++i) a.in[i] = (const float*)d_in[i];
    a.out = (float*)d_out; a.ws = (unsigned char*)d_ws;
#if DBG_STOP == 200
    for (int s = 0; s <= DBG_HI; ++s) { a.ph_lo = s; a.ph_hi = s + 1; hipLaunchKernelGGL(mk_fwd, dim3(grid), dim3(512), LDS_BYTES, stream, a); }
    { char* w = (char*)d_ws; const size_t nblk = (WS_R_END1 - WS_RSTD) / 1024; unsigned long long* ck0 = (unsigned long long*)(w + WS_R_END1); unsigned long long* ck1 = ck0 + nblk; unsigned long long* first = (unsigned long long*)(w + 4096);
#ifdef DBG_WARMFIRST
      for (int s = DBG_LOSTEP; s <= DBG_HI; ++s) { a.ph_lo = s; a.ph_hi = s + 1; hipLaunchKernelGGL(mk_fwd, dim3(grid), dim3(512), LDS_BYTES, stream, a); }
#endif
      hipLaunchKernelGGL(dbg_cksum, dim3(2048), dim3(256), 0, stream, (const unsigned long long*)(w + WS_RSTD), nblk, ck0);
      for (int s = DBG_LOSTEP; s <= DBG_HI; ++s) { a.ph_lo = s; a.ph_hi = s + 1; hipLaunchKernelGGL(mk_fwd, dim3(grid), dim3(512), LDS_BYTES, stream, a); }
      hipLaunchKernelGGL(dbg_cksum, dim3(2048), dim3(256), 0, stream, (const unsigned long long*)(w + WS_RSTD), nblk, ck1);
      (void)hipMemsetAsync(first, 0xFF, 8, stream);
      hipLaunchKernelGGL(dbg_ckcmp, dim3(1024), dim3(256), 0, stream, (const unsigned long long*)ck0, (const unsigned long long*)ck1, nblk, first);
      hipLaunchKernelGGL(dbg_fill2, dim3(2048), dim3(256), 0, stream, (float*)d_out, (const unsigned long long*)first); }
#elif DBG_STOP == 100
    for (int s = 0; s <= 6; ++s) { a.ph_lo = s; a.ph_hi = s + 1; hipLaunchKernelGGL(mk_fwd, dim3(grid), dim3(512), LDS_BYTES, stream, a); }
    { char* w = (char*)d_ws; const size_t SZ = (size_t)NTOK * DM * 2; char* cp = w + WS_R_END1;
      hipMemcpyAsync(cp, w + WS_M, SZ, hipMemcpyDeviceToDevice, stream); hipMemcpyAsync(cp + SZ, w + WS_SC, 2 * SZ, hipMemcpyDeviceToDevice, stream);
      a.ph_lo = 6; a.ph_hi = 7; hipLaunchKernelGGL(mk_fwd, dim3(grid), dim3(512), LDS_BYTES, stream, a);
      unsigned* cnt = (unsigned*)(w + 4096); hipMemsetAsync(cnt, 0, 64, stream);
      hipLaunchKernelGGL(dbg_cmp3, dim3(2048), dim3(256), 0, stream, (const unsigned short*)(w + WS_M), (const unsigned short*)cp, (const unsigned short*)(w + WS_SC), (const unsigned short*)(cp + SZ), (const unsigned short*)(w + WS_SC + SZ), (const unsigned short*)(cp + 2 * SZ), cnt);
      hipLaunchKernelGGL(dbg_fill, dim3(2048), dim3(256), 0, stream, (float*)d_out, (const unsigned*)cnt); }
#elif DBG_STOP >= 0
    for (int s = 0; s <= DBG_STOP; ++s) { a.ph_lo = s; a.ph_hi = s + 1; hipLaunchKernelGGL(mk_fwd, dim3(grid), dim3(512), LDS_BYTES, stream, a); }
#ifdef DBG_TWICE
    { a.ph_lo = DBG_STOP; a.ph_hi = DBG_STOP + 1; hipLaunchKernelGGL(mk_fwd, dim3(grid), dim3(512), LDS_BYTES, stream, a); }
#endif
    hipLaunchKernelGGL(dbg_dump, dim3(2048), dim3(256), 0, stream, (const unsigned short*)((const char*)d_ws + DBG_LO), (size_t)((WS_END - DBG_LO) / 2), (const unsigned*)d_out, (float*)d_out, DBG_STOP >= 7 ? 1 : 0);
#elif MK_ONE_LAUNCH
    a.ph_lo = 0; a.ph_hi = NSTEPS;
    hipLaunchKernelGGL(mk_fwd, dim3(grid), dim3(512), LDS_BYTES, stream, a);
#else
    for (int s = 0; s < NSTEPS; ++s) { a.ph_lo = s; a.ph_hi = s + 1; hipLaunchKernelGGL(mk_fwd, dim3(grid), dim3(512), LDS_BYTES, stream, a);
#ifdef DUP_MASK
        if ((DUP_MASK >> s) & 1u) { hipLaunchKernelGGL(mk_fwd, dim3(grid), dim3(512), LDS_BYTES, stream, a); }
#endif
    }
#endif
}
```

```cpp
#include <hip/hip_runtime.h>
#include <cstdio>
#include <cstdint>

#ifndef SITE_MASK
#define SITE_MASK 0xffffffffu
#endif
#define SITE_ON(i) (((SITE_MASK) >> (i)) & 1u)

#ifndef DUP_DRY
#define DUP_DRY 0
#endif
#ifndef DBG_STOP
#define DBG_STOP -1
#endif
#ifndef DBG_LO
#define DBG_LO WS_WIN
#endif
#ifndef MK_ONE_LAUNCH
#define MK_ONE_LAUNCH 1
#endif

namespace pg8 {
#define PG8_LAS __attribute__((address_space(3)))
typedef unsigned short bf16_t;
typedef short bf16x8 __attribute__((ext_vector_type(8)));
typedef float f32x4 __attribute__((ext_vector_type(4)));
typedef unsigned u32x4 __attribute__((ext_vector_type(4)));
constexpr int BM = 256, BK = 64, HALF = 128, HTB = HALF * BK * 2  , STAGE_BYTES = 8 * HTB, NXCD = 8, WGM = 8;

__host__ __device__ __forceinline__ int lds_byte(int r, int c) { const int st = (r >> 4) * 2 + (c >> 5), rr = r & 15, cc = c & 31, ob = rr * 64 + cc * 2; return st * 1024 + (ob ^ (((ob >> 9) & 1) << 5)); }
__host__ __device__ __forceinline__ void stage_rc(int b, int& R, int& C) { const int st = b / 1024, sb = b % 1024, swz = sb ^ (((sb >> 9) & 1) << 5); R = (st >> 1) * 16 + swz / 64; C = (st & 1) * 32 + (swz % 64) / 2; }
__host__ __device__ __forceinline__ int perm32(int rho) { const int n = rho >> 4, i = rho & 15; return 8 * (i >> 2) + 4 * n + (i & 3); }
struct Unit { int pm, pn, aux; const char* a; const char* b; };
struct Gemm { int K, P; };
__device__ __forceinline__ unsigned cvt_pk_bf16(float lo, float hi) { unsigned r; asm volatile("v_cvt_pk_bf16_f32 %0, %1, %2" : "=v"(r) : "v"(lo), "v"(hi)); return r; }
template <class Epi, class Sched, bool ALIGN_EPI = false, bool SP2 = false>
__device__ __forceinline__ void gemm_phase(PG8_LAS unsigned char* lds, const Gemm g, const Sched& S, const Epi& E) {
    int tid_ = threadIdx.x; asm volatile("" : "+v"(tid_)); const int tid = tid_, wid = __builtin_amdgcn_readfirstlane(tid >> 6), lane = tid & 63, wr = wid >> 2, wc = wid & 3, fr = lane & 15, fq = lane >> 4;
    const int K = g.K, nt = K / BK;
    unsigned voffA[2], voffB[2];
#pragma unroll
    for (int i = 0; i < 2; ++i) { int R, C; stage_rc(tid * 16 + i * 8192, R, C); const int Rb = Epi::PERM ? ((R & ~31) + perm32(R & 31)) : R;
        voffA[i] = (unsigned)(R * K + C) * 2u; voffB[i] = (unsigned)(Rb * K + C) * 2u; }
    const size_t kstep = (size_t)(BK * 2);
    const size_t hstep = (size_t)HALF * K * 2;
    const unsigned ldsw = (unsigned)wid * 1024u;
    const int aoff = lds_byte(wr * 64 + fr, fq * 8), boff = lds_byte(wc * 32 + fr, fq * 8);
#define PG8_SA(b, h) (((b) * 2 + (h)) * HTB)
#define PG8_SB(b, h) ((4 + (b) * 2 + (h)) * HTB)
#define PG8_STAGE(bufoff, gbase, voff) do { _Pragma("unroll") for (int _i = 0; _i < 2; ++_i) \
        __builtin_amdgcn_global_load_lds((const unsigned*)((const char*)(gbase) + (voff)[_i]), (PG8_LAS unsigned*)(lds + (bufoff) + ldsw + _i * 8192), 16, 0, 0); } while (0)
#define PG8_LDA(dst, b, h) do { _Pragma("unroll") for (int m = 0; m < 4; ++m) _Pragma("unroll") for (int k = 0; k < 2; ++k) dst[m][k] = *(const PG8_LAS bf16x8*)(lds + PG8_SA(b, h) + aoff + m * 2048 + k * 1024); } while (0)
#define PG8_LDB(dst, b, h) do { _Pragma("unroll") for (int n = 0; n < 2; ++n) _Pragma("unroll") for (int k = 0; k < 2; ++k) dst[n][k] = *(const PG8_LAS bf16x8*)(lds + PG8_SB(b, h) + boff + n * 2048 + k * 1024); } while (0)
#define PG8_MMA(ai, bj, At, Bt) do { __builtin_amdgcn_s_setprio(1); _Pragma("unroll") for (int m = 0; m < 4; ++m) _Pragma("unroll") for (int n = 0; n < 2; ++n) _Pragma("unroll") for (int k = 0; k < 2; ++k) \
        acc[ai][bj][m][n] = __builtin_amdgcn_mfma_f32_16x16x32_bf16(Bt[n][k], At[m][k], acc[ai][bj][m][n], 0, 0, 0); __builtin_amdgcn_s_setprio(0); } while (0)
#define PG8_WAIT_V(n) asm volatile("s_waitcnt vmcnt(" #n ")" ::: "memory")
#define PG8_WAIT_L(n) asm volatile("s_waitcnt lgkmcnt(" #n ")" ::: "memory")
#define PG8_BAR __builtin_amdgcn_s_barrier()
#define PG8_SCHED __builtin_amdgcn_sched_barrier(0)
    Unit cur, nxt; int ui = 0;
    if (!S.next(0, cur)) return;
    f32x4 acc[2][2][4][2];
#pragma unroll
    for (int a = 0; a < 2; ++a)
#pragma unroll
        for (int b = 0; b < 2; ++b)
#pragma unroll
            for (int m = 0; m < 4; ++m)
#pragma unroll
                for (int n = 0; n < 2; ++n) acc[a][b][m][n] = (f32x4){0.f, 0.f, 0.f, 0.f};
    bf16x8 At[4][2], B0[2][2], B1[2][2];
    const char* cA = cur.a; const char* cB = cur.b;
    S.a_ready(cur);
    if constexpr (SP2) {
        PG8_STAGE(PG8_SB(0, 0), cB, voffB); PG8_STAGE(PG8_SB(0, 1), cB + hstep, voffB); PG8_STAGE(PG8_SA(0, 0), cA, voffA); PG8_STAGE(PG8_SA(0, 1), cA + hstep, voffA);
        if (wr == 1) PG8_BAR;
        PG8_WAIT_V(2); PG8_BAR;
        PG8_STAGE(PG8_SB(1, 0), cB + kstep, voffB); PG8_STAGE(PG8_SA(1, 0), cA + kstep, voffA); PG8_STAGE(PG8_SB(1, 1), cB + hstep + kstep, voffB);
        PG8_WAIT_V(6); PG8_BAR;
    } else {
        PG8_STAGE(PG8_SB(0, 0), cB, voffB); PG8_STAGE(PG8_SA(0, 0), cA, voffA); PG8_STAGE(PG8_SB(0, 1), cB + hstep, voffB); PG8_STAGE(PG8_SA(0, 1), cA + hstep, voffA);
        if (wr == 1) PG8_BAR;
        PG8_WAIT_V(4); PG8_BAR;
        PG8_STAGE(PG8_SB(1, 0), cB + kstep, voffB); PG8_STAGE(PG8_SA(1, 0), cA + kstep, voffA); PG8_STAGE(PG8_SB(1, 1), cB + hstep + kstep, voffB);
        PG8_WAIT_V(6); PG8_BAR;
    }
    for (;;) {
        const bool has_next = S.next(ui + 1, nxt);
        const char* nA = has_next ? nxt.a : cA; const char* nB = has_next ? nxt.b : cB;
        for (int t = 0; t < nt; t += 2) {
            const bool last = (t == nt - 2);
            const char* a1 = cA + (size_t)(t + 1) * kstep;
            const char* a2 = last ? nA : cA + (size_t)(t + 2) * kstep; const char* b2 = last ? nB : cB + (size_t)(t + 2) * kstep;
            const char* a3 = a2 + kstep; const char* b3 = b2 + kstep;
            if (last && has_next) S.a_ready(nxt);
            if constexpr (SP2) {
            PG8_LDB(B0, 0, 0); PG8_LDB(B1, 0, 1); PG8_SCHED; PG8_LDA(At, 0, 0); PG8_STAGE(PG8_SA(1, 1), a1 + hstep, voffA);
            PG8_WAIT_V(8); PG8_WAIT_L(0); PG8_BAR; PG8_MMA(0, 0, At, B0); PG8_MMA(0, 1, At, B1); PG8_BAR; PG8_SCHED;
            PG8_LDA(At, 0, 1); PG8_STAGE(PG8_SB(0, 0), b2, voffB); PG8_STAGE(PG8_SB(0, 1), b2 + hstep, voffB); PG8_STAGE(PG8_SA(0, 0), a2, voffA);
            PG8_WAIT_V(8); PG8_WAIT_L(0); PG8_BAR; PG8_MMA(1, 0, At, B0); PG8_MMA(1, 1, At, B1); PG8_BAR; PG8_SCHED;
            PG8_LDB(B0, 1, 0); PG8_LDB(B1, 1, 1); PG8_SCHED; PG8_LDA(At, 1, 0); PG8_STAGE(PG8_SA(0, 1), a2 + hstep, voffA);
            PG8_WAIT_V(8); PG8_WAIT_L(0); PG8_BAR; PG8_MMA(0, 0, At, B0); PG8_MMA(0, 1, At, B1); PG8_BAR; PG8_SCHED;
            PG8_LDA(At, 1, 1); PG8_STAGE(PG8_SB(1, 0), b3, voffB); PG8_STAGE(PG8_SB(1, 1), b3 + hstep, voffB); PG8_STAGE(PG8_SA(1, 0), a3, voffA);
            PG8_WAIT_V(8); PG8_WAIT_L(0); PG8_BAR; PG8_MMA(1, 0, At, B0); PG8_MMA(1, 1, At, B1); PG8_BAR; PG8_SCHED;
            } else {
            PG8_LDB(B0, 0, 0); PG8_SCHED; PG8_LDA(At, 0, 0); PG8_STAGE(PG8_SA(1, 1), a1 + hstep, voffA);
            PG8_WAIT_L(8); PG8_BAR; PG8_WAIT_L(0); PG8_MMA(0, 0, At, B0); PG8_BAR; PG8_SCHED;
            PG8_LDB(B1, 0, 1); PG8_STAGE(PG8_SB(0, 0), b2, voffB);
            PG8_BAR; PG8_WAIT_L(0); PG8_MMA(0, 1, At, B1); PG8_BAR;
            PG8_LDA(At, 0, 1); PG8_STAGE(PG8_SA(0, 0), a2, voffA);
            PG8_BAR; PG8_WAIT_L(0); PG8_MMA(1, 0, At, B0); PG8_BAR; PG8_SCHED;
            PG8_STAGE(PG8_SB(0, 1), b2 + hstep, voffB);
            PG8_WAIT_V(6); PG8_BAR; PG8_MMA(1, 1, At, B1); PG8_BAR;
            PG8_LDB(B0, 1, 0); PG8_SCHED; PG8_LDA(At, 1, 0); PG8_STAGE(PG8_SA(0, 1), a2 + hstep, voffA);
            PG8_WAIT_L(8); PG8_BAR; PG8_WAIT_L(0); PG8_MMA(0, 0, At, B0); PG8_BAR; PG8_SCHED;
            PG8_LDB(B1, 1, 1); PG8_STAGE(PG8_SB(1, 0), b3, voffB);
            PG8_BAR; PG8_WAIT_L(0); PG8_MMA(0, 1, At, B1); PG8_BAR;
            PG8_LDA(At, 1, 1); PG8_STAGE(PG8_SA(1, 0), a3, voffA);
            PG8_BAR; PG8_WAIT_L(0); PG8_MMA(1, 0, At, B0); PG8_BAR; PG8_SCHED;
            PG8_STAGE(PG8_SB(1, 1), b3 + hstep, voffB);
            PG8_WAIT_V(6); PG8_BAR; PG8_MMA(1, 1, At, B1); PG8_BAR;
            }
        }
        if constexpr (ALIGN_EPI) { if (wr == 0) PG8_BAR; }
        if constexpr (!Epi::AFTER_DRAIN) { E(acc, cur, wr, wc, fr, fq); S.done(cur); }
        if (!has_next) break;
#pragma unroll
        for (int a = 0; a < 2; ++a)
#pragma unroll
            for (int b = 0; b < 2; ++b)
#pragma unroll
                for (int m = 0; m < 4; ++m)
#pragma unroll
                    for (int n = 0; n < 2; ++n) acc[a][b][m][n] = (f32x4){0.f, 0.f, 0.f, 0.f};
        cur = nxt; cA = nA; cB = nB; ++ui;
        if constexpr (ALIGN_EPI) { if (wr == 1) PG8_BAR; }
    }
    PG8_WAIT_V(0);
    if constexpr (!ALIGN_EPI) { if (wr == 0) PG8_BAR; }
    PG8_BAR;
    if constexpr (Epi::AFTER_DRAIN) { E.fused(acc, cur, wr, wc, fr, fq, lds, wid, lane); S.done(cur); }
#undef PG8_SA
#undef PG8_SB
#undef PG8_STAGE
#undef PG8_LDA
#undef PG8_LDB
#undef PG8_MMA
#undef PG8_WAIT_V
#undef PG8_WAIT_L
#undef PG8_BAR
#undef PG8_SCHED
}
template <class Epi, class Sched, bool ALIGN_EPI = false, bool SP2 = false>
__device__ __forceinline__ void gemm_phase_carry(PG8_LAS unsigned char* lds, const Gemm g, const Sched& S, const Epi& E) {
    int tid_ = threadIdx.x; asm volatile("" : "+v"(tid_)); const int tid = tid_, wid = __builtin_amdgcn_readfirstlane(tid >> 6), lane = tid & 63, wr = wid >> 2, wc = wid & 3, fr = lane & 15, fq = lane >> 4;
    const int K = g.K, nt = K / BK;
    unsigned voffA[2], voffB[2];
#pragma unroll
    for (int i = 0; i < 2; ++i) { int R, C; stage_rc(tid * 16 + i * 8192, R, C); const int Rb = Epi::PERM ? ((R & ~31) + perm32(R & 31)) : R;
        voffA[i] = (unsigned)(R * K + C) * 2u; voffB[i] = (unsigned)(Rb * K + C) * 2u; }
    const size_t kstep = (size_t)(BK * 2);
    const size_t hstep = (size_t)HALF * K * 2;
    const unsigned ldsw = (unsigned)wid * 1024u;
    const int aoff = lds_byte(wr * 64 + fr, fq * 8), boff = lds_byte(wc * 32 + fr, fq * 8);
#define PG8_SA(b, h) (((b) * 2 + (h)) * HTB)
#define PG8_SB(b, h) ((4 + (b) * 2 + (h)) * HTB)
#define PG8_STAGE(bufoff, gbase, voff) do { _Pragma("unroll") for (int _i = 0; _i < 2; ++_i) \
        __builtin_amdgcn_global_load_lds((const unsigned*)((const char*)(gbase) + (voff)[_i]), (PG8_LAS unsigned*)(lds + (bufoff) + ldsw + _i * 8192), 16, 0, 0); } while (0)
#define PG8_LDA(dst, b, h) do { _Pragma("unroll") for (int m = 0; m < 4; ++m) _Pragma("unroll") for (int k = 0; k < 2; ++k) dst[m][k] = *(const PG8_LAS bf16x8*)(lds + PG8_SA(b, h) + aoff + m * 2048 + k * 1024); } while (0)
#define PG8_LDB(dst, b, h) do { _Pragma("unroll") for (int n = 0; n < 2; ++n) _Pragma("unroll") for (int k = 0; k < 2; ++k) dst[n][k] = *(const PG8_LAS bf16x8*)(lds + PG8_SB(b, h) + boff + n * 2048 + k * 1024); } while (0)
#define PG8_MMA(ai, bj, At, Bt) do { __builtin_amdgcn_s_setprio(1); _Pragma("unroll") for (int m = 0; m < 4; ++m) _Pragma("unroll") for (int n = 0; n < 2; ++n) _Pragma("unroll") for (int k = 0; k < 2; ++k) \
        acc[ai][bj][m][n] = __builtin_amdgcn_mfma_f32_16x16x32_bf16(Bt[n][k], At[m][k], acc[ai][bj][m][n], 0, 0, 0); __builtin_amdgcn_s_setprio(0); } while (0)
#define PG8_WAIT_V(n) asm volatile("s_waitcnt vmcnt(" #n ")" ::: "memory")
#define PG8_WAIT_L(n) asm volatile("s_waitcnt lgkmcnt(" #n ")" ::: "memory")
#define PG8_BAR __builtin_amdgcn_s_barrier()
#define PG8_SCHED __builtin_amdgcn_sched_barrier(0)
    Unit cur, nxt; int ui = 0; bool kz = true;
    if (!S.next(0, cur)) return;
    f32x4 acc[2][2][4][2];
#pragma unroll
    for (int a = 0; a < 2; ++a)
#pragma unroll
        for (int b = 0; b < 2; ++b)
#pragma unroll
            for (int m = 0; m < 4; ++m)
#pragma unroll
                for (int n = 0; n < 2; ++n) if (kz) acc[a][b][m][n] = (f32x4){0.f, 0.f, 0.f, 0.f};
    bf16x8 At[4][2], B0[2][2], B1[2][2];
    const char* cA = cur.a; const char* cB = cur.b;
    S.a_ready(cur);
    if constexpr (SP2) {
        PG8_STAGE(PG8_SB(0, 0), cB, voffB); PG8_STAGE(PG8_SB(0, 1), cB + hstep, voffB); PG8_STAGE(PG8_SA(0, 0), cA, voffA); PG8_STAGE(PG8_SA(0, 1), cA + hstep, voffA);
        if (wr == 1) PG8_BAR;
        PG8_WAIT_V(2); PG8_BAR;
        PG8_STAGE(PG8_SB(1, 0), cB + kstep, voffB); PG8_STAGE(PG8_SA(1, 0), cA + kstep, voffA); PG8_STAGE(PG8_SB(1, 1), cB + hstep + kstep, voffB);
        PG8_WAIT_V(6); PG8_BAR;
    } else {
        PG8_STAGE(PG8_SB(0, 0), cB, voffB); PG8_STAGE(PG8_SA(0, 0), cA, voffA); PG8_STAGE(PG8_SB(0, 1), cB + hstep, voffB); PG8_STAGE(PG8_SA(0, 1), cA + hstep, voffA);
        if (wr == 1) PG8_BAR;
        PG8_WAIT_V(4); PG8_BAR;
        PG8_STAGE(PG8_SB(1, 0), cB + kstep, voffB); PG8_STAGE(PG8_SA(1, 0), cA + kstep, voffA); PG8_STAGE(PG8_SB(1, 1), cB + hstep + kstep, voffB);
        PG8_WAIT_V(6); PG8_BAR;
    }
    for (;;) {
        const bool has_next = S.next(ui + 1, nxt);
        const char* nA = has_next ? nxt.a : cA; const char* nB = has_next ? nxt.b : cB;
        for (int t = 0; t < nt; t += 2) {
            const bool last = (t == nt - 2);
            const char* a1 = cA + (size_t)(t + 1) * kstep;
            const char* a2 = last ? nA : cA + (size_t)(t + 2) * kstep; const char* b2 = last ? nB : cB + (size_t)(t + 2) * kstep;
            const char* a3 = a2 + kstep; const char* b3 = b2 + kstep;
            if (last && has_next) S.a_ready(nxt);
            if constexpr (SP2) {
            PG8_LDB(B0, 0, 0); PG8_LDB(B1, 0, 1); PG8_SCHED; PG8_LDA(At, 0, 0); PG8_STAGE(PG8_SA(1, 1), a1 + hstep, voffA);
            PG8_WAIT_V(8); PG8_WAIT_L(0); PG8_BAR; PG8_MMA(0, 0, At, B0); PG8_MMA(0, 1, At, B1); PG8_BAR; PG8_SCHED;
            PG8_LDA(At, 0, 1); PG8_STAGE(PG8_SB(0, 0), b2, voffB); PG8_STAGE(PG8_SB(0, 1), b2 + hstep, voffB); PG8_STAGE(PG8_SA(0, 0), a2, voffA);
            PG8_WAIT_V(8); PG8_WAIT_L(0); PG8_BAR; PG8_MMA(1, 0, At, B0); PG8_MMA(1, 1, At, B1); PG8_BAR; PG8_SCHED;
            PG8_LDB(B0, 1, 0); PG8_LDB(B1, 1, 1); PG8_SCHED; PG8_LDA(At, 1, 0); PG8_STAGE(PG8_SA(0, 1), a2 + hstep, voffA);
            PG8_WAIT_V(8); PG8_WAIT_L(0); PG8_BAR; PG8_MMA(0, 0, At, B0); PG8_MMA(0, 1, At, B1); PG8_BAR; PG8_SCHED;
            PG8_LDA(At, 1, 1); PG8_STAGE(PG8_SB(1, 0), b3, voffB); PG8_STAGE(PG8_SB(1, 1), b3 + hstep, voffB); PG8_STAGE(PG8_SA(1, 0), a3, voffA);
            PG8_WAIT_V(8); PG8_WAIT_L(0); PG8_BAR; PG8_MMA(1, 0, At, B0); PG8_MMA(1, 1, At, B1); PG8_BAR; PG8_SCHED;
            } else {
            PG8_LDB(B0, 0, 0); PG8_SCHED; PG8_LDA(At, 0, 0); PG8_STAGE(PG8_SA(1, 1), a1 + hstep, voffA);
            PG8_WAIT_L(8); PG8_BAR; PG8_WAIT_L(0); PG8_MMA(0, 0, At, B0); PG8_BAR; PG8_SCHED;
            PG8_LDB(B1, 0, 1); PG8_STAGE(PG8_SB(0, 0), b2, voffB);
            PG8_BAR; PG8_WAIT_L(0); PG8_MMA(0, 1, At, B1); PG8_BAR;
            PG8_LDA(At, 0, 1); PG8_STAGE(PG8_SA(0, 0), a2, voffA);
            PG8_BAR; PG8_WAIT_L(0); PG8_MMA(1, 0, At, B0); PG8_BAR; PG8_SCHED;
            PG8_STAGE(PG8_SB(0, 1), b2 + hstep, voffB);
            PG8_WAIT_V(6); PG8_BAR; PG8_MMA(1, 1, At, B1); PG8_BAR;
            PG8_LDB(B0, 1, 0); PG8_SCHED; PG8_LDA(At, 1, 0); PG8_STAGE(PG8_SA(0, 1), a2 + hstep, voffA);
            PG8_WAIT_L(8); PG8_BAR; PG8_WAIT_L(0); PG8_MMA(0, 0, At, B0); PG8_BAR; PG8_SCHED;
            PG8_LDB(B1, 1, 1); PG8_STAGE(PG8_SB(1, 0), b3, voffB);
            PG8_BAR; PG8_WAIT_L(0); PG8_MMA(0, 1, At, B1); PG8_BAR;
            PG8_LDA(At, 1, 1); PG8_STAGE(PG8_SA(1, 0), a3, voffA);
            PG8_BAR; PG8_WAIT_L(0); PG8_MMA(1, 0, At, B0); PG8_BAR; PG8_SCHED;
            PG8_STAGE(PG8_SB(1, 1), b3 + hstep, voffB);
            PG8_WAIT_V(6); PG8_BAR; PG8_MMA(1, 1, At, B1); PG8_BAR;
            }
        }
        if constexpr (ALIGN_EPI) { if (wr == 0) PG8_BAR; }
        if constexpr (!Epi::AFTER_DRAIN) { E(acc, cur, wr, wc, fr, fq); S.done(cur); }
        if (!has_next) break; kz = false;
#pragma unroll
        for (int a = 0; a < 2; ++a)
#pragma unroll
            for (int b = 0; b < 2; ++b)
#pragma unroll
                for (int m = 0; m < 4; ++m)
#pragma unroll
                    for (int n = 0; n < 2; ++n) if (kz) acc[a][b][m][n] = (f32x4){0.f, 0.f, 0.f, 0.f};
        cur = nxt; cA = nA; cB = nB; ++ui;
        if constexpr (ALIGN_EPI) { if (wr == 1) PG8_BAR; }
    }
    PG8_WAIT_V(0);
    if constexpr (!ALIGN_EPI) { if (wr == 0) PG8_BAR; }
    PG8_BAR;
    if constexpr (Epi::AFTER_DRAIN) { E.fused(acc, cur, wr, wc, fr, fq, lds, wid, lane); S.done(cur); }
#undef PG8_SA
#undef PG8_SB
#undef PG8_STAGE
#undef PG8_LDA
#undef PG8_LDB
#undef PG8_MMA
#undef PG8_WAIT_V
#undef PG8_WAIT_L
#undef PG8_BAR
#undef PG8_SCHED
}
typedef int i32x4v __attribute__((ext_vector_type(4))); typedef int i32x8v __attribute__((ext_vector_type(8)));
__device__ __forceinline__ f32x4 mma8(bf16x8 b0, bf16x8 b1, bf16x8 a0, bf16x8 a1, f32x4 c) {
    const i32x4v bl = __builtin_bit_cast(i32x4v, b0), bh = __builtin_bit_cast(i32x4v, b1), al = __builtin_bit_cast(i32x4v, a0), ah = __builtin_bit_cast(i32x4v, a1);
    const i32x8v B = __builtin_shufflevector(bl, bh, 0, 1, 2, 3, 4, 5, 6, 7), A = __builtin_shufflevector(al, ah, 0, 1, 2, 3, 4, 5, 6, 7);
    return __builtin_amdgcn_mfma_scale_f32_16x16x128_f8f6f4(B, A, c, 0, 0, 0, 0x7f7f7f7f, 0, 0x7f7f7f7f);
}
__device__ __forceinline__ f32x4 mma8v(const i32x8v& B, const i32x8v& A, f32x4 c) { const int one = 0x7f7f7f7f;
    asm volatile("v_mfma_scale_f32_16x16x128_f8f6f4 %0, %1, %2, %0, %3, %3 op_sel_hi:[0,0,0]" : "+v"(c) : "v"(B), "v"(A), "v"(one)); return c; }
template <class Epi, class Sched, bool ALIGN_EPI = false, bool SP2 = false>
__device__ __forceinline__ void gemm_phase8(PG8_LAS unsigned char* lds, const Gemm g, const Sched& S, const Epi& E) {
    int tid_ = threadIdx.x; asm volatile("" : "+v"(tid_)); const int tid = tid_, wid = __builtin_amdgcn_readfirstlane(tid >> 6), lane = tid & 63, wr = wid >> 2, wc = wid & 3, fr = lane & 15, fq = lane >> 4;
    const int K = g.P ? g.P : g.K, nt = g.K / BK;
    unsigned voffA[2], voffB[2];
#pragma unroll
    for (int i = 0; i < 2; ++i) { int R, C; stage_rc(tid * 16 + i * 8192, R, C); const int Rb = Epi::PERM ? ((R & ~31) + perm32(R & 31)) : R;
        voffA[i] = (unsigned)(R * K + C) * 2u; voffB[i] = (unsigned)(Rb * K + C) * 2u; }
    const size_t kstep = (size_t)(BK * 2);
    const size_t hstep = (size_t)HALF * K * 2;
    const unsigned ldsw = (unsigned)wid * 1024u;
    const int aoff = lds_byte(wr * 64 + fr, fq * 8), boff = lds_byte(wc * 32 + fr, fq * 8);
#define PG8_SA(b, h) (((b) * 2 + (h)) * HTB)
#define PG8_SB(b, h) ((4 + (b) * 2 + (h)) * HTB)
#define PG8_STAGE(bufoff, gbase, voff) do { _Pragma("unroll") for (int _i = 0; _i < 2; ++_i) \
        __builtin_amdgcn_global_load_lds((const unsigned*)((const char*)(gbase) + (voff)[_i]), (PG8_LAS unsigned*)(lds + (bufoff) + ldsw + _i * 8192), 16, 0, 0); } while (0)
#define PG8_LDA(dst, b, h) do { _Pragma("unroll") for (int m = 0; m < 4; ++m) { dst[m].lo = *(const PG8_LAS i32x4v*)(lds + PG8_SA(b, h) + aoff + m * 2048); dst[m].hi = *(const PG8_LAS i32x4v*)(lds + PG8_SA(b, h) + aoff + m * 2048 + 1024); } } while (0)
#define PG8_LDB(dst, b, h) do { _Pragma("unroll") for (int n = 0; n < 2; ++n) { dst[n].lo = *(const PG8_LAS i32x4v*)(lds + PG8_SB(b, h) + boff + n * 2048); dst[n].hi = *(const PG8_LAS i32x4v*)(lds + PG8_SB(b, h) + boff + n * 2048 + 1024); } } while (0)
#define PG8_MMA(ai, bj, At, Bt) do { __builtin_amdgcn_s_setprio(1); _Pragma("unroll") for (int m = 0; m < 4; ++m) _Pragma("unroll") for (int n = 0; n < 2; ++n) \
        acc[ai][bj][m][n] = mma8v(Bt[n], At[m], acc[ai][bj][m][n]); __builtin_amdgcn_s_setprio(0); } while (0)
#define PG8_WAIT_V(n) asm volatile("s_waitcnt vmcnt(" #n ")" ::: "memory")
#define PG8_WAIT_L(n) asm volatile("s_waitcnt lgkmcnt(" #n ")" ::: "memory")
#define PG8_BAR __builtin_amdgcn_s_barrier()
#define PG8_SCHED __builtin_amdgcn_sched_barrier(0)
    Unit cur, nxt; int ui = 0;
    if (!S.next(0, cur)) return;
    f32x4 acc[2][2][4][2];
#pragma unroll
    for (int a = 0; a < 2; ++a)
#pragma unroll
        for (int b = 0; b < 2; ++b)
#pragma unroll
            for (int m = 0; m < 4; ++m)
#pragma unroll
                for (int n = 0; n < 2; ++n) acc[a][b][m][n] = (f32x4){0.f, 0.f, 0.f, 0.f};
    i32x8v At[4], B0[2], B1[2];
    const char* cA = cur.a; const char* cB = cur.b;
    S.a_ready(cur);
    if constexpr (SP2) {
        PG8_STAGE(PG8_SB(0, 0), cB, voffB); PG8_STAGE(PG8_SB(0, 1), cB + hstep, voffB); PG8_STAGE(PG8_SA(0, 0), cA, voffA); PG8_STAGE(PG8_SA(0, 1), cA + hstep, voffA);
        if (wr == 1) PG8_BAR;
        PG8_WAIT_V(2); PG8_BAR;
        PG8_STAGE(PG8_SB(1, 0), cB + kstep, voffB); PG8_STAGE(PG8_SA(1, 0), cA + kstep, voffA); PG8_STAGE(PG8_SB(1, 1), cB + hstep + kstep, voffB);
        PG8_WAIT_V(6); PG8_BAR;
    } else {
        PG8_STAGE(PG8_SB(0, 0), cB, voffB); PG8_STAGE(PG8_SA(0, 0), cA, voffA); PG8_STAGE(PG8_SB(0, 1), cB + hstep, voffB); PG8_STAGE(PG8_SA(0, 1), cA + hstep, voffA);
        if (wr == 1) PG8_BAR;
        PG8_WAIT_V(4); PG8_BAR;
        PG8_STAGE(PG8_SB(1, 0), cB + kstep, voffB); PG8_STAGE(PG8_SA(1, 0), cA + kstep, voffA); PG8_STAGE(PG8_SB(1, 1), cB + hstep + kstep, voffB);
        PG8_WAIT_V(6); PG8_BAR;
    }
    for (;;) {
        const bool has_next = S.next(ui + 1, nxt);
        const char* nA = has_next ? nxt.a : cA; const char* nB = has_next ? nxt.b : cB;
        for (int t = 0; t < nt; t += 2) {
            const bool last = (t == nt - 2);
            const char* a1 = cA + (size_t)(t + 1) * kstep;
            const char* a2 = last ? nA : cA + (size_t)(t + 2) * kstep; const char* b2 = last ? nB : cB + (size_t)(t + 2) * kstep;
            const char* a3 = a2 + kstep; const char* b3 = b2 + kstep;
            if (last && has_next) S.a_ready(nxt);
            if constexpr (SP2) {
            PG8_LDB(B0, 0, 0); PG8_LDB(B1, 0, 1); PG8_SCHED; PG8_LDA(At, 0, 0); PG8_STAGE(PG8_SA(1, 1), a1 + hstep, voffA);
            PG8_WAIT_V(8); PG8_WAIT_L(0); PG8_BAR; PG8_MMA(0, 0, At, B0); PG8_MMA(0, 1, At, B1); PG8_BAR; PG8_SCHED;
            PG8_LDA(At, 0, 1); PG8_STAGE(PG8_SB(0, 0), b2, voffB); PG8_STAGE(PG8_SB(0, 1), b2 + hstep, voffB); PG8_STAGE(PG8_SA(0, 0), a2, voffA);
            PG8_WAIT_V(8); PG8_WAIT_L(0); PG8_BAR; PG8_MMA(1, 0, At, B0); PG8_MMA(1, 1, At, B1); PG8_BAR; PG8_SCHED;
            PG8_LDB(B0, 1, 0); PG8_LDB(B1, 1, 1); PG8_SCHED; PG8_LDA(At, 1, 0); PG8_STAGE(PG8_SA(0, 1), a2 + hstep, voffA);
            PG8_WAIT_V(8); PG8_WAIT_L(0); PG8_BAR; PG8_MMA(0, 0, At, B0); PG8_MMA(0, 1, At, B1); PG8_BAR; PG8_SCHED;
            PG8_LDA(At, 1, 1); PG8_STAGE(PG8_SB(1, 0), b3, voffB); PG8_STAGE(PG8_SB(1, 1), b3 + hstep, voffB); PG8_STAGE(PG8_SA(1, 0), a3, voffA);
            PG8_WAIT_V(8); PG8_WAIT_L(0); PG8_BAR; PG8_MMA(1, 0, At, B0); PG8_MMA(1, 1, At, B1); PG8_BAR; PG8_SCHED;
            } else {
            PG8_LDB(B0, 0, 0); PG8_SCHED; PG8_LDA(At, 0, 0); PG8_STAGE(PG8_SA(1, 1), a1 + hstep, voffA);
            PG8_WAIT_L(8); PG8_BAR; PG8_WAIT_L(0); PG8_MMA(0, 0, At, B0); PG8_BAR; PG8_SCHED;
            PG8_LDB(B1, 0, 1); PG8_STAGE(PG8_SB(0, 0), b2, voffB);
            PG8_BAR; PG8_WAIT_L(0); PG8_MMA(0, 1, At, B1); PG8_BAR;
            PG8_LDA(At, 0, 1); PG8_STAGE(PG8_SA(0, 0), a2, voffA);
            PG8_BAR; PG8_WAIT_L(0); PG8_MMA(1, 0, At, B0); PG8_BAR; PG8_SCHED;
            PG8_STAGE(PG8_SB(0, 1), b2 + hstep, voffB);
            PG8_WAIT_V(6); PG8_BAR; PG8_MMA(1, 1, At, B1); PG8_BAR;
            PG8_LDB(B0, 1, 0); PG8_SCHED; PG8_LDA(At, 1, 0); PG8_STAGE(PG8_SA(0, 1), a2 + hstep, voffA);
            PG8_WAIT_L(8); PG8_BAR; PG8_WAIT_L(0); PG8_MMA(0, 0, At, B0); PG8_BAR; PG8_SCHED;
            PG8_LDB(B1, 1, 1); PG8_STAGE(PG8_SB(1, 0), b3, voffB);
            PG8_BAR; PG8_WAIT_L(0); PG8_MMA(0, 1, At, B1); PG8_BAR;
            PG8_LDA(At, 1, 1); PG8_STAGE(PG8_SA(1, 0), a3, voffA);
            PG8_BAR; PG8_WAIT_L(0); PG8_MMA(1, 0, At, B0); PG8_BAR; PG8_SCHED;
            PG8_STAGE(PG8_SB(1, 1), b3 + hstep, voffB);
            PG8_WAIT_V(6); PG8_BAR; PG8_MMA(1, 1, At, B1); PG8_BAR;
            }
        }
        if constexpr (ALIGN_EPI) { if (wr == 0) PG8_BAR; }
        if constexpr (!Epi::AFTER_DRAIN) { E(acc, cur, wr, wc, fr, fq); S.done(cur); }
        if (!has_next) break;
#pragma unroll
        for (int a = 0; a < 2; ++a)
#pragma unroll
            for (int b = 0; b < 2; ++b)
#pragma unroll
                for (int m = 0; m < 4; ++m)
#pragma unroll
                    for (int n = 0; n < 2; ++n) acc[a][b][m][n] = (f32x4){0.f, 0.f, 0.f, 0.f};
        cur = nxt; cA = nA; cB = nB; ++ui;
        if constexpr (ALIGN_EPI) { if (wr == 1) PG8_BAR; }
    }
    PG8_WAIT_V(0);
    if constexpr (!ALIGN_EPI) { if (wr == 0) PG8_BAR; }
    PG8_BAR;
    if constexpr (Epi::AFTER_DRAIN) { E.fused(acc, cur, wr, wc, fr, fq, lds, wid, lane); S.done(cur); }
#undef PG8_SA
#undef PG8_SB
#undef PG8_STAGE
#undef PG8_LDA
#undef PG8_LDB
#undef PG8_MMA
#undef PG8_WAIT_V
#undef PG8_WAIT_L
#undef PG8_BAR
#undef PG8_SCHED
}
struct OrderBase {
    int nM, nN, nwg, G, c;
    __device__ __forceinline__ void init(int nM_, int nN_, int G_, int c_) { nM = nM_; nN = nN_; nwg = nM_ * nN_; G = G_; c = c_; }
    __device__ __forceinline__ bool map(int i, int& pm, int& pn) const {
        const long L = (long)i * G + c; if (L >= nwg) return false;
        int wgid = (int)L; { const int q = nwg / NXCD, r = nwg % NXCD, xcd = wgid % NXCD, off = wgid / NXCD; wgid = (xcd < r ? xcd * (q + 1) : r * (q + 1) + (xcd - r) * q) + off; }
        const int nig = WGM * nN, gid = wgid / nig, fm = gid * WGM, gsz = (nM - fm) < WGM ? (nM - fm) : WGM;
        pm = fm + ((wgid % nig) % gsz); pn = (wgid % nig) / gsz; return true;
    }
    __device__ __forceinline__ void a_ready(const Unit&) const {}
    __device__ __forceinline__ void done(const Unit&) const {}
};
struct PlainOrder : OrderBase {
    const char* A; const char* B; size_t ta, tb;
    __device__ __forceinline__ bool next(int i, Unit& u) const { int pm, pn; if (!map(i, pm, pn)) return false; u.pm = pm; u.pn = pn; u.aux = 0; u.a = A + (size_t)pm * ta; u.b = B + (size_t)pn * tb; return true; }
};
struct BranchOrder : OrderBase {
    const char* A; const char* B; size_t ta, tb, za, zb;
    __device__ __forceinline__ bool next(int i, Unit& u) const { const int ti = i / 3, br = i - 3 * ti; int pm, pn; if (!map(ti, pm, pn)) return false; u.pm = pm; u.pn = pn; u.aux = br;
        u.a = A + (size_t)br * za + (size_t)pm * ta; u.b = B + (size_t)br * zb + (size_t)pn * tb; return true; }
};
struct MoeOrder : OrderBase {
    const char* A; const char* B; size_t ta, tb, zb; int t1, t2, t3, t4, t5, t6, t7;
    __device__ __forceinline__ bool next(int i, Unit& u) const { int pm, pn; if (!map(i, pm, pn)) return false; u.pm = pm; u.pn = pn;
        const int e = (pm >= t1) + (pm >= t2) + (pm >= t3) + (pm >= t4) + (pm >= t5) + (pm >= t6) + (pm >= t7); u.aux = e;
        u.a = A + (size_t)pm * ta; u.b = B + (size_t)e * zb + (size_t)pn * tb; return true; }
};
struct TailOrder {
    int ntail, G, c; const char* A; const char* B; size_t ta, tb, zb, kq; int t1, t2, t3, t4, t5, t6, t7;
    __device__ __forceinline__ bool next(int i, Unit& u) const { const long L = (long)i * G + c; if (L >= ntail) return false; const int l = (int)L, q = l & 3, pn = (l >> 2) & 7, pm = 128 + (l >> 5);
        const int e = (pm >= t1) + (pm >= t2) + (pm >= t3) + (pm >= t4) + (pm >= t5) + (pm >= t6) + (pm >= t7); u.pm = pm; u.pn = pn; u.aux = q;
        u.a = A + (size_t)pm * ta + (size_t)q * kq; u.b = B + (size_t)e * zb + (size_t)pn * tb + (size_t)q * kq; return true; }
    __device__ __forceinline__ void a_ready(const Unit&) const {}
    __device__ __forceinline__ void done(const Unit&) const {}
};
}

constexpr int NTOK = 16384, DM = 2048, SEQ = 2048, NBATCH = 8, NHEAD = 8, HD = 64, DFF = 7168, NEXP = 8;
constexpr int NIN = 10828, NINP = 11008;
constexpr int WBR_W = 512, KVR = 256;
constexpr float EPS = 1e-6f, LOG2E = 1.4426950408889634f, C2 = 0.125f * LOG2E;
constexpr int MOE_ROWS = 2 * NTOK + NEXP * 256;
constexpr int NSTEPS = 24;
constexpr float W8SCALE = 64.f, WD8SCALE = 128.f, H8SCALE = 8.f;

constexpr size_t al256(size_t x) { return (x + 255) & ~(size_t)255; }
constexpr size_t WS_CTL = 0, CTL_ZERO_BYTES = 1u << 20;
constexpr size_t SZ_WIN = (size_t)NINP * DM * 2, SZ_WUKV = (size_t)1024 * KVR * 2, SZ_WBR = (size_t)DM * WBR_W * 2, SZ_WOUT = (size_t)DM * DM * 2;
constexpr size_t SZ_WGU = (size_t)2 * DFF * DM * 2, SZ_WD = (size_t)DM * DFF * 2;
constexpr size_t WS_WIN = CTL_ZERO_BYTES, WS_WUKV = WS_WIN + 2 * SZ_WIN, WS_WBR = WS_WUKV + 2 * SZ_WUKV, WS_WOUT = WS_WBR + 6 * SZ_WBR;
constexpr size_t WS_WGU0 = WS_WOUT + 2 * SZ_WOUT, WS_WD0 = WS_WGU0 + SZ_WGU, WS_WGUM = WS_WD0 + SZ_WD, WS_WDM = WS_WGUM + NEXP * SZ_WGU;
constexpr size_t WS_RSTD = WS_WDM + NEXP * SZ_WD, WS_SSP = WS_RSTD + (size_t)NTOK * 4, WS_XB = WS_SSP + (size_t)NTOK * 32 * 4;
constexpr size_t WS_R = WS_XB + (size_t)NTOK * DM * 2;
constexpr size_t WS_Z8 = WS_R, WS_DLAT = WS_Z8 + (size_t)8 * NTOK * 512 * 2, WS_DIQ = WS_DLAT + (size_t)NTOK * 256 * 2, WS_DIK = WS_DIQ + (size_t)NTOK * 256 * 2;
constexpr size_t WS_FFW = WS_DIK + (size_t)NTOK * 64 * 2, WS_GATES = WS_FFW + (size_t)NTOK * 16 * 4, WS_C2F = WS_GATES + (size_t)NTOK * 6144 * 2;
constexpr size_t WS_DKV = WS_C2F + (size_t)NBATCH * NHEAD * SEQ * 4, WS_SC = WS_DKV + (size_t)NTOK * 1024 * 2, WS_MASK = WS_SC + (size_t)NTOK * SEQ * 4;
constexpr size_t WS_YATT = WS_MASK + (size_t)NTOK * 64 * 4, WS_M = WS_YATT + (size_t)3 * NTOK * 512 * 2, WS_R_END1 = WS_M + (size_t)NTOK * DM * 2;
constexpr size_t WS_HID = WS_R;
constexpr size_t WS_XG = WS_R, WS_HIDM = WS_XG + (size_t)MOE_ROWS * DM * 2, WS_Y = WS_HIDM + (size_t)MOE_ROWS * DFF * 2, WS_ROWTOK = WS_Y + (size_t)2 * NTOK * DM * 4;
constexpr size_t WS_ROWW = WS_ROWTOK + (size_t)MOE_ROWS * 4, WS_RSTDG = WS_ROWW + (size_t)MOE_ROWS * 4, WS_TOKINFO = WS_RSTDG + (size_t)MOE_ROWS * 4;
constexpr size_t WS_TOKW = WS_TOKINFO + (size_t)2 * NTOK * 8, WS_WGCNT = WS_TOKW + (size_t)2 * NTOK * 4, WS_META = WS_WGCNT + 256 * 8 * 4, WS_R_END2 = WS_META + 256;
constexpr size_t WS_END = WS_R_END1 > WS_R_END2 ? WS_R_END1 : WS_R_END2;
constexpr size_t WS_XB8 = WS_WGUM + NEXP * SZ_WGU / 2;
constexpr size_t WS_WING8 = WS_XB8 + (size_t)NTOK * DM;
static_assert(WS_WING8 + (size_t)2 * 6144 * DM <= WS_WDM, "fp8 side buffers fit the freed half of the MoE gate/up region");
static_assert((size_t)2 * NTOK * DM * 2 + (size_t)4 * 2048 * DM * 2 + (size_t)2 * NTOK * 4 <= (size_t)2 * NTOK * DM * 4, "tail partials fit the slack of the Y region");
constexpr int CW_ATTQ = 65536;
constexpr int CW_BAR = 4096;

constexpr int RING_BYTES = 131072, LDSCTL_OFF = RING_BYTES, MISC_OFF = LDSCTL_OFF + 320, LDS_BYTES = 147456;

#define GAS __attribute__((address_space(1)))
#define LAS __attribute__((address_space(3)))
typedef unsigned short bf16_t;
typedef float f32x4 __attribute__((ext_vector_type(4)));
typedef unsigned u32x4 __attribute__((ext_vector_type(4)));
typedef unsigned u32x2 __attribute__((ext_vector_type(2)));
typedef short bf16x8 __attribute__((ext_vector_type(8)));
typedef float f32x16 __attribute__((ext_vector_type(16)));
#define LDS_WAIT() asm volatile("s_waitcnt lgkmcnt(0)" ::: "memory")
#define VM_WAIT() asm volatile("s_waitcnt vmcnt(0)" ::: "memory")
__device__ __forceinline__ float bflo(unsigned w) { return __uint_as_float(w << 16); }
__device__ __forceinline__ float bfhi(unsigned w) { return __uint_as_float(w & 0xffff0000u); }
typedef float f32x2_t __attribute__((ext_vector_type(2))); typedef __bf16 bf16x2_t __attribute__((ext_vector_type(2)));
__device__ __forceinline__ unsigned pk2(float lo, float hi) { f32x2_t v = {lo, hi}; bf16x2_t b = __builtin_convertvector(v, bf16x2_t); return __builtin_bit_cast(unsigned, b); }
__device__ __forceinline__ int opq(int v) { asm volatile("" : "+s"(v)); return v; }
__device__ __forceinline__ float wave_sum(float v) {
#pragma unroll
    for (int o = 1; o < 64; o <<= 1) v += __shfl_xor(v, o);
    return v;
}
__device__ __forceinline__ u32x2 pack8_fp8(const float (&e)[8]) {
    float c[8];
#pragma unroll
    for (int i = 0; i < 8; ++i) c[i] = __builtin_amdgcn_fmed3f(e[i], -448.f, 448.f);
    int w0 = __builtin_amdgcn_cvt_pk_fp8_f32(c[0], c[1], 0, false); w0 = __builtin_amdgcn_cvt_pk_fp8_f32(c[2], c[3], w0, true);
    int w1 = __builtin_amdgcn_cvt_pk_fp8_f32(c[4], c[5], 0, false); w1 = __builtin_amdgcn_cvt_pk_fp8_f32(c[6], c[7], w1, true);
    u32x2 r; r.x = (unsigned)w0; r.y = (unsigned)w1; return r; }
__device__ __forceinline__ float sigm(float v) { return __builtin_amdgcn_rcpf(1.f + __builtin_amdgcn_exp2f(-v * LOG2E)); }
__device__ __forceinline__ float softplus2(float z) { return fmaxf(z, 0.f) + __builtin_amdgcn_logf(1.f + __builtin_amdgcn_exp2f(-fabsf(z))); }

#define XB_TMO      128
#define XB_XCNT(j)  (256  + 64 * (j))
#define XB_XSUB(j)  (1280 + 64 * (j))
#define XB_XGEN(j)  (2304 + 64 * (j))
#define XB_TOP      3328
#define XB_TOPGEN   3392
#define XCD_BAR_WORDS 3456
#define XB_SPIN_CAP (1u << 18)

__device__ __forceinline__ unsigned xb_ld(unsigned* p)              { return __hip_atomic_load(p, __ATOMIC_RELAXED, __HIP_MEMORY_SCOPE_AGENT); }
__device__ __forceinline__ unsigned xb_add(unsigned* p, unsigned v) { return __hip_atomic_fetch_add(p, v, __ATOMIC_RELAXED, __HIP_MEMORY_SCOPE_AGENT); }
__device__ __forceinline__ unsigned xb_xcc_id() { return (unsigned)__builtin_amdgcn_s_getreg((3 << 11) | 20) & 0xFu; }
#define XB_SPIN(cond, bar) do { unsigned _sp = 0; while (cond) { __builtin_amdgcn_s_sleep(1); \
    if ((++_sp & 255u) == 0u) { if (xb_ld(&(bar)[XB_TMO])) break; if (_sp > XB_SPIN_CAP) { atomicAdd(&(bar)[XB_TMO], 1u); break; } } } } while (0)

struct XcdBarrier {
    unsigned* bar; unsigned x;
    volatile LAS unsigned* st;
};

__device__ __forceinline__ XcdBarrier xcd_barrier_post(unsigned* bar, volatile LAS unsigned* st) {
    XcdBarrier b; b.bar = bar; b.x = xb_xcc_id(); b.st = st;
    if (threadIdx.x == 0) (void)xb_add(&bar[XB_XCNT(b.x)], 1u);
    return b;
}
__device__ __forceinline__ void xcd_barrier_complete(unsigned* bar, unsigned x, unsigned& nloc, unsigned& nx) {
    const unsigned G = gridDim.x * gridDim.y * gridDim.z;
    unsigned sum, cnt, mine, sp = 0u;
    for (;;) {
        sum = 0u; cnt = 0u; mine = 0u;
#pragma unroll
        for (unsigned j = 0; j < 16; ++j) { const unsigned c = xb_ld(&bar[XB_XCNT(j)]); sum += c; cnt += (c > 0u) ? 1u : 0u; mine = (j == x) ? c : mine; }
        if (sum == G) break;
        __builtin_amdgcn_s_sleep(1);
        if ((++sp & 255u) == 0u) { if (xb_ld(&bar[XB_TMO])) break; if (sp > XB_SPIN_CAP) { atomicAdd(&bar[XB_TMO], 1u); break; } }
    }
    nloc = mine > 0u ? mine : 1u; nx = cnt > 0u ? cnt : 1u;
}

__device__ __attribute__((noinline)) void xcd_barrier_impl(GAS unsigned* bar_, unsigned x_, LAS unsigned* st_) { XcdBarrier b; b.bar = (unsigned*)bar_; b.x = x_; b.st = st_;
    asm volatile("s_waitcnt vmcnt(0)" ::: "memory");
    __syncthreads();
    if (threadIdx.x == 0) {
        unsigned* bar = b.bar;
        __builtin_amdgcn_s_waitcnt(0);
        unsigned nloc = b.st[0], nx = b.st[1];
        if (nloc == 0u) { xcd_barrier_complete(bar, b.x, nloc, nx); b.st[0] = nloc; b.st[1] = nx; }
        const unsigned old = xb_add(&bar[XB_XSUB(b.x)], 1u);
        const unsigned gen = old / nloc;
        if (old + 1u == (gen + 1u) * nloc) {
            __builtin_amdgcn_fence(__ATOMIC_RELEASE, "agent");
            asm volatile("s_waitcnt vmcnt(0)" ::: "memory");
            const unsigned og = xb_add(&bar[XB_TOP], 1u);
            const unsigned tg = og / nx;
            if (og + 1u == (tg + 1u) * nx) xb_add(&bar[XB_TOPGEN], 1u);
            else XB_SPIN(xb_ld(&bar[XB_TOPGEN]) == tg, bar);
            __builtin_amdgcn_fence(__ATOMIC_ACQUIRE, "agent");
            xb_add(&bar[XB_XGEN(b.x)], 1u);
            asm volatile("s_waitcnt vmcnt(0)" ::: "memory");
        } else {
            XB_SPIN(xb_ld(&bar[XB_XGEN(b.x)]) == gen, bar);
            __builtin_amdgcn_fence(__ATOMIC_ACQUIRE, "agent");
            asm volatile("s_waitcnt vmcnt(0)" ::: "memory");
        }
    }
    __syncthreads();
}
__device__ __forceinline__ void xcd_barrier(const XcdBarrier& b) { xcd_barrier_impl((GAS unsigned*)b.bar, b.x, (LAS unsigned*)b.st); }

#define ACC_T const pg8::f32x4 (&acc)[2][2][4][2]
__device__ __forceinline__ u32x4 pack8(f32x4 v0, f32x4 v1) { u32x4 w; w.x = pk2(v0[0], v0[1]); w.y = pk2(v0[2], v0[3]); w.z = pk2(v1[0], v1[1]); w.w = pk2(v1[2], v1[3]); return w; }
__device__ __forceinline__ f32x4 sigm4(f32x4 v) { f32x4 r; r[0] = sigm(v[0]); r[1] = sigm(v[1]); r[2] = sigm(v[2]); r[3] = sigm(v[3]); return r; }

struct EpiWin {
    static constexpr bool PERM = true, AFTER_DRAIN = false;
    const float* rstd; bf16_t* z8; bf16_t* dlat; bf16_t* diq; bf16_t* dik; float* ffw; bf16_t* gates;
    __device__ __forceinline__ void operator()(ACC_T, const pg8::Unit& u, int wr, int wc, int fr, int fq) const {
        const int row0 = u.pm * 256 + wr * 64 + fr, pn = u.pn, cl = wc * 32 + 8 * fq;
        float rsv[2][4];
#pragma unroll
        for (int ai = 0; ai < 2; ++ai)
#pragma unroll
            for (int m = 0; m < 4; ++m) rsv[ai][m] = rstd[row0 + ai * 128 + m * 16];
        if (pn == 18) {
#pragma unroll
            for (int ai = 0; ai < 2; ++ai)
#pragma unroll
                for (int m = 0; m < 4; ++m) { const int row = row0 + ai * 128 + m * 16; const float rs = rsv[ai][m];
                    const f32x4 v0 = acc[ai][0][m][0] * rs, v1 = acc[ai][0][m][1] * rs;
                    if (cl < 64) *(u32x4*)(dik + (size_t)row * 64 + cl) = pack8(v0, v1);
                    else if (cl == 64) { *(f32x4*)(ffw + (size_t)row * 16) = v0; *(f32x4*)(ffw + (size_t)row * 16 + 4) = v1; }
                    else if (cl == 72) { *(f32x4*)(ffw + (size_t)row * 16 + 8) = v0; } }
            return;
        }
        bf16_t* dst; int ldc, colbase; bool sg = false; float scale = 1.f;
        if (pn < 16) { const int idx = pn >> 1; dst = z8 + (size_t)idx * NTOK * 512; ldc = 512; colbase = (pn & 1) * 256; sg = (idx == 3); scale = (idx == 4 || idx == 7) ? C2 : 1.f; }
        else if (pn == 16) { dst = dlat; ldc = 256; colbase = 0; }
        else if (pn == 17) { dst = diq; ldc = 256; colbase = 0; }
        else { dst = gates; ldc = 6144; colbase = (pn - 19) * 256; sg = true; }
        if (sg) {
#pragma unroll
            for (int ai = 0; ai < 2; ++ai)
#pragma unroll
                for (int m = 0; m < 4; ++m) { const int row = row0 + ai * 128 + m * 16; const float rs = rsv[ai][m]; bf16_t* rowp = dst + (size_t)row * ldc + colbase + cl;
#pragma unroll
                    for (int bj = 0; bj < 2; ++bj) *(u32x4*)(rowp + bj * 128) = pack8(sigm4(acc[ai][bj][m][0] * rs), sigm4(acc[ai][bj][m][1] * rs)); }
        } else {
#pragma unroll
            for (int ai = 0; ai < 2; ++ai)
#pragma unroll
                for (int m = 0; m < 4; ++m) { const int row = row0 + ai * 128 + m * 16; const float rs = rsv[ai][m] * scale; bf16_t* rowp = dst + (size_t)row * ldc + colbase + cl;
#pragma unroll
                    for (int bj = 0; bj < 2; ++bj) *(u32x4*)(rowp + bj * 128) = pack8(acc[ai][bj][m][0] * rs, acc[ai][bj][m][1] * rs); }
        }
    }
};
struct EpiGate {
    static constexpr bool PERM = true, AFTER_DRAIN = false;
    const float* rstd; bf16_t* gates; float scale;
    __device__ __forceinline__ void operator()(ACC_T, const pg8::Unit& u, int wr, int wc, int fr, int fq) const {
        const int row0 = u.pm * 256 + wr * 64 + fr, col0 = u.pn * 256 + wc * 32 + 8 * fq;
        float rsv[2][4];
#pragma unroll
        for (int ai = 0; ai < 2; ++ai)
#pragma unroll
            for (int m = 0; m < 4; ++m) rsv[ai][m] = rstd[row0 + ai * 128 + m * 16];
#pragma unroll
        for (int ai = 0; ai < 2; ++ai)
#pragma unroll
            for (int m = 0; m < 4; ++m) { const int row = row0 + ai * 128 + m * 16; const float rs = rsv[ai][m] * scale; bf16_t* rowp = gates + (size_t)row * 6144 + col0;
#pragma unroll
                for (int bj = 0; bj < 2; ++bj) *(u32x4*)(rowp + bj * 128) = pack8(sigm4(acc[ai][bj][m][0] * rs), sigm4(acc[ai][bj][m][1] * rs)); }
    }
};
struct EpiPlain {
    static constexpr bool PERM = true, AFTER_DRAIN = false;
    bf16_t* O; int ldc;
    __device__ __forceinline__ void operator()(ACC_T, const pg8::Unit& u, int wr, int wc, int fr, int fq) const {
        const int row0 = u.pm * 256 + wr * 64 + fr, col0 = u.pn * 256 + wc * 32 + 8 * fq;
#pragma unroll
        for (int ai = 0; ai < 2; ++ai)
#pragma unroll
            for (int m = 0; m < 4; ++m) { bf16_t* rowp = O + (size_t)(row0 + ai * 128 + m * 16) * ldc + col0;
#pragma unroll
                for (int bj = 0; bj < 2; ++bj) *(u32x4*)(rowp + bj * 128) = pack8(acc[ai][bj][m][0], acc[ai][bj][m][1]); }
    }
};
struct EpiBranch {
    static constexpr bool PERM = true, AFTER_DRAIN = false;
    const bf16_t* gates; bf16_t* M;
    __device__ __forceinline__ void operator()(pg8::f32x4 (&acc)[2][2][4][2], const pg8::Unit& u, int wr, int wc, int fr, int fq) const {
        const int row0 = u.pm * 256 + wr * 64 + fr, col0 = u.pn * 256 + wc * 32 + 8 * fq, br = u.aux;
#pragma unroll
        for (int am = 0; am < 8; ++am) { const int ai = am >> 2, mb = am & 3;
            u32x4 gv[4][2], hv[4][2];
#pragma unroll
            for (int m = mb; m < mb + 1; ++m)
#pragma unroll
                for (int bj = 0; bj < 2; ++bj) { const int row = row0 + ai * 128 + m * 16, col = col0 + bj * 128;
                    gv[m][bj] = *(const u32x4*)(gates + (size_t)row * 6144 + br * 2048 + col);
                    hv[m][bj] = gv[m][bj]; if (br < 2) hv[m][bj] = *(const u32x4*)(gates + (size_t)row * 6144 + (br + 1) * 2048 + col); }
#pragma unroll
            for (int m = mb; m < mb + 1; ++m)
#pragma unroll
                for (int bj = 0; bj < 2; ++bj) { const int row = row0 + ai * 128 + m * 16, col = col0 + bj * 128; const u32x4 g = gv[m][bj], h = hv[m][bj];
                    float f[8] = {bflo(g.x), bfhi(g.x), bflo(g.y), bfhi(g.y), bflo(g.z), bfhi(g.z), bflo(g.w), bfhi(g.w)};
                    if (br < 2) { const float d[8] = {bflo(h.x), bfhi(h.x), bflo(h.y), bfhi(h.y), bflo(h.z), bfhi(h.z), bflo(h.w), bfhi(h.w)};
#pragma unroll
                        for (int i = 0; i < 8; ++i) f[i] = f[i] * __builtin_amdgcn_rcpf(fmaxf(d[i], 1.0e-20f)); }
                    pg8::f32x4& v0 = acc[ai][bj][m][0]; pg8::f32x4& v1 = acc[ai][bj][m][1];
                    v0[0] *= f[0]; v0[1] *= f[1]; v0[2] *= f[2]; v0[3] *= f[3]; v1[0] *= f[4]; v1[1] *= f[5]; v1[2] *= f[6]; v1[3] *= f[7];
                    if (br == 2) { *(u32x4*)(M + (size_t)row * DM + col) = pack8(v0, v1); v0 = (pg8::f32x4){0.f, 0.f, 0.f, 0.f}; v1 = (pg8::f32x4){0.f, 0.f, 0.f, 0.f}; } }
        }
    }
};
struct EpiResid {
    static constexpr bool PERM = true, AFTER_DRAIN = false;
    const float* xold; float* x; bf16_t* xb; float* ssp; unsigned char* xb8; float ascale;
    __device__ __forceinline__ void operator()(ACC_T, const pg8::Unit& u, int wr, int wc, int fr, int fq) const {
        const int row0 = u.pm * 256 + wr * 64 + fr, col0 = u.pn * 256 + wc * 32 + 8 * fq;
#pragma unroll
        for (int am = 0; am < 4; ++am) { const int ai = am >> 1, mb = (am & 1) * 2;
            f32x4 ov[4][2][2];
#pragma unroll
            for (int m = mb; m < mb + 2; ++m)
#pragma unroll
                for (int bj = 0; bj < 2; ++bj) { const size_t off = (size_t)(row0 + ai * 128 + m * 16) * DM + col0 + bj * 128; ov[m][bj][0] = *(const f32x4*)(xold + off); ov[m][bj][1] = *(const f32x4*)(xold + off + 4); }
#pragma unroll
            for (int m = mb; m < mb + 2; ++m) { const int row = row0 + ai * 128 + m * 16; float ss = 0.f;
#pragma unroll
                for (int bj = 0; bj < 2; ++bj) { const size_t off = (size_t)row * DM + col0 + bj * 128;
                    const f32x4 v0 = ov[m][bj][0] + acc[ai][bj][m][0] * ascale, v1 = ov[m][bj][1] + acc[ai][bj][m][1] * ascale;
                    *(f32x4*)(x + off) = v0; *(f32x4*)(x + off + 4) = v1; if (xb) *(u32x4*)(xb + off) = pack8(v0, v1);
                    if (xb8) { const float e[8] = {v0[0], v0[1], v0[2], v0[3], v1[0], v1[1], v1[2], v1[3]}; *(u32x2*)(xb8 + off) = pack8_fp8(e); }
                    ss += (v0[0] * v0[0] + v0[1] * v0[1]) + (v0[2] * v0[2] + v0[3] * v0[3]) + (v1[0] * v1[0] + v1[1] * v1[1]) + (v1[2] * v1[2] + v1[3] * v1[3]); }
                ss += __shfl_xor(ss, 16); ss += __shfl_xor(ss, 32);
                if (fq == 0) ssp[(size_t)row * 32 + u.pn * 4 + wc] = ss; }
        }
    }
};
struct EpiSwiglu {
    static constexpr bool PERM = true, AFTER_DRAIN = false;
    const float* rstd; bf16_t* hid; float oscale; int f8out;
    __device__ __forceinline__ void operator()(ACC_T, const pg8::Unit& u, int wr, int wc, int fr, int fq) const {
        const int row0 = u.pm * 256 + wr * 64 + fr, col0 = u.pn * 128 + wc * 32 + 8 * fq;
        float rsv[2][4];
#pragma unroll
        for (int ai = 0; ai < 2; ++ai)
#pragma unroll
            for (int m = 0; m < 4; ++m) rsv[ai][m] = rstd[row0 + ai * 128 + m * 16];
#pragma unroll
        for (int ai = 0; ai < 2; ++ai)
#pragma unroll
            for (int m = 0; m < 4; ++m) { const int row = row0 + ai * 128 + m * 16; const float rs = rsv[ai][m] * oscale;
                f32x4 h0, h1;
#pragma unroll
                for (int j = 0; j < 4; ++j) { const float g0 = acc[ai][0][m][0][j] * rs, u0 = acc[ai][1][m][0][j] * rs, g1 = acc[ai][0][m][1][j] * rs, u1 = acc[ai][1][m][1][j] * rs;
                    h0[j] = g0 * u0 * sigm(g0); h1[j] = g1 * u1 * sigm(g1); }
                if (f8out) { const float e[8] = {h0[0] * H8SCALE, h0[1] * H8SCALE, h0[2] * H8SCALE, h0[3] * H8SCALE, h1[0] * H8SCALE, h1[1] * H8SCALE, h1[2] * H8SCALE, h1[3] * H8SCALE}; *(u32x2*)((unsigned char*)hid + (size_t)row * DFF + col0) = pack8_fp8(e); }
                else *(u32x4*)(hid + (size_t)row * DFF + col0) = pack8(h0, h1); }
    }
};
struct EpiMoeDown {
    static constexpr bool PERM = true, AFTER_DRAIN = false;
    const int* rowtok; const float* roww; bf16_t* y; float oscale;
    __device__ __forceinline__ void operator()(ACC_T, const pg8::Unit& u, int wr, int wc, int fr, int fq) const {
        const int row0 = u.pm * 256 + wr * 64 + fr, col0 = u.pn * 256 + wc * 32 + 8 * fq;
        int tkv[2][4]; float wv[2][4];
#pragma unroll
        for (int ai = 0; ai < 2; ++ai)
#pragma unroll
            for (int m = 0; m < 4; ++m) { tkv[ai][m] = rowtok[row0 + ai * 128 + m * 16]; wv[ai][m] = roww[row0 + ai * 128 + m * 16]; }
#pragma unroll
        for (int ai = 0; ai < 2; ++ai)
#pragma unroll
            for (int m = 0; m < 4; ++m) { const int tk = tkv[ai][m];
                if (tk >= 0) { const float w = wv[ai][m] * oscale; bf16_t* d = y + (size_t)(tk & 1) * NTOK * DM + (size_t)(tk >> 1) * DM + col0;
#pragma unroll
                    for (int bj = 0; bj < 2; ++bj) *(u32x4*)(d + bj * 128) = pack8(acc[ai][bj][m][0] * w, acc[ai][bj][m][1] * w); } }
    }
};

struct EpiMoeTail {
    static constexpr bool PERM = true, AFTER_DRAIN = false;
    const int* rowtok; const float* roww; bf16_t* yp; float oscale;
    __device__ __forceinline__ void operator()(ACC_T, const pg8::Unit& u, int wr, int wc, int fr, int fq) const {
        const int row0 = u.pm * 256 + wr * 64 + fr, col0 = u.pn * 256 + wc * 32 + 8 * fq;
        int tkv[2][4]; float wv[2][4];
#pragma unroll
        for (int ai = 0; ai < 2; ++ai)
#pragma unroll
            for (int m = 0; m < 4; ++m) { tkv[ai][m] = rowtok[row0 + ai * 128 + m * 16]; wv[ai][m] = roww[row0 + ai * 128 + m * 16]; }
#pragma unroll
        for (int ai = 0; ai < 2; ++ai)
#pragma unroll
            for (int m = 0; m < 4; ++m) { const int row = row0 + ai * 128 + m * 16;
                if (tkv[ai][m] >= 0) { const float w = wv[ai][m] * oscale; bf16_t* d = yp + ((size_t)u.aux * 2048 + (size_t)(row - 32768)) * DM + col0;
#pragma unroll
                    for (int bj = 0; bj < 2; ++bj) *(u32x4*)(d + bj * 128) = pack8(acc[ai][bj][m][0] * w, acc[ai][bj][m][1] * w); } }
    }
};
struct Args { const float* in[22]; float* out; unsigned char* ws; int ph_lo, ph_hi; };

__host__ __device__ __forceinline__ int win_src(int n) {
    if (n < 1536) return n;
    if (n < 2048) return 1544 + (n - 1536);
    if (n < 4096) return 2056 + (n - 2048);
    if (n < 4352) return 4104 + (n - 4096);
    if (n < 4608) return 4360 + (n - 4352);
    if (n < 4672) return 4616 + (n - 4608);
    if (n < 4680) return 1536 + (n - 4672);
    if (n < 4684) return 4680 + (n - 4680);
    if (n < 4864) return -1;
    return 4684 + (n - 4864);
}

__device__ __forceinline__ void conv_item(int map, const float* W0, const float* W1, int K, int Ns, int dstN, bf16_t* WT, const float* gain, LAS float* scr, int it, int lane, float f8scale) {
    const int nblk = dstN >> 5, nit = (K >> 6) * nblk;
    if (it >= nit) return;
    {
        const int kb = it / nblk, nb = it - kb * nblk, k0 = kb << 6, n0 = nb << 5;
        const float* src = W0; int sc;
        if (map == 0) sc = n0 + (lane & 31);
        else if (map == 1) sc = win_src(n0 + (lane & 31));
        else { const int t = nb >> 3, r = nb & 7; src = (r < 4) ? W0 : W1; sc = 128 * t + 32 * (r & 3) + (lane & 31); }
        const float* sp = src + (size_t)k0 * Ns + (sc < 0 ? 0 : sc);
#pragma unroll
        for (int hh = 0; hh < 2; ++hh) { float tv[16];
#pragma unroll
            for (int i = 0; i < 16; ++i) tv[i] = __builtin_nontemporal_load(sp + (size_t)(2 * (16 * hh + i) + (lane >> 5)) * Ns);
#pragma unroll
            for (int i = 0; i < 16; ++i) scr[(2 * (16 * hh + i) + (lane >> 5)) * 33 + (lane & 31)] = (sc < 0) ? 0.f : tv[i]; }
        LDS_WAIT(); asm volatile("" ::: "memory");
        const int c = lane & 7;
        f32x4 g0 = {1.f, 1.f, 1.f, 1.f}, g1 = {1.f, 1.f, 1.f, 1.f};
        if (gain) { g0 = *(const f32x4*)(gain + k0 + 8 * c); g1 = *(const f32x4*)(gain + k0 + 8 * c + 4); }
#pragma unroll
        for (int j = 0; j < 4; ++j) { const int n = (lane >> 3) + 8 * j; const LAS float* s = scr + (8 * c) * 33 + n;
            if (f8scale != 0.f) { const float e[8] = {s[0 * 33] * g0[0] * f8scale, s[1 * 33] * g0[1] * f8scale, s[2 * 33] * g0[2] * f8scale, s[3 * 33] * g0[3] * f8scale, s[4 * 33] * g1[0] * f8scale, s[5 * 33] * g1[1] * f8scale, s[6 * 33] * g1[2] * f8scale, s[7 * 33] * g1[3] * f8scale};
                *(u32x2*)((unsigned char*)WT + (size_t)(n0 + n) * K + k0 + 8 * c) = pack8_fp8(e); }
            else {
            u32x4 o; o.x = pk2(s[0 * 33] * g0[0], s[1 * 33] * g0[1]); o.y = pk2(s[2 * 33] * g0[2], s[3 * 33] * g0[3]); o.z = pk2(s[4 * 33] * g1[0], s[5 * 33] * g1[1]); o.w = pk2(s[6 * 33] * g1[2], s[7 * 33] * g1[3]);
            *(u32x4*)(WT + (size_t)(n0 + n) * K + k0 + 8 * c) = o; } }
        LDS_WAIT(); asm volatile("" ::: "memory");
    }
}
__device__ __forceinline__ void conv_matrix(int map, const float* W0, const float* W1, int K, int Ns, int dstN, bf16_t* WT, const float* gain, LAS float* scr, int gw, int NGW, int lane, float f8scale = 0.f) {
    const int nit = (K >> 6) * (dstN >> 5);
    for (int it = gw; it < nit; it += NGW) conv_item(map, W0, W1, K, Ns, dstN, WT, gain, scr, it, lane, f8scale);
}

namespace att {
constexpr int NSLOT = 4, SLOTB = 8192, L_K = 0, L_V = NSLOT * SLOTB, L_WS = 2 * NSLOT * SLOTB, L_CS = L_WS + 2048, L_LUT = L_CS + NSLOT * 256, L_OST = L_LUT + 512, L_MW = L_OST + 8 * 4096, L_END = L_MW + 8 * NSLOT * 256;
static_assert(L_END <= 131072, "attention LDS image");
typedef short s16x4 __attribute__((ext_vector_type(4)));
constexpr float SB_CUT = 64.f;
__device__ __forceinline__ int crow(int r, int hi) { return (r & 3) + 8 * (r >> 2) + 4 * hi; }
__device__ __forceinline__ void glds16(const void* gsrc, unsigned lds_dst) { unsigned keep;
    asm volatile("s_mov_b32 %0, m0\n\ts_mov_b32 m0, %2\n\ts_nop 0\n\tglobal_load_lds_dwordx4 %1, off\n\ts_mov_b32 m0, %0" : "=&s"(keep) : "v"(gsrc), "s"(lds_dst) : "memory"); }
__device__ __forceinline__ void glds4(const void* gsrc, unsigned lds_dst) { unsigned keep;
    asm volatile("s_mov_b32 %0, m0\n\ts_mov_b32 m0, %2\n\ts_nop 0\n\tglobal_load_lds_dword %1, off\n\ts_mov_b32 m0, %0" : "=&s"(keep) : "v"(gsrc), "s"(lds_dst) : "memory"); }
#define ATT_MFMA(a, b, c) __builtin_amdgcn_mfma_f32_32x32x16_bf16(a, b, c, 0, 0, 0)
__device__ __forceinline__ void qkt(f32x16& p0, f32x16& p1, const LAS unsigned char* Kslot, const bf16x8* qr, int r32, int hi) {
    const LAS unsigned char* kb = Kslot + hi * 1024 + r32 * 16;
#pragma unroll
    for (int d0 = 0; d0 < 4; ++d0) { const bf16x8 b0 = *(const LAS bf16x8*)(kb + d0 * 2048), b1 = *(const LAS bf16x8*)(kb + d0 * 2048 + 512);
        p0 = ATT_MFMA(b0, qr[d0], p0); p1 = ATT_MFMA(b1, qr[d0], p1); }
}
__device__ __forceinline__ void pv(f32x16* o, int vb, bf16x8 pa0, bf16x8 pa1, bf16x8 pa2, bf16x8 pa3) {
#pragma unroll
    for (int d0 = 0; d0 < 2; ++d0) { s16x4 lo[4], hi[4];
#pragma unroll
        for (int ks = 0; ks < 4; ++ks) {
            asm volatile("ds_read_b64_tr_b16 %0,%1 offset:%c2" : "=&v"(lo[ks]) : "v"(vb), "i"(d0 * 4096 + ks * 1024) : "memory");
            asm volatile("ds_read_b64_tr_b16 %0,%1 offset:%c2" : "=&v"(hi[ks]) : "v"(vb), "i"(d0 * 4096 + ks * 1024 + 512) : "memory"); }
        asm volatile("s_waitcnt lgkmcnt(0)" ::: "memory"); __builtin_amdgcn_sched_barrier(0);
#define ATT_PK(k) (bf16x8){lo[k][0], lo[k][1], lo[k][2], lo[k][3], hi[k][0], hi[k][1], hi[k][2], hi[k][3]}
        o[d0] = ATT_MFMA(pa0, ATT_PK(0), o[d0]); o[d0] = ATT_MFMA(pa1, ATT_PK(1), o[d0]); o[d0] = ATT_MFMA(pa2, ATT_PK(2), o[d0]); o[d0] = ATT_MFMA(pa3, ATT_PK(3), o[d0]);
#undef ATT_PK
    }
}
__device__ __forceinline__ void kload(bf16x8 (&kf)[8], unsigned kaddr) {
#pragma unroll
    for (int d0 = 0; d0 < 4; ++d0) {
        asm volatile("ds_read_b128 %0, %1 offset:%c2" : "=&v"(kf[2 * d0]) : "v"(kaddr), "i"(d0 * 2048) : "memory");
        asm volatile("ds_read_b128 %0, %1 offset:%c2" : "=&v"(kf[2 * d0 + 1]) : "v"(kaddr), "i"(d0 * 2048 + 512) : "memory"); }
}
__device__ __forceinline__ void vload(s16x4 (&vf)[16], int vb) {
#pragma unroll
    for (int d0 = 0; d0 < 2; ++d0)
#pragma unroll
        for (int ks = 0; ks < 4; ++ks) {
            asm volatile("ds_read_b64_tr_b16 %0,%1 offset:%c2" : "=&v"(vf[d0 * 8 + ks * 2]) : "v"(vb), "i"(d0 * 4096 + ks * 1024) : "memory");
            asm volatile("ds_read_b64_tr_b16 %0,%1 offset:%c2" : "=&v"(vf[d0 * 8 + ks * 2 + 1]) : "v"(vb), "i"(d0 * 4096 + ks * 1024 + 512) : "memory"); }
}
__device__ __forceinline__ void pvmma(f32x16* o, s16x4 (&vf)[16], bf16x8 pa0, bf16x8 pa1, bf16x8 pa2, bf16x8 pa3) {
    asm volatile("s_waitcnt lgkmcnt(0)" : "+v"(vf[0]), "+v"(vf[1]), "+v"(vf[2]), "+v"(vf[3]), "+v"(vf[4]), "+v"(vf[5]), "+v"(vf[6]), "+v"(vf[7]),
                                          "+v"(vf[8]), "+v"(vf[9]), "+v"(vf[10]), "+v"(vf[11]), "+v"(vf[12]), "+v"(vf[13]), "+v"(vf[14]), "+v"(vf[15]) :: "memory");
#define ATT_PK(d, k) (bf16x8){vf[d * 8 + 2 * k][0], vf[d * 8 + 2 * k][1], vf[d * 8 + 2 * k][2], vf[d * 8 + 2 * k][3], vf[d * 8 + 2 * k + 1][0], vf[d * 8 + 2 * k + 1][1], vf[d * 8 + 2 * k + 1][2], vf[d * 8 + 2 * k + 1][3]}
    o[0] = ATT_MFMA(pa0, ATT_PK(0, 0), o[0]); o[1] = ATT_MFMA(pa0, ATT_PK(1, 0), o[1]); o[0] = ATT_MFMA(pa1, ATT_PK(0, 1), o[0]); o[1] = ATT_MFMA(pa1, ATT_PK(1, 1), o[1]);
    o[0] = ATT_MFMA(pa2, ATT_PK(0, 2), o[0]); o[1] = ATT_MFMA(pa2, ATT_PK(1, 2), o[1]); o[0] = ATT_MFMA(pa3, ATT_PK(0, 3), o[0]); o[1] = ATT_MFMA(pa3, ATT_PK(1, 3), o[1]);
#undef ATT_PK
}
__device__ __forceinline__ float hmax(float v) { const auto rr = __builtin_amdgcn_permlane32_swap(__float_as_uint(v), __float_as_uint(v), false, false); return fmaxf(__uint_as_float(rr[0]), __uint_as_float(rr[1])); }
__device__ __forceinline__ float hsum(float v) { const auto rr = __builtin_amdgcn_permlane32_swap(__float_as_uint(v), __float_as_uint(v), false, false); return __uint_as_float(rr[0]) + __uint_as_float(rr[1]); }

__device__ __forceinline__ void attn_begin(LAS unsigned char* lds, int var, int b, int h, int qb, const bf16_t* K, int pk, const bf16_t* V, int pv_, const float* c2f, const unsigned* mask) {
    int tid = threadIdx.x; asm volatile("" : "+v"(tid));
    const int lane = tid & 63, wid = __builtin_amdgcn_readfirstlane(tid >> 6);
    const size_t rowbase = (size_t)b * SEQ; const int q0 = qb * 256, NT = (q0 + 256) / 64;
    const unsigned lds0 = (unsigned)(uintptr_t)lds;
    const bf16_t* ksrc = K + rowbase * pk + h * 64 + (size_t)lane * pk + wid * 8;
    const bf16_t* vsrc = V + rowbase * pv_ + h * 64 + (size_t)(16 * (wid & 3) + (lane >> 2)) * pv_ + (wid >> 2) * 32 + (lane & 3) * 8;
#pragma unroll
    for (int i = 0; i < 2; ++i) { const int tile = (var == 1) ? NT - 1 - i : i;
        glds16(ksrc + (size_t)tile * 64 * pk, (unsigned)__builtin_amdgcn_readfirstlane(lds0 + L_K + wid * 1024 + i * SLOTB)); glds16(vsrc + (size_t)tile * 64 * pv_, (unsigned)__builtin_amdgcn_readfirstlane(lds0 + L_V + wid * 1024 + i * SLOTB));
        if (var == 0 && wid == 0) glds4(c2f + ((size_t)b * NHEAD + h) * SEQ + tile * 64 + lane, (unsigned)__builtin_amdgcn_readfirstlane(lds0 + L_CS + i * 256));
        if (var == 2) glds4(mask + (rowbase + q0 + wid * 32 + (lane >> 1)) * 64 + (lane & 1) + tile * 2, (unsigned)__builtin_amdgcn_readfirstlane(lds0 + L_MW + (wid * NSLOT + i) * 256)); }
}
template <int N> __device__ __forceinline__ void wait_bar() { asm volatile("s_waitcnt vmcnt(%0) lgkmcnt(0)\n\ts_barrier" :: "n"(N) : "memory"); }
template <int VAR, class Next> __device__ __forceinline__ void attn_unit(LAS unsigned char* lds, unsigned tnext, const Next& next, int b, int h, int qb,
        const bf16_t* Q, const bf16_t* K, int pk, const bf16_t* V, int pv_, const float* c2f, const unsigned* mask, const float* relb, const bf16_t* ogate, bf16_t* O) {
    int tid = threadIdx.x; asm volatile("" : "+v"(tid));
    const int lane = tid & 63, r32 = lane & 31, hi = lane >> 5, wid = __builtin_amdgcn_readfirstlane(tid >> 6);
    const size_t rowbase = (size_t)b * SEQ; const int q0 = qb * 256, qrel = wid * 32 + r32, t = q0 + qrel;
    const unsigned lds0 = (unsigned)(uintptr_t)lds;
    LAS float* wsf = (LAS float*)(lds + L_WS) + wid * 64;
    const bf16_t* Kh = K + rowbase * pk + h * 64; const bf16_t* Vh = V + rowbase * pv_ + h * 64;
    const bf16_t* ksrc = Kh + (size_t)lane * pk + wid * 8;
    const bf16_t* vsrc = Vh + (size_t)(16 * (wid & 3) + (lane >> 2)) * pv_ + (wid >> 2) * 32 + (lane & 3) * 8;
    const unsigned kdst = lds0 + L_K + wid * 1024, vdst = lds0 + L_V + wid * 1024;
    const int vb0 = (int)(lds0 + L_V) + ((lane >> 4) & 1) * 32 + (lane & 3) * 8 + (4 * hi + ((lane & 15) >> 2)) * 64;
    const int NT = (q0 + 256) / 64;
    const float* c2h = c2f + ((size_t)b * NHEAD + h) * SEQ;
#define ATT_DMA(tile, slot) do { glds16(ksrc + (size_t)(tile) * 64 * pk, (unsigned)__builtin_amdgcn_readfirstlane(kdst + (slot) * SLOTB)); glds16(vsrc + (size_t)(tile) * 64 * pv_, (unsigned)__builtin_amdgcn_readfirstlane(vdst + (slot) * SLOTB)); \
        if (VAR == 0 && wid == 0) glds4(c2h + (tile) * 64 + lane, (unsigned)__builtin_amdgcn_readfirstlane(lds0 + L_CS + (slot) * 256)); \
        if (VAR == 2) glds4(mrow + (tile) * 2, (unsigned)__builtin_amdgcn_readfirstlane(lds0 + L_MW + (wid * NSLOT + (slot)) * 256)); } while (0)
#define ATT_TILE(i) ((VAR == 1) ? NT - 1 - (i) : (i))
    const unsigned* mrow = nullptr; if (VAR == 2) mrow = mask + (rowbase + q0 + wid * 32 + (lane >> 1)) * 64 + (lane & 1);
    if (VAR == 2 && tid < 128) {
        int bk; if (tid < 16) bk = tid; else { bk = 16 + (int)(logf((float)tid / 16.0f) / 2.0794415416798357f * 16.0f); if (bk > 31) bk = 31; }
        ((LAS float*)(lds + L_LUT))[tid] = relb[bk * NHEAD + h] * LOG2E; }
    bf16x8 qr[4];
    { const bf16_t* Qw = Q + (rowbase + t) * 512 + h * 64;
#pragma unroll
      for (int d0 = 0; d0 < 4; ++d0) qr[d0] = *(const bf16x8*)(Qw + d0 * 16 + hi * 8); }
    float mrun = -1.0e30f, lrun = 0.f, R = 0.f; bool wdone = false;
    LAS unsigned* votes = (LAS unsigned*)(lds + L_CS);
    f32x16 o[2];
#pragma unroll
    for (int r = 0; r < 16; ++r) { o[0][r] = 0.f; o[1][r] = 0.f; }
    asm volatile("s_waitcnt vmcnt(0) lgkmcnt(0)\n\ts_barrier" ::: "memory");
#pragma unroll
    for (int d0 = 0; d0 < 4; ++d0) asm volatile("" : "+v"(qr[d0]));
#pragma unroll 1
    for (int it2 = 0; it2 < NT; it2 += 2) {
        if (it2 + 2 < NT) { ATT_DMA(ATT_TILE(it2 + 2), (it2 + 2) & (NSLOT - 1)); ATT_DMA(ATT_TILE(it2 + 3), (it2 + 3) & (NSLOT - 1)); }
#pragma unroll 1
        for (int it = it2; it < it2 + 2; ++it) {
        const int tile = ATT_TILE(it), slot = it & (NSLOT - 1);
        const bool active = (tile * 64 <= q0 + wid * 32 + 31) && !(VAR == 1 && wdone);
        if (active) {
        f32x16 p0, p1;
        if (VAR == 0) { const LAS f32x4* cs = (const LAS f32x4*)(lds + L_CS + slot * 256 + 16 * hi);
#pragma unroll
            for (int g = 0; g < 4; ++g) { const f32x4 ca = cs[2 * g], cb = cs[8 + 2 * g];
#pragma unroll
                for (int i = 0; i < 4; ++i) { p0[4 * g + i] = ca[i]; p1[4 * g + i] = cb[i]; } }
        } else {
#pragma unroll
            for (int r = 0; r < 16; ++r) { p0[r] = 0.f; p1[r] = 0.f; } }
        u32x2 mw = {0u, 0u}; float bfar = 0.f;
        if (VAR == 2) { mw = *(const LAS u32x2*)(lds + L_MW + (wid * NSLOT + slot) * 256 + r32 * 8); bfar = ((const LAS float*)(lds + L_LUT))[127]; }
        bf16x8 kf[8]; kload(kf, lds0 + L_K + slot * SLOTB + hi * 1024 + r32 * 16);
        asm volatile("s_waitcnt lgkmcnt(0)" : "+v"(kf[0]), "+v"(kf[1]), "+v"(kf[2]), "+v"(kf[3]), "+v"(kf[4]), "+v"(kf[5]), "+v"(kf[6]), "+v"(kf[7]), "+v"(mw.x), "+v"(mw.y), "+v"(bfar) :: "memory");
#pragma unroll
        for (int d0 = 0; d0 < 4; ++d0) { p0 = ATT_MFMA(kf[2 * d0], qr[d0], p0); p1 = ATT_MFMA(kf[2 * d0 + 1], qr[d0], p1); }
        s16x4 vf[16]; vload(vf, vb0 + slot * SLOTB);
        const int kv0 = tile * 64 + 4 * hi;
        const bool band = (tile * 64 + 63 > q0 + wid * 32);
        f32x16 pw0v, pw1v;
        if (VAR == 1) {
            f32x16 L0, L1;
#pragma unroll
            for (int r = 0; r < 16; ++r) { L0[r] = softplus2(p0[r]); L1[r] = softplus2(p1[r]); }
            if (band) {
#pragma unroll
                for (int r = 0; r < 16; ++r) { const int kv = kv0 + (r & 3) + 8 * (r >> 2); if (kv >= t) L0[r] = 0.f; if (kv + 32 >= t) L1[r] = 0.f; } }
            float G[8], T[8], S[8];
#pragma unroll
            for (int g = 0; g < 4; ++g) { G[g] = (L0[4 * g] + L0[4 * g + 1]) + (L0[4 * g + 2] + L0[4 * g + 3]); G[4 + g] = (L1[4 * g] + L1[4 * g + 1]) + (L1[4 * g + 2] + L1[4 * g + 3]); }
#pragma unroll
            for (int k = 0; k < 8; ++k) T[k] = hsum(G[k]);
            S[7] = 0.f;
#pragma unroll
            for (int k = 6; k >= 0; --k) S[k] = S[k + 1] + T[k + 1];
            const float tot = S[0] + T[0];
#pragma unroll
            for (int g = 0; g < 4; ++g) {
#pragma unroll
                for (int blk = 0; blk < 2; ++blk) { const int k = blk * 4 + g; const float off = R + S[k] + (hi == 0 ? T[k] - G[k] : 0.f);
                    f32x16& Lb = blk ? L1 : L0; f32x16& zb = blk ? p1 : p0; f32x16& ob = blk ? pw1v : pw0v;
                    const float e3 = Lb[4 * g + 3], e2 = e3 + Lb[4 * g + 2], e1 = e2 + Lb[4 * g + 1], e0 = e1 + Lb[4 * g];
                    ob[4 * g + 3] = __builtin_amdgcn_exp2f(zb[4 * g + 3] - (off + e3)); ob[4 * g + 2] = __builtin_amdgcn_exp2f(zb[4 * g + 2] - (off + e2));
                    ob[4 * g + 1] = __builtin_amdgcn_exp2f(zb[4 * g + 1] - (off + e1)); ob[4 * g] = __builtin_amdgcn_exp2f(zb[4 * g] - (off + e0)); } }
            if (band) {
#pragma unroll
                for (int r = 0; r < 16; ++r) { const int kv = kv0 + (r & 3) + 8 * (r >> 2); if (kv >= t) pw0v[r] = 0.f; if (kv + 32 >= t) pw1v[r] = 0.f; } }
            R += tot;
        } else {
            if (VAR == 0) {
                if (band) {
#pragma unroll
                    for (int r = 0; r < 16; ++r) { const int kv = kv0 + (r & 3) + 8 * (r >> 2); if (kv > t) p0[r] = -INFINITY; if (kv + 32 > t) p1[r] = -INFINITY; } }
            } else {
                const LAS float* lut = (const LAS float*)(lds + L_LUT);
                if (tile * 64 + 63 + 113 <= q0 + wid * 32) {
#pragma unroll
                    for (int r = 0; r < 16; ++r) { p0[r] += bfar; p1[r] += bfar; }
                } else {
#pragma unroll
                    for (int r = 0; r < 16; ++r) { const int kv = kv0 + (r & 3) + 8 * (r >> 2); int d0 = t - kv, d1 = d0 - 32; d0 = d0 < 0 ? 0 : (d0 > 127 ? 127 : d0); d1 = d1 < 0 ? 0 : (d1 > 127 ? 127 : d1);
                        p0[r] += lut[d0]; p1[r] += lut[d1]; } }
#pragma unroll
                for (int r = 0; r < 16; ++r) { const int bit = (r & 3) + 8 * (r >> 2) + 4 * hi; if (!((mw.x >> bit) & 1u)) p0[r] = -INFINITY; if (!((mw.y >> bit) & 1u)) p1[r] = -INFINITY; }
            }
            const float nmr = -mrun; f32x16 d0 = p0 + nmr, d1 = p1 + nmr;
            float rx = fmaxf(d0[0], d1[0]);
#pragma unroll
            for (int r = 1; r < 16; ++r) rx = fmaxf(rx, fmaxf(d0[r], d1[r]));
            rx = hmax(rx);
            if (__any(rx > 8.0f)) {
                float rm = fmaxf(p0[0], p1[0]);
#pragma unroll
                for (int r = 1; r < 16; ++r) rm = fmaxf(rm, fmaxf(p0[r], p1[r]));
                rm = hmax(rm);
                const float mnew = fmaxf(mrun, rm), f = __builtin_amdgcn_exp2f(mrun - mnew);
                lrun *= f; if (hi == 0) wsf[r32] = f;
                asm volatile("s_waitcnt lgkmcnt(0)" ::: "memory");
#pragma unroll
                for (int r = 0; r < 16; ++r) { const float fr = wsf[crow(r, hi)]; o[0][r] *= fr; o[1][r] *= fr; }
                mrun = mnew; const float nmn = -mnew; d0 = p0 + nmn; d1 = p1 + nmn;
            }
            float sacc = 0.f;
#pragma unroll
            for (int r = 0; r < 16; ++r) { pw0v[r] = __builtin_amdgcn_exp2f(d0[r]); pw1v[r] = __builtin_amdgcn_exp2f(d1[r]); sacc += pw0v[r] + pw1v[r]; }
            lrun += sacc;
        }
        u32x4 w0, w1, w2, w3;
        w0 = (u32x4){pk2(pw0v[0], pw0v[1]), pk2(pw0v[2], pw0v[3]), pk2(pw0v[4], pw0v[5]), pk2(pw0v[6], pw0v[7])}; w1 = (u32x4){pk2(pw0v[8], pw0v[9]), pk2(pw0v[10], pw0v[11]), pk2(pw0v[12], pw0v[13]), pk2(pw0v[14], pw0v[15])};
        w2 = (u32x4){pk2(pw1v[0], pw1v[1]), pk2(pw1v[2], pw1v[3]), pk2(pw1v[4], pw1v[5]), pk2(pw1v[6], pw1v[7])}; w3 = (u32x4){pk2(pw1v[8], pw1v[9]), pk2(pw1v[10], pw1v[11]), pk2(pw1v[12], pw1v[13]), pk2(pw1v[14], pw1v[15])};
        pvmma(o, vf, __builtin_bit_cast(bf16x8, w0), __builtin_bit_cast(bf16x8, w1), __builtin_bit_cast(bf16x8, w2), __builtin_bit_cast(bf16x8, w3));
        if (VAR == 1) wdone = !__any(R <= SB_CUT);
        }
        }
        const int vbank = (it2 >> 1) & 1;
        if (VAR == 1 && lane == 0) votes[vbank * 8 + wid] = wdone ? 1u : 0u;
        if (tid == 0) *(volatile LAS unsigned*)(lds + MISC_OFF + 260) = tnext;
        wait_bar<0>();
        if (VAR == 1) { const LAS u32x4* vp = (const LAS u32x4*)(votes + vbank * 8); const u32x4 va = vp[0], vb = vp[1]; if ((va.x & va.y & va.z & va.w & vb.x & vb.y & vb.z & vb.w) != 0u) break; }
    }
    if (VAR == 1) asm volatile("s_waitcnt vmcnt(0)\n\ts_barrier" ::: "memory");
    next();
    u32x4 ogv[4] = {};
    if (VAR == 0) {
#pragma unroll
        for (int i = 0; i < 4; ++i) ogv[i] = *(const u32x4*)(ogate + (rowbase + q0 + wid * 32 + i * 8 + (lane >> 3)) * 512 + h * 64 + (lane & 7) * 8); }
    float linv = 1.f;
    if (VAR != 1) { const float lt = hsum(lrun); linv = 1.0f / lt; }
    if (hi == 0) wsf[32 + r32] = linv; asm volatile("s_waitcnt lgkmcnt(0)" ::: "memory");
    { LAS bf16_t* stg = (LAS bf16_t*)(lds + L_OST) + wid * 2048;
#pragma unroll
      for (int r = 0; r < 16; ++r) { const int orow = crow(r, hi); const float li = wsf[32 + orow];
#pragma unroll
          for (int d0 = 0; d0 < 2; ++d0) stg[orow * 64 + d0 * 32 + r32] = (bf16_t)(pk2(o[d0][r] * li, 0.f) & 0xffffu); }
      asm volatile("s_waitcnt lgkmcnt(0)" ::: "memory");
      bf16_t* Ow = O + (rowbase + q0 + wid * 32) * 512 + h * 64;
#pragma unroll
      for (int i = 0; i < 4; ++i) { const int row = i * 8 + (lane >> 3), ch = lane & 7; u32x4 v = *(const LAS u32x4*)(stg + row * 64 + ch * 8);
          if (VAR == 0) { const u32x4 g = ogv[i];
              v.x = pk2(bflo(v.x) * bflo(g.x), bfhi(v.x) * bfhi(g.x)); v.y = pk2(bflo(v.y) * bflo(g.y), bfhi(v.y) * bfhi(g.y)); v.z = pk2(bflo(v.z) * bflo(g.z), bfhi(v.z) * bfhi(g.z)); v.w = pk2(bflo(v.w) * bflo(g.w), bfhi(v.w) * bfhi(g.w)); }
          *(u32x4*)(Ow + (size_t)row * 512 + ch * 8) = v; } }
    asm volatile("s_waitcnt lgkmcnt(0)\n\ts_barrier" ::: "memory");
#undef ATT_DMA
#undef ATT_TILE
}
}

typedef __attribute__((address_space(4))) const char* kptr_t; typedef const float* cfp_t; typedef const __attribute__((address_space(4))) cfp_t* kslot_t;
__device__ __forceinline__ const float* arg_ptr(int i) { kptr_t ka = (kptr_t)__builtin_amdgcn_kernarg_segment_ptr(); asm volatile("" : "+s"(ka)); return *(kslot_t)(ka + 8 * i); }
#define x_in arg_ptr(0)
#define w_in arg_ptr(1)
#define b_forget arg_ptr(2)
#define q_norm arg_ptr(3)
#define k_norm arg_ptr(4)
#define kv_norm arg_ptr(5)
#define w_ukv arg_ptr(6)
#define w_br0 arg_ptr(7)
#define w_br1 arg_ptr(8)
#define w_br2 arg_ptr(9)
#define w_out arg_ptr(10)
#define rel_bias arg_ptr(11)
#define norm_mix arg_ptr(12)
#define norm_ffn arg_ptr(13)
#define w_fg arg_ptr(14)
#define w_fu arg_ptr(15)
#define w_fd arg_ptr(16)
#define w_router arg_ptr(17)
#define w_mg arg_ptr(18)
#define w_mu arg_ptr(19)
#define w_md arg_ptr(20)
#define norm_final arg_ptr(21)
#define X ((float*)arg_ptr(22))
#define WIN ((bf16_t*)(ws + WS_WIN))
#define WUKV ((bf16_t*)(ws + WS_WUKV))
#define WBR ((bf16_t*)(ws + WS_WBR))
#define WOUT ((bf16_t*)(ws + WS_WOUT))
#define WGU0 ((bf16_t*)(ws + WS_WGU0))
#define WD0 ((bf16_t*)(ws + WS_WD0))
#define WGUM ((bf16_t*)(ws + WS_WGUM))
#define WDM ((bf16_t*)(ws + WS_WDM))
#define RSTD ((float*)(ws + WS_RSTD))
#define SSP ((float*)(ws + WS_SSP))
#define XB ((bf16_t*)(ws + WS_XB))
#define Z8 ((bf16_t*)(ws + WS_Z8))
#define DLAT ((bf16_t*)(ws + WS_DLAT))
#define DIQ ((bf16_t*)(ws + WS_DIQ))
#define DIK ((bf16_t*)(ws + WS_DIK))
#define FFW ((float*)(ws + WS_FFW))
#define GATES ((bf16_t*)(ws + WS_GATES))
#define C2F ((float*)(ws + WS_C2F))
#define DKV ((bf16_t*)(ws + WS_DKV))
#define SC ((float*)(ws + WS_SC))
#define MASK ((unsigned*)(ws + WS_MASK))
#define YATT ((bf16_t*)(ws + WS_YATT))
#define MB ((bf16_t*)(ws + WS_M))
#define HID ((bf16_t*)(ws + WS_HID))
#define XG ((bf16_t*)(ws + WS_XG))
#define XB8 ((unsigned char*)(ws + WS_XB8))
#define WING8 ((unsigned char*)(ws + WS_WING8))
#define HIDM ((bf16_t*)(ws + WS_HIDM))
#define Y ((bf16_t*)(ws + WS_Y))
#define YP ((bf16_t*)(ws + WS_Y + (size_t)2 * NTOK * DM * 2))
#define POSR ((int*)(ws + WS_Y + (size_t)2 * NTOK * DM * 2 + (size_t)4 * 2048 * DM * 2))
#define ROWTOK ((int*)(ws + WS_ROWTOK))
#define ROWW ((float*)(ws + WS_ROWW))
#define RSTDG ((float*)(ws + WS_RSTDG))
#define TOKINFO ((int*)(ws + WS_TOKINFO))
#define TOKW ((float*)(ws + WS_TOKW))
#define WGCNT ((int*)(ws + WS_WGCNT))
#define META ((int*)(ws + WS_META))


struct Bg { unsigned char* ws; LAS float* scr; int l, gw, next, end, inflight; float tv[32]; f32x4 g0, g1; };
struct BgJob { int map, K, Ns, dstN, it; const float* W0; const float* W1; bf16_t* WT; const float* gain; float f8s; };
__device__ __forceinline__ BgJob bg_job(const Bg& B, int slot) {
    unsigned char* ws = B.ws; BgJob J; J.map = 0; J.K = DM; J.Ns = DM; J.dstN = DM; J.W0 = nullptr; J.W1 = nullptr; J.WT = nullptr; J.gain = nullptr; J.f8s = 0.f; int q = 0, es = -1, e = 0;
    if (B.l == 1) { e = 3 + slot / 11; es = slot - (slot / 11) * 11; }
    else if (slot >= 22) { e = (slot - 22) / 11; es = (slot - 22) - e * 11; }
    else if (slot < 7) { J.map = 2; J.W0 = w_fg; J.W1 = w_fu; J.K = DM; J.Ns = DFF; J.dstN = 2 * DFF; J.WT = WGU0; J.gain = norm_ffn; q = slot; }
    else if (slot < 11) { J.W0 = w_fd; J.K = DFF; J.Ns = DM; J.dstN = DM; J.WT = WD0; J.f8s = WD8SCALE; q = slot - 7; }
    else if (slot < 14) { J.map = 1; J.W0 = w_in + (size_t)DM * NIN; J.K = DM; J.Ns = NIN; J.dstN = 19 * 256; J.WT = WIN + (size_t)NINP * DM; J.gain = norm_mix + DM; q = slot - 11; }
    else if (slot < 17) { J.W0 = w_in + (size_t)DM * NIN + 4684; J.K = DM; J.Ns = NIN; J.dstN = 6144; J.WT = (bf16_t*)(WING8 + (size_t)6144 * DM); J.gain = norm_mix + DM; J.f8s = W8SCALE; q = slot - 14; }
    else if (slot == 17) { J.W0 = w_ukv + (size_t)KVR * 1024; J.K = KVR; J.Ns = 1024; J.dstN = 1024; J.WT = WUKV + (size_t)1024 * KVR; J.gain = kv_norm + KVR; }
    else if (slot < 21) { const int i = slot - 18; J.W0 = (i == 0 ? w_br0 : (i == 1 ? w_br1 : w_br2)) + (size_t)WBR_W * DM; J.K = WBR_W; J.Ns = DM; J.dstN = DM; J.WT = WBR + (size_t)(3 + i) * DM * WBR_W; }
    else { J.W0 = w_out + (size_t)DM * DM; J.K = DM; J.Ns = DM; J.dstN = DM; J.WT = WOUT + (size_t)DM * DM; }
    if (es >= 0) {
        if (es < 7) { J.map = 2; J.W0 = w_mg + (size_t)e * DM * DFF; J.W1 = w_mu + (size_t)e * DM * DFF; J.K = DM; J.Ns = DFF; J.dstN = 2 * DFF; J.WT = (bf16_t*)((unsigned char*)WGUM + (size_t)e * 2 * DFF * DM); J.gain = norm_ffn + DM; J.f8s = W8SCALE; q = es; }
        else { J.W0 = w_md + (size_t)e * DFF * DM; J.K = DFF; J.Ns = DM; J.dstN = DM; J.WT = (bf16_t*)((unsigned char*)WDM + (size_t)e * DM * DFF); J.f8s = WD8SCALE; q = es - 7; } }
    J.it = B.gw + q * 2048; return J;
}
__device__ __forceinline__ void bg_src(const BgJob& J, int lane, const char*& ub, unsigned& loff, int& sc, int& k0, int& n0) {
    const int nblk = J.dstN >> 5, kb = J.it / nblk, nb = J.it - kb * nblk; k0 = kb << 6; n0 = nb << 5; const float* src = J.W0; int scu;
    if (J.map == 0) { scu = n0; sc = n0 + (lane & 31); }
    else if (J.map == 1) { scu = 0; sc = win_src(n0 + (lane & 31)); }
    else { const int t = nb >> 3, r = nb & 7; src = (r < 4) ? J.W0 : J.W1; scu = 128 * t + 32 * (r & 3); sc = scu + (lane & 31); }
    ub = (const char*)(src + (size_t)k0 * J.Ns + scu); loff = (unsigned)(((lane >> 5) * J.Ns + ((sc < 0 ? 0 : sc) - scu)) * 4);
}
__device__ __forceinline__ bool bg_issue(Bg& B, int slot, bool want, int lane) {
    const BgJob J = bg_job(B, slot); const bool valid = want && J.it < (J.K >> 6) * (J.dstN >> 5);
    const char* ub; unsigned loff; int sc, k0, n0; bg_src(J, lane, ub, loff, sc, k0, n0); size_t rs2 = (size_t)J.Ns * 8;
    if (!valid) { ub = (const char*)norm_ffn; loff = (unsigned)(lane * 4); rs2 = 256; }
    B.g0 = (f32x4){1.f, 1.f, 1.f, 1.f}; B.g1 = B.g0; if (valid && J.gain) { B.g0 = *(const f32x4*)(J.gain + k0 + 8 * (lane & 7)); B.g1 = *(const f32x4*)(J.gain + k0 + 8 * (lane & 7) + 4); }
#pragma unroll
    for (int i = 0; i < 32; ++i) B.tv[i] = __builtin_nontemporal_load((const float*)(ub + (size_t)i * rs2 + loff));
    return valid;
}
__device__ __forceinline__ void bg_finish(Bg& B, int slot, int lane) {
    const BgJob J = bg_job(B, slot); const char* ub; unsigned loff; int sc, k0, n0; bg_src(J, lane, ub, loff, sc, k0, n0); LAS float* scr = B.scr; const int K = J.K;
#pragma unroll
    for (int i = 0; i < 32; ++i) scr[(2 * i + (lane >> 5)) * 33 + (lane & 31)] = (sc < 0) ? 0.f : B.tv[i];
    LDS_WAIT(); asm volatile("" ::: "memory");
    const int c = lane & 7; const float f8scale = J.f8s;
    const f32x4 g0 = B.g0, g1 = B.g1;
#pragma unroll
    for (int j = 0; j < 4; ++j) { const int n = (lane >> 3) + 8 * j; const LAS float* s = scr + (8 * c) * 33 + n;
        if (f8scale != 0.f) { const float e[8] = {s[0 * 33] * g0[0] * f8scale, s[1 * 33] * g0[1] * f8scale, s[2 * 33] * g0[2] * f8scale, s[3 * 33] * g0[3] * f8scale, s[4 * 33] * g1[0] * f8scale, s[5 * 33] * g1[1] * f8scale, s[6 * 33] * g1[2] * f8scale, s[7 * 33] * g1[3] * f8scale};
            __builtin_nontemporal_store(pack8_fp8(e), (u32x2*)((unsigned char*)J.WT + (size_t)(n0 + n) * K + k0 + 8 * c)); }
        else { u32x4 o; o.x = pk2(s[0 * 33] * g0[0], s[1 * 33] * g0[1]); o.y = pk2(s[2 * 33] * g0[2], s[3 * 33] * g0[3]); o.z = pk2(s[4 * 33] * g1[0], s[5 * 33] * g1[1]); o.w = pk2(s[6 * 33] * g1[2], s[7 * 33] * g1[3]);
            __builtin_nontemporal_store(o, (u32x4*)(J.WT + (size_t)(n0 + n) * K + k0 + 8 * c)); } }
    LDS_WAIT(); asm volatile("" ::: "memory");
}
__device__ __forceinline__ void bg_tick(Bg& B, int lane) {
    if (B.inflight >= 0) { bg_finish(B, B.inflight, lane); B.inflight = -1; }
    const bool want = B.next < B.end; const int slot = want ? B.next : B.end - 1;
    if (bg_issue(B, slot, want, lane)) B.inflight = slot;
    if (want) ++B.next;
}

template <int NJ> __device__ __forceinline__ void select_core(const float* sc_row, unsigned* mask_row, int t, int lane, LAS unsigned* hist, Bg& B) {
    unsigned key[NJ];
#pragma unroll
    for (int j = 0; j < NJ; ++j) { const int s = 64 * j + lane; const unsigned u = __float_as_uint(sc_row[s <= t ? s : t]); const unsigned k = (u & 0x80000000u) ? ~u : (u | 0x80000000u); key[j] = (s <= t) ? k : 0u; }
    unsigned prefix = 0u; int need = 256;
#pragma unroll
    for (int lv = 0; lv < 4; ++lv) { const int shift = 24 - 8 * lv; const unsigned pmask = (lv == 0) ? 0u : (0xffffffffu << (shift + 8));
        { unsigned zz = 0u; asm volatile("" : "+v"(zz)); *(LAS u32x4*)(hist + 4 * lane) = (u32x4){zz, zz, zz, zz}; }
#pragma unroll
        for (int j = 0; j < NJ; ++j) if (key[j] != 0u && (key[j] & pmask) == prefix) atomicAdd((unsigned*)(hist + ((key[j] >> shift) & 255u)), 1u);
        const u32x4 hv = *(const LAS u32x4*)(hist + 4 * lane);
        const int mys = (int)(hv.x + hv.y + hv.z + hv.w); int inc = mys;
#pragma unroll
        for (int o = 1; o < 64; o <<= 1) { const int tv = __shfl_down(inc, o); if (lane + o < 64) inc += tv; }
        const int c3 = inc - mys, c2 = c3 + (int)hv.w, c1 = c2 + (int)hv.z, c0 = c1 + (int)hv.y;
        int fd = -1, fc = 0;
        if (c3 < need && need <= c3 + (int)hv.w) { fd = 3; fc = c3; } else if (c2 < need && need <= c2 + (int)hv.z) { fd = 2; fc = c2; }
        else if (c1 < need && need <= c1 + (int)hv.y) { fd = 1; fc = c1; } else if (c0 < need && need <= c0 + (int)hv.x) { fd = 0; fc = c0; }
        const unsigned long long fb = __ballot(fd >= 0); const int src = (int)__builtin_ctzll(fb | (1ull << 63));
        const int D = __shfl(4 * lane + fd, src), CA = __shfl(fc, src);
        prefix |= (unsigned)D << shift; need -= CA;
        bg_tick(B, lane);
    }
    const unsigned T = prefix;
    int run = 0; unsigned myw = 0u;
#pragma unroll
    for (int j = 0; j < NJ; ++j) { const bool eq = key[j] == T; const unsigned long long beq = __ballot(eq);
        const int pre = run + (int)__builtin_amdgcn_mbcnt_hi((unsigned)(beq >> 32), __builtin_amdgcn_mbcnt_lo((unsigned)beq, 0u));
        const bool sel = (key[j] > T) || (eq && pre < need); run += __popcll(beq);
        const unsigned long long bs = __ballot(sel); myw = (lane == 2 * j) ? (unsigned)bs : myw; myw = (lane == 2 * j + 1) ? (unsigned)(bs >> 32) : myw; }
    mask_row[lane] = myw;
    bg_tick(B, lane);
}
__device__ __forceinline__ void select_row(const float* sc_row, unsigned* mask_row, int t, int lane, LAS unsigned* hist, Bg& B) {
    asm volatile("" : "+v"(lane));
    if (t < 256) { const int lo = 32 * lane; mask_row[lane] = (t >= lo + 31) ? 0xffffffffu : (t < lo ? 0u : ((2u << (t - lo)) - 1u)); return; }
    if (t < 512) select_core<8>(sc_row, mask_row, t, lane, hist, B);
    else if (t < 1024) select_core<16>(sc_row, mask_row, t, lane, hist, B);
    else if (t < 1536) select_core<24>(sc_row, mask_row, t, lane, hist, B);
    else select_core<32>(sc_row, mask_row, t, lane, hist, B);
}

__global__ void __launch_bounds__(512, 2) mk_fwd(Args args) {
    extern __shared__ __attribute__((aligned(16))) unsigned char lds_raw[];
    LAS unsigned char* lds = (LAS unsigned char*)lds_raw;
    volatile LAS unsigned* MISC = (volatile LAS unsigned*)(lds + MISC_OFF);
    constexpr int G = 256, NGW = G * 8;
    const int bid = blockIdx.x; __builtin_assume(bid >= 0 && bid < G);
    unsigned* ctl = (unsigned*)((unsigned char*)arg_ptr(23) + WS_CTL);
    for (int u = threadIdx.x; u < (LDS_BYTES - LDSCTL_OFF) / 4; u += 512) ((LAS unsigned*)(lds + LDSCTL_OFF))[u] = 0u;
#define SITE_PROLOG unsigned char* ws = (unsigned char*)arg_ptr(23); int tid = threadIdx.x; asm volatile("" : "+v"(tid)); \
    const int lane = tid & 63, wave = __builtin_amdgcn_readfirstlane(tid >> 6), gw = bid * 8 + wave; (void)ws; (void)lane; (void)gw;
    __syncthreads();
#if MK_ONE_LAUNCH && DBG_STOP < 0
    constexpr int lo = 0, hi = NSTEPS;
#else
    const int lo = args.ph_lo, hi = args.ph_hi;
#endif
    XcdBarrier bar; bar.bar = ctl + CW_BAR; bar.x = 0; bar.st = nullptr;
    if (hi - lo > 1) bar = xcd_barrier_post(ctl + CW_BAR, MISC + 8);
    int step = 0;
#define STEP_IF if (step >= lo && step < hi)
#ifndef PROBE_AMP
#define PROBE_AMP 1ull
#endif
#ifdef PROBE_MASK
    unsigned long long pr_prev = wall_clock64(), pr_acc = 0ull;
#define STEP_END do { if (step >= lo && step + 1 < hi) xcd_barrier(bar); { const unsigned long long pr_t = wall_clock64(); if ((PROBE_MASK >> step) & 1u) pr_acc += pr_t - pr_prev; pr_prev = pr_t; } ++step; } while (0)
#else
#define STEP_END do { if (step >= lo && step + 1 < hi) xcd_barrier(bar); ++step; } while (0)
#endif

    if (SITE_ON(0)) STEP_IF { SITE_PROLOG
        LAS float* scr = (LAS float*)(lds + wave * 16384);
        { const int l = 0;
            conv_matrix(1, w_in + (size_t)l * DM * NIN, nullptr, DM, NIN, 19 * 256, WIN + (size_t)l * NINP * DM, norm_mix + l * DM, scr, gw, NGW, lane);
            conv_matrix(0, w_in + (size_t)l * DM * NIN + 4684, nullptr, DM, NIN, 6144, (bf16_t*)(WING8 + (size_t)l * 6144 * DM), norm_mix + l * DM, scr, gw, NGW, lane, W8SCALE);
            conv_matrix(0, w_ukv + (size_t)l * KVR * 1024, nullptr, KVR, 1024, 1024, WUKV + (size_t)l * 1024 * KVR, kv_norm + l * KVR, scr, gw, NGW, lane);
            conv_matrix(0, w_br0 + (size_t)l * WBR_W * DM, nullptr, WBR_W, DM, DM, WBR + (size_t)(l * 3 + 0) * DM * WBR_W, nullptr, scr, gw, NGW, lane);
            conv_matrix(0, w_br1 + (size_t)l * WBR_W * DM, nullptr, WBR_W, DM, DM, WBR + (size_t)(l * 3 + 1) * DM * WBR_W, nullptr, scr, gw, NGW, lane);
            conv_matrix(0, w_br2 + (size_t)l * WBR_W * DM, nullptr, WBR_W, DM, DM, WBR + (size_t)(l * 3 + 2) * DM * WBR_W, nullptr, scr, gw, NGW, lane);
            conv_matrix(0, w_out + (size_t)l * DM * DM, nullptr, DM, DM, DM, WOUT + (size_t)l * DM * DM, nullptr, scr, gw, NGW, lane);
        }
        for (int m = gw; m < NTOK; m += NGW) {
            const f32x4* xr = (const f32x4*)(x_in + (size_t)m * DM) + lane; f32x4 v[8]; float s = 0.f;
#pragma unroll
            for (int j = 0; j < 8; ++j) { v[j] = xr[64 * j]; s += (v[j][0] * v[j][0] + v[j][1] * v[j][1]) + (v[j][2] * v[j][2] + v[j][3] * v[j][3]); }
            s = wave_sum(s);
            u32x2* o = (u32x2*)(XB + (size_t)m * DM) + lane;
#pragma unroll
            for (int j = 0; j < 8; ++j) { u32x2 w; w.x = pk2(v[j][0], v[j][1]); w.y = pk2(v[j][2], v[j][3]); o[64 * j] = w; }
            { unsigned* o8 = (unsigned*)(XB8 + (size_t)m * DM) + lane;
#pragma unroll
              for (int j = 0; j < 8; ++j) { const float c0 = __builtin_amdgcn_fmed3f(v[j][0], -448.f, 448.f), c1 = __builtin_amdgcn_fmed3f(v[j][1], -448.f, 448.f), c2 = __builtin_amdgcn_fmed3f(v[j][2], -448.f, 448.f), c3 = __builtin_amdgcn_fmed3f(v[j][3], -448.f, 448.f);
                  int w = __builtin_amdgcn_cvt_pk_fp8_f32(c0, c1, 0, false); w = __builtin_amdgcn_cvt_pk_fp8_f32(c2, c3, w, true); o8[64 * j] = (unsigned)w; } }
            if (lane == 0) RSTD[m] = 1.0f / sqrtf(s * (1.0f / DM) + EPS);
        }
    }
    STEP_END;

    for (int l = 0; l < 2; ++l) {
        if (SITE_ON(1)) STEP_IF { SITE_PROLOG
            { pg8::PlainOrder S; S.init(NTOK / 256, 19, G, bid); S.A = (const char*)XB; S.ta = (size_t)256 * DM * 2; S.B = (const char*)(WIN + (size_t)l * NINP * DM); S.tb = (size_t)256 * DM * 2;
              EpiWin E{RSTD, Z8, DLAT, DIQ, DIK, FFW, GATES};
              pg8::gemm_phase<EpiWin, pg8::PlainOrder, true, true>(lds, pg8::Gemm{opq(DM), 0}, S, E); }
            { pg8::PlainOrder S; S.init(NTOK / 256, 24, G, bid); S.A = (const char*)XB8; S.ta = (size_t)256 * DM; S.B = (const char*)(WING8 + (size_t)l * 6144 * DM); S.tb = (size_t)256 * DM;
              EpiGate E{RSTD, GATES, 1.0f / W8SCALE};
              pg8::gemm_phase8<EpiGate, pg8::PlainOrder, true, true>(lds, pg8::Gemm{opq(DM / 2), 0}, S, E); }
        }
        STEP_END;
        if (SITE_ON(2)) STEP_IF { SITE_PROLOG
            {
                const float* gq = q_norm + l * HD + 8 * (lane & 7); const float* gk = k_norm + l * HD + 8 * (lane & 7);
                const f32x4 gq0 = *(const f32x4*)gq, gq1 = *(const f32x4*)(gq + 4), gk0 = *(const f32x4*)gk, gk1 = *(const f32x4*)(gk + 4);
                auto headnorm = [&](const u32x4 w, const f32x4 g0, const f32x4 g1, const float mul) -> u32x4 {
                    float v[8] = {bflo(w.x), bfhi(w.x), bflo(w.y), bfhi(w.y), bflo(w.z), bfhi(w.z), bflo(w.w), bfhi(w.w)}; float ss = 0.f;
#pragma unroll
                    for (int i = 0; i < 8; ++i) ss += v[i] * v[i];
                    ss += __shfl_xor(ss, 1); ss += __shfl_xor(ss, 2); ss += __shfl_xor(ss, 4);
                    const float rs = (1.0f / sqrtf(ss * (1.0f / 64.0f) + EPS)) * mul;
                    u32x4 o; o.x = pk2(v[0] * rs * g0[0], v[1] * rs * g0[1]); o.y = pk2(v[2] * rs * g0[2], v[3] * rs * g0[3]); o.z = pk2(v[4] * rs * g1[0], v[5] * rs * g1[1]); o.w = pk2(v[6] * rs * g1[2], v[7] * rs * g1[3]);
                    return o; };
#pragma unroll 1
                for (int mb = 0; mb < 8; mb += 4) { u32x4 wq[4], wk[4]; u32x2 wl[4];
#pragma unroll
                    for (int r = 0; r < 4; ++r) { const size_t m = (size_t)gw + (size_t)(mb + r) * NGW;
                        wq[r] = *(const u32x4*)(Z8 + m * 512 + 8 * lane); wk[r] = *(const u32x4*)(Z8 + (size_t)NTOK * 512 + m * 512 + 8 * lane); wl[r] = *(const u32x2*)(DLAT + m * 256 + 4 * lane); }
#pragma unroll
                    for (int r = 0; r < 4; ++r) { const size_t m = (size_t)gw + (size_t)(mb + r) * NGW;
                        const u32x4 oq = headnorm(wq[r], gq0, gq1, C2), ok = headnorm(wk[r], gk0, gk1, 1.0f);
                        const float a0 = bflo(wl[r].x), a1 = bfhi(wl[r].x), a2 = bflo(wl[r].y), a3 = bfhi(wl[r].y);
                        const float ss = wave_sum((a0 * a0 + a1 * a1) + (a2 * a2 + a3 * a3)); const float rs = 1.0f / sqrtf(ss * (1.0f / 256.0f) + EPS);
                        u32x2 ol; ol.x = pk2(a0 * rs, a1 * rs); ol.y = pk2(a2 * rs, a3 * rs);
                        *(u32x4*)(Z8 + m * 512 + 8 * lane) = oq; *(u32x4*)(Z8 + (size_t)NTOK * 512 + m * 512 + 8 * lane) = ok; *(u32x2*)(DLAT + m * 256 + 4 * lane) = ol; }
                }
            }
            if (bid < NBATCH * NHEAD) {
                const int b = bid >> 3, h = bid & 7; const float bias = b_forget[l * NHEAD + h]; LAS float* wt = (LAS float*)lds;
                const float* fp = FFW + ((size_t)b * SEQ + 4 * tid) * 16 + h; float v[4]; float tot = 0.f;
#pragma unroll
                for (int i = 0; i < 4; ++i) { tot += -softplus2(-(fp[i * 16] + bias) * LOG2E); v[i] = tot; }
                float inc = tot;
#pragma unroll
                for (int o = 1; o < 64; o <<= 1) { const float tv = __shfl_up(inc, o); if (lane >= o) inc += tv; }
                __syncthreads(); if (lane == 63) wt[wave] = inc; __syncthreads();
                float base = inc - tot;
                for (int w = 0; w < wave; ++w) base += wt[w];
                *(f32x4*)(C2F + ((size_t)b * NHEAD + h) * SEQ + 4 * tid) = (f32x4){-(base + v[0]), -(base + v[1]), -(base + v[2]), -(base + v[3])};
            }
            {
                const int id = bid * 8 + wave, b = id >> 8, rr = id & 255;
                int g, base; if (rr < 10) { g = 0; base = 0; } else if (rr < 30) { g = 1; base = 10; } else if (rr < 60) { g = 2; base = 30; } else if (rr < 100) { g = 3; base = 60; } else if (rr < 150) { g = 4; base = 100; } else if (rr < 210) { g = 5; base = 150; } else { g = 6; base = 210; }
                const int off = rr - base, tt = 10 * g + off / (g + 1), cch = off - (off / (g + 1)) * (g + 1);
                if (rr < 238) {
                int ln = lane; asm volatile("" : "+v"(ln)); const int r32 = ln & 31, hh = ln >> 5; const size_t trow = (size_t)b * SEQ + tt * 32 + r32;
                bf16x8 bq[4][4];
#pragma unroll
                for (int h = 0; h < 4; ++h)
#pragma unroll
                    for (int d0 = 0; d0 < 4; ++d0) bq[h][d0] = *(const bf16x8*)(DIQ + trow * 256 + h * 64 + d0 * 16 + 8 * hh);
                const f32x4 wv = *(const f32x4*)(FFW + trow * 16 + 8) * 0.0625f;
                const int st0 = cch * 10, st1 = (st0 + 9 < tt) ? st0 + 9 : tt;
                bf16x8 ak[4], an[4];
                { const size_t srow = (size_t)b * SEQ + st0 * 32 + r32;
#pragma unroll
                  for (int d0 = 0; d0 < 4; ++d0) an[d0] = *(const bf16x8*)(DIK + srow * 64 + d0 * 16 + 8 * hh); }
                for (int st = st0; st <= st1; ++st) {
#pragma unroll
                    for (int d0 = 0; d0 < 4; ++d0) ak[d0] = an[d0];
                    { const int sn = (st < st1) ? st + 1 : st; const size_t srow = (size_t)b * SEQ + sn * 32 + r32;
#pragma unroll
                      for (int d0 = 0; d0 < 4; ++d0) an[d0] = *(const bf16x8*)(DIK + srow * 64 + d0 * 16 + 8 * hh); }
                    f32x16 sc;
#pragma unroll
                    for (int r = 0; r < 16; ++r) sc[r] = 0.f;
#pragma unroll
                    for (int h = 0; h < 4; ++h) { f32x16 a;
#pragma unroll
                        for (int r = 0; r < 16; ++r) a[r] = 0.f;
#pragma unroll
                        for (int d0 = 0; d0 < 4; ++d0) a = __builtin_amdgcn_mfma_f32_32x32x16_bf16(ak[d0], bq[h][d0], a, 0, 0, 0);
#pragma unroll
                        for (int r = 0; r < 16; ++r) sc[r] += fmaxf(a[r], 0.f) * wv[h]; }
                    float* sp = SC + trow * SEQ + st * 32 + 4 * hh;
#pragma unroll
                    for (int g = 0; g < 4; ++g) *(f32x4*)(sp + 8 * g) = (f32x4){sc[4 * g], sc[4 * g + 1], sc[4 * g + 2], sc[4 * g + 3]};
                }
                }
            }
        }
        STEP_END;
        if (SITE_ON(3)) STEP_IF { SITE_PROLOG
            { pg8::PlainOrder S; S.init(NTOK / 256, 4, G, bid); S.A = (const char*)DLAT; S.ta = (size_t)256 * KVR * 2; S.B = (const char*)(WUKV + (size_t)l * 1024 * KVR); S.tb = (size_t)256 * KVR * 2;
              EpiPlain E{DKV, 1024};
              pg8::gemm_phase<EpiPlain, pg8::PlainOrder, true, true>(lds, pg8::Gemm{opq(KVR), 0}, S, E); }
        }
        STEP_END;
        if (SITE_ON(4)) STEP_IF { SITE_PROLOG
            Bg B; B.ws = ws; B.scr = (LAS float*)(lds + 16384 + wave * 8704); B.l = l; B.gw = gw; B.next = 0; B.end = 55; B.inflight = -1; B.g0 = (f32x4){1.f, 1.f, 1.f, 1.f}; B.g1 = B.g0;
#pragma unroll
            for (int i = 0; i < 32; ++i) B.tv[i] = 0.f;
            for (int k = 0; k < 8; ++k) { const int idx = gw + k * NGW; const int b = idx / SEQ, t0 = idx - b * SEQ, t = (b & 1) ? SEQ - 1 - t0 : t0; const size_t row = (size_t)b * SEQ + t;
                select_row(SC + row * SEQ, MASK + row * 64, t, lane, (LAS unsigned*)(lds + wave * 1024), B);
                const int upto = ((k + 1) * 55) >> 3;
                while (B.next < upto) bg_tick(B, lane); }
            while (B.inflight >= 0 || B.next < B.end) bg_tick(B, lane);
        }
        STEP_END;
        if (SITE_ON(5)) STEP_IF { SITE_PROLOG
            const int xq = bid & 7; unsigned* qctr = ctl + CW_ATTQ + (l * 8 + xq) * 32;
            unsigned ticket = 0u; if (tid == 0) ticket = __hip_atomic_fetch_add(qctr, 1u, __ATOMIC_RELAXED, __HIP_MEMORY_SCOPE_AGENT);
            if (tid == 0) MISC[65] = ticket;
            __syncthreads();
            unsigned u = MISC[65];
#define ATT_DECODE(uu, var, qb, hh) int var, qb, hh; if ((uu) < 64u) { var = 1; qb = 7 - (int)((uu) >> 3); hh = (int)((uu) & 7u); } else { const unsigned v_ = (uu) - 64u; qb = 7 - (int)(v_ >> 4); var = (v_ & 1u) ? 2 : 0; hh = (int)((v_ >> 1) & 7u); }
#define ATT_BEGIN(var, b, hh, qb) do { if (var == 0) att::attn_begin(lds, 0, b, hh, qb, Z8 + (size_t)1 * NTOK * 512, 512, Z8 + (size_t)2 * NTOK * 512, 512, C2F, nullptr); \
                else if (var == 1) att::attn_begin(lds, 1, b, hh, qb, Z8 + (size_t)5 * NTOK * 512, 512, Z8 + (size_t)6 * NTOK * 512, 512, nullptr, nullptr); \
                else att::attn_begin(lds, 2, b, hh, qb, DKV, 1024, DKV + 512, 1024, nullptr, MASK); } while (0)
            const int b = xq;
            if (u < 192u) { ATT_DECODE(u, var0, qb0, h0) ATT_BEGIN(var0, b, h0, qb0); }
            while (u < 192u) {
                ATT_DECODE(u, var, qb, h)
                if (tid == 0) ticket = __hip_atomic_fetch_add(qctr, 1u, __ATOMIC_RELAXED, __HIP_MEMORY_SCOPE_AGENT);
                unsigned unext = 192u;
                auto next = [&]() { unext = MISC[65]; if (unext < 192u) { ATT_DECODE(unext, varn, qbn, hn) ATT_BEGIN(varn, b, hn, qbn); } };
#ifdef ATT_PROBE_VAR
                const unsigned long long pa_t0 = wall_clock64();
#endif
                if (var == 0) att::attn_unit<0>(lds, ticket, next, b, h, qb, Z8, Z8 + (size_t)1 * NTOK * 512, 512, Z8 + (size_t)2 * NTOK * 512, 512, C2F, nullptr, nullptr, Z8 + (size_t)3 * NTOK * 512, YATT);
                else if (var == 1) att::attn_unit<1>(lds, ticket, next, b, h, qb, Z8 + (size_t)4 * NTOK * 512, Z8 + (size_t)5 * NTOK * 512, 512, Z8 + (size_t)6 * NTOK * 512, 512, nullptr, nullptr, nullptr, nullptr, YATT + (size_t)NTOK * 512);
                else att::attn_unit<2>(lds, ticket, next, b, h, qb, Z8 + (size_t)7 * NTOK * 512, DKV, 1024, DKV + 512, 1024, nullptr, MASK, rel_bias, nullptr, YATT + (size_t)2 * NTOK * 512);
#ifdef ATT_PROBE_VAR
                if (var == ATT_PROBE_VAR) pr_acc += wall_clock64() - pa_t0;
#endif
                u = unext;
            }
#undef ATT_DECODE
#undef ATT_BEGIN
        }
        STEP_END;
        if (SITE_ON(6)) STEP_IF { SITE_PROLOG
            pg8::BranchOrder S; S.init(NTOK / 256, DM / 256, G, bid); S.A = (const char*)YATT; S.ta = (size_t)256 * WBR_W * 2; S.za = (size_t)NTOK * WBR_W * 2;
            S.B = (const char*)(WBR + (size_t)l * 3 * DM * WBR_W); S.tb = (size_t)256 * WBR_W * 2; S.zb = (size_t)DM * WBR_W * 2;
            EpiBranch E{GATES, MB};
            pg8::gemm_phase_carry<EpiBranch, pg8::BranchOrder, true, true>(lds, pg8::Gemm{opq(WBR_W), 0}, S, E);
        }
        STEP_END;
        if (SITE_ON(7)) STEP_IF { SITE_PROLOG
            pg8::PlainOrder S; S.init(NTOK / 256, DM / 256, G, bid); S.A = (const char*)MB; S.ta = (size_t)256 * DM * 2; S.B = (const char*)(WOUT + (size_t)l * DM * DM); S.tb = (size_t)256 * DM * 2;
            EpiResid E{l == 0 ? x_in : (const float*)X, X, l == 0 ? XB : nullptr, SSP, l == 0 ? nullptr : XB8, 1.0f};
            pg8::gemm_phase<EpiResid, pg8::PlainOrder, true, true>(lds, pg8::Gemm{opq(DM), 0}, S, E);
        }
        STEP_END;
        if (l == 0) {
            if (SITE_ON(8)) STEP_IF { SITE_PROLOG for (int r = bid * 512 + tid; r < NTOK; r += G * 512) { const f32x4* p = (const f32x4*)(SSP + (size_t)r * 32); float s = 0.f;
#pragma unroll
                    for (int j = 0; j < 8; ++j) { const f32x4 v = p[j]; s += (v[0] + v[1]) + (v[2] + v[3]); }
                    RSTD[r] = 1.0f / sqrtf(s * (1.0f / DM) + EPS); } }
            STEP_END;
            if (SITE_ON(9)) STEP_IF { SITE_PROLOG
                pg8::PlainOrder S; S.init(NTOK / 256, DFF / 128, G, bid); S.A = (const char*)XB; S.ta = (size_t)256 * DM * 2; S.B = (const char*)WGU0; S.tb = (size_t)256 * DM * 2;
                EpiSwiglu E{RSTD, HID, 1.0f, 1};
                pg8::gemm_phase<EpiSwiglu, pg8::PlainOrder, true, true>(lds, pg8::Gemm{opq(DM), 0}, S, E);
            }
            STEP_END;
            if (SITE_ON(10)) STEP_IF { SITE_PROLOG
                pg8::PlainOrder S; S.init(NTOK / 256, DM / 256, G, bid); S.A = (const char*)HID; S.ta = (size_t)256 * DFF; S.B = (const char*)WD0; S.tb = (size_t)256 * DFF;
                EpiResid E{X, X, XB, SSP, XB8, 1.0f / (WD8SCALE * H8SCALE)};
                pg8::gemm_phase8<EpiResid, pg8::PlainOrder, true, true>(lds, pg8::Gemm{opq(DFF / 2), 0}, S, E);
            }
            STEP_END;
            if (SITE_ON(11)) STEP_IF { SITE_PROLOG for (int r = bid * 512 + tid; r < NTOK; r += G * 512) { const f32x4* p = (const f32x4*)(SSP + (size_t)r * 32); float s = 0.f;
#pragma unroll
                    for (int j = 0; j < 8; ++j) { const f32x4 v = p[j]; s += (v[0] + v[1]) + (v[2] + v[3]); }
                    RSTD[r] = 1.0f / sqrtf(s * (1.0f / DM) + EPS); } }
            STEP_END;
        } else {
            if (SITE_ON(12)) STEP_IF { SITE_PROLOG
                LAS int* le = (LAS int*)lds;
                for (int wgi = bid; wgi < NTOK / 64; wgi += G) {
                    __syncthreads();
                    {
                        const int tok = wgi * 64 + lane; const float* xr = X + (size_t)tok * DM + 256 * wave;
                        const float* gp = norm_ffn + DM + 256 * wave; const float* wp = w_router + (size_t)(256 * wave) * 8;
                        float lg[8]; float ss = 0.f;
#pragma unroll
                        for (int e = 0; e < 8; ++e) lg[e] = 0.f;
#pragma unroll 1
                        for (int k8 = 0; k8 < 8; ++k8) { f32x4 xv[8];
#pragma unroll
                            for (int j = 0; j < 8; ++j) xv[j] = *(const f32x4*)(xr + 32 * k8 + 4 * j);
#pragma unroll
                            for (int j = 0; j < 8; ++j)
#pragma unroll
                                for (int c = 0; c < 4; ++c) { const int k = 32 * k8 + 4 * j + c; const float xv1 = xv[j][c]; ss += xv1 * xv1; const float xg = xv1 * gp[k]; const float* wr = wp + k * 8;
#pragma unroll
                                    for (int e = 0; e < 8; ++e) lg[e] += xg * wr[e]; } }
                        LAS float* part = (LAS float*)(lds + 1024) + (wave * 64 + lane) * 9;
#pragma unroll
                        for (int e = 0; e < 8; ++e) part[e] = lg[e];
                        part[8] = ss;
                        __syncthreads();
                        if (wave == 0) { float L[8]; float S = 0.f;
#pragma unroll
                            for (int e = 0; e < 8; ++e) L[e] = 0.f;
                            for (int w = 0; w < 8; ++w) { const LAS float* pp = (const LAS float*)(lds + 1024) + (w * 64 + lane) * 9;
#pragma unroll
                                for (int e = 0; e < 8; ++e) L[e] += pp[e];
                                S += pp[8]; }
                            const float rs = 1.0f / sqrtf(S * (1.0f / DM) + EPS);
#pragma unroll
                            for (int e = 0; e < 8; ++e) L[e] *= rs;
                            float v0 = L[0]; int i0 = 0;
#pragma unroll
                            for (int e = 1; e < 8; ++e) if (L[e] > v0) { v0 = L[e]; i0 = e; }
                            float v1 = -INFINITY; int i1 = 0;
#pragma unroll
                            for (int e = 0; e < 8; ++e) if (e != i0 && L[e] > v1) { v1 = L[e]; i1 = e; }
                            const float ex = __expf(v1 - v0), w0 = 1.0f / (1.0f + ex), w1 = ex / (1.0f + ex);
                            le[lane * 2] = i0; le[lane * 2 + 1] = i1; TOKW[(size_t)tok * 2] = w0; TOKW[(size_t)tok * 2 + 1] = w1; RSTD[tok] = rs; }
                    }
                    __syncthreads();
                    if (tid < 128) { const int e = le[tid]; int rk = 0; for (int j = 0; j < tid; ++j) rk += (le[j] == e); const int tok = wgi * 64 + (tid >> 1);
                        TOKINFO[((size_t)tok * 2 + (tid & 1)) * 2] = e; TOKINFO[((size_t)tok * 2 + (tid & 1)) * 2 + 1] = rk; }
                    if (tid >= 128 && tid < 136) { const int e = tid - 128; int c = 0; for (int j = 0; j < 128; ++j) c += (le[j] == e); WGCNT[wgi * 8 + e] = c; }
                }
            }
            STEP_END;
            if (SITE_ON(13)) STEP_IF { SITE_PROLOG
                LAS int* lc = (LAS int*)lds;
                for (int wgi = bid; wgi < NTOK / 64; wgi += G) {
                    __syncthreads();
                    { const int e = wave; int all = 0, before = 0;
#pragma unroll
                      for (int c = 0; c < 4; ++c) { const int w = 4 * lane + c; const int v = WGCNT[w * 8 + e]; all += v; before += (w < wgi) ? v : 0; }
#pragma unroll
                      for (int o = 1; o < 64; o <<= 1) { all += __shfl_xor(all, o); before += __shfl_xor(before, o); }
                      if (lane == 0) { lc[e] = all; lc[8 + e] = before; } }
                    __syncthreads();
                    if (tid == 0) { int tb = 0; for (int e = 0; e < 8; ++e) { lc[16 + e] = tb * 256; tb += (lc[e] + 255) >> 8; if (wgi == 0) META[e] = lc[16 + e] >> 8; } if (wgi == 0) META[8] = tb; }
                    __syncthreads();
                    for (int hb = 0; hb < 2; ++hb) {
                        int rr[8]; u32x4 d0[8], d1[8];
#pragma unroll
                        for (int i = 0; i < 8; ++i) { const int p = wave * 16 + hb * 8 + i, tok = wgi * 64 + (p >> 1), slot = p & 1;
                            const int e = TOKINFO[((size_t)tok * 2 + slot) * 2], rk = TOKINFO[((size_t)tok * 2 + slot) * 2 + 1]; rr[i] = lc[16 + e] + lc[8 + e] + rk;
                            const u32x4* sp = (const u32x4*)(XB8 + (size_t)tok * DM) + lane; d0[i] = sp[0]; d1[i] = sp[64]; }
#pragma unroll
                        for (int i = 0; i < 8; ++i) { const int p = wave * 16 + hb * 8 + i, tok = wgi * 64 + (p >> 1), slot = p & 1; const int r = rr[i];
                            u32x4* dp = (u32x4*)((unsigned char*)XG + (size_t)r * DM) + lane; dp[0] = d0[i]; dp[64] = d1[i];
                            if (lane == 0) { POSR[tok * 2 + slot] = r; ROWTOK[r] = tok * 2 + slot; ROWW[r] = TOKW[(size_t)tok * 2 + slot]; RSTDG[r] = RSTD[tok]; } }
                    }
                    if (wgi < 8) { const int e = wgi, r0 = lc[16 + e] + lc[e], r1 = lc[16 + e] + (((lc[e] + 255) >> 8) << 8);
                        for (int r = r0 + wave; r < r1; r += 8) { u32x4* dp = (u32x4*)((unsigned char*)XG + (size_t)r * DM) + lane;
#pragma unroll
                            for (int c = 0; c < 2; ++c) dp[64 * c] = (u32x4){0u, 0u, 0u, 0u};
                            if (lane == 0) { ROWTOK[r] = -1; ROWW[r] = 0.f; RSTDG[r] = 0.f; } } }
                }
            }
            STEP_END;
            if (SITE_ON(14)) STEP_IF { SITE_PROLOG
                pg8::MoeOrder S; S.t1 = META[1]; S.t2 = META[2]; S.t3 = META[3]; S.t4 = META[4]; S.t5 = META[5]; S.t6 = META[6]; S.t7 = META[7];
                S.init(META[8], DFF / 128, G, bid); S.A = (const char*)XG; S.ta = (size_t)256 * DM; S.B = (const char*)WGUM; S.tb = (size_t)256 * DM; S.zb = SZ_WGU / 2;
                EpiSwiglu E{RSTDG, HIDM, 1.0f / W8SCALE, 1};
                pg8::gemm_phase8<EpiSwiglu, pg8::MoeOrder, true, true>(lds, pg8::Gemm{opq(DM / 2), 0}, S, E);
            }
            STEP_END;
            if (SITE_ON(15)) STEP_IF { SITE_PROLOG
                pg8::MoeOrder S; S.t1 = META[1]; S.t2 = META[2]; S.t3 = META[3]; S.t4 = META[4]; S.t5 = META[5]; S.t6 = META[6]; S.t7 = META[7];
                const int T = META[8], Tfull = T < 128 ? T : 128;
                S.init(Tfull, DM / 256, G, bid); S.A = (const char*)HIDM; S.ta = (size_t)256 * DFF; S.B = (const char*)WDM; S.tb = (size_t)256 * DFF; S.zb = SZ_WD / 2;
                EpiMoeDown E{ROWTOK, ROWW, Y, 1.0f / (WD8SCALE * H8SCALE)};
                pg8::gemm_phase8<EpiMoeDown, pg8::MoeOrder, true, true>(lds, pg8::Gemm{opq(DFF / 2), 0}, S, E);
                if (T > 128) {
                    pg8::TailOrder S2; S2.ntail = (T - 128) * 32; S2.G = G; S2.c = bid; S2.A = S.A; S2.B = S.B; S2.ta = S.ta; S2.tb = S.tb; S2.zb = S.zb; S2.kq = DFF / 4;
                    S2.t1 = S.t1; S2.t2 = S.t2; S2.t3 = S.t3; S2.t4 = S.t4; S2.t5 = S.t5; S2.t6 = S.t6; S2.t7 = S.t7;
                    EpiMoeTail E2{ROWTOK, ROWW, YP, 1.0f / (WD8SCALE * H8SCALE)};
                    pg8::gemm_phase8<EpiMoeTail, pg8::TailOrder, true, true>(lds, pg8::Gemm{opq(DFF / 8), DFF / 2}, S2, E2); }
            }
            STEP_END;
            if (SITE_ON(16)) STEP_IF { SITE_PROLOG
                f32x4 gfin[8];
#pragma unroll
                for (int j = 0; j < 8; ++j) gfin[j] = *((const f32x4*)norm_final + lane + 64 * j);
                int r0n = POSR[2 * gw], r1n = POSR[2 * gw + 1];
                for (int m = gw; m < NTOK; m += NGW) {
                    f32x4* xr = (f32x4*)(X + (size_t)m * DM) + lane; const u32x2* y0 = (const u32x2*)(Y + (size_t)m * DM) + lane; const u32x2* y1 = (const u32x2*)(Y + (size_t)NTOK * DM + (size_t)m * DM) + lane;
                    f32x4 v[8]; float s = 0.f; const int r0 = r0n, r1 = r1n;
                    { const int mn = (m + NGW < NTOK) ? m + NGW : m; r0n = POSR[2 * mn]; r1n = POSR[2 * mn + 1]; }
                    if (r0 >= 32768 || r1 >= 32768) {
#pragma unroll
                        for (int j = 0; j < 8; ++j) { f32x4 acc4 = xr[64 * j];
#pragma unroll
                            for (int sl = 0; sl < 2; ++sl) { const int r = sl ? r1 : r0;
                                if (r < 32768) { const u32x2 a = (sl ? y1 : y0)[64 * j]; acc4 += (f32x4){bflo(a.x), bfhi(a.x), bflo(a.y), bfhi(a.y)}; }
                                else { for (int q = 0; q < 4; ++q) { const u32x2 a = ((const u32x2*)(YP + ((size_t)q * 2048 + (size_t)(r - 32768)) * DM) + lane)[64 * j]; acc4 += (f32x4){bflo(a.x), bfhi(a.x), bflo(a.y), bfhi(a.y)}; } } }
                            v[j] = acc4; s += (v[j][0] * v[j][0] + v[j][1] * v[j][1]) + (v[j][2] * v[j][2] + v[j][3] * v[j][3]); }
                    } else
#pragma unroll
                    for (int j = 0; j < 8; ++j) { const u32x2 a = y0[64 * j], b = y1[64 * j]; v[j] = xr[64 * j] + (f32x4){bflo(a.x), bfhi(a.x), bflo(a.y), bfhi(a.y)} + (f32x4){bflo(b.x), bfhi(b.x), bflo(b.y), bfhi(b.y)}; s += (v[j][0] * v[j][0] + v[j][1] * v[j][1]) + (v[j][2] * v[j][2] + v[j][3] * v[j][3]); }
                    s = wave_sum(s); const float rs = 1.0f / sqrtf(s * (1.0f / DM) + EPS);
#pragma unroll
                    for (int j = 0; j < 8; ++j) xr[64 * j] = v[j] * rs * gfin[j];
                }
            }
            STEP_END;
        }
    }
#ifdef PROBE_MASK
    if (bid == 0 && threadIdx.x == 0) { const unsigned long long pr_t0 = wall_clock64(); while (wall_clock64() - pr_t0 < pr_acc * PROBE_AMP) __builtin_amdgcn_s_sleep(8); }
#endif
#undef STEP_IF
#undef STEP_END
}


#if DBG_STOP >= 0
__global__ void dbg_dump(const unsigned short* ws16, size_t n16, const unsigned* xin, float* out, int with_x) {
    for (size_t i = (size_t)blockIdx.x * blockDim.x + threadIdx.x; i < (size_t)NTOK * DM; i += (size_t)gridDim.x * blockDim.x) {
        unsigned acc = 0; for (size_t off = i; off < n16; off += (size_t)NTOK * DM) acc += ws16[off];
        if (with_x) { const unsigned u = xin[i]; acc += (u & 0xffffu) + (u >> 16); }
        out[i] = (float)(acc & 0xfffffu);
    }
}
#endif

#if DBG_STOP == 100
__global__ void dbg_cmp3(const unsigned short* a0, const unsigned short* b0, const unsigned short* a1, const unsigned short* b1, const unsigned short* a2, const unsigned short* b2, unsigned* cnt) {
    unsigned c0 = 0, c1 = 0, c2 = 0;
    for (size_t i = (size_t)blockIdx.x * blockDim.x + threadIdx.x; i < (size_t)NTOK * DM; i += (size_t)gridDim.x * blockDim.x) { c0 += a0[i] != b0[i]; c1 += a1[i] != b1[i]; c2 += a2[i] != b2[i]; }
    if (c0) atomicAdd(cnt, c0); if (c1) atomicAdd(cnt + 1, c1); if (c2) atomicAdd(cnt + 2, c2);
}
__global__ void dbg_fill(float* out, const unsigned* cnt) {
    const float E = (cnt[0] ? 3.f : 0.f) + (cnt[1] ? 10.f : 0.f) + (cnt[2] ? 30.f : 0.f);
    for (size_t i = (size_t)blockIdx.x * blockDim.x + threadIdx.x; i < (size_t)NTOK * DM; i += (size_t)gridDim.x * blockDim.x) out[i] = E;
}
#endif

#if DBG_STOP == 200
__global__ void dbg_cksum(const unsigned long long* p, size_t nblk, unsigned long long* ck) {
    for (size_t b = (size_t)blockIdx.x * blockDim.x + threadIdx.x; b < nblk; b += (size_t)gridDim.x * blockDim.x) {
        unsigned long long h = 0x9E3779B97F4A7C15ull; const unsigned long long* q = p + b * 128;
        for (int i = 0; i < 128; ++i) { h ^= q[i]; h *= 0xBF58476D1CE4E5B9ull; h ^= h >> 29; }
        ck[b] = h; }
}
__global__ void dbg_ckcmp(const unsigned long long* a, const unsigned long long* b, size_t nblk, unsigned long long* first) {
    for (size_t i = (size_t)blockIdx.x * blockDim.x + threadIdx.x; i < nblk; i += (size_t)gridDim.x * blockDim.x) if (a[i] != b[i]) atomicMin(first, (unsigned long long)i);
}
__global__ void dbg_fill2(float* out, const unsigned long long* first) {
    const unsigned long long off = WS_RSTD + (*first) * 1024ull; int id = 0;
    if (*first != ~0ull) { id = 1; if (off >= WS_Z8) id = 2; if (off >= WS_DLAT) id = 3; if (off >= WS_DIQ) id = 4; if (off >= WS_DIK) id = 5; if (off >= WS_FFW) id = 6; if (off >= WS_GATES) id = 7; if (off >= WS_C2F) id = 8;
        if (off >= WS_DKV) id = 9; if (off >= WS_SC) id = 10; if (off >= WS_MASK) id = 11; if (off >= WS_YATT) id = 12; if (off >= WS_M) id = 13; }
    const float E = 3.f * id;
    for (size_t i = (size_t)blockIdx.x * blockDim.x + threadIdx.x; i < (size_t)NTOK * DM; i += (size_t)gridDim.x * blockDim.x) out[i] = E;
}
#endif
extern "C" void kernel_launch(void* const* d_in, const int* in_sizes, int n_in, void* d_out, int out_size, void* d_ws, size_t ws_size, hipStream_t stream) {
    static int grid = 0;
    if (grid == 0) {
        if (n_in != 22 || out_size != NTOK * DM || ws_size < WS_END) { fprintf(stderr, "kernel_launch: unexpected problem (n_in %d, out %d, ws %zu, need %zu)\n", n_in, out_size, ws_size, (size_t)WS_END); grid = -1; return; }
        int dev = 0, cus = 0;
        if (hipGetDevice(&dev) != hipSuccess || hipDeviceGetAttribute(&cus, hipDeviceAttributeMultiprocessorCount, dev) != hipSuccess) { grid = -1; return; }
        if (hipFuncSetAttribute((const void*)mk_fwd, hipFuncAttributeMaxDynamicSharedMemorySize, LDS_BYTES) != hipSuccess) { fprintf(stderr, "kernel_launch: hipFuncSetAttribute failed\n"); grid = -1; return; }
        int per_cu = 0;
        if (hipOccupancyMaxActiveBlocksPerMultiprocessor(&per_cu, (const void*)mk_fwd, 512, LDS_BYTES) != hipSuccess || per_cu < 1) fprintf(stderr, "kernel_launch: occupancy query says %d\n", per_cu);
        (void)hipGetLastError();
        if (cus != 256) { fprintf(stderr, "kernel_launch: built for a 256-CU device, found %d CUs\n", cus); grid = -1; return; }
        grid = cus;
    }
    if (grid < 0) return;
    (void)hipMemsetAsync((char*)d_ws + WS_CTL, 0, CTL_ZERO_BYTES, stream);
    Args a{};
    for (int i = 0; i < 22; ++i) a.in[i] = (const float*)d_in[i];
    a.out = (float*)d_out; a.ws = (unsigned char*)d_ws;
#if DBG_STOP == 200
    for (int s = 0; s <= DBG_HI; ++s) { a.ph_lo = s; a.ph_hi = s + 1; hipLaunchKernelGGL(mk_fwd, dim3(grid), dim3(512), LDS_BYTES, stream, a); }
    { char* w = (char*)d_ws; const size_t nblk = (WS_R_END1 - WS_RSTD) / 1024; unsigned long long* ck0 = (unsigned long long*)(w + WS_R_END1); unsigned long long* ck1 = ck0 + nblk; unsigned long long* first = (unsigned long long*)(w + 4096);
#ifdef DBG_WARMFIRST
      for (int s = DBG_LOSTEP; s <= DBG_HI; ++s) { a.ph_lo = s; a.ph_hi = s + 1; hipLaunchKernelGGL(mk_fwd, dim3(grid), dim3(512), LDS_BYTES, stream, a); }
#endif
      hipLaunchKernelGGL(dbg_cksum, dim3(2048), dim3(256), 0, stream, (const unsigned long long*)(w + WS_RSTD), nblk, ck0);
      for (int s = DBG_LOSTEP; s <= DBG_HI; ++s) { a.ph_lo = s; a.ph_hi = s + 1; hipLaunchKernelGGL(mk_fwd, dim3(grid), dim3(512), LDS_BYTES, stream, a); }
      hipLaunchKernelGGL(dbg_cksum, dim3(2048), dim3(256), 0, stream, (const unsigned long long*)(w + WS_RSTD), nblk, ck1);
      (void)hipMemsetAsync(first, 0xFF, 8, stream);
      hipLaunchKernelGGL(dbg_ckcmp, dim3(1024), dim3(256), 0, stream, (const unsigned long long*)ck0, (const unsigned long long*)ck1, nblk, first);
      hipLaunchKernelGGL(dbg_fill2, dim3(2048), dim3(256), 0, stream, (float*)d_out, (const unsigned long long*)first); }
#elif DBG_STOP == 100
    for (int s = 0; s <= 6; ++s) { a.ph_lo = s; a.ph_hi = s + 1; hipLaunchKernelGGL(mk_fwd, dim3(grid), dim3(512), LDS_BYTES, stream, a); }
    { char* w = (char*)d_ws; const size_t SZ = (size_t)NTOK * DM * 2; char* cp = w + WS_R_END1;
      hipMemcpyAsync(cp, w + WS_M, SZ, hipMemcpyDeviceToDevice, stream); hipMemcpyAsync(cp + SZ, w + WS_SC, 2 * SZ, hipMemcpyDeviceToDevice, stream);
      a.ph_lo = 6; a.ph_hi = 7; hipLaunchKernelGGL(mk_fwd, dim3(grid), dim3(512), LDS_BYTES, stream, a);
      unsigned* cnt = (unsigned*)(w + 4096); hipMemsetAsync(cnt, 0, 64, stream);
      hipLaunchKernelGGL(dbg_cmp3, dim3(2048), dim3(256), 0, stream, (const unsigned short*)(w + WS_M), (const unsigned short*)cp, (const unsigned short*)(w + WS_SC), (const unsigned short*)(cp + SZ), (const unsigned short*)(w + WS_SC + SZ), (const unsigned short*)(cp + 2 * SZ), cnt);
      hipLaunchKernelGGL(dbg_fill, dim3(2048), dim3(256), 0, stream, (float*)d_out, (const unsigned*)cnt); }
#elif DBG_STOP >= 0
    for (int s = 0; s <= DBG_STOP; ++s) { a.ph_lo = s; a.ph_hi = s + 1; hipLaunchKernelGGL(mk_fwd, dim3(grid), dim3(512), LDS_BYTES, stream, a); }
#ifdef DBG_TWICE
    { a.ph_lo = DBG_STOP; a.ph_hi = DBG_STOP + 1; hipLaunchKernelGGL(mk_fwd, dim3(grid), dim3(512), LDS_BYTES, stream, a); }
#endif
    hipLaunchKernelGGL(dbg_dump, dim3(2048), dim3(256), 0, stream, (const unsigned short*)((const char*)d_ws + DBG_LO), (size_t)((WS_END - DBG_LO) / 2), (const unsigned*)d_out, (float*)d_out, DBG_STOP >= 7 ? 1 : 0);
#elif MK_ONE_LAUNCH
    a.ph_lo = 0; a.ph_hi = NSTEPS;
    hipLaunchKernelGGL(mk_fwd, dim3(grid), dim3(512), LDS_BYTES, stream, a);
#else
    for (int s = 0; s < NSTEPS; ++s) { a.ph_lo = s; a.ph_hi = s + 1; hipLaunchKernelGGL(mk_fwd, dim3(grid), dim3(512), LDS_BYTES, stream, a);
#ifdef DUP_MASK
        if ((DUP_MASK >> s) & 1u) { hipLaunchKernelGGL(mk_fwd, dim3(grid), dim3(512), LDS_BYTES, stream, a); }
#endif
    }
#endif
}
```
